# Optimizing an MI355X kernel written in HIP

```python
import math
import jax, jax.numpy as jnp
from jax import lax
import numpy as np

D_MODEL = 1024
BATCH = 8
SEQ = 4096
DEPTH = 4

HGRN_HEADS = 8
HGRN_DK = 128
HGRN_DV = D_MODEL // HGRN_HEADS
D_HGRN_K = HGRN_HEADS * HGRN_DK
D_HGRN_V = HGRN_HEADS * HGRN_DV
MLSTM_HEADS = 4
D_MLSTM = D_MODEL
MLSTM_DH = D_MLSTM // MLSTM_HEADS
MLSTM_CONV = 4
QKV_BLOCK = 4
N_QKV_BLOCKS = D_MLSTM // QKV_BLOCK
CHUNK = 64
IN_SIZES = (D_HGRN_K, D_HGRN_K, D_HGRN_V, D_HGRN_V, D_MLSTM, D_MLSTM, D_MODEL, D_MODEL)
D_IN = sum(IN_SIZES)
IN_SPLITS = tuple(int(s) for s in np.cumsum(IN_SIZES)[:-1])
D_FF = 2816
N_EXPERTS = 8
TOP_K = 2
D_FF_EXPERT = 3584
N_DENSE = (DEPTH + 1) // 2
N_MOE = DEPTH // 2
EPS = 1e-6
NEG = -1e30

kernel_name = 'hybrid_hgrn2_mlstm_moe_adaln'


def rmsnorm(x, g):
    xf = x.astype(jnp.float32)
    y = xf * lax.rsqrt(jnp.mean(xf * xf, axis=-1, keepdims=True) + EPS)
    return (y * g).astype(x.dtype)


def head_rmsnorm(o):
    return o * lax.rsqrt(jnp.mean(o * o, axis=-1, keepdims=True) + EPS)


def head_layernorm(o):
    mu = jnp.mean(o, axis=-1, keepdims=True)
    oc = o - mu
    return oc * lax.rsqrt(jnp.mean(oc * oc, axis=-1, keepdims=True) + EPS)


def to_chunks(t, heads):
    b, s, w = t.shape
    return t.reshape(b, s // CHUNK, CHUNK, heads, w // heads).transpose(1, 0, 3, 2, 4)


def gate_chunks(t):
    b, s, h = t.shape
    return t.reshape(b, s // CHUNK, CHUNK, h).transpose(1, 0, 3, 2)


def from_chunks(o):
    nc, b, h, l, d = o.shape
    return o.transpose(1, 0, 3, 2, 4).reshape(b, nc * l, h, d)


def hgrn_lower_bounds(lb_raw):
    p = jax.nn.softmax(lb_raw.astype(jnp.float32), axis=0)
    return jnp.cumsum(p, axis=0) - p[0:1]


def hgrn2_chunked(q, k, v, log_f):
    L = q.shape[-2]
    causal = jnp.tril(jnp.ones((L, L), dtype=bool))

    def step(state, inp):
        qc, kc, vc, lfc = inp
        b = jnp.cumsum(lfc, axis=-2)
        diff = b[..., :, None, :] - b[..., None, :, :]
        decay = jnp.exp(jnp.where(causal[:, :, None], diff, NEG))
        scores = jnp.einsum('bhtd,bhtsd,bhsd->bhts', qc, decay, kc)
        o = (jnp.einsum('bhts,bhsv->bhtv', scores, vc)
             + jnp.einsum('bhtd,bhdv->bhtv', qc * jnp.exp(b), state))
        b_last = b[..., -1:, :]
        state = (jnp.exp(b_last[..., 0, :])[..., None] * state
                 + jnp.einsum('bhsd,bhsv->bhdv', kc * jnp.exp(b_last - b), vc))
        return state, o

    nc, bsz, heads, l, dk = q.shape
    init = jnp.zeros((bsz, heads, dk, v.shape[-1]), jnp.float32)
    _, o = lax.scan(step, init, (q, k, v, log_f))
    return o


def hgrn2_branch(q, f_pre, i, g, lb, gnorm):
    f32 = jnp.float32
    bsz, s, _ = q.shape
    q = jax.nn.silu(q.astype(f32))
    fp = f_pre.astype(f32)
    lb = lb.astype(f32)
    f = lb + (1.0 - lb) * jax.nn.sigmoid(fp)
    log_f = jnp.log(f)
    k = (1.0 - lb) * jax.nn.sigmoid(-fp)
    o = hgrn2_chunked(to_chunks(q, HGRN_HEADS), to_chunks(k, HGRN_HEADS),
                      to_chunks(i.astype(f32), HGRN_HEADS), to_chunks(log_f, HGRN_HEADS))
    o = head_rmsnorm(from_chunks(o)).reshape(bsz, s, D_HGRN_V)
    return o * gnorm * jax.nn.silu(g.astype(f32))


def causal_conv(x, w, b):
    kw = w.shape[0]
    y = lax.conv_general_dilated(x, w[:, None, :], window_strides=(1,), padding=[(kw - 1, 0)],
                                 dimension_numbers=('NWC', 'WIO', 'NWC'),
                                 feature_group_count=x.shape[-1])
    return y + b


def blockdiag(x, w):
    bsz, s, _ = x.shape
    xb = x.reshape(bsz, s, N_QKV_BLOCKS, QKV_BLOCK)
    return jnp.einsum('bsni,nio->bsno', xb, w).reshape(bsz, s, D_MLSTM)


def mlstm_chunked(q, k, v, log_i, log_f):
    L = q.shape[-2]
    causal = jnp.tril(jnp.ones((L, L), dtype=bool))

    def step(carry, inp):
        C, n, m = carry
        qc, kc, vc, lic, lfc = inp
        b = jnp.cumsum(lfc, axis=-1)
        d = jnp.where(causal, b[..., :, None] - b[..., None, :] + lic[..., None, :], NEG)
        m_inter = b + m[..., None]
        m_t = jnp.maximum(m_inter, jnp.max(d, axis=-1))
        s = jnp.einsum('bhtd,bhsd->bhts', qc, kc) * jnp.exp(d - m_t[..., None])
        w_inter = jnp.exp(m_inter - m_t)
        num = (jnp.einsum('bhts,bhsv->bhtv', s, vc)
               + w_inter[..., None] * jnp.einsum('bhtd,bhdv->bhtv', qc, C))
        den = jnp.sum(s, axis=-1) + w_inter * jnp.einsum('bhtd,bhd->bht', qc, n)
        h = num / jnp.maximum(jnp.abs(den), jnp.exp(-m_t))[..., None]
        b_last = b[..., -1]
        g = b_last[..., None] - b + lic
        m_new = jnp.maximum(b_last + m, jnp.max(g, axis=-1))
        w_s = jnp.exp(g - m_new[..., None])
        decay = jnp.exp(b_last + m - m_new)
        C = decay[..., None, None] * C + jnp.einsum('bhs,bhsd,bhsv->bhdv', w_s, kc, vc)
        n = decay[..., None] * n + jnp.einsum('bhs,bhsd->bhd', w_s, kc)
        return (C, n, m_new), h

    nc, bsz, heads, l, dk = q.shape
    init = (jnp.zeros((bsz, heads, dk, v.shape[-1]), jnp.float32),
            jnp.zeros((bsz, heads, dk), jnp.float32),
            jnp.zeros((bsz, heads), jnp.float32))
    _, h = lax.scan(step, init, (q, k, v, log_i, log_f))
    return h


def mlstm_branch(xm, o_pre, conv_w, conv_b, wq, wk, wv, w_ig, b_ig, w_fg, b_fg, gnorm, skip):
    f32 = jnp.float32
    bsz, s, _ = xm.shape
    xm = xm.astype(f32)
    xc = jax.nn.silu(causal_conv(xm, conv_w.astype(f32), conv_b.astype(f32)))
    q = blockdiag(xc, wq)
    k = blockdiag(xc, wk)
    v = blockdiag(xm, wv)
    qkv = jnp.concatenate([q, k, v], axis=-1)
    log_i = (qkv @ w_ig + b_ig).astype(f32)
    log_f = jax.nn.log_sigmoid((qkv @ w_fg + b_fg).astype(f32))
    hc = mlstm_chunked(to_chunks(q, MLSTM_HEADS), to_chunks(k * (MLSTM_DH ** -0.5), MLSTM_HEADS),
                       to_chunks(v, MLSTM_HEADS), gate_chunks(log_i), gate_chunks(log_f))
    h = head_layernorm(from_chunks(hc)).reshape(bsz, s, D_MLSTM) * gnorm + skip * xc
    return jax.nn.sigmoid(o_pre.astype(f32)) * h


def hybrid_mixer(h, lb, w_in, hgrn_gnorm, conv_w, conv_b, wq, wk, wv, w_ig, b_ig, w_fg, b_fg,
                 mlstm_gnorm, skip, w_proj_a, w_proj_b, w_out):
    proj = h @ w_in
    q_a, f_a, i_a, g_a, xm_b, o_b, gate_a, gate_b = jnp.split(proj, IN_SPLITS, axis=-1)
    y_a = hgrn2_branch(q_a, f_a, i_a, g_a, lb, hgrn_gnorm) @ w_proj_a
    y_b = mlstm_branch(xm_b, o_b, conv_w, conv_b, wq, wk, wv, w_ig, b_ig, w_fg, b_fg,
                       mlstm_gnorm, skip) @ w_proj_b
    mixed = (jax.nn.sigmoid(gate_a.astype(jnp.float32)) * y_a
             + jax.nn.sigmoid(gate_b.astype(jnp.float32)) * y_b)
    return (mixed @ w_out).astype(h.dtype)


def swiglu(h, w1, w3, w2):
    return (jax.nn.silu(h @ w1) * (h @ w3)) @ w2


def moe_swiglu(h, router, w1, w3, w2):
    logits = (h @ router).astype(jnp.float32)
    top_v, top_i = lax.top_k(logits, TOP_K)
    top_w = jax.nn.softmax(top_v, axis=-1)
    gates = jnp.sum(jax.nn.one_hot(top_i, N_EXPERTS, dtype=jnp.float32) * top_w[..., None], axis=-2)
    out = jnp.zeros(h.shape, jnp.float32)
    for e in range(N_EXPERTS):
        out = out + gates[..., e:e + 1] * swiglu(h, w1[e], w3[e], w2[e])
    return out.astype(h.dtype)


def setup_inputs(seed: int = 0) -> dict:
    key = jax.random.key(seed)
    ks = iter(jax.random.split(key, 40))
    f32 = jnp.float32

    def nrm(shape, scale):
        return scale * jax.random.normal(next(ks), shape, f32)

    D = D_MODEL
    return {
        'x': nrm((BATCH, SEQ, D), 1.0),
        'c': nrm((BATCH, D), 1.0),
        'w_ada': nrm((DEPTH, D, 6 * D), 0.3 * D ** -0.5),
        'b_ada': nrm((DEPTH, 6 * D), 0.02),
        'g_pre_mix': 1.0 + nrm((DEPTH, D), 0.05),
        'g_post_mix': 1.0 + nrm((DEPTH, D), 0.05),
        'g_pre_ffn': 1.0 + nrm((DEPTH, D), 0.05),
        'g_post_ffn': 1.0 + nrm((DEPTH, D), 0.05),
        'w_in': nrm((DEPTH, D, D_IN), D ** -0.5),
        'hgrn_lb': 1.0 + nrm((DEPTH, D_HGRN_K), 0.5),
        'hgrn_gnorm': 1.0 + nrm((DEPTH, D_HGRN_V), 0.05),
        'mlstm_conv_w': nrm((DEPTH, MLSTM_CONV, D_MLSTM), MLSTM_CONV ** -0.5),
        'mlstm_conv_b': nrm((DEPTH, D_MLSTM), 0.02),
        'mlstm_wq': nrm((DEPTH, N_QKV_BLOCKS, QKV_BLOCK, QKV_BLOCK), QKV_BLOCK ** -0.5),
        'mlstm_wk': nrm((DEPTH, N_QKV_BLOCKS, QKV_BLOCK, QKV_BLOCK), QKV_BLOCK ** -0.5),
        'mlstm_wv': nrm((DEPTH, N_QKV_BLOCKS, QKV_BLOCK, QKV_BLOCK), QKV_BLOCK ** -0.5),
        'mlstm_w_ig': nrm((DEPTH, 3 * D_MLSTM, MLSTM_HEADS), 0.1 * (3 * D_MLSTM) ** -0.5),
        'mlstm_b_ig': nrm((DEPTH, MLSTM_HEADS), 0.1),
        'mlstm_w_fg': nrm((DEPTH, 3 * D_MLSTM, MLSTM_HEADS), 0.1 * (3 * D_MLSTM) ** -0.5),
        'mlstm_b_fg': jnp.linspace(3.0, 6.0, MLSTM_HEADS, dtype=f32)[None, :] + nrm((DEPTH, MLSTM_HEADS), 0.1),
        'mlstm_gnorm': 1.0 + nrm((DEPTH, D_MLSTM), 0.05),
        'mlstm_skip': 1.0 + nrm((DEPTH, D_MLSTM), 0.05),
        'w_proj_a': nrm((DEPTH, D_HGRN_V, D), D_HGRN_V ** -0.5),
        'w_proj_b': nrm((DEPTH, D_MLSTM, D), D_MLSTM ** -0.5),
        'w_out': nrm((DEPTH, D, D), D ** -0.5),
        'ffn_w1': nrm((N_DENSE, D, D_FF), D ** -0.5),
        'ffn_w3': nrm((N_DENSE, D, D_FF), D ** -0.5),
        'ffn_w2': nrm((N_DENSE, D_FF, D), D_FF ** -0.5),
        'moe_router': nrm((N_MOE, D, N_EXPERTS), D ** -0.5),
        'moe_w1': nrm((N_MOE, N_EXPERTS, D, D_FF_EXPERT), D ** -0.5),
        'moe_w3': nrm((N_MOE, N_EXPERTS, D, D_FF_EXPERT), D ** -0.5),
        'moe_w2': nrm((N_MOE, N_EXPERTS, D_FF_EXPERT, D), D_FF_EXPERT ** -0.5),
    }


def reference(x, c, w_ada, b_ada, g_pre_mix, g_post_mix, g_pre_ffn, g_post_ffn, w_in, hgrn_lb,
              hgrn_gnorm, mlstm_conv_w, mlstm_conv_b, mlstm_wq, mlstm_wk, mlstm_wv, mlstm_w_ig,
              mlstm_b_ig, mlstm_w_fg, mlstm_b_fg, mlstm_gnorm, mlstm_skip, w_proj_a, w_proj_b, w_out,
              ffn_w1, ffn_w3, ffn_w2, moe_router, moe_w1, moe_w3, moe_w2):
    lower_bounds = hgrn_lower_bounds(hgrn_lb)
    c_act = jax.nn.silu(c)
    for l in range(DEPTH):
        mod = c_act @ w_ada[l] + b_ada[l]
        sh_m, sc_m, gt_m, sh_f, sc_f, gt_f = [m[:, None, :] for m in jnp.split(mod, 6, axis=-1)]
        h = rmsnorm(x, g_pre_mix[l]) * (1.0 + sc_m) + sh_m
        y = hybrid_mixer(h, lower_bounds[l], w_in[l], hgrn_gnorm[l], mlstm_conv_w[l], mlstm_conv_b[l],
                         mlstm_wq[l], mlstm_wk[l], mlstm_wv[l], mlstm_w_ig[l], mlstm_b_ig[l],
                         mlstm_w_fg[l], mlstm_b_fg[l], mlstm_gnorm[l], mlstm_skip[l],
                         w_proj_a[l], w_proj_b[l], w_out[l])
        x = x + (gt_m * rmsnorm(y, g_post_mix[l])).astype(x.dtype)
        h = rmsnorm(x, g_pre_ffn[l]) * (1.0 + sc_f) + sh_f
        j = l // 2
        if l % 2 == 0:
            y = swiglu(h, ffn_w1[j], ffn_w3[j], ffn_w2[j]).astype(x.dtype)
        else:
            y = moe_swiglu(h, moe_router[j], moe_w1[j], moe_w3[j], moe_w2[j])
        x = x + (gt_f * rmsnorm(y, g_post_ffn[l])).astype(x.dtype)
    return x
```

```cpp
#include <hip/hip_runtime.h>
#include <cstdio>
#include <cstdint>
namespace pg8 {
#define PG8_LAS __attribute__((address_space(3)))
typedef unsigned short bf16_t;
typedef short bf16x8 __attribute__((ext_vector_type(8)));
typedef float f32x4 __attribute__((ext_vector_type(4)));
typedef unsigned u32x4 __attribute__((ext_vector_type(4)));
constexpr int BM = 256, BK = 64, HALF = 128, HTB = HALF * BK * 2  , STAGE_BYTES = 8 * HTB, NXCD = 8, WGM = 8;

__host__ __device__ __forceinline__ int lds_byte(int r, int c) { const int st = (r >> 4) * 2 + (c >> 5), rr = r & 15, cc = c & 31, ob = rr * 64 + cc * 2; return st * 1024 + (ob ^ (((ob >> 9) & 1) << 5)); }
__host__ __device__ __forceinline__ void stage_rc(int b, int& R, int& C) { const int st = b / 1024, sb = b % 1024, swz = sb ^ (((sb >> 9) & 1) << 5); R = (st >> 1) * 16 + swz / 64; C = (st & 1) * 32 + (swz % 64) / 2; }
__host__ __device__ __forceinline__ int perm32(int rho) { const int n = rho >> 4, i = rho & 15; return 8 * (i >> 2) + 4 * n + (i & 3); }

struct Unit { int pm, pn; };
struct Gemm { const bf16_t* A; const bf16_t* Bt; int M, N, K; };

struct StaticOrder {
    int nM, nN, nwg, G, c;
    __host__ __device__ void init(int M, int N, int G_, int c_) { nM = M / BM; nN = N / BM; nwg = nM * nN; G = G_; c = c_; }
    __host__ __device__ bool next(int i, Unit& u) const {
        const long L = (long)i * G + c; if (L >= nwg) return false;
        int wgid = (int)L; { const int q = nwg / NXCD, r = nwg % NXCD, xcd = wgid % NXCD, off = wgid / NXCD; wgid = (xcd < r ? xcd * (q + 1) : r * (q + 1) + (xcd - r) * q) + off; }
        const int nig = WGM * nN, gid = wgid / nig, fm = gid * WGM, gsz = (nM - fm) < WGM ? (nM - fm) : WGM;
        u.pm = fm + ((wgid % nig) % gsz); u.pn = (wgid % nig) / gsz; return true;
    }
    __device__ __forceinline__ void a_ready(const Unit&) const {}
    __device__ __forceinline__ void done(const Unit&) const {}
};
__device__ __forceinline__ unsigned cvt_pk_bf16(float lo, float hi) { unsigned r; asm volatile("v_cvt_pk_bf16_f32 %0, %1, %2" : "=v"(r) : "v"(lo), "v"(hi)); return r; }
struct UOrder {
    int mode, nM, nN, nwg, G, c, NT; const PG8_LAS int* tab;
    __device__ __forceinline__ void init(int mode_, int M, int N, int G_, int c_) { mode = mode_; nM = M / BM; nN = N / BM; nwg = nM * nN; G = G_; c = c_; NT = 1; tab = nullptr; }
    __device__ __forceinline__ bool next(int i, Unit& u) const {
        const int which = (mode == 1) ? (i & 1) : 0; const int ii = (mode == 1) ? (i >> 1) : i;
        const long L = (long)ii * G + c; if (L >= nwg) return false;
        int wgid = (int)L; { const int q = nwg / NXCD, r = nwg % NXCD, xcd = wgid % NXCD, off = wgid / NXCD; wgid = (xcd < r ? xcd * (q + 1) : r * (q + 1) + (xcd - r) * q) + off; }
        if (mode == 2) {
            int r = wgid, E = 0;
#pragma unroll
            for (int k = 0; k < 7; ++k) { const int uk = tab[k] * NT; if (E == k && r >= uk) { r -= uk; E = k + 1; } }
            const int P = tab[E], B = tab[8 + E];
            const int nig = WGM * NT, gid = r / nig, fm = gid * WGM, gsz = (P - fm) < WGM ? (P - fm) : WGM, rr = r - gid * nig;
            u.pm = __builtin_amdgcn_readfirstlane(B + fm + rr % gsz); u.pn = __builtin_amdgcn_readfirstlane(E * NT + rr / gsz); return true;
        }
        const int nig = WGM * nN, gid = wgid / nig, fm = gid * WGM, gsz = (nM - fm) < WGM ? (nM - fm) : WGM;
        u.pm = fm + ((wgid % nig) % gsz); u.pn = (wgid % nig) / gsz;
        if (which) { u.pm += nM; u.pn += nN; }
        return true;
    }
    __device__ __forceinline__ void a_ready(const Unit&) const {}
    __device__ __forceinline__ void done(const Unit&) const {}
};

__device__ __forceinline__ float fsig(float v) { return __builtin_amdgcn_rcpf(1.0f + __expf(-v)); }
__device__ __forceinline__ float bflo(unsigned w) { return __uint_as_float(w << 16); }
__device__ __forceinline__ float bfhi(unsigned w) { return __uint_as_float(w & 0xffff0000u); }
#define PG8_X8(x, ai, bj, m) float x[8]; { const f32x4 _a = acc[ai][bj][m][0], _b = acc[ai][bj][m][1]; x[0] = _a[0]; x[1] = _a[1]; x[2] = _a[2]; x[3] = _a[3]; x[4] = _b[0]; x[5] = _b[1]; x[6] = _b[2]; x[7] = _b[3]; }
#define PG8_PACK8(w, x) u32x4 w; w.x = cvt_pk_bf16(x[0], x[1]); w.y = cvt_pk_bf16(x[2], x[3]); w.z = cvt_pk_bf16(x[4], x[5]); w.w = cvt_pk_bf16(x[6], x[7]);

struct EpiWin {
    static constexpr bool PERM = true, AFTER_DRAIN = false;
    bf16_t* P; const float* lb; size_t pstride;
    __device__ __forceinline__ void operator()(const f32x4 (&acc)[2][2][4][2], const Unit& u, int wr, int wc, int fr, int fq) const {
        const int part = u.pn >> 2;
        const int mode = (part == 0 || part == 3) ? 1 : (part == 1) ? 3 : (part >= 5) ? 2 : 0;
        bf16_t* base = P + (size_t)part * pstride;
        const int row0 = u.pm * BM + wr * 64 + fr, col0 = (u.pn & 3) * BM + wc * 32 + 8 * fq;
        float lbv[2][8];
#pragma unroll
        for (int bj = 0; bj < 2; ++bj)
#pragma unroll
            for (int j = 0; j < 8; ++j) lbv[bj][j] = 0.f;
        if (mode == 3) {
#pragma unroll
            for (int bj = 0; bj < 2; ++bj) { const f32x4 a = *(const f32x4*)(lb + col0 + bj * HALF), b = *(const f32x4*)(lb + col0 + bj * HALF + 4);
                lbv[bj][0] = a[0]; lbv[bj][1] = a[1]; lbv[bj][2] = a[2]; lbv[bj][3] = a[3]; lbv[bj][4] = b[0]; lbv[bj][5] = b[1]; lbv[bj][6] = b[2]; lbv[bj][7] = b[3]; }
        }
#pragma unroll
        for (int ai = 0; ai < 2; ++ai)
#pragma unroll
            for (int m = 0; m < 4; ++m) { bf16_t* rowp = base + (size_t)(row0 + ai * HALF + m * 16) * 1024 + col0;
#pragma unroll
                for (int bj = 0; bj < 2; ++bj) { PG8_X8(x, ai, bj, m)
                    if (mode != 0) {
#pragma unroll
                        for (int j = 0; j < 8; ++j) { const float s = fsig(x[j]);
                            if (mode == 1) x[j] = x[j] * s; else if (mode == 2) x[j] = s; else x[j] = fmaxf(__logf(lbv[bj][j] + (1.0f - lbv[bj][j]) * s), -30.0f); } }
                    PG8_PACK8(w, x) *(u32x4*)(rowp + bj * HALF) = w; } }
    }
};
struct EpiProj {
    static constexpr bool PERM = true, AFTER_DRAIN = false;
    const bf16_t* gates; size_t pstride; float* T1; bf16_t* MX;
    __device__ __forceinline__ void operator()(const f32x4 (&acc)[2][2][4][2], const Unit& u, int wr, int wc, int fr, int fq) const {
        const int which = u.pn >> 2;
        const bf16_t* g = gates + (size_t)which * pstride;
        const int row0 = (u.pm & 127) * BM + wr * 64 + fr, col0 = (u.pn & 3) * BM + wc * 32 + 8 * fq;
#pragma unroll
        for (int ai = 0; ai < 2; ++ai)
#pragma unroll
            for (int m = 0; m < 4; ++m) { const size_t off = (size_t)(row0 + ai * HALF + m * 16) * 1024 + col0;
#pragma unroll
                for (int bj = 0; bj < 2; ++bj) { PG8_X8(x, ai, bj, m)
                    const u32x4 gv = *(const u32x4*)(g + off + bj * HALF);
                    x[0] *= bflo(gv.x); x[1] *= bfhi(gv.x); x[2] *= bflo(gv.y); x[3] *= bfhi(gv.y); x[4] *= bflo(gv.z); x[5] *= bfhi(gv.z); x[6] *= bflo(gv.w); x[7] *= bfhi(gv.w);
                    float* tp = T1 + off + bj * HALF;
                    if (which == 0) { *(f32x4*)tp = (f32x4){x[0], x[1], x[2], x[3]}; *(f32x4*)(tp + 4) = (f32x4){x[4], x[5], x[6], x[7]}; }
                    else { const f32x4 t0 = *(const f32x4*)tp, t1 = *(const f32x4*)(tp + 4);
                        x[0] += t0[0]; x[1] += t0[1]; x[2] += t0[2]; x[3] += t0[3]; x[4] += t1[0]; x[5] += t1[1]; x[6] += t1[2]; x[7] += t1[3];
                        PG8_PACK8(w, x) *(u32x4*)(MX + off + bj * HALF) = w; } } }
    }
};
struct EpiSwi {
    static constexpr bool PERM = true, AFTER_DRAIN = false;
    bf16_t* Gm; int ldg, NT;
    __device__ __forceinline__ void operator()(const f32x4 (&acc)[2][2][4][2], const Unit& u, int wr, int wc, int fr, int fq) const {
        const int pnl = u.pn - (u.pn / NT) * NT;
        const int row0 = u.pm * BM + wr * 64 + fr, col0 = pnl * HALF + wc * 32 + 8 * fq;
#pragma unroll
        for (int ai = 0; ai < 2; ++ai)
#pragma unroll
            for (int m = 0; m < 4; ++m) { bf16_t* rowp = Gm + (size_t)(row0 + ai * HALF + m * 16) * ldg + col0;
                PG8_X8(x, ai, 0, m) PG8_X8(y, ai, 1, m)
#pragma unroll
                for (int j = 0; j < 8; ++j) x[j] = x[j] * fsig(x[j]) * y[j];
                PG8_PACK8(w, x) *(u32x4*)rowp = w; }
    }
};
struct EpiPlain {
    static constexpr bool PERM = true, AFTER_DRAIN = false;
    bf16_t* O; int ldc;
    __device__ __forceinline__ void operator()(const f32x4 (&acc)[2][2][4][2], const Unit& u, int wr, int wc, int fr, int fq) const {
        const int row0 = u.pm * BM + wr * 64 + fr, col0 = (u.pn & 3) * BM + wc * 32 + 8 * fq;
#pragma unroll
        for (int ai = 0; ai < 2; ++ai)
#pragma unroll
            for (int m = 0; m < 4; ++m) { bf16_t* rowp = O + (size_t)(row0 + ai * HALF + m * 16) * ldc + col0;
#pragma unroll
                for (int bj = 0; bj < 2; ++bj) { PG8_X8(x, ai, bj, m) PG8_PACK8(w, x) *(u32x4*)(rowp + bj * HALF) = w; } }
    }
};
template <class Epi, class Sched, bool ALIGN_EPI = false, bool SP2 = false>
__device__ __forceinline__ void gemm_phase(PG8_LAS unsigned char* lds, const Gemm g, const Sched& S, const Epi& E) {
    int tid_ = threadIdx.x; asm volatile("" : "+v"(tid_));
    const int tid = tid_, wid = __builtin_amdgcn_readfirstlane(tid >> 6), lane = tid & 63, wr = wid >> 2, wc = wid & 3, fr = lane & 15, fq = lane >> 4;
    const int K = g.K, nt = K / BK;
    unsigned voffA[2], voffB[2];
#pragma unroll
    for (int i = 0; i < 2; ++i) { int R, C; stage_rc(tid * 16 + i * 8192, R, C); const int Rb = Epi::PERM ? ((R & ~31) + perm32(R & 31)) : R;
        voffA[i] = (unsigned)(R * K + C) * 2u; voffB[i] = (unsigned)(Rb * K + C) * 2u; }
    const size_t kstep = (size_t)(BK * 2);
    const size_t hstep = (size_t)HALF * K * 2;
    const size_t tstep = 2 * hstep;
    const unsigned ldsw = (unsigned)wid * 1024u;
    const int aoff = lds_byte(wr * 64 + fr, fq * 8), boff = lds_byte(wc * 32 + fr, fq * 8);
#define PG8_SA(b, h) (((b) * 2 + (h)) * HTB)
#define PG8_SB(b, h) ((4 + (b) * 2 + (h)) * HTB)
#define PG8_STAGE(bufoff, gbase, voff) do { _Pragma("unroll") for (int _i = 0; _i < 2; ++_i) \
        __builtin_amdgcn_global_load_lds((const unsigned*)((const char*)(gbase) + (voff)[_i]), (PG8_LAS unsigned*)(lds + (bufoff) + ldsw + _i * 8192), 16, 0, 0); } while (0)
#define PG8_LDA(dst, b, h) do { _Pragma("unroll") for (int m = 0; m < 4; ++m) _Pragma("unroll") for (int k = 0; k < 2; ++k) dst[m][k] = *(const PG8_LAS bf16x8*)(lds + PG8_SA(b, h) + aoff + m * 2048 + k * 1024); } while (0)
#define PG8_LDB(dst, b, h) do { _Pragma("unroll") for (int n = 0; n < 2; ++n) _Pragma("unroll") for (int k = 0; k < 2; ++k) dst[n][k] = *(const PG8_LAS bf16x8*)(lds + PG8_SB(b, h) + boff + n * 2048 + k * 1024); } while (0)
#define PG8_MMA(ai, bj, At, Bt) do { __builtin_amdgcn_s_setprio(1); _Pragma("unroll") for (int m = 0; m < 4; ++m) _Pragma("unroll") for (int n = 0; n < 2; ++n) _Pragma("unroll") for (int k = 0; k < 2; ++k) \
        acc[ai][bj][m][n] = __builtin_amdgcn_mfma_f32_16x16x32_bf16(Bt[n][k], At[m][k], acc[ai][bj][m][n], 0, 0, 0); __builtin_amdgcn_s_setprio(0); } while (0)
#define PG8_WAIT_V(n) asm volatile("s_waitcnt vmcnt(" #n ")" ::: "memory")
#define PG8_WAIT_L(n) asm volatile("s_waitcnt lgkmcnt(" #n ")" ::: "memory")
#define PG8_BAR __builtin_amdgcn_s_barrier()
#define PG8_SCHED __builtin_amdgcn_sched_barrier(0)
    Unit cur, nxt; int ui = 0;
    if (!S.next(0, cur)) return;
    f32x4 acc[2][2][4][2];
#pragma unroll
    for (int a = 0; a < 2; ++a)
#pragma unroll
        for (int b = 0; b < 2; ++b)
#pragma unroll
            for (int m = 0; m < 4; ++m)
#pragma unroll
                for (int n = 0; n < 2; ++n) acc[a][b][m][n] = (f32x4){0.f, 0.f, 0.f, 0.f};
    bf16x8 At[4][2], B0[2][2], B1[2][2];
    const char* cA = (const char*)g.A + (size_t)cur.pm * tstep; const char* cB = (const char*)g.Bt + (size_t)cur.pn * tstep;
    S.a_ready(cur);
    if constexpr (SP2) {
        PG8_STAGE(PG8_SB(0, 0), cB, voffB); PG8_STAGE(PG8_SB(0, 1), cB + hstep, voffB); PG8_STAGE(PG8_SA(0, 0), cA, voffA); PG8_STAGE(PG8_SA(0, 1), cA + hstep, voffA);
        if (wr == 1) PG8_BAR;
        PG8_WAIT_V(2); PG8_BAR;
        PG8_STAGE(PG8_SB(1, 0), cB + kstep, voffB); PG8_STAGE(PG8_SA(1, 0), cA + kstep, voffA); PG8_STAGE(PG8_SB(1, 1), cB + hstep + kstep, voffB);
        PG8_WAIT_V(6); PG8_BAR;
    } else {
        PG8_STAGE(PG8_SB(0, 0), cB, voffB); PG8_STAGE(PG8_SA(0, 0), cA, voffA); PG8_STAGE(PG8_SB(0, 1), cB + hstep, voffB); PG8_STAGE(PG8_SA(0, 1), cA + hstep, voffA);
        if (wr == 1) PG8_BAR;
        PG8_WAIT_V(4); PG8_BAR;
        PG8_STAGE(PG8_SB(1, 0), cB + kstep, voffB); PG8_STAGE(PG8_SA(1, 0), cA + kstep, voffA); PG8_STAGE(PG8_SB(1, 1), cB + hstep + kstep, voffB);
        PG8_WAIT_V(6); PG8_BAR;
    }
    for (;;) {
        const bool has_next = S.next(ui + 1, nxt);
        const char* nA = has_next ? (const char*)g.A + (size_t)nxt.pm * tstep : cA; const char* nB = has_next ? (const char*)g.Bt + (size_t)nxt.pn * tstep : cB;
        for (int t = 0; t < nt; t += 2) {
            const bool last = (t == nt - 2);
            const char* a1 = cA + (size_t)(t + 1) * kstep;
            const char* a2 = last ? nA : cA + (size_t)(t + 2) * kstep; const char* b2 = last ? nB : cB + (size_t)(t + 2) * kstep;
            const char* a3 = a2 + kstep; const char* b3 = b2 + kstep;
            if (last && has_next) S.a_ready(nxt);
            if constexpr (SP2) {
            PG8_LDB(B0, 0, 0); PG8_LDB(B1, 0, 1); PG8_SCHED; PG8_LDA(At, 0, 0); PG8_STAGE(PG8_SA(1, 1), a1 + hstep, voffA);
            PG8_WAIT_V(8); PG8_WAIT_L(0); PG8_BAR; PG8_MMA(0, 0, At, B0); PG8_MMA(0, 1, At, B1); PG8_BAR; PG8_SCHED;
            PG8_LDA(At, 0, 1); PG8_STAGE(PG8_SB(0, 0), b2, voffB); PG8_STAGE(PG8_SB(0, 1), b2 + hstep, voffB); PG8_STAGE(PG8_SA(0, 0), a2, voffA);
            PG8_WAIT_V(8); PG8_WAIT_L(0); PG8_BAR; PG8_MMA(1, 0, At, B0); PG8_MMA(1, 1, At, B1); PG8_BAR; PG8_SCHED;
            PG8_LDB(B0, 1, 0); PG8_LDB(B1, 1, 1); PG8_SCHED; PG8_LDA(At, 1, 0); PG8_STAGE(PG8_SA(0, 1), a2 + hstep, voffA);
            PG8_WAIT_V(8); PG8_WAIT_L(0); PG8_BAR; PG8_MMA(0, 0, At, B0); PG8_MMA(0, 1, At, B1); PG8_BAR; PG8_SCHED;
            PG8_LDA(At, 1, 1); PG8_STAGE(PG8_SB(1, 0), b3, voffB); PG8_STAGE(PG8_SB(1, 1), b3 + hstep, voffB); PG8_STAGE(PG8_SA(1, 0), a3, voffA);
            PG8_WAIT_V(8); PG8_WAIT_L(0); PG8_BAR; PG8_MMA(1, 0, At, B0); PG8_MMA(1, 1, At, B1); PG8_BAR; PG8_SCHED;
            } else {
            PG8_LDB(B0, 0, 0); PG8_SCHED; PG8_LDA(At, 0, 0); PG8_STAGE(PG8_SA(1, 1), a1 + hstep, voffA);
            PG8_WAIT_L(8); PG8_BAR; PG8_WAIT_L(0); PG8_MMA(0, 0, At, B0); PG8_BAR; PG8_SCHED;
            PG8_LDB(B1, 0, 1); PG8_STAGE(PG8_SB(0, 0), b2, voffB);
            PG8_BAR; PG8_WAIT_L(0); PG8_MMA(0, 1, At, B1); PG8_BAR;
            PG8_LDA(At, 0, 1); PG8_STAGE(PG8_SA(0, 0), a2, voffA);
            PG8_BAR; PG8_WAIT_L(0); PG8_MMA(1, 0, At, B0); PG8_BAR; PG8_SCHED;
            PG8_STAGE(PG8_SB(0, 1), b2 + hstep, voffB);
            PG8_WAIT_V(6); PG8_BAR; PG8_MMA(1, 1, At, B1); PG8_BAR;
            PG8_LDB(B0, 1, 0); PG8_SCHED; PG8_LDA(At, 1, 0); PG8_STAGE(PG8_SA(0, 1), a2 + hstep, voffA);
            PG8_WAIT_L(8); PG8_BAR; PG8_WAIT_L(0); PG8_MMA(0, 0, At, B0); PG8_BAR; PG8_SCHED;
            PG8_LDB(B1, 1, 1); PG8_STAGE(PG8_SB(1, 0), b3, voffB);
            PG8_BAR; PG8_WAIT_L(0); PG8_MMA(0, 1, At, B1); PG8_BAR;
            PG8_LDA(At, 1, 1); PG8_STAGE(PG8_SA(1, 0), a3, voffA);
            PG8_BAR; PG8_WAIT_L(0); PG8_MMA(1, 0, At, B0); PG8_BAR; PG8_SCHED;
            PG8_STAGE(PG8_SB(1, 1), b3 + hstep, voffB);
            PG8_WAIT_V(6); PG8_BAR; PG8_MMA(1, 1, At, B1); PG8_BAR;
            }
        }
        if constexpr (ALIGN_EPI) { if (wr == 0) PG8_BAR; }
        if constexpr (!Epi::AFTER_DRAIN) { E(acc, cur, wr, wc, fr, fq); S.done(cur); }
        if (!has_next) break;
#pragma unroll
        for (int a = 0; a < 2; ++a)
#pragma unroll
            for (int b = 0; b < 2; ++b)
#pragma unroll
                for (int m = 0; m < 4; ++m)
#pragma unroll
                    for (int n = 0; n < 2; ++n) acc[a][b][m][n] = (f32x4){0.f, 0.f, 0.f, 0.f};
        cur = nxt; cA = nA; cB = nB; ++ui;
        if constexpr (ALIGN_EPI) { if (wr == 1) PG8_BAR; }
    }
    PG8_WAIT_V(0);
    if constexpr (!ALIGN_EPI) { if (wr == 0) PG8_BAR; }
    PG8_BAR;
    if constexpr (Epi::AFTER_DRAIN) { E.fused(acc, cur, wr, wc, fr, fq, lds, wid, lane); S.done(cur); }
#undef PG8_SA
#undef PG8_SB
#undef PG8_STAGE
#undef PG8_LDA
#undef PG8_LDB
#undef PG8_MMA
#undef PG8_WAIT_V
#undef PG8_WAIT_L
#undef PG8_BAR
#undef PG8_SCHED
}
}
constexpr int NWAVES = 8, NTHR = 512;
constexpr int D = 1024, NBATCH = 8, SEQ = 4096, M = NBATCH * SEQ, DEPTH = 4;
constexpr int DIN = 8192, DFF = 2816, NEXP = 8, DFE = 3584;
constexpr float EPS = 1e-6f;
constexpr size_t MiB = 1u << 20;
constexpr size_t WS_CTL = 0, CTL_ZERO_BYTES = 2 * MiB;
constexpr size_t WS_MOD = 1 * MiB;
constexpr size_t WS_LB = 2 * MiB;
constexpr size_t WS_LI = 2 * MiB + 64 * 1024, WS_LF = WS_LI + 512 * 1024;
constexpr size_t WS_TOKEP = 4 * MiB;
constexpr size_t WS_TOKW = WS_TOKEP + 512 * 1024;
constexpr size_t WS_TOKD = WS_TOKW + 256 * 1024;
constexpr size_t WS_WIN = 6 * MiB, WS_WAB = 22 * MiB, WS_WO = 26 * MiB, WS_WF = 28 * MiB;
constexpr size_t WF_W2_DENSE = 12 * MiB, WF_W2_MOE = 112 * MiB;
constexpr size_t WS_H = 196 * MiB;
constexpr size_t WS_PROJ = 260 * MiB, PART = 64 * MiB;
constexpr size_t WS_MQ = 772 * MiB, WS_MK = 836 * MiB, WS_MV = 900 * MiB, WS_XC = 964 * MiB;
constexpr size_t WS_AG = 772 * MiB, WS_YS = 904 * MiB;
constexpr size_t WS_END = 1036 * MiB;
constexpr size_t PSTRIDE = (size_t)M * 1024;
enum { P_QA = 0, P_LF = 1, P_VA = 2, P_GA = 3, P_XM = 4, P_OS = 5, P_GTA = 6, P_GTB = 7 };
constexpr int CW_BAR = 4096;
constexpr int CW_CNT = 16384;
constexpr int RING_BYTES = 131072, MISC_OFF = RING_BYTES, LDS_BYTES = 147456;

#define GAS __attribute__((address_space(1)))
#define LAS __attribute__((address_space(3)))
typedef unsigned short bf16;
typedef unsigned v4u __attribute__((ext_vector_type(4)));
typedef unsigned v2u __attribute__((ext_vector_type(2)));
typedef float f32x4 __attribute__((ext_vector_type(4)));
#define LDS_WAIT() asm volatile("s_waitcnt lgkmcnt(0)" ::: "memory")
#define VM_WAIT() asm volatile("s_waitcnt vmcnt(0)" ::: "memory")
__device__ __forceinline__ unsigned f2bf(float f) { unsigned u = __builtin_bit_cast(unsigned, f); return (u + 0x7fffu + ((u >> 16) & 1u)) >> 16; }
__device__ __forceinline__ unsigned pk2(float lo, float hi) { return f2bf(lo) | (f2bf(hi) << 16); }
__device__ __forceinline__ float bflo(unsigned w) { return __uint_as_float(w << 16); }
__device__ __forceinline__ float bfhi(unsigned w) { return __uint_as_float(w & 0xffff0000u); }
__device__ __forceinline__ float bf2f(bf16 b) { return __uint_as_float((unsigned)b << 16); }
__device__ __forceinline__ float fsigm(float v) { return 1.0f / (1.0f + __expf(-v)); }
__device__ __forceinline__ float wave_sum(float v) {
#pragma unroll
    for (int o = 1; o < 64; o <<= 1) v += __shfl_xor(v, o);
    return v;
}
__device__ __forceinline__ float half_sum(float v) {
#pragma unroll
    for (int o = 1; o < 32; o <<= 1) v += __shfl_xor(v, o);
    return v;
}
__device__ __forceinline__ float sum16(float v) {
#pragma unroll
    for (int o = 1; o < 16; o <<= 1) v += __shfl_xor(v, o);
    return v;
}

__device__ __forceinline__ int opq_v(int v) { asm volatile("" : "+v"(v)); return v; }
__device__ __forceinline__ int opq_s(int v) { asm volatile("" : "+s"(v)); return v; }
__device__ __forceinline__ unsigned char* opq_p(unsigned char* p) { asm volatile("" : "+s"(p)); return p; }
#define TID() opq_v((int)threadIdx.x)
#define BID() opq_s((int)blockIdx.x)
#define XB_TMO      128
#define XB_XCNT(j)  (256  + 64 * (j))
#define XB_XSUB(j)  (1280 + 64 * (j))
#define XB_XGEN(j)  (2304 + 64 * (j))
#define XB_TOP      3328
#define XB_TOPGEN   3392
#define XCD_BAR_WORDS 3456
#define XB_SPIN_CAP (1u << 18)

__device__ __forceinline__ unsigned xb_ld(unsigned* p)              { return __hip_atomic_load(p, __ATOMIC_RELAXED, __HIP_MEMORY_SCOPE_AGENT); }
__device__ __forceinline__ unsigned xb_add(unsigned* p, unsigned v) { return __hip_atomic_fetch_add(p, v, __ATOMIC_RELAXED, __HIP_MEMORY_SCOPE_AGENT); }
__device__ __forceinline__ unsigned xb_xcc_id() { return (unsigned)__builtin_amdgcn_s_getreg((3 << 11) | 20) & 0xFu; }
#define XB_SPIN(cond, bar) do { unsigned _sp = 0; while (cond) { __builtin_amdgcn_s_sleep(1); \
    if ((++_sp & 255u) == 0u) { if (xb_ld(&(bar)[XB_TMO])) break; if (_sp > XB_SPIN_CAP) { atomicAdd(&(bar)[XB_TMO], 1u); break; } } } } while (0)

struct XcdBarrier {
    unsigned* bar; unsigned x;
    volatile LAS unsigned* st;
};

__device__ __forceinline__ XcdBarrier xcd_barrier_post(unsigned* bar, volatile LAS unsigned* st) {
    XcdBarrier b; b.bar = bar; b.x = xb_xcc_id(); b.st = st;
    if (threadIdx.x == 0) (void)xb_add(&bar[XB_XCNT(b.x)], 1u);
    return b;
}
__device__ __forceinline__ void xcd_barrier_complete(unsigned* bar, unsigned x, unsigned& nloc, unsigned& nx) {
    const unsigned G = gridDim.x * gridDim.y * gridDim.z;
    unsigned sum, cnt, mine, sp = 0u;
    for (;;) {
        sum = 0u; cnt = 0u; mine = 0u;
#pragma unroll
        for (unsigned j = 0; j < 16; ++j) { const unsigned c = xb_ld(&bar[XB_XCNT(j)]); sum += c; cnt += (c > 0u) ? 1u : 0u; mine = (j == x) ? c : mine; }
        if (sum == G) break;
        __builtin_amdgcn_s_sleep(1);
        if ((++sp & 255u) == 0u) { if (xb_ld(&bar[XB_TMO])) break; if (sp > XB_SPIN_CAP) { atomicAdd(&bar[XB_TMO], 1u); break; } }
    }
    nloc = mine > 0u ? mine : 1u; nx = cnt > 0u ? cnt : 1u;
}

__device__ __forceinline__ void xcd_barrier(const XcdBarrier& b) {
    asm volatile("s_waitcnt vmcnt(0)" ::: "memory");
    __syncthreads();
    if (threadIdx.x == 0) {
        unsigned* bar = b.bar;
        __builtin_amdgcn_s_waitcnt(0);
        unsigned nloc = b.st[0], nx = b.st[1];
        if (nloc == 0u) { xcd_barrier_complete(bar, b.x, nloc, nx); b.st[0] = nloc; b.st[1] = nx; }
        const unsigned old = xb_add(&bar[XB_XSUB(b.x)], 1u);
        const unsigned gen = old / nloc;
        if (old + 1u == (gen + 1u) * nloc) {
            __builtin_amdgcn_fence(__ATOMIC_RELEASE, "agent");
            asm volatile("s_waitcnt vmcnt(0)" ::: "memory");
            const unsigned og = xb_add(&bar[XB_TOP], 1u);
            const unsigned tg = og / nx;
            if (og + 1u == (tg + 1u) * nx) xb_add(&bar[XB_TOPGEN], 1u);
            else XB_SPIN(xb_ld(&bar[XB_TOPGEN]) == tg, bar);
            __builtin_amdgcn_fence(__ATOMIC_ACQUIRE, "agent");
            xb_add(&bar[XB_XGEN(b.x)], 1u);
            asm volatile("s_waitcnt vmcnt(0)" ::: "memory");
        } else {
            XB_SPIN(xb_ld(&bar[XB_XGEN(b.x)]) == gen, bar);
            __builtin_amdgcn_fence(__ATOMIC_ACQUIRE, "agent");
            asm volatile("s_waitcnt vmcnt(0)" ::: "memory");
        }
    }
    __syncthreads();
}
struct Ctx { const float* in[32]; float* out; unsigned char* ws; int ph_lo, ph_hi; };
enum { I_X = 0, I_C, I_WADA, I_BADA, I_GPREMIX, I_GPOSTMIX, I_GPREFFN, I_GPOSTFFN, I_WIN, I_HLB, I_HGN, I_CONVW, I_CONVB, I_WQ, I_WK, I_WV, I_WIG, I_BIG, I_WFG, I_BFG,
       I_MGN, I_MSKIP, I_WPA, I_WPB, I_WOUT, I_F1, I_F3, I_F2, I_ROUTER, I_M1, I_M3, I_M2 };

__device__ __forceinline__ void ph_mod(const Ctx& c, LAS unsigned char* lds) {
    LAS float* cact = (LAS float*)lds;
    LAS float* part = (LAS float*)(lds + 32768);
    float* MOD = (float*)(c.ws + WS_MOD);
    const float* cin = c.in[I_C]; const float* wada = c.in[I_WADA]; const float* bada = c.in[I_BADA];
    const int tid = TID(), lane = tid & 63, wave = tid >> 6;
    for (int i = tid; i < 8192; i += NTHR) { const float v = cin[i]; cact[i] = v * fsigm(v); }
    __syncthreads();
    for (int u = BID(); u < 384; u += gridDim.x) {
        const int l = u / 96, jb = u % 96, j = jb * 64 + lane;
        const float* w = wada + ((size_t)l * 1024 + wave * 128) * 6144 + j;
        const LAS float* ca = cact + wave * 128;
        float a0 = 0.f, a1 = 0.f, a2 = 0.f, a3 = 0.f, a4 = 0.f, a5 = 0.f, a6 = 0.f, a7 = 0.f;
#pragma unroll 8
        for (int k = 0; k < 128; ++k) { const float wv = w[(size_t)k * 6144];
            a0 += ca[k] * wv; a1 += ca[1024 + k] * wv; a2 += ca[2048 + k] * wv; a3 += ca[3072 + k] * wv;
            a4 += ca[4096 + k] * wv; a5 += ca[5120 + k] * wv; a6 += ca[6144 + k] * wv; a7 += ca[7168 + k] * wv; }
        LAS float* pw = part + wave * 512 + lane;
        pw[0] = a0; pw[64] = a1; pw[128] = a2; pw[192] = a3; pw[256] = a4; pw[320] = a5; pw[384] = a6; pw[448] = a7;
        __syncthreads();
        { const int b = wave; float s = bada[l * 6144 + j];
#pragma unroll
            for (int ww = 0; ww < 8; ++ww) s += part[ww * 512 + b * 64 + lane];
            MOD[(size_t)(l * 8 + b) * 6144 + j] = s; }
        __syncthreads();
    }
}
__device__ __forceinline__ void ph_lb(const Ctx& c) {
    if (BID() != 0) return;
    float* LB = (float*)(c.ws + WS_LB); const float* raw = c.in[I_HLB];
    for (int col = TID(); col < 1024; col += NTHR) {
        const float r0 = raw[col], r1 = raw[1024 + col], r2 = raw[2048 + col], r3 = raw[3072 + col];
        const float mx = fmaxf(fmaxf(r0, r1), fmaxf(r2, r3));
        const float e0 = __expf(r0 - mx), e1 = __expf(r1 - mx), e2 = __expf(r2 - mx), e3 = __expf(r3 - mx), inv = 1.0f / (e0 + e1 + e2 + e3);
        LB[col] = 0.f; LB[1024 + col] = e1 * inv; LB[2048 + col] = (e1 + e2) * inv; LB[3072 + col] = (e1 + e2 + e3) * inv;
    }
}
__device__ __forceinline__ void cvt_item(const float* W, int K, int N, bf16* WT, int rowbase, int mode, LAS float* scr, int item, int lane) {
    const int nblk = N / 32, kb = item / nblk, nb = item % nblk, k0 = 64 * kb, n0 = 32 * nb;
#pragma unroll 8
    for (int i = 0; i < 32; ++i) { const int kk = 2 * i + (lane >> 5); scr[kk * 33 + (lane & 31)] = W[(size_t)(k0 + kk) * N + n0 + (lane & 31)]; }
    LDS_WAIT(); asm volatile("" ::: "memory");
    const int drow0 = rowbase + (mode ? ((n0 >> 7) * 256 + (n0 & 127)) : n0);
    const int cc = lane & 7;
#pragma unroll
    for (int j = 0; j < 4; ++j) { const int n = (lane >> 3) + 8 * j; const LAS float* s = scr + (8 * cc) * 33 + n;
        v4u o; o.x = pk2(s[0 * 33], s[1 * 33]); o.y = pk2(s[2 * 33], s[3 * 33]); o.z = pk2(s[4 * 33], s[5 * 33]); o.w = pk2(s[6 * 33], s[7 * 33]);
        *(v4u*)(WT + (size_t)(drow0 + n) * K + k0 + 8 * cc) = o; }
    LDS_WAIT(); asm volatile("" ::: "memory");
}
__device__ __forceinline__ void ph_cvt(const Ctx& c, int l, LAS unsigned char* lds) {
    const int tid = TID(), lane = tid & 63, wave = __builtin_amdgcn_readfirstlane(tid >> 6);
    LAS float* scr = (LAS float*)(lds + wave * 16384);
    const int gw = BID() * NWAVES + wave, NGW = gridDim.x * NWAVES;
    bf16* WIN = (bf16*)(c.ws + WS_WIN); bf16* WAB = (bf16*)(c.ws + WS_WAB); bf16* WO = (bf16*)(c.ws + WS_WO); bf16* WF = (bf16*)(c.ws + WS_WF);
    const bool moe = (l & 1) != 0; const int j = l >> 1;
    constexpr int I_IN = 16 * 256, I_SQ = 16 * 32, I_D13 = 16 * 88, I_D2 = 44 * 32, I_M13 = 16 * 112, I_M2E = 56 * 32;
    const int total = I_IN + 3 * I_SQ + (moe ? (2 * NEXP * I_M13 + NEXP * I_M2E) : (2 * I_D13 + I_D2));
    for (int it = gw; it < total; it += NGW) {
        int r = it;
        if (r < I_IN) { cvt_item(c.in[I_WIN] + (size_t)l * D * DIN, D, DIN, WIN, 0, 0, scr, r, lane); continue; } r -= I_IN;
        if (r < I_SQ) { cvt_item(c.in[I_WPA] + (size_t)l * D * D, D, D, WAB, 0, 0, scr, r, lane); continue; } r -= I_SQ;
        if (r < I_SQ) { cvt_item(c.in[I_WPB] + (size_t)l * D * D, D, D, WAB, 1024, 0, scr, r, lane); continue; } r -= I_SQ;
        if (r < I_SQ) { cvt_item(c.in[I_WOUT] + (size_t)l * D * D, D, D, WO, 0, 0, scr, r, lane); continue; } r -= I_SQ;
        if (!moe) {
            if (r < I_D13) { cvt_item(c.in[I_F1] + (size_t)j * D * DFF, D, DFF, WF, 0, 1, scr, r, lane); continue; } r -= I_D13;
            if (r < I_D13) { cvt_item(c.in[I_F3] + (size_t)j * D * DFF, D, DFF, WF, 128, 1, scr, r, lane); continue; } r -= I_D13;
            cvt_item(c.in[I_F2] + (size_t)j * DFF * D, DFF, D, (bf16*)(c.ws + WS_WF + WF_W2_DENSE), 0, 0, scr, r, lane);
        } else {
            if (r < NEXP * I_M13) { const int e = r / I_M13; cvt_item(c.in[I_M1] + ((size_t)j * NEXP + e) * D * DFE, D, DFE, WF, e * 2 * DFE, 1, scr, r - e * I_M13, lane); continue; } r -= NEXP * I_M13;
            if (r < NEXP * I_M13) { const int e = r / I_M13; cvt_item(c.in[I_M3] + ((size_t)j * NEXP + e) * D * DFE, D, DFE, WF, e * 2 * DFE + 128, 1, scr, r - e * I_M13, lane); continue; } r -= NEXP * I_M13;
            { const int e = r / I_M2E; cvt_item(c.in[I_M2] + ((size_t)j * NEXP + e) * DFE * D, DFE, D, (bf16*)(c.ws + WS_WF + WF_W2_MOE), e * D, 0, scr, r - e * I_M2E, lane); }
        }
    }
}

__device__ __forceinline__ void ld_row_f32(const float* p, int lane, f32x4 (&v)[4]) {
#pragma unroll
    for (int j = 0; j < 4; ++j) v[j] = *(const f32x4*)(p + 4 * lane + 256 * j);
}
__device__ __forceinline__ void ld_row_bf16(const bf16* p, int lane, f32x4 (&v)[4]) {
#pragma unroll
    for (int j = 0; j < 4; ++j) { const v2u w = *(const v2u*)(p + 4 * lane + 256 * j); v[j] = (f32x4){bflo(w.x), bfhi(w.x), bflo(w.y), bfhi(w.y)}; }
}
__device__ __forceinline__ void st_row_bf16(bf16* p, int lane, const f32x4 (&v)[4]) {
#pragma unroll
    for (int j = 0; j < 4; ++j) { v2u w; w.x = pk2(v[j][0], v[j][1]); w.y = pk2(v[j][2], v[j][3]); *(v2u*)(p + 4 * lane + 256 * j) = w; }
}
__device__ __forceinline__ float row_sumsq(const f32x4 (&v)[4]) {
    float s = 0.f;
#pragma unroll
    for (int j = 0; j < 4; ++j) s += (v[j][0] * v[j][0] + v[j][1] * v[j][1]) + (v[j][2] * v[j][2] + v[j][3] * v[j][3]);
    return wave_sum(s);
}
__device__ __forceinline__ void norm_mod(const f32x4 (&x)[4], const f32x4 (&g)[4], const f32x4 (&sc)[4], const f32x4 (&sh)[4], f32x4 (&h)[4]) {
    const float r = rsqrtf(row_sumsq(x) * (1.0f / 1024.0f) + EPS);
#pragma unroll
    for (int j = 0; j < 4; ++j) h[j] = (x[j] * r) * g[j] * (sc[j] + 1.0f) + sh[j];
}
__device__ __forceinline__ const float* modp(const Ctx& c, int l, int b, int which) { return (const float*)(c.ws + WS_MOD) + ((size_t)(l * 8 + b) * 6 + which) * 1024; }

__device__ __forceinline__ void ph_norm0(const Ctx& c) {
    const int tid = TID(), lane = tid & 63, wave = tid >> 6, gw = BID() * NWAVES + wave, NGW = gridDim.x * NWAVES;
    bf16* H = (bf16*)(c.ws + WS_H);
    for (int slot = gw; slot < M / 16; slot += NGW) {
        const int row0 = slot * 16, b = row0 / SEQ;
        f32x4 g[4], sc[4], sh[4]; ld_row_f32(c.in[I_GPREMIX], lane, g); ld_row_f32(modp(c, 0, b, 1), lane, sc); ld_row_f32(modp(c, 0, b, 0), lane, sh);
        for (int r = 0; r < 16; ++r) { f32x4 x[4], h[4]; ld_row_f32(c.in[I_X] + (size_t)(row0 + r) * D, lane, x); norm_mod(x, g, sc, sh, h); st_row_bf16(H + (size_t)(row0 + r) * D, lane, h); }
    }
}
__device__ __forceinline__ void ph_prep(const Ctx& c, int l) {
    const int tid = TID(), lane = tid & 63, wave = tid >> 6, gw = BID() * NWAVES + wave, NGW = gridDim.x * NWAVES;
    const bf16* XM = (const bf16*)(c.ws + WS_PROJ) + (size_t)P_XM * PSTRIDE;
    bf16* MQ = (bf16*)(c.ws + WS_MQ); bf16* MK = (bf16*)(c.ws + WS_MK); bf16* MV = (bf16*)(c.ws + WS_MV); bf16* XC = (bf16*)(c.ws + WS_XC);
    float* LI = (float*)(c.ws + WS_LI); float* LF = (float*)(c.ws + WS_LF);
    const float* cw = c.in[I_CONVW] + (size_t)l * 4 * D; const float* cb = c.in[I_CONVB] + (size_t)l * D;
    const float* wq = c.in[I_WQ] + (size_t)l * 256 * 16; const float* wk = c.in[I_WK] + (size_t)l * 256 * 16; const float* wv = c.in[I_WV] + (size_t)l * 256 * 16;
    const float* wig = c.in[I_WIG] + (size_t)l * 3072 * 4; const float* wfg = c.in[I_WFG] + (size_t)l * 3072 * 4;
    const f32x4 big = *(const f32x4*)(c.in[I_BIG] + l * 4), bfg = *(const f32x4*)(c.in[I_BFG] + l * 4);
    for (int slot = gw; slot < M / 16; slot += NGW) {
        for (int r = 0; r < 16; ++r) {
            const int row = slot * 16 + r, t = row & (SEQ - 1);
            f32x4 gi = {0.f, 0.f, 0.f, 0.f}, gf = {0.f, 0.f, 0.f, 0.f};
#pragma unroll 1
            for (int j = 0; j < 4; ++j) {
                const int ch = 4 * lane + 256 * j, n = lane + 64 * j;
                f32x4 y = *(const f32x4*)(cb + ch); f32x4 xt = {0.f, 0.f, 0.f, 0.f};
#pragma unroll
                for (int jj = 0; jj < 4; ++jj) {
                    if (t - 3 + jj >= 0) { const v2u w = *(const v2u*)(XM + (size_t)(row - 3 + jj) * D + ch); const f32x4 xv = {bflo(w.x), bfhi(w.x), bflo(w.y), bfhi(w.y)};
                        y += *(const f32x4*)(cw + jj * D + ch) * xv; if (jj == 3) xt = xv; }
                }
                f32x4 xc; xc[0] = y[0] * fsigm(y[0]); xc[1] = y[1] * fsigm(y[1]); xc[2] = y[2] * fsigm(y[2]); xc[3] = y[3] * fsigm(y[3]);
                f32x4 q = {0.f, 0.f, 0.f, 0.f}, k = q, v = q;
#pragma unroll
                for (int i = 0; i < 4; ++i) { q += *(const f32x4*)(wq + n * 16 + i * 4) * xc[i]; k += *(const f32x4*)(wk + n * 16 + i * 4) * xc[i]; v += *(const f32x4*)(wv + n * 16 + i * 4) * xt[i]; }
#pragma unroll
                for (int o = 0; o < 4; ++o) {
                    gi += *(const f32x4*)(wig + (size_t)(ch + o) * 4) * q[o] + *(const f32x4*)(wig + (size_t)(1024 + ch + o) * 4) * k[o] + *(const f32x4*)(wig + (size_t)(2048 + ch + o) * 4) * v[o];
                    gf += *(const f32x4*)(wfg + (size_t)(ch + o) * 4) * q[o] + *(const f32x4*)(wfg + (size_t)(1024 + ch + o) * 4) * k[o] + *(const f32x4*)(wfg + (size_t)(2048 + ch + o) * 4) * v[o];
                }
                const size_t off = (size_t)row * D + ch;
                { v2u w; w.x = pk2(q[0], q[1]); w.y = pk2(q[2], q[3]); *(v2u*)(MQ + off) = w; }
                { v2u w; w.x = pk2(k[0] * 0.0625f, k[1] * 0.0625f); w.y = pk2(k[2] * 0.0625f, k[3] * 0.0625f); *(v2u*)(MK + off) = w; }
                { v2u w; w.x = pk2(v[0], v[1]); w.y = pk2(v[2], v[3]); *(v2u*)(MV + off) = w; }
                { v2u w; w.x = pk2(xc[0], xc[1]); w.y = pk2(xc[2], xc[3]); *(v2u*)(XC + off) = w; }
            }
#pragma unroll
            for (int hh = 0; hh < 4; ++hh) { gi[hh] = wave_sum(gi[hh]); gf[hh] = wave_sum(gf[hh]); }
            gi += big; gf += bfg;
            if (lane < 4) { const float z = lane == 0 ? gf[0] : lane == 1 ? gf[1] : lane == 2 ? gf[2] : gf[3]; const float li = lane == 0 ? gi[0] : lane == 1 ? gi[1] : lane == 2 ? gi[2] : gi[3];
                LI[(size_t)row * 4 + lane] = li; LF[(size_t)row * 4 + lane] = fminf(z, 0.f) - __logf(1.0f + __expf(-fabsf(z))); }
        }
    }
}

__device__ __forceinline__ void ph_scan_a(const Ctx& c, LAS unsigned char* lds) {
    const int tid = TID();
    bf16* PJ = (bf16*)(c.ws + WS_PROJ);
    const bf16* Q = PJ + (size_t)P_QA * PSTRIDE; const bf16* LFp = PJ + (size_t)P_LF * PSTRIDE; bf16* V = PJ + (size_t)P_VA * PSTRIDE;
    LAS bf16* sq = (LAS bf16*)lds;
    LAS bf16* sf = (LAS bf16*)(lds + 32768);
    LAS bf16* sv = (LAS bf16*)(lds + 65536);
    LAS float* so = (LAS float*)(lds + 73728);
    const int dg = tid & 15, vv = tid >> 4;
    for (int u = BID(); u < 256; u += gridDim.x) {
        const int b = u >> 5, h = (u >> 2) & 7, vs = u & 3;
        const size_t rowbase = (size_t)b * SEQ;
        float S[8];
#pragma unroll
        for (int j = 0; j < 8; ++j) S[j] = 0.f;
        v4u rq[2], rf[2], rv = {0u, 0u, 0u, 0u};
#define SA_LOAD(ch) do { _Pragma("unroll") for (int k2 = 0; k2 < 2; ++k2) { const int p = tid + NTHR * k2, rr = p >> 4, c8 = p & 15; const size_t o_ = (rowbase + (size_t)(ch) * 64 + rr) * D + h * 128 + c8 * 8; \
            rq[k2] = *(const v4u*)(Q + o_); rf[k2] = *(const v4u*)(LFp + o_); } \
            if (tid < 256) { const int rr = tid >> 2, c8 = tid & 3; rv = *(const v4u*)(V + (rowbase + (size_t)(ch) * 64 + rr) * D + h * 128 + vs * 32 + c8 * 8); } } while (0)
        SA_LOAD(0);
        for (int ch = 0; ch < 64; ++ch) {
            const int buf = ch & 1;
#pragma unroll
            for (int k2 = 0; k2 < 2; ++k2) { const int p = tid + NTHR * k2; *(LAS v4u*)(sq + buf * 8192 + p * 8) = rq[k2]; *(LAS v4u*)(sf + buf * 8192 + p * 8) = rf[k2]; }
            if (tid < 256) *(LAS v4u*)(sv + buf * 2048 + tid * 8) = rv;
            __syncthreads();
            if (ch + 1 < 64) SA_LOAD(ch + 1);
            for (int i = 0; i < 64; ++i) {
                const v4u qv = *(const LAS v4u*)(sq + buf * 8192 + i * 128 + dg * 8), fv = *(const LAS v4u*)(sf + buf * 8192 + i * 128 + dg * 8);
                const float vt = bf2f(sv[buf * 2048 + i * 32 + vv]);
                const float qq[8] = {bflo(qv.x), bfhi(qv.x), bflo(qv.y), bfhi(qv.y), bflo(qv.z), bfhi(qv.z), bflo(qv.w), bfhi(qv.w)};
                const float ff[8] = {bflo(fv.x), bfhi(fv.x), bflo(fv.y), bfhi(fv.y), bflo(fv.z), bfhi(fv.z), bflo(fv.w), bfhi(fv.w)};
                float o = 0.f;
#pragma unroll
                for (int j = 0; j < 8; ++j) { const float f = __expf(ff[j]); S[j] = f * S[j] + (1.0f - f) * vt; o += S[j] * qq[j]; }
                o = sum16(o);
                if (dg == 0) so[i * 32 + vv] = o;
            }
            __syncthreads();
            { const int rr = tid >> 3, c4 = (tid & 7) * 4; const f32x4 ov = *(const LAS f32x4*)(so + rr * 32 + c4);
                v2u w; w.x = pk2(ov[0], ov[1]); w.y = pk2(ov[2], ov[3]); *(v2u*)(V + (rowbase + (size_t)ch * 64 + rr) * D + h * 128 + vs * 32 + c4) = w; }
        }
#undef SA_LOAD
        __syncthreads();
    }
}

__device__ __forceinline__ void ph_scan_m(const Ctx& c, LAS unsigned char* lds) {
    const int tid = TID();
    const bf16* MQ = (const bf16*)(c.ws + WS_MQ); const bf16* MK = (const bf16*)(c.ws + WS_MK); bf16* MV = (bf16*)(c.ws + WS_MV);
    const float* LI = (const float*)(c.ws + WS_LI); const float* LF = (const float*)(c.ws + WS_LF);
    LAS bf16* sq = (LAS bf16*)lds;
    LAS bf16* sk = (LAS bf16*)(lds + 32768);
    LAS bf16* sv = (LAS bf16*)(lds + 65536);
    LAS float* sli = (LAS float*)(lds + 69632);
    LAS float* slf = (LAS float*)(lds + 69888);
    LAS float* so = (LAS float*)(lds + 70144);
    const int dg = tid & 15, vv = tid >> 4;
    for (int u = BID(); u < 256; u += gridDim.x) {
        const int b = u >> 5, h = (u >> 3) & 3, vs = u & 7;
        const size_t rowbase = (size_t)b * SEQ;
        float C[16], nn[16], m = 0.f;
#pragma unroll
        for (int j = 0; j < 16; ++j) { C[j] = 0.f; nn[j] = 0.f; }
        v4u rq[4], rk[4], rv = {0u, 0u, 0u, 0u}; float rli = 0.f, rlf = 0.f;
#define SM_LOAD(ch) do { _Pragma("unroll") for (int k2 = 0; k2 < 4; ++k2) { const int p = tid + NTHR * k2, rr = p >> 5, c8 = p & 31; const size_t o_ = (rowbase + (size_t)(ch) * 64 + rr) * D + h * 256 + c8 * 8; \
            rq[k2] = *(const v4u*)(MQ + o_); rk[k2] = *(const v4u*)(MK + o_); } \
            if (tid < 256) { const int rr = tid >> 2, c8 = tid & 3; rv = *(const v4u*)(MV + (rowbase + (size_t)(ch) * 64 + rr) * D + h * 256 + vs * 32 + c8 * 8); } \
            if (tid < 64) { rli = LI[(rowbase + (size_t)(ch) * 64 + tid) * 4 + h]; rlf = LF[(rowbase + (size_t)(ch) * 64 + tid) * 4 + h]; } } while (0)
        SM_LOAD(0);
        for (int ch = 0; ch < 64; ++ch) {
#pragma unroll
            for (int k2 = 0; k2 < 4; ++k2) { const int p = tid + NTHR * k2; *(LAS v4u*)(sq + p * 8) = rq[k2]; *(LAS v4u*)(sk + p * 8) = rk[k2]; }
            if (tid < 256) *(LAS v4u*)(sv + tid * 8) = rv;
            if (tid < 64) { sli[tid] = rli; slf[tid] = rlf; }
            __syncthreads();
            if (ch + 1 < 64) SM_LOAD(ch + 1);
            for (int i = 0; i < 64; ++i) {
                const float li = sli[i], lf = slf[i];
                const float mn = fmaxf(lf + m, li), fg = __expf(lf + m - mn), ig = __expf(li - mn); m = mn;
                const float vt = bf2f(sv[i * 32 + vv]) * ig;
                float num = 0.f, den = 0.f;
#pragma unroll
                for (int hh = 0; hh < 2; ++hh) {
                    const v4u qv = *(const LAS v4u*)(sq + i * 256 + dg * 16 + hh * 8), kv = *(const LAS v4u*)(sk + i * 256 + dg * 16 + hh * 8);
                    const float qq[8] = {bflo(qv.x), bfhi(qv.x), bflo(qv.y), bfhi(qv.y), bflo(qv.z), bfhi(qv.z), bflo(qv.w), bfhi(qv.w)};
                    const float kk[8] = {bflo(kv.x), bfhi(kv.x), bflo(kv.y), bfhi(kv.y), bflo(kv.z), bfhi(kv.z), bflo(kv.w), bfhi(kv.w)};
#pragma unroll
                    for (int j = 0; j < 8; ++j) { const int jj = hh * 8 + j; C[jj] = fg * C[jj] + kk[j] * vt; nn[jj] = fg * nn[jj] + ig * kk[j]; num += qq[j] * C[jj]; den += qq[j] * nn[jj]; }
                }
                num = sum16(num); den = sum16(den);
                if (dg == 0) so[i * 32 + vv] = num / fmaxf(fabsf(den), __expf(-m));
            }
            __syncthreads();
            { const int rr = tid >> 3, c4 = (tid & 7) * 4; const f32x4 ov = *(const LAS f32x4*)(so + rr * 32 + c4);
                v2u w; w.x = pk2(ov[0], ov[1]); w.y = pk2(ov[2], ov[3]); *(v2u*)(MV + (rowbase + (size_t)ch * 64 + rr) * D + h * 256 + vs * 32 + c4) = w; }
        }
#undef SM_LOAD
        __syncthreads();
    }
}

__device__ __forceinline__ void ph_post(const Ctx& c, int l) {
    const int tid = TID(), lane = tid & 63, wave = tid >> 6, gw = BID() * NWAVES + wave, NGW = gridDim.x * NWAVES;
    bf16* PJ = (bf16*)(c.ws + WS_PROJ);
    const bf16* OA = PJ + (size_t)P_VA * PSTRIDE; const bf16* GS = PJ + (size_t)P_GA * PSTRIDE; const bf16* OS = PJ + (size_t)P_OS * PSTRIDE;
    bf16* AO = PJ + (size_t)P_QA * PSTRIDE; bf16* BO = PJ + (size_t)P_LF * PSTRIDE;
    const bf16* HM = (const bf16*)(c.ws + WS_MV); const bf16* XC = (const bf16*)(c.ws + WS_XC);
    f32x4 gna[4], gnm[4], skp[4]; ld_row_f32(c.in[I_HGN] + (size_t)l * D, lane, gna); ld_row_f32(c.in[I_MGN] + (size_t)l * D, lane, gnm); ld_row_f32(c.in[I_MSKIP] + (size_t)l * D, lane, skp);
    for (int slot = gw; slot < M / 16; slot += NGW) {
        for (int r = 0; r < 16; ++r) {
            const size_t ro = (size_t)(slot * 16 + r) * D;
            f32x4 oa[4], gs[4], hm[4], xc[4], os[4], ao[4], bo[4];
            ld_row_bf16(OA + ro, lane, oa); ld_row_bf16(GS + ro, lane, gs); ld_row_bf16(HM + ro, lane, hm); ld_row_bf16(XC + ro, lane, xc); ld_row_bf16(OS + ro, lane, os);
#pragma unroll
            for (int j = 0; j < 4; ++j) {
                const float ss = half_sum((oa[j][0] * oa[j][0] + oa[j][1] * oa[j][1]) + (oa[j][2] * oa[j][2] + oa[j][3] * oa[j][3]));
                const float ra = rsqrtf(ss * (1.0f / 128.0f) + EPS);
                ao[j] = oa[j] * ra * gna[j] * gs[j];
                const float mu = wave_sum((hm[j][0] + hm[j][1]) + (hm[j][2] + hm[j][3])) * (1.0f / 256.0f);
                const f32x4 d = hm[j] - mu;
                const float var = wave_sum((d[0] * d[0] + d[1] * d[1]) + (d[2] * d[2] + d[3] * d[3])) * (1.0f / 256.0f);
                const float rb = rsqrtf(var + EPS);
                bo[j] = os[j] * (d * rb * gnm[j] + skp[j] * xc[j]);
            }
            st_row_bf16(AO + ro, lane, ao); st_row_bf16(BO + ro, lane, bo);
        }
    }
}
constexpr int TAB_OFF = MISC_OFF + 256;
__device__ __forceinline__ void moe_tables(const Ctx& c, int jm, LAS unsigned char* lds) {
    LAS int* tab = (LAS int*)(lds + TAB_OFF);
    __syncthreads();
    if (TID() == 0) { unsigned* cnt = (unsigned*)c.ws + CW_CNT + 64 * jm; int accp = 0;
        for (int e = 0; e < 8; ++e) { const int n = (int)__hip_atomic_load(cnt + e, __ATOMIC_RELAXED, __HIP_MEMORY_SCOPE_AGENT); const int p = (n + 255) >> 8; tab[e] = p; tab[8 + e] = accp; accp += p; }
        tab[16] = accp; }
    __syncthreads();
}
__device__ __forceinline__ void ph_res1(const Ctx& c, int l, LAS unsigned char* lds) {
    const int tid = TID(), lane = tid & 63, wave = tid >> 6, gw = BID() * NWAVES + wave, NGW = gridDim.x * NWAVES;
    const bool moe = (l & 1) != 0; const int jm = l >> 1;
    LAS float* rt = (LAS float*)lds;
    if (moe) { const f32x4* src = (const f32x4*)(c.in[I_ROUTER] + (size_t)jm * D * NEXP); for (int i = tid; i < D * NEXP / 4; i += NTHR) ((LAS f32x4*)rt)[i] = src[i]; }
    __syncthreads();
    const float* xin = (l == 0) ? c.in[I_X] : c.out;
    const bf16* Y = (const bf16*)(c.ws + WS_PROJ) + (size_t)P_OS * PSTRIDE; bf16* H = (bf16*)(c.ws + WS_H);
    unsigned* cnt = (unsigned*)c.ws + CW_CNT + 64 * jm;
    int* TOKEP = (int*)(c.ws + WS_TOKEP); float* TOKW = (float*)(c.ws + WS_TOKW);
    for (int slot = gw; slot < M / 16; slot += NGW) {
        const int row0 = slot * 16, b = row0 / SEQ;
        f32x4 gpm[4], gt[4], gpf[4], scf[4], shf[4];
        ld_row_f32(c.in[I_GPOSTMIX] + (size_t)l * D, lane, gpm); ld_row_f32(modp(c, l, b, 2), lane, gt); ld_row_f32(c.in[I_GPREFFN] + (size_t)l * D, lane, gpf);
        ld_row_f32(modp(c, l, b, 4), lane, scf); ld_row_f32(modp(c, l, b, 3), lane, shf);
        for (int r = 0; r < 16; ++r) {
            const int row = row0 + r; const size_t ro = (size_t)row * D;
            f32x4 y[4], x[4], h[4]; ld_row_bf16(Y + ro, lane, y); ld_row_f32(xin + ro, lane, x);
            const float rr = rsqrtf(row_sumsq(y) * (1.0f / 1024.0f) + EPS);
#pragma unroll
            for (int j = 0; j < 4; ++j) { x[j] = x[j] + gt[j] * (y[j] * rr * gpm[j]); *(f32x4*)(c.out + ro + 4 * lane + 256 * j) = x[j]; }
            norm_mod(x, gpf, scf, shf, h); st_row_bf16(H + ro, lane, h);
            if (moe) {
                f32x4 l0 = {0.f, 0.f, 0.f, 0.f}, l1 = l0;
#pragma unroll
                for (int j = 0; j < 4; ++j)
#pragma unroll
                    for (int i = 0; i < 4; ++i) { const int ch = 4 * lane + 256 * j + i; l0 += *(const LAS f32x4*)(rt + ch * 8) * h[j][i]; l1 += *(const LAS f32x4*)(rt + ch * 8 + 4) * h[j][i]; }
                float lg[8];
#pragma unroll
                for (int e = 0; e < 4; ++e) { lg[e] = wave_sum(l0[e]); lg[4 + e] = wave_sum(l1[e]); }
                int i1 = 0; float v1 = lg[0];
#pragma unroll
                for (int e = 1; e < 8; ++e) if (lg[e] > v1) { v1 = lg[e]; i1 = e; }
                int i2 = -1; float v2 = -3.0e38f;
#pragma unroll
                for (int e = 0; e < 8; ++e) if (e != i1 && lg[e] > v2) { v2 = lg[e]; i2 = e; }
                if (lane == 0) { const float w1 = 1.0f / (1.0f + __expf(v2 - v1));
                    const int p1 = (int)atomicAdd(cnt + i1, 1u), p2 = (int)atomicAdd(cnt + i2, 1u);
                    *(int4*)(TOKEP + (size_t)row * 4) = make_int4(i1, p1, i2, p2); *(float2*)(TOKW + (size_t)row * 2) = make_float2(w1, 1.0f - w1); }
            }
        }
    }
}
__device__ __forceinline__ void ph_gather(const Ctx& c, int l, LAS unsigned char* lds) {
    const int tid = TID(), lane = tid & 63, wave = tid >> 6, gw = BID() * NWAVES + wave, NGW = gridDim.x * NWAVES;
    moe_tables(c, l >> 1, lds); const LAS int* tab = (const LAS int*)(lds + TAB_OFF);
    const bf16* H = (const bf16*)(c.ws + WS_H); bf16* AG = (bf16*)(c.ws + WS_AG);
    const int* TOKEP = (const int*)(c.ws + WS_TOKEP); int* TOKD = (int*)(c.ws + WS_TOKD);
    for (int row = gw; row < M; row += NGW) {
        const int4 ep = *(const int4*)(TOKEP + (size_t)row * 4);
        const int d1 = tab[8 + ep.x] * 256 + ep.y, d2 = tab[8 + ep.z] * 256 + ep.w;
        const v4u a = *(const v4u*)(H + (size_t)row * D + lane * 8), b = *(const v4u*)(H + (size_t)row * D + 512 + lane * 8);
        *(v4u*)(AG + (size_t)d1 * D + lane * 8) = a; *(v4u*)(AG + (size_t)d1 * D + 512 + lane * 8) = b;
        *(v4u*)(AG + (size_t)d2 * D + lane * 8) = a; *(v4u*)(AG + (size_t)d2 * D + 512 + lane * 8) = b;
        if (lane == 0) *(int2*)(TOKD + (size_t)row * 2) = make_int2(d1, d2);
    }
}
__device__ __forceinline__ void ph_res2(const Ctx& c, int l) {
    const int tid = TID(), lane = tid & 63, wave = tid >> 6, gw = BID() * NWAVES + wave, NGW = gridDim.x * NWAVES;
    const bool moe = (l & 1) != 0;
    const bf16* Y2 = (const bf16*)(c.ws + WS_PROJ) + (size_t)4 * PSTRIDE; const bf16* YS = (const bf16*)(c.ws + WS_YS); bf16* H = (bf16*)(c.ws + WS_H);
    const int* TOKD = (const int*)(c.ws + WS_TOKD); const float* TOKW = (const float*)(c.ws + WS_TOKW);
    const int ln = (l + 1 < DEPTH) ? l + 1 : l;
    for (int slot = gw; slot < M / 16; slot += NGW) {
        const int row0 = slot * 16, b = row0 / SEQ;
        f32x4 gpo[4], gt[4], gpm[4], scm[4], shm[4];
        ld_row_f32(c.in[I_GPOSTFFN] + (size_t)l * D, lane, gpo); ld_row_f32(modp(c, l, b, 5), lane, gt); ld_row_f32(c.in[I_GPREMIX] + (size_t)ln * D, lane, gpm);
        ld_row_f32(modp(c, ln, b, 1), lane, scm); ld_row_f32(modp(c, ln, b, 0), lane, shm);
        for (int r = 0; r < 16; ++r) {
            const int row = row0 + r; const size_t ro = (size_t)row * D;
            f32x4 y[4], x[4], h[4];
            if (moe) { const int2 d = *(const int2*)(TOKD + (size_t)row * 2); const float2 w = *(const float2*)(TOKW + (size_t)row * 2);
                f32x4 ya[4], yb[4]; ld_row_bf16(YS + (size_t)d.x * D, lane, ya); ld_row_bf16(YS + (size_t)d.y * D, lane, yb);
#pragma unroll
                for (int j = 0; j < 4; ++j) y[j] = ya[j] * w.x + yb[j] * w.y; }
            else ld_row_bf16(Y2 + ro, lane, y);
            ld_row_f32(c.out + ro, lane, x);
            const float rr = rsqrtf(row_sumsq(y) * (1.0f / 1024.0f) + EPS);
#pragma unroll
            for (int j = 0; j < 4; ++j) { x[j] = x[j] + gt[j] * (y[j] * rr * gpo[j]); *(f32x4*)(c.out + ro + 4 * lane + 256 * j) = x[j]; }
            if (l + 1 < DEPTH) { norm_mod(x, gpm, scm, shm, h); st_row_bf16(H + ro, lane, h); }
        }
    }
}

constexpr int PH_PER_LAYER = 12, NPH = 2 + DEPTH * PH_PER_LAYER;
__global__ void __launch_bounds__(NTHR, 2) fwd(Ctx c) {
    extern __shared__ __attribute__((aligned(16))) unsigned char lds_raw[];
    LAS unsigned char* lds = (LAS unsigned char*)lds_raw;
    volatile LAS unsigned* MISC = (volatile LAS unsigned*)(lds + MISC_OFF);
    if (threadIdx.x < 64) MISC[threadIdx.x] = 0u;
    __syncthreads();
    const int lo = c.ph_lo, hi = c.ph_hi, G = gridDim.x;
    XcdBarrier bar; bar.bar = (unsigned*)c.ws + CW_BAR; bar.x = 0; bar.st = MISC + 8;
    if (hi - lo > 1) bar = xcd_barrier_post((unsigned*)c.ws + CW_BAR, MISC + 8);
#ifndef PH_MASK
#define PH_MASK 0xFFFF
#endif
#define IN(p) (lo <= (p) && (p) < hi)
#define ON(k) ((PH_MASK >> (k)) & 1)
#define BAR_AFTER(p) do { if ((p) + 1 < hi) xcd_barrier(bar); } while (0)
    if (ON(12) && IN(0)) { ph_mod(c, lds); ph_lb(c); ph_cvt(c, 0, lds); BAR_AFTER(0); }
    if (ON(13) && IN(1)) { ph_norm0(c); BAR_AFTER(1); }
    for (int l = 0; l < DEPTH; ++l) {
        const int base = 2 + l * PH_PER_LAYER; const bool moe = (l & 1) != 0;
        Ctx cl = c; cl.ws = opq_p(c.ws); cl.out = (float*)opq_p((unsigned char*)c.out);
        unsigned char* ws = cl.ws; bf16* PJ = (bf16*)(ws + WS_PROJ); const int bid = BID();
        int KD = opq_s(D);
        if (ON(0) && IN(base + 0)) {
            pg8::Gemm g{(const bf16*)(ws + WS_H), (const bf16*)(ws + WS_WIN), M, DIN, KD}; pg8::UOrder S; S.init(0, M, DIN, G, bid);
            pg8::EpiWin E{PJ, (const float*)(ws + WS_LB) + l * 1024, PSTRIDE};
            pg8::gemm_phase<pg8::EpiWin, pg8::UOrder, true, true>(lds, g, S, E);
            BAR_AFTER(base + 0); }
        if (ON(1) && IN(base + 1)) { ph_prep(cl, l); BAR_AFTER(base + 1); }
        if (ON(2) && IN(base + 2)) { ph_scan_a(cl, lds); BAR_AFTER(base + 2); }
        if (ON(3) && IN(base + 3)) { ph_scan_m(cl, lds); BAR_AFTER(base + 3); }
        if (ON(4) && IN(base + 4)) { ph_post(cl, l); BAR_AFTER(base + 4); }
        if (ON(5) && IN(base + 5)) {
            pg8::Gemm g{PJ + (size_t)P_QA * PSTRIDE, (const bf16*)(ws + WS_WAB), M, D, KD}; pg8::UOrder S; S.init(1, M, D, G, bid);
            pg8::EpiProj E{PJ + (size_t)P_GTA * PSTRIDE, PSTRIDE, (float*)(PJ + (size_t)P_GA * PSTRIDE), PJ + (size_t)P_VA * PSTRIDE};
            pg8::gemm_phase<pg8::EpiProj, pg8::UOrder, true, true>(lds, g, S, E);
            BAR_AFTER(base + 5); }
        if (ON(6) && IN(base + 6)) {
            pg8::Gemm g{PJ + (size_t)P_VA * PSTRIDE, (const bf16*)(ws + WS_WO), M, D, KD}; pg8::UOrder S; S.init(0, M, D, G, bid);
            pg8::EpiPlain E{PJ + (size_t)P_OS * PSTRIDE, D};
            pg8::gemm_phase<pg8::EpiPlain, pg8::UOrder, true, true>(lds, g, S, E);
            BAR_AFTER(base + 6); }
        if (ON(7) && IN(base + 7)) { ph_res1(cl, l, lds); BAR_AFTER(base + 7); }
        if (ON(8) && IN(base + 8) && moe) { ph_gather(cl, l, lds); BAR_AFTER(base + 8); }
        if (ON(9) && IN(base + 9)) {
            pg8::Gemm g{(const bf16*)(ws + (moe ? WS_AG : WS_H)), (const bf16*)(ws + WS_WF), M, 2 * DFF, KD}; pg8::UOrder S; S.init(0, M, 2 * DFF, G, bid);
            pg8::EpiSwi E{PJ, moe ? DFE : DFF, moe ? 28 : 22};
            if (moe) { moe_tables(cl, l >> 1, lds); S.mode = 2; S.NT = 28; S.tab = (const LAS int*)(lds + TAB_OFF); S.nwg = __builtin_amdgcn_readfirstlane(S.tab[16]) * 28; }
            pg8::gemm_phase<pg8::EpiSwi, pg8::UOrder, true, true>(lds, g, S, E);
            BAR_AFTER(base + 9); }
        if (ON(10) && IN(base + 10)) {
            pg8::Gemm g{PJ, (const bf16*)(ws + WS_WF + (moe ? WF_W2_MOE : WF_W2_DENSE)), M, D, moe ? DFE : DFF}; pg8::UOrder S; S.init(0, M, D, G, bid);
            pg8::EpiPlain E{moe ? (bf16*)(ws + WS_YS) : PJ + (size_t)4 * PSTRIDE, D};
            if (moe) { moe_tables(cl, l >> 1, lds); S.mode = 2; S.NT = 4; S.tab = (const LAS int*)(lds + TAB_OFF); S.nwg = __builtin_amdgcn_readfirstlane(S.tab[16]) * 4; }
            pg8::gemm_phase<pg8::EpiPlain, pg8::UOrder, true, true>(lds, g, S, E);
            BAR_AFTER(base + 10); }
        if (ON(11) && IN(base + 11)) { ph_res2(cl, l); if (l + 1 < DEPTH) ph_cvt(cl, l + 1, lds); BAR_AFTER(base + 11); }
    }
#undef IN
#undef BAR_AFTER
}

#ifndef MK_ONE_LAUNCH
#define MK_ONE_LAUNCH 0
#endif
extern "C" void kernel_launch(void* const* d_in, const int* in_sizes, int n_in, void* d_out, int out_size, void* d_ws, size_t ws_size, hipStream_t stream) {
    static int grid = 0;
    if (grid == 0) {
        if (n_in != 32 || in_sizes[0] != M * D || out_size != M * D || ws_size < WS_END) { fprintf(stderr, "kernel_launch: unexpected shapes / workspace (%d inputs, ws %zu < %zu)\n", n_in, ws_size, (size_t)WS_END); grid = -1; return; }
        int dev = 0, cus = 0;
        if (hipGetDevice(&dev) != hipSuccess || hipDeviceGetAttribute(&cus, hipDeviceAttributeMultiprocessorCount, dev) != hipSuccess) { grid = -1; return; }
        if (hipFuncSetAttribute((const void*)fwd, hipFuncAttributeMaxDynamicSharedMemorySize, LDS_BYTES) != hipSuccess) { fprintf(stderr, "kernel_launch: hipFuncSetAttribute failed\n"); grid = -1; return; }
        (void)hipGetLastError();
        grid = cus;
    }
    if (grid < 0) return;
    if (hipMemsetAsync((char*)d_ws + WS_CTL, 0, CTL_ZERO_BYTES, stream) != hipSuccess) return;
    Ctx c{};
    for (int i = 0; i < 32; ++i) c.in[i] = (const float*)d_in[i];
    c.out = (float*)d_out; c.ws = (unsigned char*)d_ws;
#if MK_ONE_LAUNCH
    c.ph_lo = 0; c.ph_hi = NPH;
    hipLaunchKernelGGL(fwd, dim3(grid), dim3(NTHR), LDS_BYTES, stream, c);
#else
    for (int p = 0; p < NPH; ++p) {
        if (p >= 2) { const int l = (p - 2) / PH_PER_LAYER, k = (p - 2) % PH_PER_LAYER; if (k == 8 && !(l & 1)) continue; }
        c.ph_lo = p; c.ph_hi = p + 1;
        hipLaunchKernelGGL(fwd, dim3(grid), dim3(NTHR), LDS_BYTES, stream, c);
    }
#endif
}
```

```cpp
#include <hip/hip_runtime.h>
#include <cstdio>
#include <cstdint>
namespace pg8 {
#define PG8_LAS __attribute__((address_space(3)))
typedef unsigned short bf16_t;
typedef short bf16x8 __attribute__((ext_vector_type(8)));
typedef float f32x4 __attribute__((ext_vector_type(4)));
typedef unsigned u32x4 __attribute__((ext_vector_type(4)));
constexpr int BM = 256, BK = 64, HALF = 128, HTB = HALF * BK * 2  , STAGE_BYTES = 8 * HTB, NXCD = 8, WGM = 8;

__host__ __device__ __forceinline__ int lds_byte(int r, int c) { const int st = (r >> 4) * 2 + (c >> 5), rr = r & 15, cc = c & 31, ob = rr * 64 + cc * 2; return st * 1024 + (ob ^ (((ob >> 9) & 1) << 5)); }
__host__ __device__ __forceinline__ void stage_rc(int b, int& R, int& C) { const int st = b / 1024, sb = b % 1024, swz = sb ^ (((sb >> 9) & 1) << 5); R = (st >> 1) * 16 + swz / 64; C = (st & 1) * 32 + (swz % 64) / 2; }
__host__ __device__ __forceinline__ int perm32(int rho) { const int n = rho >> 4, i = rho & 15; return 8 * (i >> 2) + 4 * n + (i & 3); }

struct Unit { int pm, pn; };
struct Gemm { const bf16_t* A; const bf16_t* Bt; int M, N, K; };

struct StaticOrder {
    int nM, nN, nwg, G, c;
    __host__ __device__ void init(int M, int N, int G_, int c_) { nM = M / BM; nN = N / BM; nwg = nM * nN; G = G_; c = c_; }
    __host__ __device__ bool next(int i, Unit& u) const {
        const long L = (long)i * G + c; if (L >= nwg) return false;
        int wgid = (int)L; { const int q = nwg / NXCD, r = nwg % NXCD, xcd = wgid % NXCD, off = wgid / NXCD; wgid = (xcd < r ? xcd * (q + 1) : r * (q + 1) + (xcd - r) * q) + off; }
        const int nig = WGM * nN, gid = wgid / nig, fm = gid * WGM, gsz = (nM - fm) < WGM ? (nM - fm) : WGM;
        u.pm = fm + ((wgid % nig) % gsz); u.pn = (wgid % nig) / gsz; return true;
    }
    __device__ __forceinline__ void a_ready(const Unit&) const {}
    __device__ __forceinline__ void done(const Unit&) const {}
};
__device__ __forceinline__ unsigned cvt_pk_bf16(float lo, float hi) { unsigned r; asm volatile("v_cvt_pk_bf16_f32 %0, %1, %2" : "=v"(r) : "v"(lo), "v"(hi)); return r; }
struct UOrder {
    int mode, nM, nN, nwg, G, c, NT; const PG8_LAS int* tab;
    __device__ __forceinline__ void init(int mode_, int M, int N, int G_, int c_) { mode = mode_; nM = M / BM; nN = N / BM; nwg = nM * nN; G = G_; c = c_; NT = 1; tab = nullptr; }
    __device__ __forceinline__ bool next(int i, Unit& u) const {
        const int which = (mode == 1) ? (i & 1) : 0; const int ii = (mode == 1) ? (i >> 1) : i;
        const long L = (long)ii * G + c; if (L >= nwg) return false;
        int wgid = (int)L; { const int q = nwg / NXCD, r = nwg % NXCD, xcd = wgid % NXCD, off = wgid / NXCD; wgid = (xcd < r ? xcd * (q + 1) : r * (q + 1) + (xcd - r) * q) + off; }
        if (mode == 2) {
            int r = wgid, E = 0;
#pragma unroll
            for (int k = 0; k < 7; ++k) { const int uk = tab[k] * NT; if (E == k && r >= uk) { r -= uk; E = k + 1; } }
            const int P = tab[E], B = tab[8 + E];
            const int nig = WGM * NT, gid = r / nig, fm = gid * WGM, gsz = (P - fm) < WGM ? (P - fm) : WGM, rr = r - gid * nig;
            u.pm = __builtin_amdgcn_readfirstlane(B + fm + rr % gsz); u.pn = __builtin_amdgcn_readfirstlane(E * NT + rr / gsz); return true;
        }
        const int nig = WGM * nN, gid = wgid / nig, fm = gid * WGM, gsz = (nM - fm) < WGM ? (nM - fm) : WGM;
        u.pm = fm + ((wgid % nig) % gsz); u.pn = (wgid % nig) / gsz;
        if (which) { u.pm += nM; u.pn += nN; }
        return true;
    }
    __device__ __forceinline__ void a_ready(const Unit&) const {}
    __device__ __forceinline__ void done(const Unit&) const {}
};

__device__ __forceinline__ float fsig(float v) { return __builtin_amdgcn_rcpf(1.0f + __expf(-v)); }
__device__ __forceinline__ float bflo(unsigned w) { return __uint_as_float(w << 16); }
__device__ __forceinline__ float bfhi(unsigned w) { return __uint_as_float(w & 0xffff0000u); }
#define PG8_X8(x, ai, bj, m) float x[8]; { const f32x4 _a = acc[ai][bj][m][0], _b = acc[ai][bj][m][1]; x[0] = _a[0]; x[1] = _a[1]; x[2] = _a[2]; x[3] = _a[3]; x[4] = _b[0]; x[5] = _b[1]; x[6] = _b[2]; x[7] = _b[3]; }
#define PG8_PACK8(w, x) u32x4 w; w.x = cvt_pk_bf16(x[0], x[1]); w.y = cvt_pk_bf16(x[2], x[3]); w.z = cvt_pk_bf16(x[4], x[5]); w.w = cvt_pk_bf16(x[6], x[7]);

struct EpiWin {
    static constexpr bool PERM = true, AFTER_DRAIN = false;
    bf16_t* P; const float* lb; size_t pstride;
    __device__ __forceinline__ void operator()(const f32x4 (&acc)[2][2][4][2], const Unit& u, int wr, int wc, int fr, int fq) const {
        const int part = u.pn >> 2;
        const int mode = (part == 0 || part == 3) ? 1 : (part == 1) ? 3 : (part >= 5) ? 2 : 0;
        bf16_t* base = P + (size_t)part * pstride;
        const int row0 = u.pm * BM + wr * 64 + fr, col0 = (u.pn & 3) * BM + wc * 32 + 8 * fq;
        float lbv[2][8];
#pragma unroll
        for (int bj = 0; bj < 2; ++bj)
#pragma unroll
            for (int j = 0; j < 8; ++j) lbv[bj][j] = 0.f;
        if (mode == 3) {
#pragma unroll
            for (int bj = 0; bj < 2; ++bj) { const f32x4 a = *(const f32x4*)(lb + col0 + bj * HALF), b = *(const f32x4*)(lb + col0 + bj * HALF + 4);
                lbv[bj][0] = a[0]; lbv[bj][1] = a[1]; lbv[bj][2] = a[2]; lbv[bj][3] = a[3]; lbv[bj][4] = b[0]; lbv[bj][5] = b[1]; lbv[bj][6] = b[2]; lbv[bj][7] = b[3]; }
        }
#pragma unroll
        for (int ai = 0; ai < 2; ++ai)
#pragma unroll
            for (int m = 0; m < 4; ++m) { bf16_t* rowp = base + (size_t)(row0 + ai * HALF + m * 16) * 1024 + col0;
#pragma unroll
                for (int bj = 0; bj < 2; ++bj) { PG8_X8(x, ai, bj, m)
                    if (mode != 0) {
#pragma unroll
                        for (int j = 0; j < 8; ++j) { const float s = fsig(x[j]);
                            if (mode == 1) x[j] = x[j] * s; else if (mode == 2) x[j] = s; else x[j] = fmaxf(__logf(lbv[bj][j] + (1.0f - lbv[bj][j]) * s), -30.0f); } }
                    PG8_PACK8(w, x) *(u32x4*)(rowp + bj * HALF) = w; } }
    }
};
struct EpiProj {
    static constexpr bool PERM = true, AFTER_DRAIN = false;
    const bf16_t* gates; size_t pstride; float* T1; bf16_t* MX;
    __device__ __forceinline__ void operator()(const f32x4 (&acc)[2][2][4][2], const Unit& u, int wr, int wc, int fr, int fq) const {
        const int which = u.pn >> 2;
        const bf16_t* g = gates + (size_t)which * pstride;
        const int row0 = (u.pm & 127) * BM + wr * 64 + fr, col0 = (u.pn & 3) * BM + wc * 32 + 8 * fq;
#pragma unroll
        for (int ai = 0; ai < 2; ++ai)
#pragma unroll
            for (int m = 0; m < 4; ++m) { const size_t off = (size_t)(row0 + ai * HALF + m * 16) * 1024 + col0;
#pragma unroll
                for (int bj = 0; bj < 2; ++bj) { PG8_X8(x, ai, bj, m)
                    const u32x4 gv = *(const u32x4*)(g + off + bj * HALF);
                    x[0] *= bflo(gv.x); x[1] *= bfhi(gv.x); x[2] *= bflo(gv.y); x[3] *= bfhi(gv.y); x[4] *= bflo(gv.z); x[5] *= bfhi(gv.z); x[6] *= bflo(gv.w); x[7] *= bfhi(gv.w);
                    float* tp = T1 + off + bj * HALF;
                    if (which == 0) { *(f32x4*)tp = (f32x4){x[0], x[1], x[2], x[3]}; *(f32x4*)(tp + 4) = (f32x4){x[4], x[5], x[6], x[7]}; }
                    else { const f32x4 t0 = *(const f32x4*)tp, t1 = *(const f32x4*)(tp + 4);
                        x[0] += t0[0]; x[1] += t0[1]; x[2] += t0[2]; x[3] += t0[3]; x[4] += t1[0]; x[5] += t1[1]; x[6] += t1[2]; x[7] += t1[3];
                        PG8_PACK8(w, x) *(u32x4*)(MX + off + bj * HALF) = w; } } }
    }
};
struct EpiSwi {
    static constexpr bool PERM = true, AFTER_DRAIN = false;
    bf16_t* Gm; int ldg, NT;
    __device__ __forceinline__ void operator()(const f32x4 (&acc)[2][2][4][2], const Unit& u, int wr, int wc, int fr, int fq) const {
        const int pnl = u.pn - (u.pn / NT) * NT;
        const int row0 = u.pm * BM + wr * 64 + fr, col0 = pnl * HALF + wc * 32 + 8 * fq;
#pragma unroll
        for (int ai = 0; ai < 2; ++ai)
#pragma unroll
            for (int m = 0; m < 4; ++m) { bf16_t* rowp = Gm + (size_t)(row0 + ai * HALF + m * 16) * ldg + col0;
                PG8_X8(x, ai, 0, m) PG8_X8(y, ai, 1, m)
#pragma unroll
                for (int j = 0; j < 8; ++j) x[j] = x[j] * fsig(x[j]) * y[j];
                PG8_PACK8(w, x) *(u32x4*)rowp = w; }
    }
};
struct EpiPlain {
    static constexpr bool PERM = true, AFTER_DRAIN = false;
    bf16_t* O; int ldc;
    __device__ __forceinline__ void operator()(const f32x4 (&acc)[2][2][4][2], const Unit& u, int wr, int wc, int fr, int fq) const {
        const int row0 = u.pm * BM + wr * 64 + fr, col0 = (u.pn & 3) * BM + wc * 32 + 8 * fq;
#pragma unroll
        for (int ai = 0; ai < 2; ++ai)
#pragma unroll
            for (int m = 0; m < 4; ++m) { bf16_t* rowp = O + (size_t)(row0 + ai * HALF + m * 16) * ldc + col0;
#pragma unroll
                for (int bj = 0; bj < 2; ++bj) { PG8_X8(x, ai, bj, m) PG8_PACK8(w, x) *(u32x4*)(rowp + bj * HALF) = w; } }
    }
};
template <class Epi, class Sched, bool ALIGN_EPI = false, bool SP2 = false>
__device__ __forceinline__ void gemm_phase(PG8_LAS unsigned char* lds, const Gemm g, const Sched& S, const Epi& E) {
    int tid_ = threadIdx.x; asm volatile("" : "+v"(tid_));
    const int tid = tid_, wid = __builtin_amdgcn_readfirstlane(tid >> 6), lane = tid & 63, wr = wid >> 2, wc = wid & 3, fr = lane & 15, fq = lane >> 4;
    const int K = g.K, nt = K / BK;
    unsigned voffA[2], voffB[2];
#pragma unroll
    for (int i = 0; i < 2; ++i) { int R, C; stage_rc(tid * 16 + i * 8192, R, C); const int Rb = Epi::PERM ? ((R & ~31) + perm32(R & 31)) : R;
        voffA[i] = (unsigned)(R * K + C) * 2u; voffB[i] = (unsigned)(Rb * K + C) * 2u; }
    const size_t kstep = (size_t)(BK * 2);
    const size_t hstep = (size_t)HALF * K * 2;
    const size_t tstep = 2 * hstep;
    const unsigned ldsw = (unsigned)wid * 1024u;
    const int aoff = lds_byte(wr * 64 + fr, fq * 8), boff = lds_byte(wc * 32 + fr, fq * 8);
#define PG8_SA(b, h) (((b) * 2 + (h)) * HTB)
#define PG8_SB(b, h) ((4 + (b) * 2 + (h)) * HTB)
#define PG8_STAGE(bufoff, gbase, voff) do { _Pragma("unroll") for (int _i = 0; _i < 2; ++_i) \
        __builtin_amdgcn_global_load_lds((const unsigned*)((const char*)(gbase) + (voff)[_i]), (PG8_LAS unsigned*)(lds + (bufoff) + ldsw + _i * 8192), 16, 0, 0); } while (0)
#define PG8_LDA(dst, b, h) do { _Pragma("unroll") for (int m = 0; m < 4; ++m) _Pragma("unroll") for (int k = 0; k < 2; ++k) dst[m][k] = *(const PG8_LAS bf16x8*)(lds + PG8_SA(b, h) + aoff + m * 2048 + k * 1024); } while (0)
#define PG8_LDB(dst, b, h) do { _Pragma("unroll") for (int n = 0; n < 2; ++n) _Pragma("unroll") for (int k = 0; k < 2; ++k) dst[n][k] = *(const PG8_LAS bf16x8*)(lds + PG8_SB(b, h) + boff + n * 2048 + k * 1024); } while (0)
#define PG8_MMA(ai, bj, At, Bt) do { __builtin_amdgcn_s_setprio(1); _Pragma("unroll") for (int m = 0; m < 4; ++m) _Pragma("unroll") for (int n = 0; n < 2; ++n) _Pragma("unroll") for (int k = 0; k < 2; ++k) \
        acc[ai][bj][m][n] = __builtin_amdgcn_mfma_f32_16x16x32_bf16(Bt[n][k], At[m][k], acc[ai][bj][m][n], 0, 0, 0); __builtin_amdgcn_s_setprio(0); } while (0)
#define PG8_WAIT_V(n) asm volatile("s_waitcnt vmcnt(" #n ")" ::: "memory")
#define PG8_WAIT_L(n) asm volatile("s_waitcnt lgkmcnt(" #n ")" ::: "memory")
#define PG8_BAR __builtin_amdgcn_s_barrier()
#define PG8_SCHED __builtin_amdgcn_sched_barrier(0)
    Unit cur, nxt; int ui = 0;
    if (!S.next(0, cur)) return;
    f32x4 acc[2][2][4][2];
#pragma unroll
    for (int a = 0; a < 2; ++a)
#pragma unroll
        for (int b = 0; b < 2; ++b)
#pragma unroll
            for (int m = 0; m < 4; ++m)
#pragma unroll
                for (int n = 0; n < 2; ++n) acc[a][b][m][n] = (f32x4){0.f, 0.f, 0.f, 0.f};
    bf16x8 At[4][2], B0[2][2], B1[2][2];
    const char* cA = (const char*)g.A + (size_t)cur.pm * tstep; const char* cB = (const char*)g.Bt + (size_t)cur.pn * tstep;
    S.a_ready(cur);
    if constexpr (SP2) {
        PG8_STAGE(PG8_SB(0, 0), cB, voffB); PG8_STAGE(PG8_SB(0, 1), cB + hstep, voffB); PG8_STAGE(PG8_SA(0, 0), cA, voffA); PG8_STAGE(PG8_SA(0, 1), cA + hstep, voffA);
        if (wr == 1) PG8_BAR;
        PG8_WAIT_V(2); PG8_BAR;
        PG8_STAGE(PG8_SB(1, 0), cB + kstep, voffB); PG8_STAGE(PG8_SA(1, 0), cA + kstep, voffA); PG8_STAGE(PG8_SB(1, 1), cB + hstep + kstep, voffB);
        PG8_WAIT_V(6); PG8_BAR;
    } else {
        PG8_STAGE(PG8_SB(0, 0), cB, voffB); PG8_STAGE(PG8_SA(0, 0), cA, voffA); PG8_STAGE(PG8_SB(0, 1), cB + hstep, voffB); PG8_STAGE(PG8_SA(0, 1), cA + hstep, voffA);
        if (wr == 1) PG8_BAR;
        PG8_WAIT_V(4); PG8_BAR;
        PG8_STAGE(PG8_SB(1, 0), cB + kstep, voffB); PG8_STAGE(PG8_SA(1, 0), cA + kstep, voffA); PG8_STAGE(PG8_SB(1, 1), cB + hstep + kstep, voffB);
        PG8_WAIT_V(6); PG8_BAR;
    }
    for (;;) {
        const bool has_next = S.next(ui + 1, nxt);
        const char* nA = has_next ? (const char*)g.A + (size_t)nxt.pm * tstep : cA; const char* nB = has_next ? (const char*)g.Bt + (size_t)nxt.pn * tstep : cB;
        for (int t = 0; t < nt; t += 2) {
            const bool last = (t == nt - 2);
            const char* a1 = cA + (size_t)(t + 1) * kstep;
            const char* a2 = last ? nA : cA + (size_t)(t + 2) * kstep; const char* b2 = last ? nB : cB + (size_t)(t + 2) * kstep;
            const char* a3 = a2 + kstep; const char* b3 = b2 + kstep;
            if (last && has_next) S.a_ready(nxt);
            if constexpr (SP2) {
            PG8_LDB(B0, 0, 0); PG8_LDB(B1, 0, 1); PG8_SCHED; PG8_LDA(At, 0, 0); PG8_STAGE(PG8_SA(1, 1), a1 + hstep, voffA);
            PG8_WAIT_V(8); PG8_WAIT_L(0); PG8_BAR; PG8_MMA(0, 0, At, B0); PG8_MMA(0, 1, At, B1); PG8_BAR; PG8_SCHED;
            PG8_LDA(At, 0, 1); PG8_STAGE(PG8_SB(0, 0), b2, voffB); PG8_STAGE(PG8_SB(0, 1), b2 + hstep, voffB); PG8_STAGE(PG8_SA(0, 0), a2, voffA);
            PG8_WAIT_V(8); PG8_WAIT_L(0); PG8_BAR; PG8_MMA(1, 0, At, B0); PG8_MMA(1, 1, At, B1); PG8_BAR; PG8_SCHED;
            PG8_LDB(B0, 1, 0); PG8_LDB(B1, 1, 1); PG8_SCHED; PG8_LDA(At, 1, 0); PG8_STAGE(PG8_SA(0, 1), a2 + hstep, voffA);
            PG8_WAIT_V(8); PG8_WAIT_L(0); PG8_BAR; PG8_MMA(0, 0, At, B0); PG8_MMA(0, 1, At, B1); PG8_BAR; PG8_SCHED;
            PG8_LDA(At, 1, 1); PG8_STAGE(PG8_SB(1, 0), b3, voffB); PG8_STAGE(PG8_SB(1, 1), b3 + hstep, voffB); PG8_STAGE(PG8_SA(1, 0), a3, voffA);
            PG8_WAIT_V(8); PG8_WAIT_L(0); PG8_BAR; PG8_MMA(1, 0, At, B0); PG8_MMA(1, 1, At, B1); PG8_BAR; PG8_SCHED;
            } else {
            PG8_LDB(B0, 0, 0); PG8_SCHED; PG8_LDA(At, 0, 0); PG8_STAGE(PG8_SA(1, 1), a1 + hstep, voffA);
            PG8_WAIT_L(8); PG8_BAR; PG8_WAIT_L(0); PG8_MMA(0, 0, At, B0); PG8_BAR; PG8_SCHED;
            PG8_LDB(B1, 0, 1); PG8_STAGE(PG8_SB(0, 0), b2, voffB);
            PG8_BAR; PG8_WAIT_L(0); PG8_MMA(0, 1, At, B1); PG8_BAR;
            PG8_LDA(At, 0, 1); PG8_STAGE(PG8_SA(0, 0), a2, voffA);
            PG8_BAR; PG8_WAIT_L(0); PG8_MMA(1, 0, At, B0); PG8_BAR; PG8_SCHED;
            PG8_STAGE(PG8_SB(0, 1), b2 + hstep, voffB);
            PG8_WAIT_V(6); PG8_BAR; PG8_MMA(1, 1, At, B1); PG8_BAR;
            PG8_LDB(B0, 1, 0); PG8_SCHED; PG8_LDA(At, 1, 0); PG8_STAGE(PG8_SA(0, 1), a2 + hstep, voffA);
            PG8_WAIT_L(8); PG8_BAR; PG8_WAIT_L(0); PG8_MMA(0, 0, At, B0); PG8_BAR; PG8_SCHED;
            PG8_LDB(B1, 1, 1); PG8_STAGE(PG8_SB(1, 0), b3, voffB);
            PG8_BAR; PG8_WAIT_L(0); PG8_MMA(0, 1, At, B1); PG8_BAR;
            PG8_LDA(At, 1, 1); PG8_STAGE(PG8_SA(1, 0), a3, voffA);
            PG8_BAR; PG8_WAIT_L(0); PG8_MMA(1, 0, At, B0); PG8_BAR; PG8_SCHED;
            PG8_STAGE(PG8_SB(1, 1), b3 + hstep, voffB);
            PG8_WAIT_V(6); PG8_BAR; PG8_MMA(1, 1, At, B1); PG8_BAR;
            }
        }
        if constexpr (ALIGN_EPI) { if (wr == 0) PG8_BAR; }
        if constexpr (!Epi::AFTER_DRAIN) { E(acc, cur, wr, wc, fr, fq); S.done(cur); }
        if (!has_next) break;
#pragma unroll
        for (int a = 0; a < 2; ++a)
#pragma unroll
            for (int b = 0; b < 2; ++b)
#pragma unroll
                for (int m = 0; m < 4; ++m)
#pragma unroll
                    for (int n = 0; n < 2; ++n) acc[a][b][m][n] = (f32x4){0.f, 0.f, 0.f, 0.f};
        cur = nxt; cA = nA; cB = nB; ++ui;
        if constexpr (ALIGN_EPI) { if (wr == 1) PG8_BAR; }
    }
    PG8_WAIT_V(0);
    if constexpr (!ALIGN_EPI) { if (wr == 0) PG8_BAR; }
    PG8_BAR;
    if constexpr (Epi::AFTER_DRAIN) { E.fused(acc, cur, wr, wc, fr, fq, lds, wid, lane); S.done(cur); }
#undef PG8_SA
#undef PG8_SB
#undef PG8_STAGE
#undef PG8_LDA
#undef PG8_LDB
#undef PG8_MMA
#undef PG8_WAIT_V
#undef PG8_WAIT_L
#undef PG8_BAR
#undef PG8_SCHED
}
}
constexpr int NWAVES = 8, NTHR = 512;
constexpr int D = 1024, NBATCH = 8, SEQ = 4096, M = NBATCH * SEQ, DEPTH = 4;
constexpr int DIN = 8192, DFF = 2816, NEXP = 8, DFE = 3584;
constexpr float EPS = 1e-6f;
constexpr size_t MiB = 1u << 20;
constexpr size_t WS_CTL = 0, CTL_ZERO_BYTES = 2 * MiB;
constexpr size_t WS_MOD = 1 * MiB;
constexpr size_t WS_LB = 2 * MiB;
constexpr size_t WS_LI = 2 * MiB + 64 * 1024, WS_LF = WS_LI + 512 * 1024;
constexpr size_t WS_TOKEP = 4 * MiB;
constexpr size_t WS_TOKW = WS_TOKEP + 512 * 1024;
constexpr size_t WS_TOKD = WS_TOKW + 256 * 1024;
constexpr size_t WS_WIN = 6 * MiB, WS_WAB = 22 * MiB, WS_WO = 26 * MiB, WS_WF = 28 * MiB;
constexpr size_t WF_W2_DENSE = 12 * MiB, WF_W2_MOE = 112 * MiB;
constexpr size_t WS_H = 196 * MiB;
constexpr size_t WS_PROJ = 260 * MiB, PART = 64 * MiB;
constexpr size_t WS_MQ = 772 * MiB, WS_MK = 836 * MiB, WS_MV = 900 * MiB, WS_XC = 964 * MiB;
constexpr size_t WS_AG = 772 * MiB, WS_YS = 904 * MiB;
constexpr size_t WS_END = 1036 * MiB;
constexpr size_t PSTRIDE = (size_t)M * 1024;
enum { P_QA = 0, P_LF = 1, P_VA = 2, P_GA = 3, P_XM = 4, P_OS = 5, P_GTA = 6, P_GTB = 7 };
constexpr int CW_BAR = 4096;
constexpr int CW_CNT = 16384;
constexpr int RING_BYTES = 131072, MISC_OFF = RING_BYTES, LDS_BYTES = 147456;

#define GAS __attribute__((address_space(1)))
#define LAS __attribute__((address_space(3)))
typedef unsigned short bf16;
typedef unsigned v4u __attribute__((ext_vector_type(4)));
typedef unsigned v2u __attribute__((ext_vector_type(2)));
typedef float f32x4 __attribute__((ext_vector_type(4)));
#define LDS_WAIT() asm volatile("s_waitcnt lgkmcnt(0)" ::: "memory")
#define VM_WAIT() asm volatile("s_waitcnt vmcnt(0)" ::: "memory")
__device__ __forceinline__ unsigned f2bf(float f) { unsigned u = __builtin_bit_cast(unsigned, f); return (u + 0x7fffu + ((u >> 16) & 1u)) >> 16; }
__device__ __forceinline__ unsigned pk2(float lo, float hi) { return f2bf(lo) | (f2bf(hi) << 16); }
__device__ __forceinline__ float bflo(unsigned w) { return __uint_as_float(w << 16); }
__device__ __forceinline__ float bfhi(unsigned w) { return __uint_as_float(w & 0xffff0000u); }
__device__ __forceinline__ float bf2f(bf16 b) { return __uint_as_float((unsigned)b << 16); }
__device__ __forceinline__ float fsigm(float v) { return 1.0f / (1.0f + __expf(-v)); }
__device__ __forceinline__ float wave_sum(float v) {
#pragma unroll
    for (int o = 1; o < 64; o <<= 1) v += __shfl_xor(v, o);
    return v;
}
__device__ __forceinline__ float half_sum(float v) {
#pragma unroll
    for (int o = 1; o < 32; o <<= 1) v += __shfl_xor(v, o);
    return v;
}
__device__ __forceinline__ float sum16(float v) {
#pragma unroll
    for (int o = 1; o < 16; o <<= 1) v += __shfl_xor(v, o);
    return v;
}

__device__ __forceinline__ int opq_v(int v) { asm volatile("" : "+v"(v)); return v; }
__device__ __forceinline__ int opq_s(int v) { asm volatile("" : "+s"(v)); return v; }
__device__ __forceinline__ unsigned char* opq_p(unsigned char* p) { asm volatile("" : "+s"(p)); return p; }
#define TID() opq_v((int)threadIdx.x)
#define BID() opq_s((int)blockIdx.x)
#define XB_TMO      128
#define XB_XCNT(j)  (256  + 64 * (j))
#define XB_XSUB(j)  (1280 + 64 * (j))
#define XB_XGEN(j)  (2304 + 64 * (j))
#define XB_TOP      3328
#define XB_TOPGEN   3392
#define XCD_BAR_WORDS 3456
#define XB_SPIN_CAP (1u << 18)

__device__ __forceinline__ unsigned xb_ld(unsigned* p)              { return __hip_atomic_load(p, __ATOMIC_RELAXED, __HIP_MEMORY_SCOPE_AGENT); }
__device__ __forceinline__ unsigned xb_add(unsigned* p, unsigned v) { return __hip_atomic_fetch_add(p, v, __ATOMIC_RELAXED, __HIP_MEMORY_SCOPE_AGENT); }
__device__ __forceinline__ unsigned xb_xcc_id() { return (unsigned)__builtin_amdgcn_s_getreg((3 << 11) | 20) & 0xFu; }
#define XB_SPIN(cond, bar) do { unsigned _sp = 0; while (cond) { __builtin_amdgcn_s_sleep(1); \
    if ((++_sp & 255u) == 0u) { if (xb_ld(&(bar)[XB_TMO])) break; if (_sp > XB_SPIN_CAP) { atomicAdd(&(bar)[XB_TMO], 1u); break; } } } } while (0)

struct XcdBarrier {
    unsigned* bar; unsigned x;
    volatile LAS unsigned* st;
};

__device__ __forceinline__ XcdBarrier xcd_barrier_post(unsigned* bar, volatile LAS unsigned* st) {
    XcdBarrier b; b.bar = bar; b.x = xb_xcc_id(); b.st = st;
    if (threadIdx.x == 0) (void)xb_add(&bar[XB_XCNT(b.x)], 1u);
    return b;
}
__device__ __forceinline__ void xcd_barrier_complete(unsigned* bar, unsigned x, unsigned& nloc, unsigned& nx) {
    const unsigned G = gridDim.x * gridDim.y * gridDim.z;
    unsigned sum, cnt, mine, sp = 0u;
    for (;;) {
        sum = 0u; cnt = 0u; mine = 0u;
#pragma unroll
        for (unsigned j = 0; j < 16; ++j) { const unsigned c = xb_ld(&bar[XB_XCNT(j)]); sum += c; cnt += (c > 0u) ? 1u : 0u; mine = (j == x) ? c : mine; }
        if (sum == G) break;
        __builtin_amdgcn_s_sleep(1);
        if ((++sp & 255u) == 0u) { if (xb_ld(&bar[XB_TMO])) break; if (sp > XB_SPIN_CAP) { atomicAdd(&bar[XB_TMO], 1u); break; } }
    }
    nloc = mine > 0u ? mine : 1u; nx = cnt > 0u ? cnt : 1u;
}

__device__ __forceinline__ void xcd_barrier(const XcdBarrier& b) {
    asm volatile("s_waitcnt vmcnt(0)" ::: "memory");
    __syncthreads();
    if (threadIdx.x == 0) {
        unsigned* bar = b.bar;
        __builtin_amdgcn_s_waitcnt(0);
        unsigned nloc = b.st[0], nx = b.st[1];
        if (nloc == 0u) { xcd_barrier_complete(bar, b.x, nloc, nx); b.st[0] = nloc; b.st[1] = nx; }
        const unsigned old = xb_add(&bar[XB_XSUB(b.x)], 1u);
        const unsigned gen = old / nloc;
        if (old + 1u == (gen + 1u) * nloc) {
            __builtin_amdgcn_fence(__ATOMIC_RELEASE, "agent");
            asm volatile("s_waitcnt vmcnt(0)" ::: "memory");
            const unsigned og = xb_add(&bar[XB_TOP], 1u);
            const unsigned tg = og / nx;
            if (og + 1u == (tg + 1u) * nx) xb_add(&bar[XB_TOPGEN], 1u);
            else XB_SPIN(xb_ld(&bar[XB_TOPGEN]) == tg, bar);
            __builtin_amdgcn_fence(__ATOMIC_ACQUIRE, "agent");
            xb_add(&bar[XB_XGEN(b.x)], 1u);
            asm volatile("s_waitcnt vmcnt(0)" ::: "memory");
        } else {
            XB_SPIN(xb_ld(&bar[XB_XGEN(b.x)]) == gen, bar);
            __builtin_amdgcn_fence(__ATOMIC_ACQUIRE, "agent");
            asm volatile("s_waitcnt vmcnt(0)" ::: "memory");
        }
    }
    __syncthreads();
}
struct Ctx { const float* in[32]; float* out; unsigned char* ws; int ph_lo, ph_hi; };
enum { I_X = 0, I_C, I_WADA, I_BADA, I_GPREMIX, I_GPOSTMIX, I_GPREFFN, I_GPOSTFFN, I_WIN, I_HLB, I_HGN, I_CONVW, I_CONVB, I_WQ, I_WK, I_WV, I_WIG, I_BIG, I_WFG, I_BFG,
       I_MGN, I_MSKIP, I_WPA, I_WPB, I_WOUT, I_F1, I_F3, I_F2, I_ROUTER, I_M1, I_M3, I_M2 };

__device__ __forceinline__ void ph_mod(const Ctx& c, LAS unsigned char* lds) {
    LAS float* cact = (LAS float*)lds;
    LAS float* part = (LAS float*)(lds + 32768);
    float* MOD = (float*)(c.ws + WS_MOD);
    const float* cin = c.in[I_C]; const float* wada = c.in[I_WADA]; const float* bada = c.in[I_BADA];
    const int tid = TID(), lane = tid & 63, wave = tid >> 6;
    for (int i = tid; i < 8192; i += NTHR) { const float v = cin[i]; cact[i] = v * fsigm(v); }
    __syncthreads();
    for (int u = BID(); u < 384; u += gridDim.x) {
        const int l = u / 96, jb = u % 96, j = jb * 64 + lane;
        const float* w = wada + ((size_t)l * 1024 + wave * 128) * 6144 + j;
        const LAS float* ca = cact + wave * 128;
        float a0 = 0.f, a1 = 0.f, a2 = 0.f, a3 = 0.f, a4 = 0.f, a5 = 0.f, a6 = 0.f, a7 = 0.f;
#pragma unroll 8
        for (int k = 0; k < 128; ++k) { const float wv = w[(size_t)k * 6144];
            a0 += ca[k] * wv; a1 += ca[1024 + k] * wv; a2 += ca[2048 + k] * wv; a3 += ca[3072 + k] * wv;
            a4 += ca[4096 + k] * wv; a5 += ca[5120 + k] * wv; a6 += ca[6144 + k] * wv; a7 += ca[7168 + k] * wv; }
        LAS float* pw = part + wave * 512 + lane;
        pw[0] = a0; pw[64] = a1; pw[128] = a2; pw[192] = a3; pw[256] = a4; pw[320] = a5; pw[384] = a6; pw[448] = a7;
        __syncthreads();
        { const int b = wave; float s = bada[l * 6144 + j];
#pragma unroll
            for (int ww = 0; ww < 8; ++ww) s += part[ww * 512 + b * 64 + lane];
            MOD[(size_t)(l * 8 + b) * 6144 + j] = s; }
        __syncthreads();
    }
}
__device__ __forceinline__ void ph_lb(const Ctx& c) {
    if (BID() != 0) return;
    float* LB = (float*)(c.ws + WS_LB); const float* raw = c.in[I_HLB];
    for (int col = TID(); col < 1024; col += NTHR) {
        const float r0 = raw[col], r1 = raw[1024 + col], r2 = raw[2048 + col], r3 = raw[3072 + col];
        const float mx = fmaxf(fmaxf(r0, r1), fmaxf(r2, r3));
        const float e0 = __expf(r0 - mx), e1 = __expf(r1 - mx), e2 = __expf(r2 - mx), e3 = __expf(r3 - mx), inv = 1.0f / (e0 + e1 + e2 + e3);
        LB[col] = 0.f; LB[1024 + col] = e1 * inv; LB[2048 + col] = (e1 + e2) * inv; LB[3072 + col] = (e1 + e2 + e3) * inv;
    }
}
__device__ __forceinline__ void cvt_item(const float* W, int K, int N, bf16* WT, int rowbase, int mode, LAS float* scr, int item, int lane) {
    const int nblk = N / 32, kb = item / nblk, nb = item % nblk, k0 = 64 * kb, n0 = 32 * nb;
#pragma unroll 8
    for (int i = 0; i < 32; ++i) { const int kk = 2 * i + (lane >> 5); scr[kk * 33 + (lane & 31)] = W[(size_t)(k0 + kk) * N + n0 + (lane & 31)]; }
    LDS_WAIT(); asm volatile("" ::: "memory");
    const int drow0 = rowbase + (mode ? ((n0 >> 7) * 256 + (n0 & 127)) : n0);
    const int cc = lane & 7;
#pragma unroll
    for (int j = 0; j < 4; ++j) { const int n = (lane >> 3) + 8 * j; const LAS float* s = scr + (8 * cc) * 33 + n;
        v4u o; o.x = pk2(s[0 * 33], s[1 * 33]); o.y = pk2(s[2 * 33], s[3 * 33]); o.z = pk2(s[4 * 33], s[5 * 33]); o.w = pk2(s[6 * 33], s[7 * 33]);
        *(v4u*)(WT + (size_t)(drow0 + n) * K + k0 + 8 * cc) = o; }
    LDS_WAIT(); asm volatile("" ::: "memory");
}
__device__ __forceinline__ void ph_cvt(const Ctx& c, int l, LAS unsigned char* lds) {
    const int tid = TID(), lane = tid & 63, wave = __builtin_amdgcn_readfirstlane(tid >> 6);
    LAS float* scr = (LAS float*)(lds + wave * 16384);
    const int gw = BID() * NWAVES + wave, NGW = gridDim.x * NWAVES;
    bf16* WIN = (bf16*)(c.ws + WS_WIN); bf16* WAB = (bf16*)(c.ws + WS_WAB); bf16* WO = (bf16*)(c.ws + WS_WO); bf16* WF = (bf16*)(c.ws + WS_WF);
    const bool moe = (l & 1) != 0; const int j = l >> 1;
    constexpr int I_IN = 16 * 256, I_SQ = 16 * 32, I_D13 = 16 * 88, I_D2 = 44 * 32, I_M13 = 16 * 112, I_M2E = 56 * 32;
    const int total = I_IN + 3 * I_SQ + (moe ? (2 * NEXP * I_M13 + NEXP * I_M2E) : (2 * I_D13 + I_D2));
    for (int it = gw; it < total; it += NGW) {
        int r = it;
        if (r < I_IN) { cvt_item(c.in[I_WIN] + (size_t)l * D * DIN, D, DIN, WIN, 0, 0, scr, r, lane); continue; } r -= I_IN;
        if (r < I_SQ) { cvt_item(c.in[I_WPA] + (size_t)l * D * D, D, D, WAB, 0, 0, scr, r, lane); continue; } r -= I_SQ;
        if (r < I_SQ) { cvt_item(c.in[I_WPB] + (size_t)l * D * D, D, D, WAB, 1024, 0, scr, r, lane); continue; } r -= I_SQ;
        if (r < I_SQ) { cvt_item(c.in[I_WOUT] + (size_t)l * D * D, D, D, WO, 0, 0, scr, r, lane); continue; } r -= I_SQ;
        if (!moe) {
            if (r < I_D13) { cvt_item(c.in[I_F1] + (size_t)j * D * DFF, D, DFF, WF, 0, 1, scr, r, lane); continue; } r -= I_D13;
            if (r < I_D13) { cvt_item(c.in[I_F3] + (size_t)j * D * DFF, D, DFF, WF, 128, 1, scr, r, lane); continue; } r -= I_D13;
            cvt_item(c.in[I_F2] + (size_t)j * DFF * D, DFF, D, (bf16*)(c.ws + WS_WF + WF_W2_DENSE), 0, 0, scr, r, lane);
        } else {
            if (r < NEXP * I_M13) { const int e = r / I_M13; cvt_item(c.in[I_M1] + ((size_t)j * NEXP + e) * D * DFE, D, DFE, WF, e * 2 * DFE, 1, scr, r - e * I_M13, lane); continue; } r -= NEXP * I_M13;
            if (r < NEXP * I_M13) { const int e = r / I_M13; cvt_item(c.in[I_M3] + ((size_t)j * NEXP + e) * D * DFE, D, DFE, WF, e * 2 * DFE + 128, 1, scr, r - e * I_M13, lane); continue; } r -= NEXP * I_M13;
            { const int e = r / I_M2E; cvt_item(c.in[I_M2] + ((size_t)j * NEXP + e) * DFE * D, DFE, D, (bf16*)(c.ws + WS_WF + WF_W2_MOE), e * D, 0, scr, r - e * I_M2E, lane); }
        }
    }
}

__device__ __forceinline__ void ld_row_f32(const float* p, int lane, f32x4 (&v)[4]) {
#pragma unroll
    for (int j = 0; j < 4; ++j) v[j] = *(const f32x4*)(p + 4 * lane + 256 * j);
}
__device__ __forceinline__ void ld_row_bf16(const bf16* p, int lane, f32x4 (&v)[4]) {
#pragma unroll
    for (int j = 0; j < 4; ++j) { const v2u w = *(const v2u*)(p + 4 * lane + 256 * j); v[j] = (f32x4){bflo(w.x), bfhi(w.x), bflo(w.y), bfhi(w.y)}; }
}
__device__ __forceinline__ void st_row_bf16(bf16* p, int lane, const f32x4 (&v)[4]) {
#pragma unroll
    for (int j = 0; j < 4; ++j) { v2u w; w.x = pk2(v[j][0], v[j][1]); w.y = pk2(v[j][2], v[j][3]); *(v2u*)(p + 4 * lane + 256 * j) = w; }
}
__device__ __forceinline__ float row_sumsq(const f32x4 (&v)[4]) {
    float s = 0.f;
#pragma unroll
    for (int j = 0; j < 4; ++j) s += (v[j][0] * v[j][0] + v[j][1] * v[j][1]) + (v[j][2] * v[j][2] + v[j][3] * v[j][3]);
    return wave_sum(s);
}
__device__ __forceinline__ void norm_mod(const f32x4 (&x)[4], const f32x4 (&g)[4], const f32x4 (&sc)[4], const f32x4 (&sh)[4], f32x4 (&h)[4]) {
    const float r = rsqrtf(row_sumsq(x) * (1.0f / 1024.0f) + EPS);
#pragma unroll
    for (int j = 0; j < 4; ++j) h[j] = (x[j] * r) * g[j] * (sc[j] + 1.0f) + sh[j];
}
__device__ __forceinline__ const float* modp(const Ctx& c, int l, int b, int which) { return (const float*)(c.ws + WS_MOD) + ((size_t)(l * 8 + b) * 6 + which) * 1024; }

__device__ __forceinline__ void ph_norm0(const Ctx& c) {
    const int tid = TID(), lane = tid & 63, wave = tid >> 6, gw = BID() * NWAVES + wave, NGW = gridDim.x * NWAVES;
    bf16* H = (bf16*)(c.ws + WS_H);
    for (int slot = gw; slot < M / 16; slot += NGW) {
        const int row0 = slot * 16, b = row0 / SEQ;
        f32x4 g[4], sc[4], sh[4]; ld_row_f32(c.in[I_GPREMIX], lane, g); ld_row_f32(modp(c, 0, b, 1), lane, sc); ld_row_f32(modp(c, 0, b, 0), lane, sh);
        for (int r = 0; r < 16; ++r) { f32x4 x[4], h[4]; ld_row_f32(c.in[I_X] + (size_t)(row0 + r) * D, lane, x); norm_mod(x, g, sc, sh, h); st_row_bf16(H + (size_t)(row0 + r) * D, lane, h); }
    }
}
__device__ __forceinline__ void ph_prep(const Ctx& c, int l) {
    const int tid = TID(), lane = tid & 63, wave = tid >> 6, gw = BID() * NWAVES + wave, NGW = gridDim.x * NWAVES;
    const bf16* XM = (const bf16*)(c.ws + WS_PROJ) + (size_t)P_XM * PSTRIDE;
    bf16* MQ = (bf16*)(c.ws + WS_MQ); bf16* MK = (bf16*)(c.ws + WS_MK); bf16* MV = (bf16*)(c.ws + WS_MV); bf16* XC = (bf16*)(c.ws + WS_XC);
    float* LI = (float*)(c.ws + WS_LI); float* LF = (float*)(c.ws + WS_LF);
    const float* cw = c.in[I_CONVW] + (size_t)l * 4 * D; const float* cb = c.in[I_CONVB] + (size_t)l * D;
    const float* wq = c.in[I_WQ] + (size_t)l * 256 * 16; const float* wk = c.in[I_WK] + (size_t)l * 256 * 16; const float* wv = c.in[I_WV] + (size_t)l * 256 * 16;
    const float* wig = c.in[I_WIG] + (size_t)l * 3072 * 4; const float* wfg = c.in[I_WFG] + (size_t)l * 3072 * 4;
    const f32x4 big = *(const f32x4*)(c.in[I_BIG] + l * 4), bfg = *(const f32x4*)(c.in[I_BFG] + l * 4);
    for (int slot = gw; slot < M / 16; slot += NGW) {
        for (int r = 0; r < 16; ++r) {
            const int row = slot * 16 + r, t = row & (SEQ - 1);
            f32x4 gi = {0.f, 0.f, 0.f, 0.f}, gf = {0.f, 0.f, 0.f, 0.f};
#pragma unroll 1
            for (int j = 0; j < 4; ++j) {
                const int ch = 4 * lane + 256 * j, n = lane + 64 * j;
                f32x4 y = *(const f32x4*)(cb + ch); f32x4 xt = {0.f, 0.f, 0.f, 0.f};
#pragma unroll
                for (int jj = 0; jj < 4; ++jj) {
                    if (t - 3 + jj >= 0) { const v2u w = *(const v2u*)(XM + (size_t)(row - 3 + jj) * D + ch); const f32x4 xv = {bflo(w.x), bfhi(w.x), bflo(w.y), bfhi(w.y)};
                        y += *(const f32x4*)(cw + jj * D + ch) * xv; if (jj == 3) xt = xv; }
                }
                f32x4 xc; xc[0] = y[0] * fsigm(y[0]); xc[1] = y[1] * fsigm(y[1]); xc[2] = y[2] * fsigm(y[2]); xc[3] = y[3] * fsigm(y[3]);
                f32x4 q = {0.f, 0.f, 0.f, 0.f}, k = q, v = q;
#pragma unroll
                for (int i = 0; i < 4; ++i) { q += *(const f32x4*)(wq + n * 16 + i * 4) * xc[i]; k += *(const f32x4*)(wk + n * 16 + i * 4) * xc[i]; v += *(const f32x4*)(wv + n * 16 + i * 4) * xt[i]; }
#pragma unroll
                for (int o = 0; o < 4; ++o) {
                    gi += *(const f32x4*)(wig + (size_t)(ch + o) * 4) * q[o] + *(const f32x4*)(wig + (size_t)(1024 + ch + o) * 4) * k[o] + *(const f32x4*)(wig + (size_t)(2048 + ch + o) * 4) * v[o];
                    gf += *(const f32x4*)(wfg + (size_t)(ch + o) * 4) * q[o] + *(const f32x4*)(wfg + (size_t)(1024 + ch + o) * 4) * k[o] + *(const f32x4*)(wfg + (size_t)(2048 + ch + o) * 4) * v[o];
                }
                const size_t off = (size_t)row * D + ch;
                { v2u w; w.x = pk2(q[0], q[1]); w.y = pk2(q[2], q[3]); *(v2u*)(MQ + off) = w; }
                { v2u w; w.x = pk2(k[0] * 0.0625f, k[1] * 0.0625f); w.y = pk2(k[2] * 0.0625f, k[3] * 0.0625f); *(v2u*)(MK + off) = w; }
                { v2u w; w.x = pk2(v[0], v[1]); w.y = pk2(v[2], v[3]); *(v2u*)(MV + off) = w; }
                { v2u w; w.x = pk2(xc[0], xc[1]); w.y = pk2(xc[2], xc[3]); *(v2u*)(XC + off) = w; }
            }
#pragma unroll
            for (int hh = 0; hh < 4; ++hh) { gi[hh] = wave_sum(gi[hh]); gf[hh] = wave_sum(gf[hh]); }
            gi += big; gf += bfg;
            if (lane < 4) { const float z = lane == 0 ? gf[0] : lane == 1 ? gf[1] : lane == 2 ? gf[2] : gf[3]; const float li = lane == 0 ? gi[0] : lane == 1 ? gi[1] : lane == 2 ? gi[2] : gi[3];
                LI[(size_t)row * 4 + lane] = li; LF[(size_t)row * 4 + lane] = fminf(z, 0.f) - __logf(1.0f + __expf(-fabsf(z))); }
        }
    }
}

__device__ __forceinline__ void ph_scan_a(const Ctx& c, LAS unsigned char* lds) {
    const int tid = TID();
    bf16* PJ = (bf16*)(c.ws + WS_PROJ);
    const bf16* Q = PJ + (size_t)P_QA * PSTRIDE; const bf16* LFp = PJ + (size_t)P_LF * PSTRIDE; bf16* V = PJ + (size_t)P_VA * PSTRIDE;
    LAS bf16* sq = (LAS bf16*)lds;
    LAS bf16* sf = (LAS bf16*)(lds + 32768);
    LAS bf16* sv = (LAS bf16*)(lds + 65536);
    LAS float* so = (LAS float*)(lds + 73728);
    const int dg = tid & 15, vv = tid >> 4;
    for (int u = BID(); u < 256; u += gridDim.x) {
        const int b = u >> 5, h = (u >> 2) & 7, vs = u & 3;
        const size_t rowbase = (size_t)b * SEQ;
        float S[8];
#pragma unroll
        for (int j = 0; j < 8; ++j) S[j] = 0.f;
        v4u rq[2], rf[2], rv = {0u, 0u, 0u, 0u};
#define SA_LOAD(ch) do { _Pragma("unroll") for (int k2 = 0; k2 < 2; ++k2) { const int p = tid + NTHR * k2, rr = p >> 4, c8 = p & 15; const size_t o_ = (rowbase + (size_t)(ch) * 64 + rr) * D + h * 128 + c8 * 8; \
            rq[k2] = *(const v4u*)(Q + o_); rf[k2] = *(const v4u*)(LFp + o_); } \
            if (tid < 256) { const int rr = tid >> 2, c8 = tid & 3; rv = *(const v4u*)(V + (rowbase + (size_t)(ch) * 64 + rr) * D + h * 128 + vs * 32 + c8 * 8); } } while (0)
        SA_LOAD(0);
        for (int ch = 0; ch < 64; ++ch) {
            const int buf = ch & 1;
#pragma unroll
            for (int k2 = 0; k2 < 2; ++k2) { const int p = tid + NTHR * k2; *(LAS v4u*)(sq + buf * 8192 + p * 8) = rq[k2]; *(LAS v4u*)(sf + buf * 8192 + p * 8) = rf[k2]; }
            if (tid < 256) *(LAS v4u*)(sv + buf * 2048 + tid * 8) = rv;
            __syncthreads();
            if (ch + 1 < 64) SA_LOAD(ch + 1);
            for (int i = 0; i < 64; ++i) {
                const v4u qv = *(const LAS v4u*)(sq + buf * 8192 + i * 128 + dg * 8), fv = *(const LAS v4u*)(sf + buf * 8192 + i * 128 + dg * 8);
                const float vt = bf2f(sv[buf * 2048 + i * 32 + vv]);
                const float qq[8] = {bflo(qv.x), bfhi(qv.x), bflo(qv.y), bfhi(qv.y), bflo(qv.z), bfhi(qv.z), bflo(qv.w), bfhi(qv.w)};
                const float ff[8] = {bflo(fv.x), bfhi(fv.x), bflo(fv.y), bfhi(fv.y), bflo(fv.z), bfhi(fv.z), bflo(fv.w), bfhi(fv.w)};
                float o = 0.f;
#pragma unroll
                for (int j = 0; j < 8; ++j) { const float f = __expf(ff[j]); S[j] = f * S[j] + (1.0f - f) * vt; o += S[j] * qq[j]; }
                o = sum16(o);
                if (dg == 0) so[i * 32 + vv] = o;
            }
            __syncthreads();
            { const int rr = tid >> 3, c4 = (tid & 7) * 4; const f32x4 ov = *(const LAS f32x4*)(so + rr * 32 + c4);
                v2u w; w.x = pk2(ov[0], ov[1]); w.y = pk2(ov[2], ov[3]); *(v2u*)(V + (rowbase + (size_t)ch * 64 + rr) * D + h * 128 + vs * 32 + c4) = w; }
        }
#undef SA_LOAD
        __syncthreads();
    }
}

__device__ __forceinline__ void ph_scan_m(const Ctx& c, LAS unsigned char* lds) {
    const int tid = TID();
    const bf16* MQ = (const bf16*)(c.ws + WS_MQ); const bf16* MK = (const bf16*)(c.ws + WS_MK); bf16* MV = (bf16*)(c.ws + WS_MV);
    const float* LI = (const float*)(c.ws + WS_LI); const float* LF = (const float*)(c.ws + WS_LF);
    LAS bf16* sq = (LAS bf16*)lds;
    LAS bf16* sk = (LAS bf16*)(lds + 32768);
    LAS bf16* sv = (LAS bf16*)(lds + 65536);
    LAS float* sli = (LAS float*)(lds + 69632);
    LAS float* slf = (LAS float*)(lds + 69888);
    LAS float* so = (LAS float*)(lds + 70144);
    const int dg = tid & 15, vv = tid >> 4;
    for (int u = BID(); u < 256; u += gridDim.x) {
        const int b = u >> 5, h = (u >> 3) & 3, vs = u & 7;
        const size_t rowbase = (size_t)b * SEQ;
        float C[16], nn[16], m = 0.f;
#pragma unroll
        for (int j = 0; j < 16; ++j) { C[j] = 0.f; nn[j] = 0.f; }
        v4u rq[4], rk[4], rv = {0u, 0u, 0u, 0u}; float rli = 0.f, rlf = 0.f;
#define SM_LOAD(ch) do { _Pragma("unroll") for (int k2 = 0; k2 < 4; ++k2) { const int p = tid + NTHR * k2, rr = p >> 5, c8 = p & 31; const size_t o_ = (rowbase + (size_t)(ch) * 64 + rr) * D + h * 256 + c8 * 8; \
            rq[k2] = *(const v4u*)(MQ + o_); rk[k2] = *(const v4u*)(MK + o_); } \
            if (tid < 256) { const int rr = tid >> 2, c8 = tid & 3; rv = *(const v4u*)(MV + (rowbase + (size_t)(ch) * 64 + rr) * D + h * 256 + vs * 32 + c8 * 8); } \
            if (tid < 64) { rli = LI[(rowbase + (size_t)(ch) * 64 + tid) * 4 + h]; rlf = LF[(rowbase + (size_t)(ch) * 64 + tid) * 4 + h]; } } while (0)
        SM_LOAD(0);
        for (int ch = 0; ch < 64; ++ch) {
#pragma unroll
            for (int k2 = 0; k2 < 4; ++k2) { const int p = tid + NTHR * k2; *(LAS v4u*)(sq + p * 8) = rq[k2]; *(LAS v4u*)(sk + p * 8) = rk[k2]; }
            if (tid < 256) *(LAS v4u*)(sv + tid * 8) = rv;
            if (tid < 64) { sli[tid] = rli; slf[tid] = rlf; }
            __syncthreads();
            if (ch + 1 < 64) SM_LOAD(ch + 1);
            for (int i = 0; i < 64; ++i) {
                const float li = sli[i], lf = slf[i];
                const float mn = fmaxf(lf + m, li), fg = __expf(lf + m - mn), ig = __expf(li - mn); m = mn;
                const float vt = bf2f(sv[i * 32 + vv]) * ig;
                float num = 0.f, den = 0.f;
#pragma unroll
                for (int hh = 0; hh < 2; ++hh) {
                    const v4u qv = *(const LAS v4u*)(sq + i * 256 + dg * 16 + hh * 8), kv = *(const LAS v4u*)(sk + i * 256 + dg * 16 + hh * 8);
                    const float qq[8] = {bflo(qv.x), bfhi(qv.x), bflo(qv.y), bfhi(qv.y), bflo(qv.z), bfhi(qv.z), bflo(qv.w), bfhi(qv.w)};
                    const float kk[8] = {bflo(kv.x), bfhi(kv.x), bflo(kv.y), bfhi(kv.y), bflo(kv.z), bfhi(kv.z), bflo(kv.w), bfhi(kv.w)};
#pragma unroll
                    for (int j = 0; j < 8; ++j) { const int jj = hh * 8 + j; C[jj] = fg * C[jj] + kk[j] * vt; nn[jj] = fg * nn[jj] + ig * kk[j]; num += qq[j] * C[jj]; den += qq[j] * nn[jj]; }
                }
                num = sum16(num); den = sum16(den);
                if (dg == 0) so[i * 32 + vv] = num / fmaxf(fabsf(den), __expf(-m));
            }
            __syncthreads();
            { const int rr = tid >> 3, c4 = (tid & 7) * 4; const f32x4 ov = *(const LAS f32x4*)(so + rr * 32 + c4);
                v2u w; w.x = pk2(ov[0], ov[1]); w.y = pk2(ov[2], ov[3]); *(v2u*)(MV + (rowbase + (size_t)ch * 64 + rr) * D + h * 256 + vs * 32 + c4) = w; }
        }
#undef SM_LOAD
        __syncthreads();
    }
}

__device__ __forceinline__ void ph_post(const Ctx& c, int l) {
    const int tid = TID(), lane = tid & 63, wave = tid >> 6, gw = BID() * NWAVES + wave, NGW = gridDim.x * NWAVES;
    bf16* PJ = (bf16*)(c.ws + WS_PROJ);
    const bf16* OA = PJ + (size_t)P_VA * PSTRIDE; const bf16* GS = PJ + (size_t)P_GA * PSTRIDE; const bf16* OS = PJ + (size_t)P_OS * PSTRIDE;
    bf16* AO = PJ + (size_t)P_QA * PSTRIDE; bf16* BO = PJ + (size_t)P_LF * PSTRIDE;
    const bf16* HM = (const bf16*)(c.ws + WS_MV); const bf16* XC = (const bf16*)(c.ws + WS_XC);
    f32x4 gna[4], gnm[4], skp[4]; ld_row_f32(c.in[I_HGN] + (size_t)l * D, lane, gna); ld_row_f32(c.in[I_MGN] + (size_t)l * D, lane, gnm); ld_row_f32(c.in[I_MSKIP] + (size_t)l * D, lane, skp);
    for (int slot = gw; slot < M / 16; slot += NGW) {
        for (int r = 0; r < 16; ++r) {
            const size_t ro = (size_t)(slot * 16 + r) * D;
            f32x4 oa[4], gs[4], hm[4], xc[4], os[4], ao[4], bo[4];
            ld_row_bf16(OA + ro, lane, oa); ld_row_bf16(GS + ro, lane, gs); ld_row_bf16(HM + ro, lane, hm); ld_row_bf16(XC + ro, lane, xc); ld_row_bf16(OS + ro, lane, os);
#pragma unroll
            for (int j = 0; j < 4; ++j) {
                const float ss = half_sum((oa[j][0] * oa[j][0] + oa[j][1] * oa[j][1]) + (oa[j][2] * oa[j][2] + oa[j][3] * oa[j][3]));
                const float ra = rsqrtf(ss * (1.0f / 128.0f) + EPS);
                ao[j] = oa[j] * ra * gna[j] * gs[j];
                const float mu = wave_sum((hm[j][0] + hm[j][1]) + (hm[j][2] + hm[j][3])) * (1.0f / 256.0f);
                const f32x4 d = hm[j] - mu;
                const float var = wave_sum((d[0] * d[0] + d[1] * d[1]) + (d[2] * d[2] + d[3] * d[3])) * (1.0f / 256.0f);
                const float rb = rsqrtf(var + EPS);
                bo[j] = os[j] * (d * rb * gnm[j] + skp[j] * xc[j]);
            }
            st_row_bf16(AO + ro, lane, ao); st_row_bf16(BO + ro, lane, bo);
        }
    }
}
constexpr int TAB_OFF = MISC_OFF + 256;
__device__ __forceinline__ void moe_tables(const Ctx& c, int jm, LAS unsigned char* lds) {
    LAS int* tab = (LAS int*)(lds + TAB_OFF);
    __syncthreads();
    if (TID() == 0) { unsigned* cnt = (unsigned*)c.ws + CW_CNT + 64 * jm; int accp = 0;
        for (int e = 0; e < 8; ++e) { const int n = (int)__hip_atomic_load(cnt + e, __ATOMIC_RELAXED, __HIP_MEMORY_SCOPE_AGENT); const int p = (n + 255) >> 8; tab[e] = p; tab[8 + e] = accp; accp += p; }
        tab[16] = accp; }
    __syncthreads();
}
__device__ __forceinline__ void ph_res1(const Ctx& c, int l, LAS unsigned char* lds) {
    const int tid = TID(), lane = tid & 63, wave = tid >> 6, gw = BID() * NWAVES + wave, NGW = gridDim.x * NWAVES;
    const bool moe = (l & 1) != 0; const int jm = l >> 1;
    LAS float* rt = (LAS float*)lds;
    if (moe) { const f32x4* src = (const f32x4*)(c.in[I_ROUTER] + (size_t)jm * D * NEXP); for (int i = tid; i < D * NEXP / 4; i += NTHR) ((LAS f32x4*)rt)[i] = src[i]; }
    __syncthreads();
    const float* xin = (l == 0) ? c.in[I_X] : c.out;
    const bf16* Y = (const bf16*)(c.ws + WS_PROJ) + (size_t)P_OS * PSTRIDE; bf16* H = (bf16*)(c.ws + WS_H);
    unsigned* cnt = (unsigned*)c.ws + CW_CNT + 64 * jm;
    int* TOKEP = (int*)(c.ws + WS_TOKEP); float* TOKW = (float*)(c.ws + WS_TOKW);
    for (int slot = gw; slot < M / 16; slot += NGW) {
        const int row0 = slot * 16, b = row0 / SEQ;
        f32x4 gpm[4], gt[4], gpf[4], scf[4], shf[4];
        ld_row_f32(c.in[I_GPOSTMIX] + (size_t)l * D, lane, gpm); ld_row_f32(modp(c, l, b, 2), lane, gt); ld_row_f32(c.in[I_GPREFFN] + (size_t)l * D, lane, gpf);
        ld_row_f32(modp(c, l, b, 4), lane, scf); ld_row_f32(modp(c, l, b, 3), lane, shf);
        for (int r = 0; r < 16; ++r) {
            const int row = row0 + r; const size_t ro = (size_t)row * D;
            f32x4 y[4], x[4], h[4]; ld_row_bf16(Y + ro, lane, y); ld_row_f32(xin + ro, lane, x);
            const float rr = rsqrtf(row_sumsq(y) * (1.0f / 1024.0f) + EPS);
#pragma unroll
            for (int j = 0; j < 4; ++j) { x[j] = x[j] + gt[j] * (y[j] * rr * gpm[j]); *(f32x4*)(c.out + ro + 4 * lane + 256 * j) = x[j]; }
            norm_mod(x, gpf, scf, shf, h); st_row_bf16(H + ro, lane, h);
            if (moe) {
                f32x4 l0 = {0.f, 0.f, 0.f, 0.f}, l1 = l0;
#pragma unroll
                for (int j = 0; j < 4; ++j)
#pragma unroll
                    for (int i = 0; i < 4; ++i) { const int ch = 4 * lane + 256 * j + i; l0 += *(const LAS f32x4*)(rt + ch * 8) * h[j][i]; l1 += *(const LAS f32x4*)(rt + ch * 8 + 4) * h[j][i]; }
                float lg[8];
#pragma unroll
                for (int e = 0; e < 4; ++e) { lg[e] = wave_sum(l0[e]); lg[4 + e] = wave_sum(l1[e]); }
                int i1 = 0; float v1 = lg[0];
#pragma unroll
                for (int e = 1; e < 8; ++e) if (lg[e] > v1) { v1 = lg[e]; i1 = e; }
                int i2 = -1; float v2 = -3.0e38f;
#pragma unroll
                for (int e = 0; e < 8; ++e) if (e != i1 && lg[e] > v2) { v2 = lg[e]; i2 = e; }
                if (lane == 0) { const float w1 = 1.0f / (1.0f + __expf(v2 - v1));
                    const int p1 = (int)atomicAdd(cnt + i1, 1u), p2 = (int)atomicAdd(cnt + i2, 1u);
                    *(int4*)(TOKEP + (size_t)row * 4) = make_int4(i1, p1, i2, p2); *(float2*)(TOKW + (size_t)row * 2) = make_float2(w1, 1.0f - w1); }
            }
        }
    }
}
__device__ __forceinline__ void ph_gather(const Ctx& c, int l, LAS unsigned char* lds) {
    const int tid = TID(), lane = tid & 63, wave = tid >> 6, gw = BID() * NWAVES + wave, NGW = gridDim.x * NWAVES;
    moe_tables(c, l >> 1, lds); const LAS int* tab = (const LAS int*)(lds + TAB_OFF);
    const bf16* H = (const bf16*)(c.ws + WS_H); bf16* AG = (bf16*)(c.ws + WS_AG);
    const int* TOKEP = (const int*)(c.ws + WS_TOKEP); int* TOKD = (int*)(c.ws + WS_TOKD);
    for (int row = gw; row < M; row += NGW) {
        const int4 ep = *(const int4*)(TOKEP + (size_t)row * 4);
        const int d1 = tab[8 + ep.x] * 256 + ep.y, d2 = tab[8 + ep.z] * 256 + ep.w;
        const v4u a = *(const v4u*)(H + (size_t)row * D + lane * 8), b = *(const v4u*)(H + (size_t)row * D + 512 + lane * 8);
        *(v4u*)(AG + (size_t)d1 * D + lane * 8) = a; *(v4u*)(AG + (size_t)d1 * D + 512 + lane * 8) = b;
        *(v4u*)(AG + (size_t)d2 * D + lane * 8) = a; *(v4u*)(AG + (size_t)d2 * D + 512 + lane * 8) = b;
        if (lane == 0) *(int2*)(TOKD + (size_t)row * 2) = make_int2(d1, d2);
    }
}
__device__ __forceinline__ void ph_res2(const Ctx& c, int l) {
    const int tid = TID(), lane = tid & 63, wave = tid >> 6, gw = BID() * NWAVES + wave, NGW = gridDim.x * NWAVES;
    const bool moe = (l & 1) != 0;
    const bf16* Y2 = (const bf16*)(c.ws + WS_PROJ) + (size_t)4 * PSTRIDE; const bf16* YS = (const bf16*)(c.ws + WS_YS); bf16* H = (bf16*)(c.ws + WS_H);
    const int* TOKD = (const int*)(c.ws + WS_TOKD); const float* TOKW = (const float*)(c.ws + WS_TOKW);
    const int ln = (l + 1 < DEPTH) ? l + 1 : l;
    for (int slot = gw; slot < M / 16; slot += NGW) {
        const int row0 = slot * 16, b = row0 / SEQ;
        f32x4 gpo[4], gt[4], gpm[4], scm[4], shm[4];
        ld_row_f32(c.in[I_GPOSTFFN] + (size_t)l * D, lane, gpo); ld_row_f32(modp(c, l, b, 5), lane, gt); ld_row_f32(c.in[I_GPREMIX] + (size_t)ln * D, lane, gpm);
        ld_row_f32(modp(c, ln, b, 1), lane, scm); ld_row_f32(modp(c, ln, b, 0), lane, shm);
        for (int r = 0; r < 16; ++r) {
            const int row = row0 + r; const size_t ro = (size_t)row * D;
            f32x4 y[4], x[4], h[4];
            if (moe) { const int2 d = *(const int2*)(TOKD + (size_t)row * 2); const float2 w = *(const float2*)(TOKW + (size_t)row * 2);
                f32x4 ya[4], yb[4]; ld_row_bf16(YS + (size_t)d.x * D, lane, ya); ld_row_bf16(YS + (size_t)d.y * D, lane, yb);
#pragma unroll
                for (int j = 0; j < 4; ++j) y[j] = ya[j] * w.x + yb[j] * w.y; }
            else ld_row_bf16(Y2 + ro, lane, y);
            ld_row_f32(c.out + ro, lane, x);
            const float rr = rsqrtf(row_sumsq(y) * (1.0f / 1024.0f) + EPS);
#pragma unroll
            for (int j = 0; j < 4; ++j) { x[j] = x[j] + gt[j] * (y[j] * rr * gpo[j]); *(f32x4*)(c.out + ro + 4 * lane + 256 * j) = x[j]; }
            if (l + 1 < DEPTH) { norm_mod(x, gpm, scm, shm, h); st_row_bf16(H + ro, lane, h); }
        }
    }
}

constexpr int PH_PER_LAYER = 12, NPH = 2 + DEPTH * PH_PER_LAYER;
__global__ void __launch_bounds__(NTHR, 2) fwd(Ctx c) {
    extern __shared__ __attribute__((aligned(16))) unsigned char lds_raw[];
    LAS unsigned char* lds = (LAS unsigned char*)lds_raw;
    volatile LAS unsigned* MISC = (volatile LAS unsigned*)(lds + MISC_OFF);
    if (threadIdx.x < 64) MISC[threadIdx.x] = 0u;
    __syncthreads();
    const int lo = c.ph_lo, hi = c.ph_hi, G = gridDim.x;
    XcdBarrier bar; bar.bar = (unsigned*)c.ws + CW_BAR; bar.x = 0; bar.st = MISC + 8;
    if (hi - lo > 1) bar = xcd_barrier_post((unsigned*)c.ws + CW_BAR, MISC + 8);
#ifndef PH_MASK
#define PH_MASK 0xFFFF
#endif
#define IN(p) (lo <= (p) && (p) < hi)
#define ON(k) ((PH_MASK >> (k)) & 1)
#define BAR_AFTER(p) do { if ((p) + 1 < hi) xcd_barrier(bar); } while (0)
    if (ON(12) && IN(0)) { ph_mod(c, lds); ph_lb(c); ph_cvt(c, 0, lds); BAR_AFTER(0); }
    if (ON(13) && IN(1)) { ph_norm0(c); BAR_AFTER(1); }
    for (int l = 0; l < DEPTH; ++l) {
        const int base = 2 + l * PH_PER_LAYER; const bool moe = (l & 1) != 0;
        Ctx cl = c; cl.ws = opq_p(c.ws); cl.out = (float*)opq_p((unsigned char*)c.out);
        unsigned char* ws = cl.ws; bf16* PJ = (bf16*)(ws + WS_PROJ); const int bid = BID();
        int KD = opq_s(D);
        if (ON(0) && IN(base + 0)) {
            pg8::Gemm g{(const bf16*)(ws + WS_H), (const bf16*)(ws + WS_WIN), M, DIN, KD}; pg8::UOrder S; S.init(0, M, DIN, G, bid);
            pg8::EpiWin E{PJ, (const float*)(ws + WS_LB) + l * 1024, PSTRIDE};
            pg8::gemm_phase<pg8::EpiWin, pg8::UOrder, true, true>(lds, g, S, E);
            BAR_AFTER(base + 0); }
        if (ON(1) && IN(base + 1)) { ph_prep(cl, l); BAR_AFTER(base + 1); }
        if (ON(2) && IN(base + 2)) { ph_scan_a(cl, lds); BAR_AFTER(base + 2); }
        if (ON(3) && IN(base + 3)) { ph_scan_m(cl, lds); BAR_AFTER(base + 3); }
        if (ON(4) && IN(base + 4)) { ph_post(cl, l); BAR_AFTER(base + 4); }
        if (ON(5) && IN(base + 5)) {
            pg8::Gemm g{PJ + (size_t)P_QA * PSTRIDE, (const bf16*)(ws + WS_WAB), M, D, KD}; pg8::UOrder S; S.init(1, M, D, G, bid);
            pg8::EpiProj E{PJ + (size_t)P_GTA * PSTRIDE, PSTRIDE, (float*)(PJ + (size_t)P_GA * PSTRIDE), PJ + (size_t)P_VA * PSTRIDE};
            pg8::gemm_phase<pg8::EpiProj, pg8::UOrder, true, true>(lds, g, S, E);
            BAR_AFTER(base + 5); }
        if (ON(6) && IN(base + 6)) {
            pg8::Gemm g{PJ + (size_t)P_VA * PSTRIDE, (const bf16*)(ws + WS_WO), M, D, KD}; pg8::UOrder S; S.init(0, M, D, G, bid);
            pg8::EpiPlain E{PJ + (size_t)P_OS * PSTRIDE, D};
            pg8::gemm_phase<pg8::EpiPlain, pg8::UOrder, true, true>(lds, g, S, E);
            BAR_AFTER(base + 6); }
        if (ON(7) && IN(base + 7)) { ph_res1(cl, l, lds); BAR_AFTER(base + 7); }
        if (ON(8) && IN(base + 8) && moe) { ph_gather(cl, l, lds); BAR_AFTER(base + 8); }
        if (ON(9) && IN(base + 9)) {
            pg8::Gemm g{(const bf16*)(ws + (moe ? WS_AG : WS_H)), (const bf16*)(ws + WS_WF), M, 2 * DFF, KD}; pg8::UOrder S; S.init(0, M, 2 * DFF, G, bid);
            pg8::EpiSwi E{PJ, moe ? DFE : DFF, moe ? 28 : 22};
            if (moe) { moe_tables(cl, l >> 1, lds); S.mode = 2; S.NT = 28; S.tab = (const LAS int*)(lds + TAB_OFF); S.nwg = __builtin_amdgcn_readfirstlane(S.tab[16]) * 28; }
            pg8::gemm_phase<pg8::EpiSwi, pg8::UOrder, true, true>(lds, g, S, E);
            BAR_AFTER(base + 9); }
        if (ON(10) && IN(base + 10)) {
            pg8::Gemm g{PJ, (const bf16*)(ws + WS_WF + (moe ? WF_W2_MOE : WF_W2_DENSE)), M, D, moe ? DFE : DFF}; pg8::UOrder S; S.init(0, M, D, G, bid);
            pg8::EpiPlain E{moe ? (bf16*)(ws + WS_YS) : PJ + (size_t)4 * PSTRIDE, D};
            if (moe) { moe_tables(cl, l >> 1, lds); S.mode = 2; S.NT = 4; S.tab = (const LAS int*)(lds + TAB_OFF); S.nwg = __builtin_amdgcn_readfirstlane(S.tab[16]) * 4; }
            pg8::gemm_phase<pg8::EpiPlain, pg8::UOrder, true, true>(lds, g, S, E);
            BAR_AFTER(base + 10); }
        if (ON(11) && IN(base + 11)) { ph_res2(cl, l); if (l + 1 < DEPTH) ph_cvt(cl, l + 1, lds); BAR_AFTER(base + 11); }
    }
#undef IN
#undef BAR_AFTER
}

#ifndef MK_ONE_LAUNCH
#define MK_ONE_LAUNCH 1
#endif
extern "C" void kernel_launch(void* const* d_in, const int* in_sizes, int n_in, void* d_out, int out_size, void* d_ws, size_t ws_size, hipStream_t stream) {
    static int grid = 0;
    if (grid == 0) {
        if (n_in != 32 || in_sizes[0] != M * D || out_size != M * D || ws_size < WS_END) { fprintf(stderr, "kernel_launch: unexpected shapes / workspace (%d inputs, ws %zu < %zu)\n", n_in, ws_size, (size_t)WS_END); grid = -1; return; }
        int dev = 0, cus = 0;
        if (hipGetDevice(&dev) != hipSuccess || hipDeviceGetAttribute(&cus, hipDeviceAttributeMultiprocessorCount, dev) != hipSuccess) { grid = -1; return; }
        if (hipFuncSetAttribute((const void*)fwd, hipFuncAttributeMaxDynamicSharedMemorySize, LDS_BYTES) != hipSuccess) { fprintf(stderr, "kernel_launch: hipFuncSetAttribute failed\n"); grid = -1; return; }
        (void)hipGetLastError();
        grid = cus;
    }
    if (grid < 0) return;
    if (hipMemsetAsync((char*)d_ws + WS_CTL, 0, CTL_ZERO_BYTES, stream) != hipSuccess) return;
    Ctx c{};
    for (int i = 0; i < 32; ++i) c.in[i] = (const float*)d_in[i];
    c.out = (float*)d_out; c.ws = (unsigned char*)d_ws;
#if MK_ONE_LAUNCH
    c.ph_lo = 0; c.ph_hi = NPH;
    hipLaunchKernelGGL(fwd, dim3(grid), dim3(NTHR), LDS_BYTES, stream, c);
#else
    for (int p = 0; p < NPH; ++p) {
        if (p >= 2) { const int l = (p - 2) / PH_PER_LAYER, k = (p - 2) % PH_PER_LAYER; if (k == 8 && !(l & 1)) continue; }
        c.ph_lo = p; c.ph_hi = p + 1;
        hipLaunchKernelGGL(fwd, dim3(grid), dim3(NTHR), LDS_BYTES, stream, c);
    }
#endif
}
```

```cpp
#include <hip/hip_runtime.h>
#include <cstdio>
#include <cstdint>
namespace pg8 {
#define PG8_LAS __attribute__((address_space(3)))
typedef unsigned short bf16_t;
typedef short bf16x8 __attribute__((ext_vector_type(8)));
typedef float f32x4 __attribute__((ext_vector_type(4)));
typedef unsigned u32x4 __attribute__((ext_vector_type(4)));
constexpr int BM = 256, BK = 64, HALF = 128, HTB = HALF * BK * 2  , STAGE_BYTES = 8 * HTB, NXCD = 8, WGM = 8;

__host__ __device__ __forceinline__ int lds_byte(int r, int c) { const int st = (r >> 4) * 2 + (c >> 5), rr = r & 15, cc = c & 31, ob = rr * 64 + cc * 2; return st * 1024 + (ob ^ (((ob >> 9) & 1) << 5)); }
__host__ __device__ __forceinline__ void stage_rc(int b, int& R, int& C) { const int st = b / 1024, sb = b % 1024, swz = sb ^ (((sb >> 9) & 1) << 5); R = (st >> 1) * 16 + swz / 64; C = (st & 1) * 32 + (swz % 64) / 2; }
__host__ __device__ __forceinline__ int perm32(int rho) { const int n = rho >> 4, i = rho & 15; return 8 * (i >> 2) + 4 * n + (i & 3); }

struct Unit { int pm, pn; };
struct Gemm { const bf16_t* A; const bf16_t* Bt; int M, N, K; };

struct StaticOrder {
    int nM, nN, nwg, G, c;
    __host__ __device__ void init(int M, int N, int G_, int c_) { nM = M / BM; nN = N / BM; nwg = nM * nN; G = G_; c = c_; }
    __host__ __device__ bool next(int i, Unit& u) const {
        const long L = (long)i * G + c; if (L >= nwg) return false;
        int wgid = (int)L; { const int q = nwg / NXCD, r = nwg % NXCD, xcd = wgid % NXCD, off = wgid / NXCD; wgid = (xcd < r ? xcd * (q + 1) : r * (q + 1) + (xcd - r) * q) + off; }
        const int nig = WGM * nN, gid = wgid / nig, fm = gid * WGM, gsz = (nM - fm) < WGM ? (nM - fm) : WGM;
        u.pm = fm + ((wgid % nig) % gsz); u.pn = (wgid % nig) / gsz; return true;
    }
    __device__ __forceinline__ void a_ready(const Unit&) const {}
    __device__ __forceinline__ void done(const Unit&) const {}
};
__device__ __forceinline__ unsigned cvt_pk_bf16(float lo, float hi) { unsigned r; asm volatile("v_cvt_pk_bf16_f32 %0, %1, %2" : "=v"(r) : "v"(lo), "v"(hi)); return r; }
struct UOrder {
    int mode, nM, nN, nwg, G, c, NT; const PG8_LAS int* tab;
    __device__ __forceinline__ void init(int mode_, int M, int N, int G_, int c_) { mode = mode_; nM = M / BM; nN = N / BM; nwg = nM * nN; G = G_; c = c_; NT = 1; tab = nullptr; }
    __device__ __forceinline__ bool next(int i, Unit& u) const {
        const int which = (mode == 1) ? (i & 1) : 0; const int ii = (mode == 1) ? (i >> 1) : i;
        const long L = (long)ii * G + c; if (L >= nwg) return false;
        int wgid = (int)L; { const int q = nwg / NXCD, r = nwg % NXCD, xcd = wgid % NXCD, off = wgid / NXCD; wgid = (xcd < r ? xcd * (q + 1) : r * (q + 1) + (xcd - r) * q) + off; }
        if (mode == 2) {
            int r = wgid, E = 0;
#pragma unroll
            for (int k = 0; k < 7; ++k) { const int uk = tab[k] * NT; if (E == k && r >= uk) { r -= uk; E = k + 1; } }
            const int P = tab[E], B = tab[8 + E];
            const int nig = WGM * NT, gid = r / nig, fm = gid * WGM, gsz = (P - fm) < WGM ? (P - fm) : WGM, rr = r - gid * nig;
            u.pm = __builtin_amdgcn_readfirstlane(B + fm + rr % gsz); u.pn = __builtin_amdgcn_readfirstlane(E * NT + rr / gsz); return true;
        }
        const int nig = WGM * nN, gid = wgid / nig, fm = gid * WGM, gsz = (nM - fm) < WGM ? (nM - fm) : WGM;
        u.pm = fm + ((wgid % nig) % gsz); u.pn = (wgid % nig) / gsz;
        if (which) { u.pm += nM; u.pn += nN; }
        return true;
    }
    __device__ __forceinline__ void a_ready(const Unit&) const {}
    __device__ __forceinline__ void done(const Unit&) const {}
};

__device__ __forceinline__ float fsig(float v) { return __builtin_amdgcn_rcpf(1.0f + __expf(-v)); }
__device__ __forceinline__ float bflo(unsigned w) { return __uint_as_float(w << 16); }
__device__ __forceinline__ float bfhi(unsigned w) { return __uint_as_float(w & 0xffff0000u); }
#define PG8_X8(x, ai, bj, m) float x[8]; { const f32x4 _a = acc[ai][bj][m][0], _b = acc[ai][bj][m][1]; x[0] = _a[0]; x[1] = _a[1]; x[2] = _a[2]; x[3] = _a[3]; x[4] = _b[0]; x[5] = _b[1]; x[6] = _b[2]; x[7] = _b[3]; }
#define PG8_PACK8(w, x) u32x4 w; w.x = cvt_pk_bf16(x[0], x[1]); w.y = cvt_pk_bf16(x[2], x[3]); w.z = cvt_pk_bf16(x[4], x[5]); w.w = cvt_pk_bf16(x[6], x[7]);

struct EpiWin {
    static constexpr bool PERM = true, AFTER_DRAIN = false;
    bf16_t* P; const float* lb; size_t pstride;
    __device__ __forceinline__ void operator()(const f32x4 (&acc)[2][2][4][2], const Unit& u, int wr, int wc, int fr, int fq) const {
        const int part = u.pn >> 2;
        const int mode = (part == 0 || part == 3) ? 1 : (part == 1) ? 3 : (part >= 5) ? 2 : 0;
        bf16_t* base = P + (size_t)part * pstride;
        const int row0 = u.pm * BM + wr * 64 + fr, col0 = (u.pn & 3) * BM + wc * 32 + 8 * fq;
        float lbv[2][8];
#pragma unroll
        for (int bj = 0; bj < 2; ++bj)
#pragma unroll
            for (int j = 0; j < 8; ++j) lbv[bj][j] = 0.f;
        if (mode == 3) {
#pragma unroll
            for (int bj = 0; bj < 2; ++bj) { const f32x4 a = *(const f32x4*)(lb + col0 + bj * HALF), b = *(const f32x4*)(lb + col0 + bj * HALF + 4);
                lbv[bj][0] = a[0]; lbv[bj][1] = a[1]; lbv[bj][2] = a[2]; lbv[bj][3] = a[3]; lbv[bj][4] = b[0]; lbv[bj][5] = b[1]; lbv[bj][6] = b[2]; lbv[bj][7] = b[3]; }
        }
#pragma unroll
        for (int ai = 0; ai < 2; ++ai)
#pragma unroll
            for (int m = 0; m < 4; ++m) { bf16_t* rowp = base + (size_t)(row0 + ai * HALF + m * 16) * 1024 + col0;
#pragma unroll
                for (int bj = 0; bj < 2; ++bj) { PG8_X8(x, ai, bj, m)
                    if (mode != 0) {
#pragma unroll
                        for (int j = 0; j < 8; ++j) { const float s = fsig(x[j]);
                            if (mode == 1) x[j] = x[j] * s; else if (mode == 2) x[j] = s; else x[j] = fmaxf(__logf(lbv[bj][j] + (1.0f - lbv[bj][j]) * s), -30.0f); } }
                    PG8_PACK8(w, x) *(u32x4*)(rowp + bj * HALF) = w; } }
    }
};
struct EpiProj {
    static constexpr bool PERM = true, AFTER_DRAIN = false;
    const bf16_t* gates; size_t pstride; float* T1; bf16_t* MX;
    __device__ __forceinline__ void operator()(const f32x4 (&acc)[2][2][4][2], const Unit& u, int wr, int wc, int fr, int fq) const {
        const int which = u.pn >> 2;
        const bf16_t* g = gates + (size_t)which * pstride;
        const int row0 = (u.pm & 127) * BM + wr * 64 + fr, col0 = (u.pn & 3) * BM + wc * 32 + 8 * fq;
#pragma unroll
        for (int ai = 0; ai < 2; ++ai)
#pragma unroll
            for (int m = 0; m < 4; ++m) { const size_t off = (size_t)(row0 + ai * HALF + m * 16) * 1024 + col0;
#pragma unroll
                for (int bj = 0; bj < 2; ++bj) { PG8_X8(x, ai, bj, m)
                    const u32x4 gv = *(const u32x4*)(g + off + bj * HALF);
                    x[0] *= bflo(gv.x); x[1] *= bfhi(gv.x); x[2] *= bflo(gv.y); x[3] *= bfhi(gv.y); x[4] *= bflo(gv.z); x[5] *= bfhi(gv.z); x[6] *= bflo(gv.w); x[7] *= bfhi(gv.w);
                    float* tp = T1 + off + bj * HALF;
                    if (which == 0) { *(f32x4*)tp = (f32x4){x[0], x[1], x[2], x[3]}; *(f32x4*)(tp + 4) = (f32x4){x[4], x[5], x[6], x[7]}; }
                    else { const f32x4 t0 = *(const f32x4*)tp, t1 = *(const f32x4*)(tp + 4);
                        x[0] += t0[0]; x[1] += t0[1]; x[2] += t0[2]; x[3] += t0[3]; x[4] += t1[0]; x[5] += t1[1]; x[6] += t1[2]; x[7] += t1[3];
                        PG8_PACK8(w, x) *(u32x4*)(MX + off + bj * HALF) = w; } } }
    }
};
struct EpiSwi {
    static constexpr bool PERM = true, AFTER_DRAIN = false;
    bf16_t* Gm; int ldg, NT;
    __device__ __forceinline__ void operator()(const f32x4 (&acc)[2][2][4][2], const Unit& u, int wr, int wc, int fr, int fq) const {
        const int pnl = u.pn - (u.pn / NT) * NT;
        const int row0 = u.pm * BM + wr * 64 + fr, col0 = pnl * HALF + wc * 32 + 8 * fq;
#pragma unroll
        for (int ai = 0; ai < 2; ++ai)
#pragma unroll
            for (int m = 0; m < 4; ++m) { bf16_t* rowp = Gm + (size_t)(row0 + ai * HALF + m * 16) * ldg + col0;
                PG8_X8(x, ai, 0, m) PG8_X8(y, ai, 1, m)
#pragma unroll
                for (int j = 0; j < 8; ++j) x[j] = x[j] * fsig(x[j]) * y[j];
                PG8_PACK8(w, x) *(u32x4*)rowp = w; }
    }
};
struct EpiPlain {
    static constexpr bool PERM = true, AFTER_DRAIN = false;
    bf16_t* O; int ldc;
    __device__ __forceinline__ void operator()(const f32x4 (&acc)[2][2][4][2], const Unit& u, int wr, int wc, int fr, int fq) const {
        const int row0 = u.pm * BM + wr * 64 + fr, col0 = (u.pn & 3) * BM + wc * 32 + 8 * fq;
#pragma unroll
        for (int ai = 0; ai < 2; ++ai)
#pragma unroll
            for (int m = 0; m < 4; ++m) { bf16_t* rowp = O + (size_t)(row0 + ai * HALF + m * 16) * ldc + col0;
#pragma unroll
                for (int bj = 0; bj < 2; ++bj) { PG8_X8(x, ai, bj, m) PG8_PACK8(w, x) *(u32x4*)(rowp + bj * HALF) = w; } }
    }
};
template <class Epi, class Sched, bool ALIGN_EPI = false, bool SP2 = false>
__device__ __forceinline__ void gemm_phase(PG8_LAS unsigned char* lds, const Gemm g, const Sched& S, const Epi& E) {
    int tid_ = threadIdx.x; asm volatile("" : "+v"(tid_));
    const int tid = tid_, wid = __builtin_amdgcn_readfirstlane(tid >> 6), lane = tid & 63, wr = wid >> 2, wc = wid & 3, fr = lane & 15, fq = lane >> 4;
    const int K = g.K, nt = K / BK;
    unsigned voffA[2], voffB[2];
#pragma unroll
    for (int i = 0; i < 2; ++i) { int R, C; stage_rc(tid * 16 + i * 8192, R, C); const int Rb = Epi::PERM ? ((R & ~31) + perm32(R & 31)) : R;
        voffA[i] = (unsigned)(R * K + C) * 2u; voffB[i] = (unsigned)(Rb * K + C) * 2u; }
    const size_t kstep = (size_t)(BK * 2);
    const size_t hstep = (size_t)HALF * K * 2;
    const size_t tstep = 2 * hstep;
    const unsigned ldsw = (unsigned)wid * 1024u;
    const int aoff = lds_byte(wr * 64 + fr, fq * 8), boff = lds_byte(wc * 32 + fr, fq * 8);
#define PG8_SA(b, h) (((b) * 2 + (h)) * HTB)
#define PG8_SB(b, h) ((4 + (b) * 2 + (h)) * HTB)
#define PG8_STAGE(bufoff, gbase, voff) do { _Pragma("unroll") for (int _i = 0; _i < 2; ++_i) \
        __builtin_amdgcn_global_load_lds((const unsigned*)((const char*)(gbase) + (voff)[_i]), (PG8_LAS unsigned*)(lds + (bufoff) + ldsw + _i * 8192), 16, 0, 0); } while (0)
#define PG8_LDA(dst, b, h) do { _Pragma("unroll") for (int m = 0; m < 4; ++m) _Pragma("unroll") for (int k = 0; k < 2; ++k) dst[m][k] = *(const PG8_LAS bf16x8*)(lds + PG8_SA(b, h) + aoff + m * 2048 + k * 1024); } while (0)
#define PG8_LDB(dst, b, h) do { _Pragma("unroll") for (int n = 0; n < 2; ++n) _Pragma("unroll") for (int k = 0; k < 2; ++k) dst[n][k] = *(const PG8_LAS bf16x8*)(lds + PG8_SB(b, h) + boff + n * 2048 + k * 1024); } while (0)
#define PG8_MMA(ai, bj, At, Bt) do { __builtin_amdgcn_s_setprio(1); _Pragma("unroll") for (int m = 0; m < 4; ++m) _Pragma("unroll") for (int n = 0; n < 2; ++n) _Pragma("unroll") for (int k = 0; k < 2; ++k) \
        acc[ai][bj][m][n] = __builtin_amdgcn_mfma_f32_16x16x32_bf16(Bt[n][k], At[m][k], acc[ai][bj][m][n], 0, 0, 0); __builtin_amdgcn_s_setprio(0); } while (0)
#define PG8_WAIT_V(n) asm volatile("s_waitcnt vmcnt(" #n ")" ::: "memory")
#define PG8_WAIT_L(n) asm volatile("s_waitcnt lgkmcnt(" #n ")" ::: "memory")
#define PG8_BAR __builtin_amdgcn_s_barrier()
#define PG8_SCHED __builtin_amdgcn_sched_barrier(0)
    Unit cur, nxt; int ui = 0;
    if (!S.next(0, cur)) return;
    f32x4 acc[2][2][4][2];
#pragma unroll
    for (int a = 0; a < 2; ++a)
#pragma unroll
        for (int b = 0; b < 2; ++b)
#pragma unroll
            for (int m = 0; m < 4; ++m)
#pragma unroll
                for (int n = 0; n < 2; ++n) acc[a][b][m][n] = (f32x4){0.f, 0.f, 0.f, 0.f};
    bf16x8 At[4][2], B0[2][2], B1[2][2];
    const char* cA = (const char*)g.A + (size_t)cur.pm * tstep; const char* cB = (const char*)g.Bt + (size_t)cur.pn * tstep;
    S.a_ready(cur);
    if constexpr (SP2) {
        PG8_STAGE(PG8_SB(0, 0), cB, voffB); PG8_STAGE(PG8_SB(0, 1), cB + hstep, voffB); PG8_STAGE(PG8_SA(0, 0), cA, voffA); PG8_STAGE(PG8_SA(0, 1), cA + hstep, voffA);
        if (wr == 1) PG8_BAR;
        PG8_WAIT_V(2); PG8_BAR;
        PG8_STAGE(PG8_SB(1, 0), cB + kstep, voffB); PG8_STAGE(PG8_SA(1, 0), cA + kstep, voffA); PG8_STAGE(PG8_SB(1, 1), cB + hstep + kstep, voffB);
        PG8_WAIT_V(6); PG8_BAR;
    } else {
        PG8_STAGE(PG8_SB(0, 0), cB, voffB); PG8_STAGE(PG8_SA(0, 0), cA, voffA); PG8_STAGE(PG8_SB(0, 1), cB + hstep, voffB); PG8_STAGE(PG8_SA(0, 1), cA + hstep, voffA);
        if (wr == 1) PG8_BAR;
        PG8_WAIT_V(4); PG8_BAR;
        PG8_STAGE(PG8_SB(1, 0), cB + kstep, voffB); PG8_STAGE(PG8_SA(1, 0), cA + kstep, voffA); PG8_STAGE(PG8_SB(1, 1), cB + hstep + kstep, voffB);
        PG8_WAIT_V(6); PG8_BAR;
    }
    for (;;) {
        const bool has_next = S.next(ui + 1, nxt);
        const char* nA = has_next ? (const char*)g.A + (size_t)nxt.pm * tstep : cA; const char* nB = has_next ? (const char*)g.Bt + (size_t)nxt.pn * tstep : cB;
        for (int t = 0; t < nt; t += 2) {
            const bool last = (t == nt - 2);
            const char* a1 = cA + (size_t)(t + 1) * kstep;
            const char* a2 = last ? nA : cA + (size_t)(t + 2) * kstep; const char* b2 = last ? nB : cB + (size_t)(t + 2) * kstep;
            const char* a3 = a2 + kstep; const char* b3 = b2 + kstep;
            if (last && has_next) S.a_ready(nxt);
            if constexpr (SP2) {
            PG8_LDB(B0, 0, 0); PG8_LDB(B1, 0, 1); PG8_SCHED; PG8_LDA(At, 0, 0); PG8_STAGE(PG8_SA(1, 1), a1 + hstep, voffA);
            PG8_WAIT_V(8); PG8_WAIT_L(0); PG8_BAR; PG8_MMA(0, 0, At, B0); PG8_MMA(0, 1, At, B1); PG8_BAR; PG8_SCHED;
            PG8_LDA(At, 0, 1); PG8_STAGE(PG8_SB(0, 0), b2, voffB); PG8_STAGE(PG8_SB(0, 1), b2 + hstep, voffB); PG8_STAGE(PG8_SA(0, 0), a2, voffA);
            PG8_WAIT_V(8); PG8_WAIT_L(0); PG8_BAR; PG8_MMA(1, 0, At, B0); PG8_MMA(1, 1, At, B1); PG8_BAR; PG8_SCHED;
            PG8_LDB(B0, 1, 0); PG8_LDB(B1, 1, 1); PG8_SCHED; PG8_LDA(At, 1, 0); PG8_STAGE(PG8_SA(0, 1), a2 + hstep, voffA);
            PG8_WAIT_V(8); PG8_WAIT_L(0); PG8_BAR; PG8_MMA(0, 0, At, B0); PG8_MMA(0, 1, At, B1); PG8_BAR; PG8_SCHED;
            PG8_LDA(At, 1, 1); PG8_STAGE(PG8_SB(1, 0), b3, voffB); PG8_STAGE(PG8_SB(1, 1), b3 + hstep, voffB); PG8_STAGE(PG8_SA(1, 0), a3, voffA);
            PG8_WAIT_V(8); PG8_WAIT_L(0); PG8_BAR; PG8_MMA(1, 0, At, B0); PG8_MMA(1, 1, At, B1); PG8_BAR; PG8_SCHED;
            } else {
            PG8_LDB(B0, 0, 0); PG8_SCHED; PG8_LDA(At, 0, 0); PG8_STAGE(PG8_SA(1, 1), a1 + hstep, voffA);
            PG8_WAIT_L(8); PG8_BAR; PG8_WAIT_L(0); PG8_MMA(0, 0, At, B0); PG8_BAR; PG8_SCHED;
            PG8_LDB(B1, 0, 1); PG8_STAGE(PG8_SB(0, 0), b2, voffB);
            PG8_BAR; PG8_WAIT_L(0); PG8_MMA(0, 1, At, B1); PG8_BAR;
            PG8_LDA(At, 0, 1); PG8_STAGE(PG8_SA(0, 0), a2, voffA);
            PG8_BAR; PG8_WAIT_L(0); PG8_MMA(1, 0, At, B0); PG8_BAR; PG8_SCHED;
            PG8_STAGE(PG8_SB(0, 1), b2 + hstep, voffB);
            PG8_WAIT_V(6); PG8_BAR; PG8_MMA(1, 1, At, B1); PG8_BAR;
            PG8_LDB(B0, 1, 0); PG8_SCHED; PG8_LDA(At, 1, 0); PG8_STAGE(PG8_SA(0, 1), a2 + hstep, voffA);
            PG8_WAIT_L(8); PG8_BAR; PG8_WAIT_L(0); PG8_MMA(0, 0, At, B0); PG8_BAR; PG8_SCHED;
            PG8_LDB(B1, 1, 1); PG8_STAGE(PG8_SB(1, 0), b3, voffB);
            PG8_BAR; PG8_WAIT_L(0); PG8_MMA(0, 1, At, B1); PG8_BAR;
            PG8_LDA(At, 1, 1); PG8_STAGE(PG8_SA(1, 0), a3, voffA);
            PG8_BAR; PG8_WAIT_L(0); PG8_MMA(1, 0, At, B0); PG8_BAR; PG8_SCHED;
            PG8_STAGE(PG8_SB(1, 1), b3 + hstep, voffB);
            PG8_WAIT_V(6); PG8_BAR; PG8_MMA(1, 1, At, B1); PG8_BAR;
            }
        }
        if constexpr (ALIGN_EPI) { if (wr == 0) PG8_BAR; }
        if constexpr (!Epi::AFTER_DRAIN) { E(acc, cur, wr, wc, fr, fq); S.done(cur); }
        if (!has_next) break;
#pragma unroll
        for (int a = 0; a < 2; ++a)
#pragma unroll
            for (int b = 0; b < 2; ++b)
#pragma unroll
                for (int m = 0; m < 4; ++m)
#pragma unroll
                    for (int n = 0; n < 2; ++n) acc[a][b][m][n] = (f32x4){0.f, 0.f, 0.f, 0.f};
        cur = nxt; cA = nA; cB = nB; ++ui;
        if constexpr (ALIGN_EPI) { if (wr == 1) PG8_BAR; }
    }
    PG8_WAIT_V(0);
    if constexpr (!ALIGN_EPI) { if (wr == 0) PG8_BAR; }
    PG8_BAR;
    if constexpr (Epi::AFTER_DRAIN) { E.fused(acc, cur, wr, wc, fr, fq, lds, wid, lane); S.done(cur); }
#undef PG8_SA
#undef PG8_SB
#undef PG8_STAGE
#undef PG8_LDA
#undef PG8_LDB
#undef PG8_MMA
#undef PG8_WAIT_V
#undef PG8_WAIT_L
#undef PG8_BAR
#undef PG8_SCHED
}
}
constexpr int NWAVES = 8, NTHR = 512;
constexpr int D = 1024, NBATCH = 8, SEQ = 4096, M = NBATCH * SEQ, DEPTH = 4;
constexpr int DIN = 8192, DFF = 2816, NEXP = 8, DFE = 3584;
constexpr float EPS = 1e-6f;
constexpr size_t MiB = 1u << 20;
constexpr size_t WS_CTL = 0, CTL_ZERO_BYTES = 2 * MiB;
constexpr size_t WS_MOD = 1 * MiB;
constexpr size_t WS_LB = 2 * MiB;
constexpr size_t WS_LI = 2 * MiB + 64 * 1024, WS_LF = WS_LI + 512 * 1024;
constexpr size_t WS_TOKEP = 4 * MiB;
constexpr size_t WS_TOKW = WS_TOKEP + 512 * 1024;
constexpr size_t WS_TOKD = WS_TOKW + 256 * 1024;
constexpr size_t WS_WIN = 6 * MiB, WS_WAB = 22 * MiB, WS_WO = 26 * MiB, WS_WF = 28 * MiB;
constexpr size_t WF_W2_DENSE = 12 * MiB, WF_W2_MOE = 112 * MiB;
constexpr size_t WS_H = 196 * MiB;
constexpr size_t WS_PROJ = 260 * MiB, PART = 64 * MiB;
constexpr size_t WS_MQ = 772 * MiB, WS_MK = 836 * MiB, WS_MV = 900 * MiB, WS_XC = 964 * MiB;
constexpr size_t WS_AG = 772 * MiB, WS_YS = 904 * MiB;
constexpr size_t WS_END = 1036 * MiB;
constexpr size_t PSTRIDE = (size_t)M * 1024;
enum { P_QA = 0, P_LF = 1, P_VA = 2, P_GA = 3, P_XM = 4, P_OS = 5, P_GTA = 6, P_GTB = 7 };
constexpr int CW_BAR = 4096;
constexpr int CW_CNT = 16384;
constexpr int RING_BYTES = 131072, MISC_OFF = RING_BYTES, LDS_BYTES = 147456;

#define GAS __attribute__((address_space(1)))
#define LAS __attribute__((address_space(3)))
typedef unsigned short bf16;
typedef unsigned v4u __attribute__((ext_vector_type(4)));
typedef unsigned v2u __attribute__((ext_vector_type(2)));
typedef float f32x4 __attribute__((ext_vector_type(4)));
#define LDS_WAIT() asm volatile("s_waitcnt lgkmcnt(0)" ::: "memory")
#define VM_WAIT() asm volatile("s_waitcnt vmcnt(0)" ::: "memory")
__device__ __forceinline__ unsigned f2bf(float f) { unsigned u = __builtin_bit_cast(unsigned, f); return (u + 0x7fffu + ((u >> 16) & 1u)) >> 16; }
__device__ __forceinline__ unsigned pk2(float lo, float hi) { return f2bf(lo) | (f2bf(hi) << 16); }
__device__ __forceinline__ float bflo(unsigned w) { return __uint_as_float(w << 16); }
__device__ __forceinline__ float bfhi(unsigned w) { return __uint_as_float(w & 0xffff0000u); }
__device__ __forceinline__ float bf2f(bf16 b) { return __uint_as_float((unsigned)b << 16); }
__device__ __forceinline__ float fsigm(float v) { return 1.0f / (1.0f + __expf(-v)); }
__device__ __forceinline__ float wave_sum(float v) {
#pragma unroll
    for (int o = 1; o < 64; o <<= 1) v += __shfl_xor(v, o);
    return v;
}
__device__ __forceinline__ float half_sum(float v) {
#pragma unroll
    for (int o = 1; o < 32; o <<= 1) v += __shfl_xor(v, o);
    return v;
}
__device__ __forceinline__ float sum16(float v) {
#pragma unroll
    for (int o = 1; o < 16; o <<= 1) v += __shfl_xor(v, o);
    return v;
}

__device__ __forceinline__ int opq_v(int v) { asm volatile("" : "+v"(v)); return v; }
__device__ __forceinline__ int opq_s(int v) { asm volatile("" : "+s"(v)); return v; }
__device__ __forceinline__ unsigned char* opq_p(unsigned char* p) { asm volatile("" : "+s"(p)); return p; }
#define TID() opq_v((int)threadIdx.x)
#define BID() opq_s((int)blockIdx.x)
#define XB_TMO      128
#define XB_XCNT(j)  (256  + 64 * (j))
#define XB_XSUB(j)  (1280 + 64 * (j))
#define XB_XGEN(j)  (2304 + 64 * (j))
#define XB_TOP      3328
#define XB_TOPGEN   3392
#define XCD_BAR_WORDS 3456
#define XB_SPIN_CAP (1u << 18)

__device__ __forceinline__ unsigned xb_ld(unsigned* p)              { return __hip_atomic_load(p, __ATOMIC_RELAXED, __HIP_MEMORY_SCOPE_AGENT); }
__device__ __forceinline__ unsigned xb_add(unsigned* p, unsigned v) { return __hip_atomic_fetch_add(p, v, __ATOMIC_RELAXED, __HIP_MEMORY_SCOPE_AGENT); }
__device__ __forceinline__ unsigned xb_xcc_id() { return (unsigned)__builtin_amdgcn_s_getreg((3 << 11) | 20) & 0xFu; }
#define XB_SPIN(cond, bar) do { unsigned _sp = 0; while (cond) { __builtin_amdgcn_s_sleep(1); \
    if ((++_sp & 255u) == 0u) { if (xb_ld(&(bar)[XB_TMO])) break; if (_sp > XB_SPIN_CAP) { atomicAdd(&(bar)[XB_TMO], 1u); break; } } } } while (0)

struct XcdBarrier {
    unsigned* bar; unsigned x;
    volatile LAS unsigned* st;
};

__device__ __forceinline__ XcdBarrier xcd_barrier_post(unsigned* bar, volatile LAS unsigned* st) {
    XcdBarrier b; b.bar = bar; b.x = xb_xcc_id(); b.st = st;
    if (threadIdx.x == 0) (void)xb_add(&bar[XB_XCNT(b.x)], 1u);
    return b;
}
__device__ __forceinline__ void xcd_barrier_complete(unsigned* bar, unsigned x, unsigned& nloc, unsigned& nx) {
    const unsigned G = gridDim.x * gridDim.y * gridDim.z;
    unsigned sum, cnt, mine, sp = 0u;
    for (;;) {
        sum = 0u; cnt = 0u; mine = 0u;
#pragma unroll
        for (unsigned j = 0; j < 16; ++j) { const unsigned c = xb_ld(&bar[XB_XCNT(j)]); sum += c; cnt += (c > 0u) ? 1u : 0u; mine = (j == x) ? c : mine; }
        if (sum == G) break;
        __builtin_amdgcn_s_sleep(1);
        if ((++sp & 255u) == 0u) { if (xb_ld(&bar[XB_TMO])) break; if (sp > XB_SPIN_CAP) { atomicAdd(&bar[XB_TMO], 1u); break; } }
    }
    nloc = mine > 0u ? mine : 1u; nx = cnt > 0u ? cnt : 1u;
}

__device__ __forceinline__ void xcd_barrier(const XcdBarrier& b) {
    asm volatile("s_waitcnt vmcnt(0)" ::: "memory");
    __syncthreads();
    if (threadIdx.x == 0) {
        unsigned* bar = b.bar;
        __builtin_amdgcn_s_waitcnt(0);
        unsigned nloc = b.st[0], nx = b.st[1];
        if (nloc == 0u) { xcd_barrier_complete(bar, b.x, nloc, nx); b.st[0] = nloc; b.st[1] = nx; }
        const unsigned old = xb_add(&bar[XB_XSUB(b.x)], 1u);
        const unsigned gen = old / nloc;
        if (old + 1u == (gen + 1u) * nloc) {
            __builtin_amdgcn_fence(__ATOMIC_RELEASE, "agent");
            asm volatile("s_waitcnt vmcnt(0)" ::: "memory");
            const unsigned og = xb_add(&bar[XB_TOP], 1u);
            const unsigned tg = og / nx;
            if (og + 1u == (tg + 1u) * nx) xb_add(&bar[XB_TOPGEN], 1u);
            else XB_SPIN(xb_ld(&bar[XB_TOPGEN]) == tg, bar);
            __builtin_amdgcn_fence(__ATOMIC_ACQUIRE, "agent");
            xb_add(&bar[XB_XGEN(b.x)], 1u);
            asm volatile("s_waitcnt vmcnt(0)" ::: "memory");
        } else {
            XB_SPIN(xb_ld(&bar[XB_XGEN(b.x)]) == gen, bar);
            __builtin_amdgcn_fence(__ATOMIC_ACQUIRE, "agent");
            asm volatile("s_waitcnt vmcnt(0)" ::: "memory");
        }
    }
    __syncthreads();
}
struct Ctx { const float* in[32]; float* out; unsigned char* ws; int ph_lo, ph_hi; };
enum { I_X = 0, I_C, I_WADA, I_BADA, I_GPREMIX, I_GPOSTMIX, I_GPREFFN, I_GPOSTFFN, I_WIN, I_HLB, I_HGN, I_CONVW, I_CONVB, I_WQ, I_WK, I_WV, I_WIG, I_BIG, I_WFG, I_BFG,
       I_MGN, I_MSKIP, I_WPA, I_WPB, I_WOUT, I_F1, I_F3, I_F2, I_ROUTER, I_M1, I_M3, I_M2 };

__device__ __forceinline__ void ph_mod(const Ctx& c, LAS unsigned char* lds) {
    LAS float* cact = (LAS float*)lds;
    LAS float* part = (LAS float*)(lds + 32768);
    float* MOD = (float*)(c.ws + WS_MOD);
    const float* cin = c.in[I_C]; const float* wada = c.in[I_WADA]; const float* bada = c.in[I_BADA];
    const int tid = TID(), lane = tid & 63, wave = tid >> 6;
    for (int i = tid; i < 8192; i += NTHR) { const float v = cin[i]; cact[i] = v * fsigm(v); }
    __syncthreads();
    for (int u = BID(); u < 384; u += gridDim.x) {
        const int l = u / 96, jb = u % 96, j = jb * 64 + lane;
        const float* w = wada + ((size_t)l * 1024 + wave * 128) * 6144 + j;
        const LAS float* ca = cact + wave * 128;
        float a0 = 0.f, a1 = 0.f, a2 = 0.f, a3 = 0.f, a4 = 0.f, a5 = 0.f, a6 = 0.f, a7 = 0.f;
#pragma unroll 8
        for (int k = 0; k < 128; ++k) { const float wv = w[(size_t)k * 6144];
            a0 += ca[k] * wv; a1 += ca[1024 + k] * wv; a2 += ca[2048 + k] * wv; a3 += ca[3072 + k] * wv;
            a4 += ca[4096 + k] * wv; a5 += ca[5120 + k] * wv; a6 += ca[6144 + k] * wv; a7 += ca[7168 + k] * wv; }
        LAS float* pw = part + wave * 512 + lane;
        pw[0] = a0; pw[64] = a1; pw[128] = a2; pw[192] = a3; pw[256] = a4; pw[320] = a5; pw[384] = a6; pw[448] = a7;
        __syncthreads();
        { const int b = wave; float s = bada[l * 6144 + j];
#pragma unroll
            for (int ww = 0; ww < 8; ++ww) s += part[ww * 512 + b * 64 + lane];
            MOD[(size_t)(l * 8 + b) * 6144 + j] = s; }
        __syncthreads();
    }
}
__device__ __forceinline__ void ph_lb(const Ctx& c) {
    if (BID() != 0) return;
    float* LB = (float*)(c.ws + WS_LB); const float* raw = c.in[I_HLB];
    for (int col = TID(); col < 1024; col += NTHR) {
        const float r0 = raw[col], r1 = raw[1024 + col], r2 = raw[2048 + col], r3 = raw[3072 + col];
        const float mx = fmaxf(fmaxf(r0, r1), fmaxf(r2, r3));
        const float e0 = __expf(r0 - mx), e1 = __expf(r1 - mx), e2 = __expf(r2 - mx), e3 = __expf(r3 - mx), inv = 1.0f / (e0 + e1 + e2 + e3);
        LB[col] = 0.f; LB[1024 + col] = e1 * inv; LB[2048 + col] = (e1 + e2) * inv; LB[3072 + col] = (e1 + e2 + e3) * inv;
    }
}
__device__ __forceinline__ void cvt_item(const float* W, int K, int N, bf16* WT, int rowbase, int mode, LAS float* scr, int item, int lane) {
    const int nblk = N / 32, kb = item / nblk, nb = item % nblk, k0 = 64 * kb, n0 = 32 * nb;
#pragma unroll 8
    for (int i = 0; i < 32; ++i) { const int kk = 2 * i + (lane >> 5); scr[kk * 33 + (lane & 31)] = W[(size_t)(k0 + kk) * N + n0 + (lane & 31)]; }
    LDS_WAIT(); asm volatile("" ::: "memory");
    const int drow0 = rowbase + (mode ? ((n0 >> 7) * 256 + (n0 & 127)) : n0);
    const int cc = lane & 7;
#pragma unroll
    for (int j = 0; j < 4; ++j) { const int n = (lane >> 3) + 8 * j; const LAS float* s = scr + (8 * cc) * 33 + n;
        v4u o; o.x = pk2(s[0 * 33], s[1 * 33]); o.y = pk2(s[2 * 33], s[3 * 33]); o.z = pk2(s[4 * 33], s[5 * 33]); o.w = pk2(s[6 * 33], s[7 * 33]);
        *(v4u*)(WT + (size_t)(drow0 + n) * K + k0 + 8 * cc) = o; }
    LDS_WAIT(); asm volatile("" ::: "memory");
}
__device__ __forceinline__ void ph_cvt(const Ctx& c, int l, LAS unsigned char* lds) {
    const int tid = TID(), lane = tid & 63, wave = __builtin_amdgcn_readfirstlane(tid >> 6);
    LAS float* scr = (LAS float*)(lds + wave * 16384);
    const int gw = BID() * NWAVES + wave, NGW = gridDim.x * NWAVES;
    bf16* WIN = (bf16*)(c.ws + WS_WIN); bf16* WAB = (bf16*)(c.ws + WS_WAB); bf16* WO = (bf16*)(c.ws + WS_WO); bf16* WF = (bf16*)(c.ws + WS_WF);
    const bool moe = (l & 1) != 0; const int j = l >> 1;
    constexpr int I_IN = 16 * 256, I_SQ = 16 * 32, I_D13 = 16 * 88, I_D2 = 44 * 32, I_M13 = 16 * 112, I_M2E = 56 * 32;
    const int total = I_IN + 3 * I_SQ + (moe ? (2 * NEXP * I_M13 + NEXP * I_M2E) : (2 * I_D13 + I_D2));
    for (int it = gw; it < total; it += NGW) {
        int r = it;
        if (r < I_IN) { cvt_item(c.in[I_WIN] + (size_t)l * D * DIN, D, DIN, WIN, 0, 0, scr, r, lane); continue; } r -= I_IN;
        if (r < I_SQ) { cvt_item(c.in[I_WPA] + (size_t)l * D * D, D, D, WAB, 0, 0, scr, r, lane); continue; } r -= I_SQ;
        if (r < I_SQ) { cvt_item(c.in[I_WPB] + (size_t)l * D * D, D, D, WAB, 1024, 0, scr, r, lane); continue; } r -= I_SQ;
        if (r < I_SQ) { cvt_item(c.in[I_WOUT] + (size_t)l * D * D, D, D, WO, 0, 0, scr, r, lane); continue; } r -= I_SQ;
        if (!moe) {
            if (r < I_D13) { cvt_item(c.in[I_F1] + (size_t)j * D * DFF, D, DFF, WF, 0, 1, scr, r, lane); continue; } r -= I_D13;
            if (r < I_D13) { cvt_item(c.in[I_F3] + (size_t)j * D * DFF, D, DFF, WF, 128, 1, scr, r, lane); continue; } r -= I_D13;
            cvt_item(c.in[I_F2] + (size_t)j * DFF * D, DFF, D, (bf16*)(c.ws + WS_WF + WF_W2_DENSE), 0, 0, scr, r, lane);
        } else {
            if (r < NEXP * I_M13) { const int e = r / I_M13; cvt_item(c.in[I_M1] + ((size_t)j * NEXP + e) * D * DFE, D, DFE, WF, e * 2 * DFE, 1, scr, r - e * I_M13, lane); continue; } r -= NEXP * I_M13;
            if (r < NEXP * I_M13) { const int e = r / I_M13; cvt_item(c.in[I_M3] + ((size_t)j * NEXP + e) * D * DFE, D, DFE, WF, e * 2 * DFE + 128, 1, scr, r - e * I_M13, lane); continue; } r -= NEXP * I_M13;
            { const int e = r / I_M2E; cvt_item(c.in[I_M2] + ((size_t)j * NEXP + e) * DFE * D, DFE, D, (bf16*)(c.ws + WS_WF + WF_W2_MOE), e * D, 0, scr, r - e * I_M2E, lane); }
        }
    }
}

__device__ __forceinline__ void ld_row_f32(const float* p, int lane, f32x4 (&v)[4]) {
#pragma unroll
    for (int j = 0; j < 4; ++j) v[j] = *(const f32x4*)(p + 4 * lane + 256 * j);
}
__device__ __forceinline__ void ld_row_bf16(const bf16* p, int lane, f32x4 (&v)[4]) {
#pragma unroll
    for (int j = 0; j < 4; ++j) { const v2u w = *(const v2u*)(p + 4 * lane + 256 * j); v[j] = (f32x4){bflo(w.x), bfhi(w.x), bflo(w.y), bfhi(w.y)}; }
}
__device__ __forceinline__ void st_row_bf16(bf16* p, int lane, const f32x4 (&v)[4]) {
#pragma unroll
    for (int j = 0; j < 4; ++j) { v2u w; w.x = pk2(v[j][0], v[j][1]); w.y = pk2(v[j][2], v[j][3]); *(v2u*)(p + 4 * lane + 256 * j) = w; }
}
__device__ __forceinline__ float row_sumsq(const f32x4 (&v)[4]) {
    float s = 0.f;
#pragma unroll
    for (int j = 0; j < 4; ++j) s += (v[j][0] * v[j][0] + v[j][1] * v[j][1]) + (v[j][2] * v[j][2] + v[j][3] * v[j][3]);
    return wave_sum(s);
}
__device__ __forceinline__ void norm_mod(const f32x4 (&x)[4], const f32x4 (&g)[4], const f32x4 (&sc)[4], const f32x4 (&sh)[4], f32x4 (&h)[4]) {
    const float r = rsqrtf(row_sumsq(x) * (1.0f / 1024.0f) + EPS);
#pragma unroll
    for (int j = 0; j < 4; ++j) h[j] = (x[j] * r) * g[j] * (sc[j] + 1.0f) + sh[j];
}
__device__ __forceinline__ const float* modp(const Ctx& c, int l, int b, int which) { return (const float*)(c.ws + WS_MOD) + ((size_t)(l * 8 + b) * 6 + which) * 1024; }

__device__ __forceinline__ void ph_norm0(const Ctx& c) {
    const int tid = TID(), lane = tid & 63, wave = tid >> 6, gw = BID() * NWAVES + wave, NGW = gridDim.x * NWAVES;
    bf16* H = (bf16*)(c.ws + WS_H);
    for (int slot = gw; slot < M / 16; slot += NGW) {
        const int row0 = slot * 16, b = row0 / SEQ;
        f32x4 g[4], sc[4], sh[4]; ld_row_f32(c.in[I_GPREMIX], lane, g); ld_row_f32(modp(c, 0, b, 1), lane, sc); ld_row_f32(modp(c, 0, b, 0), lane, sh);
        for (int r = 0; r < 16; ++r) { f32x4 x[4], h[4]; ld_row_f32(c.in[I_X] + (size_t)(row0 + r) * D, lane, x); norm_mod(x, g, sc, sh, h); st_row_bf16(H + (size_t)(row0 + r) * D, lane, h); }
    }
}
__device__ __forceinline__ void ph_prep(const Ctx& c, int l) {
    const int tid = TID(), lane = tid & 63, wave = tid >> 6, gw = BID() * NWAVES + wave, NGW = gridDim.x * NWAVES;
    const bf16* XM = (const bf16*)(c.ws + WS_PROJ) + (size_t)P_XM * PSTRIDE;
    bf16* MQ = (bf16*)(c.ws + WS_MQ); bf16* MK = (bf16*)(c.ws + WS_MK); bf16* MV = (bf16*)(c.ws + WS_MV); bf16* XC = (bf16*)(c.ws + WS_XC);
    float* LI = (float*)(c.ws + WS_LI); float* LF = (float*)(c.ws + WS_LF);
    const float* cw = c.in[I_CONVW] + (size_t)l * 4 * D; const float* cb = c.in[I_CONVB] + (size_t)l * D;
    const float* wq = c.in[I_WQ] + (size_t)l * 256 * 16; const float* wk = c.in[I_WK] + (size_t)l * 256 * 16; const float* wv = c.in[I_WV] + (size_t)l * 256 * 16;
    const float* wig = c.in[I_WIG] + (size_t)l * 3072 * 4; const float* wfg = c.in[I_WFG] + (size_t)l * 3072 * 4;
    const f32x4 big = *(const f32x4*)(c.in[I_BIG] + l * 4), bfg = *(const f32x4*)(c.in[I_BFG] + l * 4);
    for (int slot = gw; slot < M / 16; slot += NGW) {
        for (int r = 0; r < 16; ++r) {
            const int row = slot * 16 + r, t = row & (SEQ - 1);
            f32x4 gi = {0.f, 0.f, 0.f, 0.f}, gf = {0.f, 0.f, 0.f, 0.f};
#pragma unroll 1
            for (int j = 0; j < 4; ++j) {
                const int ch = 4 * lane + 256 * j, n = lane + 64 * j;
                f32x4 y = *(const f32x4*)(cb + ch); f32x4 xt = {0.f, 0.f, 0.f, 0.f};
#pragma unroll
                for (int jj = 0; jj < 4; ++jj) {
                    if (t - 3 + jj >= 0) { const v2u w = *(const v2u*)(XM + (size_t)(row - 3 + jj) * D + ch); const f32x4 xv = {bflo(w.x), bfhi(w.x), bflo(w.y), bfhi(w.y)};
                        y += *(const f32x4*)(cw + jj * D + ch) * xv; if (jj == 3) xt = xv; }
                }
                f32x4 xc; xc[0] = y[0] * fsigm(y[0]); xc[1] = y[1] * fsigm(y[1]); xc[2] = y[2] * fsigm(y[2]); xc[3] = y[3] * fsigm(y[3]);
                f32x4 q = {0.f, 0.f, 0.f, 0.f}, k = q, v = q;
#pragma unroll
                for (int i = 0; i < 4; ++i) { q += *(const f32x4*)(wq + n * 16 + i * 4) * xc[i]; k += *(const f32x4*)(wk + n * 16 + i * 4) * xc[i]; v += *(const f32x4*)(wv + n * 16 + i * 4) * xt[i]; }
#pragma unroll
                for (int o = 0; o < 4; ++o) {
                    gi += *(const f32x4*)(wig + (size_t)(ch + o) * 4) * q[o] + *(const f32x4*)(wig + (size_t)(1024 + ch + o) * 4) * k[o] + *(const f32x4*)(wig + (size_t)(2048 + ch + o) * 4) * v[o];
                    gf += *(const f32x4*)(wfg + (size_t)(ch + o) * 4) * q[o] + *(const f32x4*)(wfg + (size_t)(1024 + ch + o) * 4) * k[o] + *(const f32x4*)(wfg + (size_t)(2048 + ch + o) * 4) * v[o];
                }
                const size_t off = (size_t)row * D + ch;
                { v2u w; w.x = pk2(q[0], q[1]); w.y = pk2(q[2], q[3]); *(v2u*)(MQ + off) = w; }
                { v2u w; w.x = pk2(k[0] * 0.0625f, k[1] * 0.0625f); w.y = pk2(k[2] * 0.0625f, k[3] * 0.0625f); *(v2u*)(MK + off) = w; }
                { v2u w; w.x = pk2(v[0], v[1]); w.y = pk2(v[2], v[3]); *(v2u*)(MV + off) = w; }
                { v2u w; w.x = pk2(xc[0], xc[1]); w.y = pk2(xc[2], xc[3]); *(v2u*)(XC + off) = w; }
            }
#pragma unroll
            for (int hh = 0; hh < 4; ++hh) { gi[hh] = wave_sum(gi[hh]); gf[hh] = wave_sum(gf[hh]); }
            gi += big; gf += bfg;
            if (lane < 4) { const float z = lane == 0 ? gf[0] : lane == 1 ? gf[1] : lane == 2 ? gf[2] : gf[3]; const float li = lane == 0 ? gi[0] : lane == 1 ? gi[1] : lane == 2 ? gi[2] : gi[3];
                LI[(size_t)row * 4 + lane] = li; LF[(size_t)row * 4 + lane] = fminf(z, 0.f) - __logf(1.0f + __expf(-fabsf(z))); }
        }
    }
}

__device__ __forceinline__ void ph_scan_a_naive(const Ctx& c, LAS unsigned char* lds) {
    const int tid = TID();
    bf16* PJ = (bf16*)(c.ws + WS_PROJ);
    const bf16* Q = PJ + (size_t)P_QA * PSTRIDE; const bf16* LFp = PJ + (size_t)P_LF * PSTRIDE; bf16* V = PJ + (size_t)P_VA * PSTRIDE;
    LAS bf16* sq = (LAS bf16*)lds;
    LAS bf16* sf = (LAS bf16*)(lds + 32768);
    LAS bf16* sv = (LAS bf16*)(lds + 65536);
    LAS float* so = (LAS float*)(lds + 73728);
    const int dg = tid & 15, vv = tid >> 4;
    for (int u = BID(); u < 256; u += gridDim.x) {
        const int b = u >> 5, h = (u >> 2) & 7, vs = u & 3;
        const size_t rowbase = (size_t)b * SEQ;
        float S[8];
#pragma unroll
        for (int j = 0; j < 8; ++j) S[j] = 0.f;
        v4u rq[2], rf[2], rv = {0u, 0u, 0u, 0u};
#define SA_LOAD(ch) do { _Pragma("unroll") for (int k2 = 0; k2 < 2; ++k2) { const int p = tid + NTHR * k2, rr = p >> 4, c8 = p & 15; const size_t o_ = (rowbase + (size_t)(ch) * 64 + rr) * D + h * 128 + c8 * 8; \
            rq[k2] = *(const v4u*)(Q + o_); rf[k2] = *(const v4u*)(LFp + o_); } \
            if (tid < 256) { const int rr = tid >> 2, c8 = tid & 3; rv = *(const v4u*)(V + (rowbase + (size_t)(ch) * 64 + rr) * D + h * 128 + vs * 32 + c8 * 8); } } while (0)
        SA_LOAD(0);
        for (int ch = 0; ch < 64; ++ch) {
            const int buf = ch & 1;
#pragma unroll
            for (int k2 = 0; k2 < 2; ++k2) { const int p = tid + NTHR * k2; *(LAS v4u*)(sq + buf * 8192 + p * 8) = rq[k2]; *(LAS v4u*)(sf + buf * 8192 + p * 8) = rf[k2]; }
            if (tid < 256) *(LAS v4u*)(sv + buf * 2048 + tid * 8) = rv;
            __syncthreads();
            if (ch + 1 < 64) SA_LOAD(ch + 1);
            for (int i = 0; i < 64; ++i) {
                const v4u qv = *(const LAS v4u*)(sq + buf * 8192 + i * 128 + dg * 8), fv = *(const LAS v4u*)(sf + buf * 8192 + i * 128 + dg * 8);
                const float vt = bf2f(sv[buf * 2048 + i * 32 + vv]);
                const float qq[8] = {bflo(qv.x), bfhi(qv.x), bflo(qv.y), bfhi(qv.y), bflo(qv.z), bfhi(qv.z), bflo(qv.w), bfhi(qv.w)};
                const float ff[8] = {bflo(fv.x), bfhi(fv.x), bflo(fv.y), bfhi(fv.y), bflo(fv.z), bfhi(fv.z), bflo(fv.w), bfhi(fv.w)};
                float o = 0.f;
#pragma unroll
                for (int j = 0; j < 8; ++j) { const float f = __expf(ff[j]); S[j] = f * S[j] + (1.0f - f) * vt; o += S[j] * qq[j]; }
                o = sum16(o);
                if (dg == 0) so[i * 32 + vv] = o;
            }
            __syncthreads();
            { const int rr = tid >> 3, c4 = (tid & 7) * 4; const f32x4 ov = *(const LAS f32x4*)(so + rr * 32 + c4);
                v2u w; w.x = pk2(ov[0], ov[1]); w.y = pk2(ov[2], ov[3]); *(v2u*)(V + (rowbase + (size_t)ch * 64 + rr) * D + h * 128 + vs * 32 + c4) = w; }
        }
#undef SA_LOAD
        __syncthreads();
    }
}

__device__ __forceinline__ void ph_scan_m_naive(const Ctx& c, LAS unsigned char* lds) {
    const int tid = TID();
    const bf16* MQ = (const bf16*)(c.ws + WS_MQ); const bf16* MK = (const bf16*)(c.ws + WS_MK); bf16* MV = (bf16*)(c.ws + WS_MV);
    const float* LI = (const float*)(c.ws + WS_LI); const float* LF = (const float*)(c.ws + WS_LF);
    LAS bf16* sq = (LAS bf16*)lds;
    LAS bf16* sk = (LAS bf16*)(lds + 32768);
    LAS bf16* sv = (LAS bf16*)(lds + 65536);
    LAS float* sli = (LAS float*)(lds + 69632);
    LAS float* slf = (LAS float*)(lds + 69888);
    LAS float* so = (LAS float*)(lds + 70144);
    const int dg = tid & 15, vv = tid >> 4;
    for (int u = BID(); u < 256; u += gridDim.x) {
        const int b = u >> 5, h = (u >> 3) & 3, vs = u & 7;
        const size_t rowbase = (size_t)b * SEQ;
        float C[16], nn[16], m = 0.f;
#pragma unroll
        for (int j = 0; j < 16; ++j) { C[j] = 0.f; nn[j] = 0.f; }
        v4u rq[4], rk[4], rv = {0u, 0u, 0u, 0u}; float rli = 0.f, rlf = 0.f;
#define SM_LOAD(ch) do { _Pragma("unroll") for (int k2 = 0; k2 < 4; ++k2) { const int p = tid + NTHR * k2, rr = p >> 5, c8 = p & 31; const size_t o_ = (rowbase + (size_t)(ch) * 64 + rr) * D + h * 256 + c8 * 8; \
            rq[k2] = *(const v4u*)(MQ + o_); rk[k2] = *(const v4u*)(MK + o_); } \
            if (tid < 256) { const int rr = tid >> 2, c8 = tid & 3; rv = *(const v4u*)(MV + (rowbase + (size_t)(ch) * 64 + rr) * D + h * 256 + vs * 32 + c8 * 8); } \
            if (tid < 64) { rli = LI[(rowbase + (size_t)(ch) * 64 + tid) * 4 + h]; rlf = LF[(rowbase + (size_t)(ch) * 64 + tid) * 4 + h]; } } while (0)
        SM_LOAD(0);
        for (int ch = 0; ch < 64; ++ch) {
#pragma unroll
            for (int k2 = 0; k2 < 4; ++k2) { const int p = tid + NTHR * k2; *(LAS v4u*)(sq + p * 8) = rq[k2]; *(LAS v4u*)(sk + p * 8) = rk[k2]; }
            if (tid < 256) *(LAS v4u*)(sv + tid * 8) = rv;
            if (tid < 64) { sli[tid] = rli; slf[tid] = rlf; }
            __syncthreads();
            if (ch + 1 < 64) SM_LOAD(ch + 1);
            for (int i = 0; i < 64; ++i) {
                const float li = sli[i], lf = slf[i];
                const float mn = fmaxf(lf + m, li), fg = __expf(lf + m - mn), ig = __expf(li - mn); m = mn;
                const float vt = bf2f(sv[i * 32 + vv]) * ig;
                float num = 0.f, den = 0.f;
#pragma unroll
                for (int hh = 0; hh < 2; ++hh) {
                    const v4u qv = *(const LAS v4u*)(sq + i * 256 + dg * 16 + hh * 8), kv = *(const LAS v4u*)(sk + i * 256 + dg * 16 + hh * 8);
                    const float qq[8] = {bflo(qv.x), bfhi(qv.x), bflo(qv.y), bfhi(qv.y), bflo(qv.z), bfhi(qv.z), bflo(qv.w), bfhi(qv.w)};
                    const float kk[8] = {bflo(kv.x), bfhi(kv.x), bflo(kv.y), bfhi(kv.y), bflo(kv.z), bfhi(kv.z), bflo(kv.w), bfhi(kv.w)};
#pragma unroll
                    for (int j = 0; j < 8; ++j) { const int jj = hh * 8 + j; C[jj] = fg * C[jj] + kk[j] * vt; nn[jj] = fg * nn[jj] + ig * kk[j]; num += qq[j] * C[jj]; den += qq[j] * nn[jj]; }
                }
                num = sum16(num); den = sum16(den);
                if (dg == 0) so[i * 32 + vv] = num / fmaxf(fabsf(den), __expf(-m));
            }
            __syncthreads();
            { const int rr = tid >> 3, c4 = (tid & 7) * 4; const f32x4 ov = *(const LAS f32x4*)(so + rr * 32 + c4);
                v2u w; w.x = pk2(ov[0], ov[1]); w.y = pk2(ov[2], ov[3]); *(v2u*)(MV + (rowbase + (size_t)ch * 64 + rr) * D + h * 256 + vs * 32 + c4) = w; }
        }
#undef SM_LOAD
        __syncthreads();
    }
}

__device__ __forceinline__ void ph_post(const Ctx& c, int l) {
    const int tid = TID(), lane = tid & 63, wave = tid >> 6, gw = BID() * NWAVES + wave, NGW = gridDim.x * NWAVES;
    bf16* PJ = (bf16*)(c.ws + WS_PROJ);
    const bf16* OA = PJ + (size_t)P_VA * PSTRIDE; const bf16* GS = PJ + (size_t)P_GA * PSTRIDE; const bf16* OS = PJ + (size_t)P_OS * PSTRIDE;
    bf16* AO = PJ + (size_t)P_QA * PSTRIDE; bf16* BO = PJ + (size_t)P_LF * PSTRIDE;
    const bf16* HM = (const bf16*)(c.ws + WS_MV); const bf16* XC = (const bf16*)(c.ws + WS_XC);
    f32x4 gna[4], gnm[4], skp[4]; ld_row_f32(c.in[I_HGN] + (size_t)l * D, lane, gna); ld_row_f32(c.in[I_MGN] + (size_t)l * D, lane, gnm); ld_row_f32(c.in[I_MSKIP] + (size_t)l * D, lane, skp);
    for (int slot = gw; slot < M / 16; slot += NGW) {
        for (int r = 0; r < 16; ++r) {
            const size_t ro = (size_t)(slot * 16 + r) * D;
            f32x4 oa[4], gs[4], hm[4], xc[4], os[4], ao[4], bo[4];
            ld_row_bf16(OA + ro, lane, oa); ld_row_bf16(GS + ro, lane, gs); ld_row_bf16(HM + ro, lane, hm); ld_row_bf16(XC + ro, lane, xc); ld_row_bf16(OS + ro, lane, os);
#pragma unroll
            for (int j = 0; j < 4; ++j) {
                const float ss = half_sum((oa[j][0] * oa[j][0] + oa[j][1] * oa[j][1]) + (oa[j][2] * oa[j][2] + oa[j][3] * oa[j][3]));
                const float ra = rsqrtf(ss * (1.0f / 128.0f) + EPS);
                ao[j] = oa[j] * ra * gna[j] * gs[j];
                const float mu = wave_sum((hm[j][0] + hm[j][1]) + (hm[j][2] + hm[j][3])) * (1.0f / 256.0f);
                const f32x4 d = hm[j] - mu;
                const float var = wave_sum((d[0] * d[0] + d[1] * d[1]) + (d[2] * d[2] + d[3] * d[3])) * (1.0f / 256.0f);
                const float rb = rsqrtf(var + EPS);
                bo[j] = os[j] * (d * rb * gnm[j] + skp[j] * xc[j]);
            }
            st_row_bf16(AO + ro, lane, ao); st_row_bf16(BO + ro, lane, bo);
        }
    }
}
typedef short bf16x8 __attribute__((ext_vector_type(8)));
#define MFMA16(a, b, c) __builtin_amdgcn_mfma_f32_16x16x32_bf16(a, b, c, 0, 0, 0)
__device__ __forceinline__ f32x4 mmT(const LAS bf16* X, int ldx, int m0, const LAS bf16* Y, int ldy, int n0, int k0, f32x4 acc, int lane) {
    const bf16x8 a = *(const LAS bf16x8*)(X + (m0 + (lane & 15)) * ldx + k0 + 8 * (lane >> 4));
    const bf16x8 b = *(const LAS bf16x8*)(Y + (n0 + (lane & 15)) * ldy + k0 + 8 * (lane >> 4));
    return MFMA16(b, a, acc);
}
__device__ __forceinline__ f32x4 mmN(const LAS bf16* X, int ldx, int m0, const LAS bf16* Y, int ldy, int n0, int k0, f32x4 acc, int lane) {
    const bf16x8 a = *(const LAS bf16x8*)(X + (m0 + (lane & 15)) * ldx + k0 + 8 * (lane >> 4));
    const bf16x8 b = *(const LAS bf16x8*)(Y + (n0 + (lane & 15)) * ldy + k0 + 8 * (lane >> 4));
    return MFMA16(a, b, acc);
}
__device__ __forceinline__ v2u pack4(const f32x4 v) { v2u w; w.x = pk2(v[0], v[1]); w.y = pk2(v[2], v[3]); return w; }

__device__ __forceinline__ void ph_scan_a(const Ctx& c, LAS unsigned char* lds) {
    const int tid = TID(), lane = tid & 63, wave = __builtin_amdgcn_readfirstlane(tid >> 6);
    bf16* PJ = (bf16*)(c.ws + WS_PROJ);
    const bf16* Q = PJ + (size_t)P_QA * PSTRIDE; const bf16* LFp = PJ + (size_t)P_LF * PSTRIDE; bf16* V = PJ + (size_t)P_VA * PSTRIDE;
    LAS bf16* LQ = (LAS bf16*)lds;
    LAS bf16* LK = (LAS bf16*)(lds + 17408);
    LAS bf16* LKT = (LAS bf16*)(lds + 34816);
    LAS bf16* LVT = (LAS bf16*)(lds + 53248);
    LAS bf16* LP = (LAS bf16*)(lds + 57856);
    LAS bf16* LST = (LAS bf16*)(lds + 67072);
    LAS float* SEG = (LAS float*)(lds + 75776);
    LAS float* ER = (LAS float*)(lds + 77824);
    LAS float* EB = (LAS float*)(lds + 78336);
    LAS float* EK = (LAS float*)(lds + 78848);
    const int d = tid & 127, seg = tid >> 7;
    for (int u = BID(); u < 256; u += gridDim.x) {
        const int b = u >> 5, h = (u >> 2) & 7, vs = u & 3;
        const size_t rowbase = (size_t)b * SEQ;
        f32x4 S[2]; S[0] = (f32x4){0.f, 0.f, 0.f, 0.f}; S[1] = S[0];
        unsigned short rq[16], rf[16]; v4u rv = {0u, 0u, 0u, 0u};
#define SA_LOAD(ch) do { const size_t o_ = (rowbase + (size_t)(ch) * 64 + seg * 16) * D + h * 128 + d; \
            _Pragma("unroll") for (int i = 0; i < 16; ++i) { rq[i] = Q[o_ + (size_t)i * D]; rf[i] = LFp[o_ + (size_t)i * D]; } \
            if (tid < 256) { const int rr = tid >> 2, c8 = tid & 3; rv = *(const v4u*)(V + (rowbase + (size_t)(ch) * 64 + rr) * D + h * 128 + vs * 32 + c8 * 8); } } while (0)
        SA_LOAD(0);
        for (int ch = 0; ch < 64; ++ch) {
            float qv[16], kv[16], cs[16]; float run = 0.f;
#pragma unroll
            for (int i = 0; i < 16; ++i) { qv[i] = bf2f(rq[i]); const float lf = bf2f(rf[i]); kv[i] = 1.0f - __expf(lf); run += lf; cs[i] = run; }
            SEG[seg * 128 + d] = run;
            __syncthreads();
            const float s0 = SEG[d], s1 = SEG[128 + d], s2 = SEG[256 + d], s3 = SEG[384 + d];
            const float pre = (seg > 0 ? s0 : 0.f) + (seg > 1 ? s1 : 0.f) + (seg > 2 ? s2 : 0.f);
            const float r = s0 + s1, btot = (s0 + s1) + (s2 + s3);
            if (tid < 256) { const int rr = tid >> 2, c8 = tid & 3; const unsigned w4[4] = {rv.x, rv.y, rv.z, rv.w};
#pragma unroll
                for (int j = 0; j < 4; ++j) { LVT[(c8 * 8 + 2 * j) * 72 + rr] = (bf16)(w4[j] & 0xffffu); LVT[(c8 * 8 + 2 * j + 1) * 72 + rr] = (bf16)(w4[j] >> 16); } }
            unsigned kt[8];
#pragma unroll
            for (int i = 0; i < 16; ++i) { const float bt = pre + cs[i]; const unsigned qb = f2bf(qv[i] * __expf(bt - r)), kb = f2bf(kv[i] * __expf(r - bt));
                LQ[(seg * 16 + i) * 136 + d] = (bf16)qb; LK[(seg * 16 + i) * 136 + d] = (bf16)kb;
                if (i & 1) kt[i >> 1] |= kb << 16; else kt[i >> 1] = kb; }
            *(LAS v4u*)(LKT + d * 72 + seg * 16) = (v4u){kt[0], kt[1], kt[2], kt[3]}; *(LAS v4u*)(LKT + d * 72 + seg * 16 + 8) = (v4u){kt[4], kt[5], kt[6], kt[7]};
            if (seg == 0) { ER[d] = __expf(r); EB[d] = __expf(btot); EK[d] = __expf(btot - r); }
            if (ch + 1 < 64) SA_LOAD(ch + 1);
            __syncthreads();
            {
                const int tt = wave >> 1;
#pragma unroll
                for (int jj = 0; jj < 2; ++jj) { const int st = (wave & 1) * 2 + jj; f32x4 acc = {0.f, 0.f, 0.f, 0.f};
                    if (st <= tt) {
#pragma unroll
                        for (int kk = 0; kk < 4; ++kk) acc = mmT(LQ, 136, tt * 16, LK, 136, st * 16, kk * 32, acc, lane);
                        if (st == tt) {
#pragma unroll
                            for (int e = 0; e < 4; ++e) if (4 * (lane >> 4) + e > (lane & 15)) acc[e] = 0.f; } }
                    *(LAS v2u*)(LP + (tt * 16 + (lane & 15)) * 72 + st * 16 + 4 * (lane >> 4)) = pack4(acc); }
#pragma unroll
                for (int j = 0; j < 2; ++j) { const int ti = wave * 2 + j, d0 = (ti >> 1) * 16, e0 = (ti & 1) * 16;
                    const f32x4 er4 = *(const LAS f32x4*)(ER + d0 + 4 * (lane >> 4));
                    *(LAS v2u*)(LST + (e0 + (lane & 15)) * 136 + d0 + 4 * (lane >> 4)) = pack4(S[j] * er4); }
            }
            __syncthreads();
            {
                const int t0 = (wave >> 1) * 16, e0 = (wave & 1) * 16; f32x4 acc = {0.f, 0.f, 0.f, 0.f};
#pragma unroll
                for (int kk = 0; kk < 2; ++kk) acc = mmT(LP, 72, t0, LVT, 72, e0, kk * 32, acc, lane);
#pragma unroll
                for (int kk = 0; kk < 4; ++kk) acc = mmT(LQ, 136, t0, LST, 136, e0, kk * 32, acc, lane);
                *(v2u*)(V + (rowbase + (size_t)ch * 64 + t0 + (lane & 15)) * D + h * 128 + vs * 32 + e0 + 4 * (lane >> 4)) = pack4(acc);
#pragma unroll
                for (int j = 0; j < 2; ++j) { const int ti = wave * 2 + j, d0 = (ti >> 1) * 16, ee0 = (ti & 1) * 16; f32x4 up = {0.f, 0.f, 0.f, 0.f};
#pragma unroll
                    for (int kk = 0; kk < 2; ++kk) up = mmN(LKT, 72, d0, LVT, 72, ee0, kk * 32, up, lane);
                    const f32x4 eb4 = *(const LAS f32x4*)(EB + d0 + 4 * (lane >> 4)), ek4 = *(const LAS f32x4*)(EK + d0 + 4 * (lane >> 4));
                    S[j] = eb4 * S[j] + ek4 * up; }
            }
        }
#undef SA_LOAD
        __syncthreads();
    }
}

__device__ __forceinline__ bf16x8 tr_frag(const LAS bf16* T, int ld, int k0, int m0, int lane) {
    const int g = lane >> 4, q = (lane & 15) >> 2, p = lane & 3;
    const unsigned a0 = (unsigned)(size_t)(T + (k0 + 8 * g + q) * ld + m0 + 4 * p), a1 = a0 + (unsigned)(4 * ld * 2);
    v2u x, y; asm volatile("ds_read_b64_tr_b16 %0, %2\n\tds_read_b64_tr_b16 %1, %3\n\ts_waitcnt lgkmcnt(0)" : "=&v"(x), "=&v"(y) : "v"(a0), "v"(a1) : "memory");
    const v4u w = {x.x, x.y, y.x, y.y}; return __builtin_bit_cast(bf16x8, w);
}
__device__ __forceinline__ void ph_scan_m(const Ctx& c, LAS unsigned char* lds) {
    const int tid = TID(), lane = tid & 63, wave = __builtin_amdgcn_readfirstlane(tid >> 6);
    const bf16* MQ = (const bf16*)(c.ws + WS_MQ); const bf16* MK = (const bf16*)(c.ws + WS_MK); bf16* MV = (bf16*)(c.ws + WS_MV);
    const float* LI = (const float*)(c.ws + WS_LI); const float* LF = (const float*)(c.ws + WS_LF);
    LAS bf16* LQ = (LAS bf16*)lds;
    LAS bf16* LK = (LAS bf16*)(lds + 33792);
    LAS bf16* LV0 = (LAS bf16*)(lds + 67584);
    LAS bf16* LV1 = (LAS bf16*)(lds + 74496);
    LAS bf16* LP = (LAS bf16*)(lds + 81408);
    LAS bf16* LCT = (LAS bf16*)(lds + 90624);
    LAS float* AS = (LAS float*)(lds + 115968);
    LAS float* MXS = (LAS float*)(lds + 116224);
    LAS float* BS = (LAS float*)(lds + 116480);
    for (int u = BID(); u < 256; u += gridDim.x) {
        const int b = u >> 5, h = (u >> 3) & 3, vs = u & 7;
        const size_t rowbase = (size_t)b * SEQ;
        f32x4 C[2][3];
#pragma unroll
        for (int i = 0; i < 2; ++i)
#pragma unroll
            for (int j = 0; j < 3; ++j) C[i][j] = (f32x4){0.f, 0.f, 0.f, 0.f};
        float m = 0.f;
        __syncthreads();
        for (int i = tid; i < 48 * 72; i += NTHR) { const int row = i / 72; LV0[i] = (bf16)(row == 32 ? 0x3f80u : 0u); LV1[i] = (bf16)0u; }
        v4u rq[4], rk[4], rv = {0u, 0u, 0u, 0u}; float rli = 0.f, rlf = 0.f;
#define SM_LOAD(ch) do { _Pragma("unroll") for (int k2 = 0; k2 < 4; ++k2) { const int p = tid + NTHR * k2, rr = p >> 5, c8 = p & 31; const size_t o_ = (rowbase + (size_t)(ch) * 64 + rr) * D + h * 256 + c8 * 8; \
            rq[k2] = *(const v4u*)(MQ + o_); rk[k2] = *(const v4u*)(MK + o_); } \
            if (tid < 256) { const int rr = tid >> 2, c8 = tid & 3; rv = *(const v4u*)(MV + (rowbase + (size_t)(ch) * 64 + rr) * D + h * 256 + vs * 32 + c8 * 8); } \
            rli = LI[(rowbase + (size_t)(ch) * 64 + lane) * 4 + h]; rlf = LF[(rowbase + (size_t)(ch) * 64 + lane) * 4 + h]; } while (0)
        SM_LOAD(0);
        for (int ch = 0; ch < 64; ++ch) {
            __syncthreads();
            float bb = rlf;
#pragma unroll
            for (int o = 1; o < 64; o <<= 1) { const float t_ = __shfl_up(bb, o); if (lane >= o) bb += t_; }
            const float aa = rli - bb; float pm = aa;
#pragma unroll
            for (int o = 1; o < 64; o <<= 1) { const float t_ = __shfl_up(pm, o); if (lane >= o) pm = fmaxf(pm, t_); }
            const float mx = fmaxf(m, pm);
            const float b63 = __shfl(bb, 63), mx63 = __shfl(mx, 63);
            if (wave == 0) { AS[lane] = aa; MXS[lane] = mx; BS[lane] = bb; }
#pragma unroll
            for (int k2 = 0; k2 < 4; ++k2) { const int p = tid + NTHR * k2, rr = p >> 5, c8 = p & 31; *(LAS v4u*)(LQ + rr * 264 + c8 * 8) = rq[k2]; *(LAS v4u*)(LK + rr * 264 + c8 * 8) = rk[k2]; }
            { const int rr = (tid >> 2) & 63; const float wv = __expf(__shfl(aa, rr) - mx63);
              if (tid < 256) { const int c8 = tid & 3; const unsigned w4[4] = {rv.x, rv.y, rv.z, rv.w};
#pragma unroll
                for (int j = 0; j < 4; ++j) { const unsigned lo = w4[j] & 0xffffu, hi = w4[j] >> 16;
                    LV0[(c8 * 8 + 2 * j) * 72 + rr] = (bf16)lo; LV0[(c8 * 8 + 2 * j + 1) * 72 + rr] = (bf16)hi;
                    LV1[(c8 * 8 + 2 * j) * 72 + rr] = (bf16)f2bf(bflo(w4[j]) * wv); LV1[(c8 * 8 + 2 * j + 1) * 72 + rr] = (bf16)f2bf(bfhi(w4[j]) * wv); } } }
            if (wave == 0) LV1[32 * 72 + lane] = (bf16)f2bf(__expf(aa - mx63));
            const float m_old = m;
            if (ch + 1 < 64) SM_LOAD(ch + 1);
            __syncthreads();
            {
                const int tt = wave >> 1;
#pragma unroll
                for (int jj = 0; jj < 2; ++jj) { const int st = (wave & 1) * 2 + jj; f32x4 acc = {0.f, 0.f, 0.f, 0.f};
                    if (st <= tt) {
#pragma unroll
                        for (int kk = 0; kk < 8; ++kk) acc = mmT(LQ, 264, tt * 16, LK, 264, st * 16, kk * 32, acc, lane);
                        const f32x4 a4 = *(const LAS f32x4*)(AS + st * 16 + 4 * (lane >> 4)); const float mxt = MXS[tt * 16 + (lane & 15)];
#pragma unroll
                        for (int e = 0; e < 4; ++e) acc[e] = (st == tt && 4 * (lane >> 4) + e > (lane & 15)) ? 0.f : acc[e] * __expf(a4[e] - mxt); }
                    *(LAS v2u*)(LP + (tt * 16 + (lane & 15)) * 72 + st * 16 + 4 * (lane >> 4)) = pack4(acc); }
#pragma unroll
                for (int i = 0; i < 2; ++i)
#pragma unroll
                    for (int j = 0; j < 3; ++j) { const int d0 = (wave * 2 + i) * 16, e0 = j * 16;
                        *(LAS v2u*)(LCT + (e0 + (lane & 15)) * 264 + d0 + 4 * (lane >> 4)) = pack4(C[i][j]); }
            }
            __syncthreads();
            {
                const int t0 = (wave >> 1) * 16, e0 = (wave & 1) * 16; f32x4 p1 = {0.f, 0.f, 0.f, 0.f}, p2 = p1, q1 = p1, q2 = p1;
#pragma unroll
                for (int kk = 0; kk < 2; ++kk) { p1 = mmT(LP, 72, t0, LV0, 72, e0, kk * 32, p1, lane); q1 = mmT(LP, 72, t0, LV0, 72, 32, kk * 32, q1, lane); }
#pragma unroll
                for (int kk = 0; kk < 8; ++kk) { p2 = mmT(LQ, 264, t0, LCT, 264, e0, kk * 32, p2, lane); q2 = mmT(LQ, 264, t0, LCT, 264, 32, kk * 32, q2, lane); }
                const float mxt = MXS[t0 + (lane & 15)], bt = BS[t0 + (lane & 15)], wi = __expf(m_old - mxt);
                const float den = __shfl(q1[0] + wi * q2[0], lane & 15);
                const float inv = 1.0f / fmaxf(fabsf(den), __expf(-(bt + mxt)));
                const f32x4 hv = (p1 + p2 * wi) * inv;
                *(v2u*)(MV + (rowbase + (size_t)ch * 64 + t0 + (lane & 15)) * D + h * 256 + vs * 32 + e0 + 4 * (lane >> 4)) = pack4(hv);
                const float dec = __expf(m_old - mx63);
#pragma unroll
                for (int i = 0; i < 2; ++i) { const int d0 = (wave * 2 + i) * 16; f32x4 up[3];
#pragma unroll
                    for (int j = 0; j < 3; ++j) up[j] = (f32x4){0.f, 0.f, 0.f, 0.f};
#pragma unroll
                    for (int kk = 0; kk < 2; ++kk) { const bf16x8 af = tr_frag(LK, 264, kk * 32, d0, lane);
#pragma unroll
                        for (int j = 0; j < 3; ++j) { const bf16x8 bfr = *(const LAS bf16x8*)(LV1 + (j * 16 + (lane & 15)) * 72 + kk * 32 + 8 * (lane >> 4)); up[j] = MFMA16(af, bfr, up[j]); } }
#pragma unroll
                    for (int j = 0; j < 3; ++j) C[i][j] = C[i][j] * dec + up[j]; }
                m = b63 + mx63;
            }
        }
#undef SM_LOAD
        __syncthreads();
    }
}
constexpr int TAB_OFF = MISC_OFF + 256;
__device__ __forceinline__ void moe_tables(const Ctx& c, int jm, LAS unsigned char* lds) {
    LAS int* tab = (LAS int*)(lds + TAB_OFF);
    __syncthreads();
    if (TID() == 0) { unsigned* cnt = (unsigned*)c.ws + CW_CNT + 64 * jm; int accp = 0;
        for (int e = 0; e < 8; ++e) { const int n = (int)__hip_atomic_load(cnt + e, __ATOMIC_RELAXED, __HIP_MEMORY_SCOPE_AGENT); const int p = (n + 255) >> 8; tab[e] = p; tab[8 + e] = accp; accp += p; }
        tab[16] = accp; }
    __syncthreads();
}
__device__ __forceinline__ void ph_res1(const Ctx& c, int l, LAS unsigned char* lds) {
    const int tid = TID(), lane = tid & 63, wave = tid >> 6, gw = BID() * NWAVES + wave, NGW = gridDim.x * NWAVES;
    const bool moe = (l & 1) != 0; const int jm = l >> 1;
    LAS float* rt = (LAS float*)lds;
    if (moe) { const f32x4* src = (const f32x4*)(c.in[I_ROUTER] + (size_t)jm * D * NEXP); for (int i = tid; i < D * NEXP / 4; i += NTHR) ((LAS f32x4*)rt)[i] = src[i]; }
    __syncthreads();
    const float* xin = (l == 0) ? c.in[I_X] : c.out;
    const bf16* Y = (const bf16*)(c.ws + WS_PROJ) + (size_t)P_OS * PSTRIDE; bf16* H = (bf16*)(c.ws + WS_H);
    unsigned* cnt = (unsigned*)c.ws + CW_CNT + 64 * jm;
    int* TOKEP = (int*)(c.ws + WS_TOKEP); float* TOKW = (float*)(c.ws + WS_TOKW);
    for (int slot = gw; slot < M / 16; slot += NGW) {
        const int row0 = slot * 16, b = row0 / SEQ;
        f32x4 gpm[4], gt[4], gpf[4], scf[4], shf[4];
        ld_row_f32(c.in[I_GPOSTMIX] + (size_t)l * D, lane, gpm); ld_row_f32(modp(c, l, b, 2), lane, gt); ld_row_f32(c.in[I_GPREFFN] + (size_t)l * D, lane, gpf);
        ld_row_f32(modp(c, l, b, 4), lane, scf); ld_row_f32(modp(c, l, b, 3), lane, shf);
        for (int r = 0; r < 16; ++r) {
            const int row = row0 + r; const size_t ro = (size_t)row * D;
            f32x4 y[4], x[4], h[4]; ld_row_bf16(Y + ro, lane, y); ld_row_f32(xin + ro, lane, x);
            const float rr = rsqrtf(row_sumsq(y) * (1.0f / 1024.0f) + EPS);
#pragma unroll
            for (int j = 0; j < 4; ++j) { x[j] = x[j] + gt[j] * (y[j] * rr * gpm[j]); *(f32x4*)(c.out + ro + 4 * lane + 256 * j) = x[j]; }
            norm_mod(x, gpf, scf, shf, h); st_row_bf16(H + ro, lane, h);
            if (moe) {
                f32x4 l0 = {0.f, 0.f, 0.f, 0.f}, l1 = l0;
#pragma unroll
                for (int j = 0; j < 4; ++j)
#pragma unroll
                    for (int i = 0; i < 4; ++i) { const int ch = 4 * lane + 256 * j + i; l0 += *(const LAS f32x4*)(rt + ch * 8) * h[j][i]; l1 += *(const LAS f32x4*)(rt + ch * 8 + 4) * h[j][i]; }
                float lg[8];
#pragma unroll
                for (int e = 0; e < 4; ++e) { lg[e] = wave_sum(l0[e]); lg[4 + e] = wave_sum(l1[e]); }
                int i1 = 0; float v1 = lg[0];
#pragma unroll
                for (int e = 1; e < 8; ++e) if (lg[e] > v1) { v1 = lg[e]; i1 = e; }
                int i2 = -1; float v2 = -3.0e38f;
#pragma unroll
                for (int e = 0; e < 8; ++e) if (e != i1 && lg[e] > v2) { v2 = lg[e]; i2 = e; }
                if (lane == 0) { const float w1 = 1.0f / (1.0f + __expf(v2 - v1));
                    const int p1 = (int)atomicAdd(cnt + i1, 1u), p2 = (int)atomicAdd(cnt + i2, 1u);
                    *(int4*)(TOKEP + (size_t)row * 4) = make_int4(i1, p1, i2, p2); *(float2*)(TOKW + (size_t)row * 2) = make_float2(w1, 1.0f - w1); }
            }
        }
    }
}
__device__ __forceinline__ void ph_gather(const Ctx& c, int l, LAS unsigned char* lds) {
    const int tid = TID(), lane = tid & 63, wave = tid >> 6, gw = BID() * NWAVES + wave, NGW = gridDim.x * NWAVES;
    moe_tables(c, l >> 1, lds); const LAS int* tab = (const LAS int*)(lds + TAB_OFF);
    const bf16* H = (const bf16*)(c.ws + WS_H); bf16* AG = (bf16*)(c.ws + WS_AG);
    const int* TOKEP = (const int*)(c.ws + WS_TOKEP); int* TOKD = (int*)(c.ws + WS_TOKD);
    for (int row = gw; row < M; row += NGW) {
        const int4 ep = *(const int4*)(TOKEP + (size_t)row * 4);
        const int d1 = tab[8 + ep.x] * 256 + ep.y, d2 = tab[8 + ep.z] * 256 + ep.w;
        const v4u a = *(const v4u*)(H + (size_t)row * D + lane * 8), b = *(const v4u*)(H + (size_t)row * D + 512 + lane * 8);
        *(v4u*)(AG + (size_t)d1 * D + lane * 8) = a; *(v4u*)(AG + (size_t)d1 * D + 512 + lane * 8) = b;
        *(v4u*)(AG + (size_t)d2 * D + lane * 8) = a; *(v4u*)(AG + (size_t)d2 * D + 512 + lane * 8) = b;
        if (lane == 0) *(int2*)(TOKD + (size_t)row * 2) = make_int2(d1, d2);
    }
}
__device__ __forceinline__ void ph_res2(const Ctx& c, int l) {
    const int tid = TID(), lane = tid & 63, wave = tid >> 6, gw = BID() * NWAVES + wave, NGW = gridDim.x * NWAVES;
    const bool moe = (l & 1) != 0;
    const bf16* Y2 = (const bf16*)(c.ws + WS_PROJ) + (size_t)4 * PSTRIDE; const bf16* YS = (const bf16*)(c.ws + WS_YS); bf16* H = (bf16*)(c.ws + WS_H);
    const int* TOKD = (const int*)(c.ws + WS_TOKD); const float* TOKW = (const float*)(c.ws + WS_TOKW);
    const int ln = (l + 1 < DEPTH) ? l + 1 : l;
    for (int slot = gw; slot < M / 16; slot += NGW) {
        const int row0 = slot * 16, b = row0 / SEQ;
        f32x4 gpo[4], gt[4], gpm[4], scm[4], shm[4];
        ld_row_f32(c.in[I_GPOSTFFN] + (size_t)l * D, lane, gpo); ld_row_f32(modp(c, l, b, 5), lane, gt); ld_row_f32(c.in[I_GPREMIX] + (size_t)ln * D, lane, gpm);
        ld_row_f32(modp(c, ln, b, 1), lane, scm); ld_row_f32(modp(c, ln, b, 0), lane, shm);
        for (int r = 0; r < 16; ++r) {
            const int row = row0 + r; const size_t ro = (size_t)row * D;
            f32x4 y[4], x[4], h[4];
            if (moe) { const int2 d = *(const int2*)(TOKD + (size_t)row * 2); const float2 w = *(const float2*)(TOKW + (size_t)row * 2);
                f32x4 ya[4], yb[4]; ld_row_bf16(YS + (size_t)d.x * D, lane, ya); ld_row_bf16(YS + (size_t)d.y * D, lane, yb);
#pragma unroll
                for (int j = 0; j < 4; ++j) y[j] = ya[j] * w.x + yb[j] * w.y; }
            else ld_row_bf16(Y2 + ro, lane, y);
            ld_row_f32(c.out + ro, lane, x);
            const float rr = rsqrtf(row_sumsq(y) * (1.0f / 1024.0f) + EPS);
#pragma unroll
            for (int j = 0; j < 4; ++j) { x[j] = x[j] + gt[j] * (y[j] * rr * gpo[j]); *(f32x4*)(c.out + ro + 4 * lane + 256 * j) = x[j]; }
            if (l + 1 < DEPTH) { norm_mod(x, gpm, scm, shm, h); st_row_bf16(H + ro, lane, h); }
        }
    }
}

constexpr int PH_PER_LAYER = 12, NPH = 2 + DEPTH * PH_PER_LAYER;
__global__ void __launch_bounds__(NTHR, 2) fwd(Ctx c) {
    extern __shared__ __attribute__((aligned(16))) unsigned char lds_raw[];
    LAS unsigned char* lds = (LAS unsigned char*)lds_raw;
    volatile LAS unsigned* MISC = (volatile LAS unsigned*)(lds + MISC_OFF);
    if (threadIdx.x < 64) MISC[threadIdx.x] = 0u;
    __syncthreads();
    const int lo = c.ph_lo, hi = c.ph_hi, G = gridDim.x;
    XcdBarrier bar; bar.bar = (unsigned*)c.ws + CW_BAR; bar.x = 0; bar.st = MISC + 8;
    if (hi - lo > 1) bar = xcd_barrier_post((unsigned*)c.ws + CW_BAR, MISC + 8);
#ifndef PH_MASK
#define PH_MASK 0xFFFF
#endif
#define IN(p) (lo <= (p) && (p) < hi)
#define ON(k) ((PH_MASK >> (k)) & 1)
#ifndef REPMASK
#define REPMASK 0
#endif
#define REP(k) for (int rep_ = 0; rep_ < (((REPMASK >> (k)) & 1) ? opq_s(2) : 1); ++rep_)
#define BAR_AFTER(p) do { if ((p) + 1 < hi) xcd_barrier(bar); } while (0)
    if (ON(12) && IN(0)) { ph_mod(c, lds); ph_lb(c); ph_cvt(c, 0, lds); BAR_AFTER(0); }
    if (ON(13) && IN(1)) { ph_norm0(c); BAR_AFTER(1); }
    for (int l = 0; l < DEPTH; ++l) {
        const int base = 2 + l * PH_PER_LAYER; const bool moe = (l & 1) != 0;
        Ctx cl = c; cl.ws = opq_p(c.ws); cl.out = (float*)opq_p((unsigned char*)c.out);
        unsigned char* ws = cl.ws; bf16* PJ = (bf16*)(ws + WS_PROJ); const int bid = BID();
        int KD = opq_s(D);
        if (ON(0) && IN(base + 0)) {
            pg8::Gemm g{(const bf16*)(ws + WS_H), (const bf16*)(ws + WS_WIN), M, DIN, KD}; pg8::UOrder S; S.init(0, M, DIN, G, bid);
            pg8::EpiWin E{PJ, (const float*)(ws + WS_LB) + l * 1024, PSTRIDE};
            REP(0) pg8::gemm_phase<pg8::EpiWin, pg8::UOrder, true, true>(lds, g, S, E);
            BAR_AFTER(base + 0); }
        if (ON(1) && IN(base + 1)) { REP(1) ph_prep(cl, l); BAR_AFTER(base + 1); }
        if (ON(2) && IN(base + 2)) { ph_scan_a(cl, lds); BAR_AFTER(base + 2); }
        if (ON(3) && IN(base + 3)) { ph_scan_m(cl, lds); BAR_AFTER(base + 3); }
        if (ON(4) && IN(base + 4)) { REP(4) ph_post(cl, l); BAR_AFTER(base + 4); }
        if (ON(5) && IN(base + 5)) {
            pg8::Gemm g{PJ + (size_t)P_QA * PSTRIDE, (const bf16*)(ws + WS_WAB), M, D, KD}; pg8::UOrder S; S.init(1, M, D, G, bid);
            pg8::EpiProj E{PJ + (size_t)P_GTA * PSTRIDE, PSTRIDE, (float*)(PJ + (size_t)P_GA * PSTRIDE), PJ + (size_t)P_VA * PSTRIDE};
            REP(5) pg8::gemm_phase<pg8::EpiProj, pg8::UOrder, true, true>(lds, g, S, E);
            BAR_AFTER(base + 5); }
        if (ON(6) && IN(base + 6)) {
            pg8::Gemm g{PJ + (size_t)P_VA * PSTRIDE, (const bf16*)(ws + WS_WO), M, D, KD}; pg8::UOrder S; S.init(0, M, D, G, bid);
            pg8::EpiPlain E{PJ + (size_t)P_OS * PSTRIDE, D};
            REP(6) pg8::gemm_phase<pg8::EpiPlain, pg8::UOrder, true, true>(lds, g, S, E);
            BAR_AFTER(base + 6); }
        if (ON(7) && IN(base + 7)) { ph_res1(cl, l, lds); BAR_AFTER(base + 7); }
        if (ON(8) && IN(base + 8) && moe) { ph_gather(cl, l, lds); BAR_AFTER(base + 8); }
        if (ON(9) && IN(base + 9)) {
            pg8::Gemm g{(const bf16*)(ws + (moe ? WS_AG : WS_H)), (const bf16*)(ws + WS_WF), M, 2 * DFF, KD}; pg8::UOrder S; S.init(0, M, 2 * DFF, G, bid);
            pg8::EpiSwi E{PJ, moe ? DFE : DFF, moe ? 28 : 22};
            if (moe) { moe_tables(cl, l >> 1, lds); S.mode = 2; S.NT = 28; S.tab = (const LAS int*)(lds + TAB_OFF); S.nwg = __builtin_amdgcn_readfirstlane(S.tab[16]) * 28; }
            REP(9) pg8::gemm_phase<pg8::EpiSwi, pg8::UOrder, true, true>(lds, g, S, E);
            BAR_AFTER(base + 9); }
        if (ON(10) && IN(base + 10)) {
            pg8::Gemm g{PJ, (const bf16*)(ws + WS_WF + (moe ? WF_W2_MOE : WF_W2_DENSE)), M, D, moe ? DFE : DFF}; pg8::UOrder S; S.init(0, M, D, G, bid);
            pg8::EpiPlain E{moe ? (bf16*)(ws + WS_YS) : PJ + (size_t)4 * PSTRIDE, D};
            if (moe) { moe_tables(cl, l >> 1, lds); S.mode = 2; S.NT = 4; S.tab = (const LAS int*)(lds + TAB_OFF); S.nwg = __builtin_amdgcn_readfirstlane(S.tab[16]) * 4; }
            REP(10) pg8::gemm_phase<pg8::EpiPlain, pg8::UOrder, true, true>(lds, g, S, E);
            BAR_AFTER(base + 10); }
        if (ON(11) && IN(base + 11)) { ph_res2(cl, l); if (l + 1 < DEPTH) ph_cvt(cl, l + 1, lds); BAR_AFTER(base + 11); }
    }
#undef IN
#undef BAR_AFTER
}

#ifndef MK_ONE_LAUNCH
#define MK_ONE_LAUNCH 1
#endif
extern "C" void kernel_launch(void* const* d_in, const int* in_sizes, int n_in, void* d_out, int out_size, void* d_ws, size_t ws_size, hipStream_t stream) {
    static int grid = 0;
    if (grid == 0) {
        if (n_in != 32 || in_sizes[0] != M * D || out_size != M * D || ws_size < WS_END) { fprintf(stderr, "kernel_launch: unexpected shapes / workspace (%d inputs, ws %zu < %zu)\n", n_in, ws_size, (size_t)WS_END); grid = -1; return; }
        int dev = 0, cus = 0;
        if (hipGetDevice(&dev) != hipSuccess || hipDeviceGetAttribute(&cus, hipDeviceAttributeMultiprocessorCount, dev) != hipSuccess) { grid = -1; return; }
        if (hipFuncSetAttribute((const void*)fwd, hipFuncAttributeMaxDynamicSharedMemorySize, LDS_BYTES) != hipSuccess) { fprintf(stderr, "kernel_launch: hipFuncSetAttribute failed\n"); grid = -1; return; }
        (void)hipGetLastError();
        grid = cus;
    }
    if (grid < 0) return;
    if (hipMemsetAsync((char*)d_ws + WS_CTL, 0, CTL_ZERO_BYTES, stream) != hipSuccess) return;
    Ctx c{};
    for (int i = 0; i < 32; ++i) c.in[i] = (const float*)d_in[i];
    c.out = (float*)d_out; c.ws = (unsigned char*)d_ws;
#if MK_ONE_LAUNCH
    c.ph_lo = 0; c.ph_hi = NPH;
    hipLaunchKernelGGL(fwd, dim3(grid), dim3(NTHR), LDS_BYTES, stream, c);
#else
    for (int p = 0; p < NPH; ++p) {
        if (p >= 2) { const int l = (p - 2) / PH_PER_LAYER, k = (p - 2) % PH_PER_LAYER; if (k == 8 && !(l & 1)) continue; }
        c.ph_lo = p; c.ph_hi = p + 1;
        hipLaunchKernelGGL(fwd, dim3(grid), dim3(NTHR), LDS_BYTES, stream, c);
    }
#endif
}
```

```cpp
#include <hip/hip_runtime.h>
#include <cstdio>
#include <cstdint>
namespace pg8 {
#define PG8_LAS __attribute__((address_space(3)))
typedef unsigned short bf16_t;
typedef short bf16x8 __attribute__((ext_vector_type(8)));
typedef float f32x4 __attribute__((ext_vector_type(4)));
typedef unsigned u32x4 __attribute__((ext_vector_type(4)));
constexpr int BM = 256, BK = 64, HALF = 128, HTB = HALF * BK * 2  , STAGE_BYTES = 8 * HTB, NXCD = 8, WGM = 8;

__host__ __device__ __forceinline__ int lds_byte(int r, int c) { const int st = (r >> 4) * 2 + (c >> 5), rr = r & 15, cc = c & 31, ob = rr * 64 + cc * 2; return st * 1024 + (ob ^ (((ob >> 9) & 1) << 5)); }
__host__ __device__ __forceinline__ void stage_rc(int b, int& R, int& C) { const int st = b / 1024, sb = b % 1024, swz = sb ^ (((sb >> 9) & 1) << 5); R = (st >> 1) * 16 + swz / 64; C = (st & 1) * 32 + (swz % 64) / 2; }
__host__ __device__ __forceinline__ int perm32(int rho) { const int n = rho >> 4, i = rho & 15; return 8 * (i >> 2) + 4 * n + (i & 3); }

struct Unit { int pm, pn; };
struct Gemm { const bf16_t* A; const bf16_t* Bt; int M, N, K; };

struct StaticOrder {
    int nM, nN, nwg, G, c;
    __host__ __device__ void init(int M, int N, int G_, int c_) { nM = M / BM; nN = N / BM; nwg = nM * nN; G = G_; c = c_; }
    __host__ __device__ bool next(int i, Unit& u) const {
        const long L = (long)i * G + c; if (L >= nwg) return false;
        int wgid = (int)L; { const int q = nwg / NXCD, r = nwg % NXCD, xcd = wgid % NXCD, off = wgid / NXCD; wgid = (xcd < r ? xcd * (q + 1) : r * (q + 1) + (xcd - r) * q) + off; }
        const int nig = WGM * nN, gid = wgid / nig, fm = gid * WGM, gsz = (nM - fm) < WGM ? (nM - fm) : WGM;
        u.pm = fm + ((wgid % nig) % gsz); u.pn = (wgid % nig) / gsz; return true;
    }
    __device__ __forceinline__ void a_ready(const Unit&) const {}
    __device__ __forceinline__ void done(const Unit&) const {}
};
__device__ __forceinline__ unsigned cvt_pk_bf16(float lo, float hi) { unsigned r; asm volatile("v_cvt_pk_bf16_f32 %0, %1, %2" : "=v"(r) : "v"(lo), "v"(hi)); return r; }
#define PG8_GAS __attribute__((address_space(1)))
struct UOrder {
    int mode, nM, nN, nwg, G, c, NT; const PG8_LAS int* tab;
    __device__ __forceinline__ void init(int mode_, int M, int N, int G_, int c_) { mode = mode_; nM = M / BM; nN = N / BM; nwg = nM * nN; G = G_; c = c_; NT = 1; tab = nullptr; }
    __device__ __forceinline__ bool next(int i, Unit& u) const {
        const int which = (mode == 1) ? (i & 1) : 0; const int ii = (mode == 1) ? (i >> 1) : i;
        const long L = (long)ii * G + c; if (L >= nwg) return false;
        int wgid = (int)L; { const int q = nwg / NXCD, r = nwg % NXCD, xcd = wgid % NXCD, off = wgid / NXCD; wgid = (xcd < r ? xcd * (q + 1) : r * (q + 1) + (xcd - r) * q) + off; }
        if (mode == 2) {
            int r = wgid, E = 0;
#pragma unroll
            for (int k = 0; k < 7; ++k) { const int uk = tab[k] * NT; if (E == k && r >= uk) { r -= uk; E = k + 1; } }
            const int P = tab[E], B = tab[8 + E];
            const int nig = WGM * NT, gid = r / nig, fm = gid * WGM, gsz = (P - fm) < WGM ? (P - fm) : WGM, rr = r - gid * nig;
            u.pm = __builtin_amdgcn_readfirstlane(B + fm + rr % gsz); u.pn = __builtin_amdgcn_readfirstlane(E * NT + rr / gsz); return true;
        }
        const int nig = WGM * nN, gid = wgid / nig, fm = gid * WGM, gsz = (nM - fm) < WGM ? (nM - fm) : WGM;
        u.pm = fm + ((wgid % nig) % gsz); u.pn = (wgid % nig) / gsz;
        if (which) { u.pm += nM; u.pn += nN; }
        return true;
    }
    __device__ __forceinline__ void a_ready(const Unit&) const {}
    __device__ __forceinline__ void done(const Unit&) const {}
};

__device__ __forceinline__ float fsig(float v) { return __builtin_amdgcn_rcpf(1.0f + __expf(-v)); }
__device__ __forceinline__ float bflo(unsigned w) { return __uint_as_float(w << 16); }
__device__ __forceinline__ float bfhi(unsigned w) { return __uint_as_float(w & 0xffff0000u); }
#define PG8_X8(x, ai, bj, m) float x[8]; { const f32x4 _a = acc[ai][bj][m][0], _b = acc[ai][bj][m][1]; x[0] = _a[0]; x[1] = _a[1]; x[2] = _a[2]; x[3] = _a[3]; x[4] = _b[0]; x[5] = _b[1]; x[6] = _b[2]; x[7] = _b[3]; }
#define PG8_PACK8(w, x) u32x4 w; w.x = cvt_pk_bf16(x[0], x[1]); w.y = cvt_pk_bf16(x[2], x[3]); w.z = cvt_pk_bf16(x[4], x[5]); w.w = cvt_pk_bf16(x[6], x[7]);

struct EpiWin {
    static constexpr bool PERM = true, AFTER_DRAIN = false;
    bf16_t* P; const float* lb; size_t pstride;
    __device__ __forceinline__ void operator()(const f32x4 (&acc)[2][2][4][2], const Unit& u, int wr, int wc, int fr, int fq) const {
        const int part = u.pn >> 2;
        const int mode = (part == 0 || part == 3) ? 1 : (part == 1) ? 3 : (part >= 5) ? 2 : 0;
        bf16_t* base = P + (size_t)part * pstride;
        const int row0 = u.pm * BM + wr * 64 + fr, col0 = (u.pn & 3) * BM + wc * 32 + 8 * fq;
        float lbv[2][8];
#pragma unroll
        for (int bj = 0; bj < 2; ++bj)
#pragma unroll
            for (int j = 0; j < 8; ++j) lbv[bj][j] = 0.f;
        if (mode == 3) {
#pragma unroll
            for (int bj = 0; bj < 2; ++bj) { const f32x4 a = *(const PG8_GAS f32x4*)(lb + col0 + bj * HALF), b = *(const PG8_GAS f32x4*)(lb + col0 + bj * HALF + 4);
                lbv[bj][0] = a[0]; lbv[bj][1] = a[1]; lbv[bj][2] = a[2]; lbv[bj][3] = a[3]; lbv[bj][4] = b[0]; lbv[bj][5] = b[1]; lbv[bj][6] = b[2]; lbv[bj][7] = b[3]; }
        }
#pragma unroll
        for (int ai = 0; ai < 2; ++ai)
#pragma unroll
            for (int m = 0; m < 4; ++m) { bf16_t* rowp = base + (size_t)(row0 + ai * HALF + m * 16) * 1024 + col0;
#pragma unroll
                for (int bj = 0; bj < 2; ++bj) { PG8_X8(x, ai, bj, m)
                    if (mode != 0) {
#pragma unroll
                        for (int j = 0; j < 8; ++j) { const float s = fsig(x[j]);
                            if (mode == 1) x[j] = x[j] * s; else if (mode == 2) x[j] = s; else x[j] = fmaxf(__logf(lbv[bj][j] + (1.0f - lbv[bj][j]) * s), -30.0f); } }
                    PG8_PACK8(w, x) *(PG8_GAS u32x4*)(rowp + bj * HALF) = w; } }
    }
};
struct EpiProj {
    static constexpr bool PERM = true, AFTER_DRAIN = false;
    const bf16_t* gates; size_t pstride; float* T1; bf16_t* MX;
    __device__ __forceinline__ void operator()(const f32x4 (&acc)[2][2][4][2], const Unit& u, int wr, int wc, int fr, int fq) const {
        const int which = u.pn >> 2;
        const bf16_t* g = gates + (size_t)which * pstride;
        const int row0 = (u.pm & 127) * BM + wr * 64 + fr, col0 = (u.pn & 3) * BM + wc * 32 + 8 * fq;
#pragma unroll
        for (int ai = 0; ai < 2; ++ai)
#pragma unroll
            for (int m = 0; m < 4; ++m) { const size_t off = (size_t)(row0 + ai * HALF + m * 16) * 1024 + col0;
#pragma unroll
                for (int bj = 0; bj < 2; ++bj) { PG8_X8(x, ai, bj, m)
                    const u32x4 gv = *(const PG8_GAS u32x4*)(g + off + bj * HALF);
                    x[0] *= bflo(gv.x); x[1] *= bfhi(gv.x); x[2] *= bflo(gv.y); x[3] *= bfhi(gv.y); x[4] *= bflo(gv.z); x[5] *= bfhi(gv.z); x[6] *= bflo(gv.w); x[7] *= bfhi(gv.w);
                    float* tp = T1 + off + bj * HALF;
                    if (which == 0) { *(PG8_GAS f32x4*)tp = (f32x4){x[0], x[1], x[2], x[3]}; *(PG8_GAS f32x4*)(tp + 4) = (f32x4){x[4], x[5], x[6], x[7]}; }
                    else { const f32x4 t0 = *(const PG8_GAS f32x4*)tp, t1 = *(const PG8_GAS f32x4*)(tp + 4);
                        x[0] += t0[0]; x[1] += t0[1]; x[2] += t0[2]; x[3] += t0[3]; x[4] += t1[0]; x[5] += t1[1]; x[6] += t1[2]; x[7] += t1[3];
                        PG8_PACK8(w, x) *(PG8_GAS u32x4*)(MX + off + bj * HALF) = w; } } }
    }
};
struct EpiSwi {
    static constexpr bool PERM = true, AFTER_DRAIN = false;
    bf16_t* Gm; int ldg, NT;
    __device__ __forceinline__ void operator()(const f32x4 (&acc)[2][2][4][2], const Unit& u, int wr, int wc, int fr, int fq) const {
        const int pnl = u.pn - (u.pn / NT) * NT;
        const int row0 = u.pm * BM + wr * 64 + fr, col0 = pnl * HALF + wc * 32 + 8 * fq;
#pragma unroll
        for (int ai = 0; ai < 2; ++ai)
#pragma unroll
            for (int m = 0; m < 4; ++m) { bf16_t* rowp = Gm + (size_t)(row0 + ai * HALF + m * 16) * ldg + col0;
                PG8_X8(x, ai, 0, m) PG8_X8(y, ai, 1, m)
#pragma unroll
                for (int j = 0; j < 8; ++j) x[j] = x[j] * fsig(x[j]) * y[j];
                PG8_PACK8(w, x) *(PG8_GAS u32x4*)rowp = w; }
    }
};
struct EpiPlain {
    static constexpr bool PERM = true, AFTER_DRAIN = false;
    bf16_t* O; int ldc;
    __device__ __forceinline__ void operator()(const f32x4 (&acc)[2][2][4][2], const Unit& u, int wr, int wc, int fr, int fq) const {
        const int row0 = u.pm * BM + wr * 64 + fr, col0 = (u.pn & 3) * BM + wc * 32 + 8 * fq;
#pragma unroll
        for (int ai = 0; ai < 2; ++ai)
#pragma unroll
            for (int m = 0; m < 4; ++m) { bf16_t* rowp = O + (size_t)(row0 + ai * HALF + m * 16) * ldc + col0;
#pragma unroll
                for (int bj = 0; bj < 2; ++bj) { PG8_X8(x, ai, bj, m) PG8_PACK8(w, x) *(PG8_GAS u32x4*)(rowp + bj * HALF) = w; } }
    }
};
template <class Epi, class Sched, bool ALIGN_EPI = false, bool SP2 = false>
__device__ __forceinline__ void gemm_phase(PG8_LAS unsigned char* lds, const Gemm g, const Sched& S, const Epi& E) {
    int tid_ = threadIdx.x; asm volatile("" : "+v"(tid_));
    const int tid = tid_, wid = __builtin_amdgcn_readfirstlane(tid >> 6), lane = tid & 63, wr = wid >> 2, wc = wid & 3, fr = lane & 15, fq = lane >> 4;
    const int K = g.K, nt = K / BK;
    unsigned voffA[2], voffB[2];
#pragma unroll
    for (int i = 0; i < 2; ++i) { int R, C; stage_rc(tid * 16 + i * 8192, R, C); const int Rb = Epi::PERM ? ((R & ~31) + perm32(R & 31)) : R;
        voffA[i] = (unsigned)(R * K + C) * 2u; voffB[i] = (unsigned)(Rb * K + C) * 2u; }
    const size_t kstep = (size_t)(BK * 2);
    const size_t hstep = (size_t)HALF * K * 2;
    const size_t tstep = 2 * hstep;
    const unsigned ldsw = (unsigned)wid * 1024u;
    const int aoff = lds_byte(wr * 64 + fr, fq * 8), boff = lds_byte(wc * 32 + fr, fq * 8);
#define PG8_SA(b, h) (((b) * 2 + (h)) * HTB)
#define PG8_SB(b, h) ((4 + (b) * 2 + (h)) * HTB)
#define PG8_STAGE(bufoff, gbase, voff) do { _Pragma("unroll") for (int _i = 0; _i < 2; ++_i) \
        __builtin_amdgcn_global_load_lds((const unsigned*)((const char*)(gbase) + (voff)[_i]), (PG8_LAS unsigned*)(lds + (bufoff) + ldsw + _i * 8192), 16, 0, 0); } while (0)
#define PG8_LDA(dst, b, h) do { _Pragma("unroll") for (int m = 0; m < 4; ++m) _Pragma("unroll") for (int k = 0; k < 2; ++k) dst[m][k] = *(const PG8_LAS bf16x8*)(lds + PG8_SA(b, h) + aoff + m * 2048 + k * 1024); } while (0)
#define PG8_LDB(dst, b, h) do { _Pragma("unroll") for (int n = 0; n < 2; ++n) _Pragma("unroll") for (int k = 0; k < 2; ++k) dst[n][k] = *(const PG8_LAS bf16x8*)(lds + PG8_SB(b, h) + boff + n * 2048 + k * 1024); } while (0)
#define PG8_MMA(ai, bj, At, Bt) do { __builtin_amdgcn_s_setprio(1); _Pragma("unroll") for (int m = 0; m < 4; ++m) _Pragma("unroll") for (int n = 0; n < 2; ++n) _Pragma("unroll") for (int k = 0; k < 2; ++k) \
        acc[ai][bj][m][n] = __builtin_amdgcn_mfma_f32_16x16x32_bf16(Bt[n][k], At[m][k], acc[ai][bj][m][n], 0, 0, 0); __builtin_amdgcn_s_setprio(0); } while (0)
#define PG8_WAIT_V(n) asm volatile("s_waitcnt vmcnt(" #n ")" ::: "memory")
#define PG8_WAIT_L(n) asm volatile("s_waitcnt lgkmcnt(" #n ")" ::: "memory")
#define PG8_BAR __builtin_amdgcn_s_barrier()
#define PG8_SCHED __builtin_amdgcn_sched_barrier(0)
    Unit cur, nxt; int ui = 0;
    if (!S.next(0, cur)) return;
    f32x4 acc[2][2][4][2];
#pragma unroll
    for (int a = 0; a < 2; ++a)
#pragma unroll
        for (int b = 0; b < 2; ++b)
#pragma unroll
            for (int m = 0; m < 4; ++m)
#pragma unroll
                for (int n = 0; n < 2; ++n) acc[a][b][m][n] = (f32x4){0.f, 0.f, 0.f, 0.f};
    bf16x8 At[4][2], B0[2][2], B1[2][2];
    const char* cA = (const char*)g.A + (size_t)cur.pm * tstep; const char* cB = (const char*)g.Bt + (size_t)cur.pn * tstep;
    S.a_ready(cur);
    if constexpr (SP2) {
        PG8_STAGE(PG8_SB(0, 0), cB, voffB); PG8_STAGE(PG8_SB(0, 1), cB + hstep, voffB); PG8_STAGE(PG8_SA(0, 0), cA, voffA); PG8_STAGE(PG8_SA(0, 1), cA + hstep, voffA);
        if (wr == 1) PG8_BAR;
        PG8_WAIT_V(2); PG8_BAR;
        PG8_STAGE(PG8_SB(1, 0), cB + kstep, voffB); PG8_STAGE(PG8_SA(1, 0), cA + kstep, voffA); PG8_STAGE(PG8_SB(1, 1), cB + hstep + kstep, voffB);
        PG8_WAIT_V(6); PG8_BAR;
    } else {
        PG8_STAGE(PG8_SB(0, 0), cB, voffB); PG8_STAGE(PG8_SA(0, 0), cA, voffA); PG8_STAGE(PG8_SB(0, 1), cB + hstep, voffB); PG8_STAGE(PG8_SA(0, 1), cA + hstep, voffA);
        if (wr == 1) PG8_BAR;
        PG8_WAIT_V(4); PG8_BAR;
        PG8_STAGE(PG8_SB(1, 0), cB + kstep, voffB); PG8_STAGE(PG8_SA(1, 0), cA + kstep, voffA); PG8_STAGE(PG8_SB(1, 1), cB + hstep + kstep, voffB);
        PG8_WAIT_V(6); PG8_BAR;
    }
    for (;;) {
        const bool has_next = S.next(ui + 1, nxt);
        const char* nA = has_next ? (const char*)g.A + (size_t)nxt.pm * tstep : cA; const char* nB = has_next ? (const char*)g.Bt + (size_t)nxt.pn * tstep : cB;
        for (int t = 0; t < nt; t += 2) {
            const bool last = (t == nt - 2);
            const char* a1 = cA + (size_t)(t + 1) * kstep;
            const char* a2 = last ? nA : cA + (size_t)(t + 2) * kstep; const char* b2 = last ? nB : cB + (size_t)(t + 2) * kstep;
            const char* a3 = a2 + kstep; const char* b3 = b2 + kstep;
            if (last && has_next) S.a_ready(nxt);
            if constexpr (SP2) {
            PG8_LDB(B0, 0, 0); PG8_LDB(B1, 0, 1); PG8_SCHED; PG8_LDA(At, 0, 0); PG8_STAGE(PG8_SA(1, 1), a1 + hstep, voffA);
            PG8_WAIT_V(8); PG8_WAIT_L(0); PG8_BAR; PG8_MMA(0, 0, At, B0); PG8_MMA(0, 1, At, B1); PG8_BAR; PG8_SCHED;
            PG8_LDA(At, 0, 1); PG8_STAGE(PG8_SB(0, 0), b2, voffB); PG8_STAGE(PG8_SB(0, 1), b2 + hstep, voffB); PG8_STAGE(PG8_SA(0, 0), a2, voffA);
            PG8_WAIT_V(8); PG8_WAIT_L(0); PG8_BAR; PG8_MMA(1, 0, At, B0); PG8_MMA(1, 1, At, B1); PG8_BAR; PG8_SCHED;
            PG8_LDB(B0, 1, 0); PG8_LDB(B1, 1, 1); PG8_SCHED; PG8_LDA(At, 1, 0); PG8_STAGE(PG8_SA(0, 1), a2 + hstep, voffA);
            PG8_WAIT_V(8); PG8_WAIT_L(0); PG8_BAR; PG8_MMA(0, 0, At, B0); PG8_MMA(0, 1, At, B1); PG8_BAR; PG8_SCHED;
            PG8_LDA(At, 1, 1); PG8_STAGE(PG8_SB(1, 0), b3, voffB); PG8_STAGE(PG8_SB(1, 1), b3 + hstep, voffB); PG8_STAGE(PG8_SA(1, 0), a3, voffA);
            PG8_WAIT_V(8); PG8_WAIT_L(0); PG8_BAR; PG8_MMA(1, 0, At, B0); PG8_MMA(1, 1, At, B1); PG8_BAR; PG8_SCHED;
            } else {
            PG8_LDB(B0, 0, 0); PG8_SCHED; PG8_LDA(At, 0, 0); PG8_STAGE(PG8_SA(1, 1), a1 + hstep, voffA);
            PG8_WAIT_L(8); PG8_BAR; PG8_WAIT_L(0); PG8_MMA(0, 0, At, B0); PG8_BAR; PG8_SCHED;
            PG8_LDB(B1, 0, 1); PG8_STAGE(PG8_SB(0, 0), b2, voffB);
            PG8_BAR; PG8_WAIT_L(0); PG8_MMA(0, 1, At, B1); PG8_BAR;
            PG8_LDA(At, 0, 1); PG8_STAGE(PG8_SA(0, 0), a2, voffA);
            PG8_BAR; PG8_WAIT_L(0); PG8_MMA(1, 0, At, B0); PG8_BAR; PG8_SCHED;
            PG8_STAGE(PG8_SB(0, 1), b2 + hstep, voffB);
            PG8_WAIT_V(6); PG8_BAR; PG8_MMA(1, 1, At, B1); PG8_BAR;
            PG8_LDB(B0, 1, 0); PG8_SCHED; PG8_LDA(At, 1, 0); PG8_STAGE(PG8_SA(0, 1), a2 + hstep, voffA);
            PG8_WAIT_L(8); PG8_BAR; PG8_WAIT_L(0); PG8_MMA(0, 0, At, B0); PG8_BAR; PG8_SCHED;
            PG8_LDB(B1, 1, 1); PG8_STAGE(PG8_SB(1, 0), b3, voffB);
            PG8_BAR; PG8_WAIT_L(0); PG8_MMA(0, 1, At, B1); PG8_BAR;
            PG8_LDA(At, 1, 1); PG8_STAGE(PG8_SA(1, 0), a3, voffA);
            PG8_BAR; PG8_WAIT_L(0); PG8_MMA(1, 0, At, B0); PG8_BAR; PG8_SCHED;
            PG8_STAGE(PG8_SB(1, 1), b3 + hstep, voffB);
            PG8_WAIT_V(6); PG8_BAR; PG8_MMA(1, 1, At, B1); PG8_BAR;
            }
        }
        if constexpr (ALIGN_EPI) { if (wr == 0) PG8_BAR; }
        if constexpr (!Epi::AFTER_DRAIN) { E(acc, cur, wr, wc, fr, fq); S.done(cur); }
        if (!has_next) break;
#pragma unroll
        for (int a = 0; a < 2; ++a)
#pragma unroll
            for (int b = 0; b < 2; ++b)
#pragma unroll
                for (int m = 0; m < 4; ++m)
#pragma unroll
                    for (int n = 0; n < 2; ++n) acc[a][b][m][n] = (f32x4){0.f, 0.f, 0.f, 0.f};
        cur = nxt; cA = nA; cB = nB; ++ui;
        if constexpr (ALIGN_EPI) { if (wr == 1) PG8_BAR; }
    }
    PG8_WAIT_V(0);
    if constexpr (!ALIGN_EPI) { if (wr == 0) PG8_BAR; }
    PG8_BAR;
    if constexpr (Epi::AFTER_DRAIN) { E.fused(acc, cur, wr, wc, fr, fq, lds, wid, lane); S.done(cur); }
#undef PG8_SA
#undef PG8_SB
#undef PG8_STAGE
#undef PG8_LDA
#undef PG8_LDB
#undef PG8_MMA
#undef PG8_WAIT_V
#undef PG8_WAIT_L
#undef PG8_BAR
#undef PG8_SCHED
}
}
constexpr int NWAVES = 8, NTHR = 512;
constexpr int D = 1024, NBATCH = 8, SEQ = 4096, M = NBATCH * SEQ, DEPTH = 4;
constexpr int DIN = 8192, DFF = 2816, NEXP = 8, DFE = 3584;
constexpr float EPS = 1e-6f;
constexpr size_t MiB = 1u << 20;
constexpr size_t WS_CTL = 0, CTL_ZERO_BYTES = 2 * MiB;
constexpr size_t WS_MOD = 1 * MiB;
constexpr size_t WS_LB = 2 * MiB;
constexpr size_t WS_LI = 2 * MiB + 64 * 1024, WS_LF = WS_LI + 512 * 1024;
constexpr size_t WS_TOKEP = 4 * MiB;
constexpr size_t WS_TOKW = WS_TOKEP + 512 * 1024;
constexpr size_t WS_TOKD = WS_TOKW + 256 * 1024;
constexpr size_t WS_WIN = 6 * MiB, WS_WAB = 22 * MiB, WS_WO = 26 * MiB, WS_WF = 28 * MiB;
constexpr size_t WF_W2_DENSE = 12 * MiB, WF_W2_MOE = 112 * MiB;
constexpr size_t WS_H = 196 * MiB;
constexpr size_t WS_PROJ = 260 * MiB, PART = 64 * MiB;
constexpr size_t WS_MQ = 772 * MiB, WS_MK = 836 * MiB, WS_MV = 900 * MiB, WS_XC = 964 * MiB;
constexpr size_t WS_AG = 772 * MiB, WS_YS = 904 * MiB;
constexpr size_t WS_END = 1036 * MiB;
constexpr size_t PSTRIDE = (size_t)M * 1024;
enum { P_QA = 0, P_LF = 1, P_VA = 2, P_GA = 3, P_XM = 4, P_OS = 5, P_GTA = 6, P_GTB = 7 };
constexpr int CW_BAR = 4096;
constexpr int CW_CNT = 16384;
constexpr int RING_BYTES = 131072, MISC_OFF = RING_BYTES, LDS_BYTES = 147456;

#define GAS __attribute__((address_space(1)))
#define LAS __attribute__((address_space(3)))
typedef unsigned short bf16;
typedef unsigned v4u __attribute__((ext_vector_type(4)));
typedef unsigned v2u __attribute__((ext_vector_type(2)));
typedef float f32x4 __attribute__((ext_vector_type(4)));
typedef float f32x2 __attribute__((ext_vector_type(2)));
typedef int i32x4 __attribute__((ext_vector_type(4)));
typedef int i32x2 __attribute__((ext_vector_type(2)));
#define LDS_WAIT() asm volatile("s_waitcnt lgkmcnt(0)" ::: "memory")
#define VM_WAIT() asm volatile("s_waitcnt vmcnt(0)" ::: "memory")
__device__ __forceinline__ unsigned f2bf(float f) { unsigned u = __builtin_bit_cast(unsigned, f); return (u + 0x7fffu + ((u >> 16) & 1u)) >> 16; }
__device__ __forceinline__ unsigned pk2(float lo, float hi) { return f2bf(lo) | (f2bf(hi) << 16); }
__device__ __forceinline__ float bflo(unsigned w) { return __uint_as_float(w << 16); }
__device__ __forceinline__ float bfhi(unsigned w) { return __uint_as_float(w & 0xffff0000u); }
__device__ __forceinline__ float bf2f(bf16 b) { return __uint_as_float((unsigned)b << 16); }
__device__ __forceinline__ float fsigm(float v) { return 1.0f / (1.0f + __expf(-v)); }
__device__ __forceinline__ float wave_sum(float v) {
#pragma unroll
    for (int o = 1; o < 64; o <<= 1) v += __shfl_xor(v, o);
    return v;
}
__device__ __forceinline__ float half_sum(float v) {
#pragma unroll
    for (int o = 1; o < 32; o <<= 1) v += __shfl_xor(v, o);
    return v;
}
__device__ __forceinline__ float sum16(float v) {
#pragma unroll
    for (int o = 1; o < 16; o <<= 1) v += __shfl_xor(v, o);
    return v;
}

__device__ __forceinline__ int opq_v(int v) { asm volatile("" : "+v"(v)); return v; }
__device__ __forceinline__ int opq_s(int v) { asm volatile("" : "+s"(v)); return v; }
__device__ __forceinline__ unsigned char* opq_p(unsigned char* p) { asm volatile("" : "+s"(p)); return p; }
#define TID() opq_v((int)threadIdx.x)
#define BID() opq_s((int)blockIdx.x)
#define XB_TMO      128
#define XB_XCNT(j)  (256  + 64 * (j))
#define XB_XSUB(j)  (1280 + 64 * (j))
#define XB_XGEN(j)  (2304 + 64 * (j))
#define XB_TOP      3328
#define XB_TOPGEN   3392
#define XCD_BAR_WORDS 3456
#define XB_SPIN_CAP (1u << 18)

__device__ __forceinline__ unsigned xb_ld(unsigned* p)              { return __hip_atomic_load(p, __ATOMIC_RELAXED, __HIP_MEMORY_SCOPE_AGENT); }
__device__ __forceinline__ unsigned xb_add(unsigned* p, unsigned v) { return __hip_atomic_fetch_add(p, v, __ATOMIC_RELAXED, __HIP_MEMORY_SCOPE_AGENT); }
__device__ __forceinline__ unsigned xb_xcc_id() { return (unsigned)__builtin_amdgcn_s_getreg((3 << 11) | 20) & 0xFu; }
#define XB_SPIN(cond, bar) do { unsigned _sp = 0; while (cond) { __builtin_amdgcn_s_sleep(1); \
    if ((++_sp & 255u) == 0u) { if (xb_ld(&(bar)[XB_TMO])) break; if (_sp > XB_SPIN_CAP) { atomicAdd(&(bar)[XB_TMO], 1u); break; } } } } while (0)

struct XcdBarrier {
    unsigned* bar; unsigned x;
    volatile LAS unsigned* st;
};

__device__ __forceinline__ XcdBarrier xcd_barrier_post(unsigned* bar, volatile LAS unsigned* st) {
    XcdBarrier b; b.bar = bar; b.x = xb_xcc_id(); b.st = st;
    if (threadIdx.x == 0) (void)xb_add(&bar[XB_XCNT(b.x)], 1u);
    return b;
}
__device__ __forceinline__ void xcd_barrier_complete(unsigned* bar, unsigned x, unsigned& nloc, unsigned& nx) {
    const unsigned G = gridDim.x * gridDim.y * gridDim.z;
    unsigned sum, cnt, mine, sp = 0u;
    for (;;) {
        sum = 0u; cnt = 0u; mine = 0u;
#pragma unroll
        for (unsigned j = 0; j < 16; ++j) { const unsigned c = xb_ld(&bar[XB_XCNT(j)]); sum += c; cnt += (c > 0u) ? 1u : 0u; mine = (j == x) ? c : mine; }
        if (sum == G) break;
        __builtin_amdgcn_s_sleep(1);
        if ((++sp & 255u) == 0u) { if (xb_ld(&bar[XB_TMO])) break; if (sp > XB_SPIN_CAP) { atomicAdd(&bar[XB_TMO], 1u); break; } }
    }
    nloc = mine > 0u ? mine : 1u; nx = cnt > 0u ? cnt : 1u;
}

__device__ __forceinline__ void xcd_barrier(const XcdBarrier& b) {
    asm volatile("s_waitcnt vmcnt(0)" ::: "memory");
    __syncthreads();
    if (threadIdx.x == 0) {
        unsigned* bar = b.bar;
        __builtin_amdgcn_s_waitcnt(0);
        unsigned nloc = b.st[0], nx = b.st[1];
        if (nloc == 0u) { xcd_barrier_complete(bar, b.x, nloc, nx); b.st[0] = nloc; b.st[1] = nx; }
        const unsigned old = xb_add(&bar[XB_XSUB(b.x)], 1u);
        const unsigned gen = old / nloc;
        if (old + 1u == (gen + 1u) * nloc) {
            __builtin_amdgcn_fence(__ATOMIC_RELEASE, "agent");
            asm volatile("s_waitcnt vmcnt(0)" ::: "memory");
            const unsigned og = xb_add(&bar[XB_TOP], 1u);
            const unsigned tg = og / nx;
            if (og + 1u == (tg + 1u) * nx) xb_add(&bar[XB_TOPGEN], 1u);
            else XB_SPIN(xb_ld(&bar[XB_TOPGEN]) == tg, bar);
            __builtin_amdgcn_fence(__ATOMIC_ACQUIRE, "agent");
            xb_add(&bar[XB_XGEN(b.x)], 1u);
            asm volatile("s_waitcnt vmcnt(0)" ::: "memory");
        } else {
            XB_SPIN(xb_ld(&bar[XB_XGEN(b.x)]) == gen, bar);
            __builtin_amdgcn_fence(__ATOMIC_ACQUIRE, "agent");
            asm volatile("s_waitcnt vmcnt(0)" ::: "memory");
        }
    }
    __syncthreads();
}
struct Ctx { const float* in[32]; float* out; unsigned char* ws; int ph_lo, ph_hi; };
enum { I_X = 0, I_C, I_WADA, I_BADA, I_GPREMIX, I_GPOSTMIX, I_GPREFFN, I_GPOSTFFN, I_WIN, I_HLB, I_HGN, I_CONVW, I_CONVB, I_WQ, I_WK, I_WV, I_WIG, I_BIG, I_WFG, I_BFG,
       I_MGN, I_MSKIP, I_WPA, I_WPB, I_WOUT, I_F1, I_F3, I_F2, I_ROUTER, I_M1, I_M3, I_M2 };

__device__ __forceinline__ void ph_mod(const Ctx& c, LAS unsigned char* lds) {
    LAS float* cact = (LAS float*)lds;
    LAS float* part = (LAS float*)(lds + 32768);
    GAS float* MOD = (GAS float*)(c.ws + WS_MOD);
    const GAS float* cin = (const GAS float*)c.in[I_C]; const GAS float* wada = (const GAS float*)c.in[I_WADA]; const GAS float* bada = (const GAS float*)c.in[I_BADA];
    const int tid = TID(), lane = tid & 63, wave = tid >> 6;
    for (int i = tid; i < 8192; i += NTHR) { const float v = cin[i]; cact[i] = v * fsigm(v); }
    __syncthreads();
    for (int u = BID(); u < 384; u += gridDim.x) {
        const int l = u / 96, jb = u % 96, j = jb * 64 + lane;
        const GAS float* w = wada + ((size_t)l * 1024 + wave * 128) * 6144 + j;
        const LAS float* ca = cact + wave * 128;
        float a0 = 0.f, a1 = 0.f, a2 = 0.f, a3 = 0.f, a4 = 0.f, a5 = 0.f, a6 = 0.f, a7 = 0.f;
#pragma unroll 8
        for (int k = 0; k < 128; ++k) { const float wv = w[(size_t)k * 6144];
            a0 += ca[k] * wv; a1 += ca[1024 + k] * wv; a2 += ca[2048 + k] * wv; a3 += ca[3072 + k] * wv;
            a4 += ca[4096 + k] * wv; a5 += ca[5120 + k] * wv; a6 += ca[6144 + k] * wv; a7 += ca[7168 + k] * wv; }
        LAS float* pw = part + wave * 512 + lane;
        pw[0] = a0; pw[64] = a1; pw[128] = a2; pw[192] = a3; pw[256] = a4; pw[320] = a5; pw[384] = a6; pw[448] = a7;
        __syncthreads();
        { const int b = wave; float s = bada[l * 6144 + j];
#pragma unroll
            for (int ww = 0; ww < 8; ++ww) s += part[ww * 512 + b * 64 + lane];
            MOD[(size_t)(l * 8 + b) * 6144 + j] = s; }
        __syncthreads();
    }
}
__device__ __forceinline__ void ph_lb(const Ctx& c) {
    if (BID() != 0) return;
    GAS float* LB = (GAS float*)(c.ws + WS_LB); const GAS float* raw = (const GAS float*)c.in[I_HLB];
    for (int col = TID(); col < 1024; col += NTHR) {
        const float r0 = raw[col], r1 = raw[1024 + col], r2 = raw[2048 + col], r3 = raw[3072 + col];
        const float mx = fmaxf(fmaxf(r0, r1), fmaxf(r2, r3));
        const float e0 = __expf(r0 - mx), e1 = __expf(r1 - mx), e2 = __expf(r2 - mx), e3 = __expf(r3 - mx), inv = 1.0f / (e0 + e1 + e2 + e3);
        LB[col] = 0.f; LB[1024 + col] = e1 * inv; LB[2048 + col] = (e1 + e2) * inv; LB[3072 + col] = (e1 + e2 + e3) * inv;
    }
}
__device__ __forceinline__ void cvt_item(const float* W, int K, int N, bf16* WT, int rowbase, int mode, LAS float* scr, int item, int lane) {
    const int nblk = N / 32, kb = item / nblk, nb = item % nblk, k0 = 64 * kb, n0 = 32 * nb;
#pragma unroll 8
    for (int i = 0; i < 32; ++i) { const int kk = 2 * i + (lane >> 5); scr[kk * 33 + (lane & 31)] = ((const GAS float*)W)[(size_t)(k0 + kk) * N + n0 + (lane & 31)]; }
    LDS_WAIT(); asm volatile("" ::: "memory");
    const int drow0 = rowbase + (mode ? ((n0 >> 7) * 256 + (n0 & 127)) : n0);
    const int cc = lane & 7;
#pragma unroll
    for (int j = 0; j < 4; ++j) { const int n = (lane >> 3) + 8 * j; const LAS float* s = scr + (8 * cc) * 33 + n;
        v4u o; o.x = pk2(s[0 * 33], s[1 * 33]); o.y = pk2(s[2 * 33], s[3 * 33]); o.z = pk2(s[4 * 33], s[5 * 33]); o.w = pk2(s[6 * 33], s[7 * 33]);
        *(GAS v4u*)(WT + (size_t)(drow0 + n) * K + k0 + 8 * cc) = o; }
    LDS_WAIT(); asm volatile("" ::: "memory");
}
__device__ __forceinline__ void ph_cvt(const Ctx& c, int l, LAS unsigned char* lds) {
    const int tid = TID(), lane = tid & 63, wave = __builtin_amdgcn_readfirstlane(tid >> 6);
    LAS float* scr = (LAS float*)(lds + wave * 16384);
    const int gw = BID() * NWAVES + wave, NGW = gridDim.x * NWAVES;
    bf16* WIN = (bf16*)(c.ws + WS_WIN); bf16* WAB = (bf16*)(c.ws + WS_WAB); bf16* WO = (bf16*)(c.ws + WS_WO); bf16* WF = (bf16*)(c.ws + WS_WF);
    const bool moe = (l & 1) != 0; const int j = l >> 1;
    constexpr int I_IN = 16 * 256, I_SQ = 16 * 32, I_D13 = 16 * 88, I_D2 = 44 * 32, I_M13 = 16 * 112, I_M2E = 56 * 32;
    const int total = I_IN + 3 * I_SQ + (moe ? (2 * NEXP * I_M13 + NEXP * I_M2E) : (2 * I_D13 + I_D2));
    for (int it = gw; it < total; it += NGW) {
        int r = it;
        if (r < I_IN) { cvt_item(c.in[I_WIN] + (size_t)l * D * DIN, D, DIN, WIN, 0, 0, scr, r, lane); continue; } r -= I_IN;
        if (r < I_SQ) { cvt_item(c.in[I_WPA] + (size_t)l * D * D, D, D, WAB, 0, 0, scr, r, lane); continue; } r -= I_SQ;
        if (r < I_SQ) { cvt_item(c.in[I_WPB] + (size_t)l * D * D, D, D, WAB, 1024, 0, scr, r, lane); continue; } r -= I_SQ;
        if (r < I_SQ) { cvt_item(c.in[I_WOUT] + (size_t)l * D * D, D, D, WO, 0, 0, scr, r, lane); continue; } r -= I_SQ;
        if (!moe) {
            if (r < I_D13) { cvt_item(c.in[I_F1] + (size_t)j * D * DFF, D, DFF, WF, 0, 1, scr, r, lane); continue; } r -= I_D13;
            if (r < I_D13) { cvt_item(c.in[I_F3] + (size_t)j * D * DFF, D, DFF, WF, 128, 1, scr, r, lane); continue; } r -= I_D13;
            cvt_item(c.in[I_F2] + (size_t)j * DFF * D, DFF, D, (bf16*)(c.ws + WS_WF + WF_W2_DENSE), 0, 0, scr, r, lane);
        } else {
            if (r < NEXP * I_M13) { const int e = r / I_M13; cvt_item(c.in[I_M1] + ((size_t)j * NEXP + e) * D * DFE, D, DFE, WF, e * 2 * DFE, 1, scr, r - e * I_M13, lane); continue; } r -= NEXP * I_M13;
            if (r < NEXP * I_M13) { const int e = r / I_M13; cvt_item(c.in[I_M3] + ((size_t)j * NEXP + e) * D * DFE, D, DFE, WF, e * 2 * DFE + 128, 1, scr, r - e * I_M13, lane); continue; } r -= NEXP * I_M13;
            { const int e = r / I_M2E; cvt_item(c.in[I_M2] + ((size_t)j * NEXP + e) * DFE * D, DFE, D, (bf16*)(c.ws + WS_WF + WF_W2_MOE), e * D, 0, scr, r - e * I_M2E, lane); }
        }
    }
}

__device__ __forceinline__ void ld_row_f32(const float* p, int lane, f32x4 (&v)[4]) {
#pragma unroll
    for (int j = 0; j < 4; ++j) v[j] = *(const GAS f32x4*)(p + 4 * lane + 256 * j);
}
__device__ __forceinline__ void ld_row_bf16(const bf16* p, int lane, f32x4 (&v)[4]) {
#pragma unroll
    for (int j = 0; j < 4; ++j) { const v2u w = *(const GAS v2u*)(p + 4 * lane + 256 * j); v[j] = (f32x4){bflo(w.x), bfhi(w.x), bflo(w.y), bfhi(w.y)}; }
}
__device__ __forceinline__ void st_row_bf16(bf16* p, int lane, const f32x4 (&v)[4]) {
#pragma unroll
    for (int j = 0; j < 4; ++j) { v2u w; w.x = pk2(v[j][0], v[j][1]); w.y = pk2(v[j][2], v[j][3]); *(GAS v2u*)(p + 4 * lane + 256 * j) = w; }
}
__device__ __forceinline__ float row_sumsq(const f32x4 (&v)[4]) {
    float s = 0.f;
#pragma unroll
    for (int j = 0; j < 4; ++j) s += (v[j][0] * v[j][0] + v[j][1] * v[j][1]) + (v[j][2] * v[j][2] + v[j][3] * v[j][3]);
    return wave_sum(s);
}
__device__ __forceinline__ void norm_mod(const f32x4 (&x)[4], const f32x4 (&g)[4], const f32x4 (&sc)[4], const f32x4 (&sh)[4], f32x4 (&h)[4]) {
    const float r = rsqrtf(row_sumsq(x) * (1.0f / 1024.0f) + EPS);
#pragma unroll
    for (int j = 0; j < 4; ++j) h[j] = (x[j] * r) * g[j] * (sc[j] + 1.0f) + sh[j];
}
__device__ __forceinline__ const float* modp(const Ctx& c, int l, int b, int which) { return (const float*)(c.ws + WS_MOD) + ((size_t)(l * 8 + b) * 6 + which) * 1024; }

__device__ __forceinline__ void ph_norm0(const Ctx& c) {
    const int tid = TID(), lane = tid & 63, wave = tid >> 6, gw = BID() * NWAVES + wave, NGW = gridDim.x * NWAVES;
    bf16* H = (bf16*)(c.ws + WS_H);
    for (int slot = gw; slot < M / 16; slot += NGW) {
        const int row0 = slot * 16, b = row0 / SEQ;
        f32x4 g[4], sc[4], sh[4]; ld_row_f32(c.in[I_GPREMIX], lane, g); ld_row_f32(modp(c, 0, b, 1), lane, sc); ld_row_f32(modp(c, 0, b, 0), lane, sh);
        for (int r = 0; r < 16; ++r) { f32x4 x[4], h[4]; ld_row_f32(c.in[I_X] + (size_t)(row0 + r) * D, lane, x); norm_mod(x, g, sc, sh, h); st_row_bf16(H + (size_t)(row0 + r) * D, lane, h); }
    }
}
__device__ __forceinline__ void ph_prep(const Ctx& c, int l) {
    const int tid = TID(), lane = tid & 63, wave = tid >> 6, gw = BID() * NWAVES + wave, NGW = gridDim.x * NWAVES;
    const bf16* XM = (const bf16*)(c.ws + WS_PROJ) + (size_t)P_XM * PSTRIDE;
    bf16* MQ = (bf16*)(c.ws + WS_MQ); bf16* MK = (bf16*)(c.ws + WS_MK); bf16* MV = (bf16*)(c.ws + WS_MV); bf16* XC = (bf16*)(c.ws + WS_XC);
    GAS float* LI = (GAS float*)(c.ws + WS_LI); GAS float* LF = (GAS float*)(c.ws + WS_LF);
    const float* cw = c.in[I_CONVW] + (size_t)l * 4 * D; const float* cb = c.in[I_CONVB] + (size_t)l * D;
    const float* wq = c.in[I_WQ] + (size_t)l * 256 * 16; const float* wk = c.in[I_WK] + (size_t)l * 256 * 16; const float* wv = c.in[I_WV] + (size_t)l * 256 * 16;
    const float* wig = c.in[I_WIG] + (size_t)l * 3072 * 4; const float* wfg = c.in[I_WFG] + (size_t)l * 3072 * 4;
    const f32x4 big = *(const GAS f32x4*)(c.in[I_BIG] + l * 4), bfg = *(const GAS f32x4*)(c.in[I_BFG] + l * 4);
    for (int slot = gw; slot < M / 16; slot += NGW) {
        for (int r = 0; r < 16; ++r) {
            const int row = slot * 16 + r, t = row & (SEQ - 1);
            f32x4 gi = {0.f, 0.f, 0.f, 0.f}, gf = {0.f, 0.f, 0.f, 0.f};
#pragma unroll 1
            for (int j = 0; j < 4; ++j) {
                const int ch = 4 * lane + 256 * j, n = lane + 64 * j;
                f32x4 y = *(const GAS f32x4*)(cb + ch); f32x4 xt = {0.f, 0.f, 0.f, 0.f};
#pragma unroll
                for (int jj = 0; jj < 4; ++jj) {
                    if (t - 3 + jj >= 0) { const v2u w = *(const GAS v2u*)(XM + (size_t)(row - 3 + jj) * D + ch); const f32x4 xv = {bflo(w.x), bfhi(w.x), bflo(w.y), bfhi(w.y)};
                        y += *(const GAS f32x4*)(cw + jj * D + ch) * xv; if (jj == 3) xt = xv; }
                }
                f32x4 xc; xc[0] = y[0] * fsigm(y[0]); xc[1] = y[1] * fsigm(y[1]); xc[2] = y[2] * fsigm(y[2]); xc[3] = y[3] * fsigm(y[3]);
                f32x4 q = {0.f, 0.f, 0.f, 0.f}, k = q, v = q;
#pragma unroll
                for (int i = 0; i < 4; ++i) { q += *(const GAS f32x4*)(wq + n * 16 + i * 4) * xc[i]; k += *(const GAS f32x4*)(wk + n * 16 + i * 4) * xc[i]; v += *(const GAS f32x4*)(wv + n * 16 + i * 4) * xt[i]; }
#pragma unroll
                for (int o = 0; o < 4; ++o) {
                    gi += *(const GAS f32x4*)(wig + (size_t)(ch + o) * 4) * q[o] + *(const GAS f32x4*)(wig + (size_t)(1024 + ch + o) * 4) * k[o] + *(const GAS f32x4*)(wig + (size_t)(2048 + ch + o) * 4) * v[o];
                    gf += *(const GAS f32x4*)(wfg + (size_t)(ch + o) * 4) * q[o] + *(const GAS f32x4*)(wfg + (size_t)(1024 + ch + o) * 4) * k[o] + *(const GAS f32x4*)(wfg + (size_t)(2048 + ch + o) * 4) * v[o];
                }
                const size_t off = (size_t)row * D + ch;
                { v2u w; w.x = pk2(q[0], q[1]); w.y = pk2(q[2], q[3]); *(GAS v2u*)(MQ + off) = w; }
                { v2u w; w.x = pk2(k[0] * 0.0625f, k[1] * 0.0625f); w.y = pk2(k[2] * 0.0625f, k[3] * 0.0625f); *(GAS v2u*)(MK + off) = w; }
                { v2u w; w.x = pk2(v[0], v[1]); w.y = pk2(v[2], v[3]); *(GAS v2u*)(MV + off) = w; }
                { v2u w; w.x = pk2(xc[0], xc[1]); w.y = pk2(xc[2], xc[3]); *(GAS v2u*)(XC + off) = w; }
            }
#pragma unroll
            for (int hh = 0; hh < 4; ++hh) { gi[hh] = wave_sum(gi[hh]); gf[hh] = wave_sum(gf[hh]); }
            gi += big; gf += bfg;
            if (lane < 4) { const float z = lane == 0 ? gf[0] : lane == 1 ? gf[1] : lane == 2 ? gf[2] : gf[3]; const float li = lane == 0 ? gi[0] : lane == 1 ? gi[1] : lane == 2 ? gi[2] : gi[3];
                LI[(size_t)row * 4 + lane] = li; LF[(size_t)row * 4 + lane] = fminf(z, 0.f) - __logf(1.0f + __expf(-fabsf(z))); }
        }
    }
}

__device__ __forceinline__ void ph_scan_a_naive(const Ctx& c, LAS unsigned char* lds) {
    const int tid = TID();
    bf16* PJ = (bf16*)(c.ws + WS_PROJ);
    const bf16* Q = PJ + (size_t)P_QA * PSTRIDE; const bf16* LFp = PJ + (size_t)P_LF * PSTRIDE; bf16* V = PJ + (size_t)P_VA * PSTRIDE;
    LAS bf16* sq = (LAS bf16*)lds;
    LAS bf16* sf = (LAS bf16*)(lds + 32768);
    LAS bf16* sv = (LAS bf16*)(lds + 65536);
    LAS float* so = (LAS float*)(lds + 73728);
    const int dg = tid & 15, vv = tid >> 4;
    for (int u = BID(); u < 256; u += gridDim.x) {
        const int b = u >> 5, h = (u >> 2) & 7, vs = u & 3;
        const size_t rowbase = (size_t)b * SEQ;
        float S[8];
#pragma unroll
        for (int j = 0; j < 8; ++j) S[j] = 0.f;
        v4u rq[2], rf[2], rv = {0u, 0u, 0u, 0u};
#define SA_LOAD(ch) do { _Pragma("unroll") for (int k2 = 0; k2 < 2; ++k2) { const int p = tid + NTHR * k2, rr = p >> 4, c8 = p & 15; const size_t o_ = (rowbase + (size_t)(ch) * 64 + rr) * D + h * 128 + c8 * 8; \
            rq[k2] = *(const GAS v4u*)(Q + o_); rf[k2] = *(const GAS v4u*)(LFp + o_); } \
            if (tid < 256) { const int rr = tid >> 2, c8 = tid & 3; rv = *(const GAS v4u*)(V + (rowbase + (size_t)(ch) * 64 + rr) * D + h * 128 + vs * 32 + c8 * 8); } } while (0)
        SA_LOAD(0);
        for (int ch = 0; ch < 64; ++ch) {
            const int buf = ch & 1;
#pragma unroll
            for (int k2 = 0; k2 < 2; ++k2) { const int p = tid + NTHR * k2; *(LAS v4u*)(sq + buf * 8192 + p * 8) = rq[k2]; *(LAS v4u*)(sf + buf * 8192 + p * 8) = rf[k2]; }
            if (tid < 256) *(LAS v4u*)(sv + buf * 2048 + tid * 8) = rv;
            __syncthreads();
            if (ch + 1 < 64) SA_LOAD(ch + 1);
            for (int i = 0; i < 64; ++i) {
                const v4u qv = *(const LAS v4u*)(sq + buf * 8192 + i * 128 + dg * 8), fv = *(const LAS v4u*)(sf + buf * 8192 + i * 128 + dg * 8);
                const float vt = bf2f(sv[buf * 2048 + i * 32 + vv]);
                const float qq[8] = {bflo(qv.x), bfhi(qv.x), bflo(qv.y), bfhi(qv.y), bflo(qv.z), bfhi(qv.z), bflo(qv.w), bfhi(qv.w)};
                const float ff[8] = {bflo(fv.x), bfhi(fv.x), bflo(fv.y), bfhi(fv.y), bflo(fv.z), bfhi(fv.z), bflo(fv.w), bfhi(fv.w)};
                float o = 0.f;
#pragma unroll
                for (int j = 0; j < 8; ++j) { const float f = __expf(ff[j]); S[j] = f * S[j] + (1.0f - f) * vt; o += S[j] * qq[j]; }
                o = sum16(o);
                if (dg == 0) so[i * 32 + vv] = o;
            }
            __syncthreads();
            { const int rr = tid >> 3, c4 = (tid & 7) * 4; const f32x4 ov = *(const LAS f32x4*)(so + rr * 32 + c4);
                v2u w; w.x = pk2(ov[0], ov[1]); w.y = pk2(ov[2], ov[3]); *(GAS v2u*)(V + (rowbase + (size_t)ch * 64 + rr) * D + h * 128 + vs * 32 + c4) = w; }
        }
#undef SA_LOAD
        __syncthreads();
    }
}

__device__ __forceinline__ void ph_scan_m_naive(const Ctx& c, LAS unsigned char* lds) {
    const int tid = TID();
    const bf16* MQ = (const bf16*)(c.ws + WS_MQ); const bf16* MK = (const bf16*)(c.ws + WS_MK); bf16* MV = (bf16*)(c.ws + WS_MV);
    const float* LI = (const float*)(c.ws + WS_LI); const float* LF = (const float*)(c.ws + WS_LF);
    LAS bf16* sq = (LAS bf16*)lds;
    LAS bf16* sk = (LAS bf16*)(lds + 32768);
    LAS bf16* sv = (LAS bf16*)(lds + 65536);
    LAS float* sli = (LAS float*)(lds + 69632);
    LAS float* slf = (LAS float*)(lds + 69888);
    LAS float* so = (LAS float*)(lds + 70144);
    const int dg = tid & 15, vv = tid >> 4;
    for (int u = BID(); u < 256; u += gridDim.x) {
        const int b = u >> 5, h = (u >> 3) & 3, vs = u & 7;
        const size_t rowbase = (size_t)b * SEQ;
        float C[16], nn[16], m = 0.f;
#pragma unroll
        for (int j = 0; j < 16; ++j) { C[j] = 0.f; nn[j] = 0.f; }
        v4u rq[4], rk[4], rv = {0u, 0u, 0u, 0u}; float rli = 0.f, rlf = 0.f;
#define SM_LOAD(ch) do { _Pragma("unroll") for (int k2 = 0; k2 < 4; ++k2) { const int p = tid + NTHR * k2, rr = p >> 5, c8 = p & 31; const size_t o_ = (rowbase + (size_t)(ch) * 64 + rr) * D + h * 256 + c8 * 8; \
            rq[k2] = *(const GAS v4u*)(MQ + o_); rk[k2] = *(const GAS v4u*)(MK + o_); } \
            if (tid < 256) { const int rr = tid >> 2, c8 = tid & 3; rv = *(const GAS v4u*)(MV + (rowbase + (size_t)(ch) * 64 + rr) * D + h * 256 + vs * 32 + c8 * 8); } \
            if (tid < 64) { rli = LI[(rowbase + (size_t)(ch) * 64 + tid) * 4 + h]; rlf = LF[(rowbase + (size_t)(ch) * 64 + tid) * 4 + h]; } } while (0)
        SM_LOAD(0);
        for (int ch = 0; ch < 64; ++ch) {
#pragma unroll
            for (int k2 = 0; k2 < 4; ++k2) { const int p = tid + NTHR * k2; *(LAS v4u*)(sq + p * 8) = rq[k2]; *(LAS v4u*)(sk + p * 8) = rk[k2]; }
            if (tid < 256) *(LAS v4u*)(sv + tid * 8) = rv;
            if (tid < 64) { sli[tid] = rli; slf[tid] = rlf; }
            __syncthreads();
            if (ch + 1 < 64) SM_LOAD(ch + 1);
            for (int i = 0; i < 64; ++i) {
                const float li = sli[i], lf = slf[i];
                const float mn = fmaxf(lf + m, li), fg = __expf(lf + m - mn), ig = __expf(li - mn); m = mn;
                const float vt = bf2f(sv[i * 32 + vv]) * ig;
                float num = 0.f, den = 0.f;
#pragma unroll
                for (int hh = 0; hh < 2; ++hh) {
                    const v4u qv = *(const LAS v4u*)(sq + i * 256 + dg * 16 + hh * 8), kv = *(const LAS v4u*)(sk + i * 256 + dg * 16 + hh * 8);
                    const float qq[8] = {bflo(qv.x), bfhi(qv.x), bflo(qv.y), bfhi(qv.y), bflo(qv.z), bfhi(qv.z), bflo(qv.w), bfhi(qv.w)};
                    const float kk[8] = {bflo(kv.x), bfhi(kv.x), bflo(kv.y), bfhi(kv.y), bflo(kv.z), bfhi(kv.z), bflo(kv.w), bfhi(kv.w)};
#pragma unroll
                    for (int j = 0; j < 8; ++j) { const int jj = hh * 8 + j; C[jj] = fg * C[jj] + kk[j] * vt; nn[jj] = fg * nn[jj] + ig * kk[j]; num += qq[j] * C[jj]; den += qq[j] * nn[jj]; }
                }
                num = sum16(num); den = sum16(den);
                if (dg == 0) so[i * 32 + vv] = num / fmaxf(fabsf(den), __expf(-m));
            }
            __syncthreads();
            { const int rr = tid >> 3, c4 = (tid & 7) * 4; const f32x4 ov = *(const LAS f32x4*)(so + rr * 32 + c4);
                v2u w; w.x = pk2(ov[0], ov[1]); w.y = pk2(ov[2], ov[3]); *(GAS v2u*)(MV + (rowbase + (size_t)ch * 64 + rr) * D + h * 256 + vs * 32 + c4) = w; }
        }
#undef SM_LOAD
        __syncthreads();
    }
}

__device__ __forceinline__ void ph_post(const Ctx& c, int l) {
    const int tid = TID(), lane = tid & 63, wave = tid >> 6, gw = BID() * NWAVES + wave, NGW = gridDim.x * NWAVES;
    bf16* PJ = (bf16*)(c.ws + WS_PROJ);
    const bf16* OA = PJ + (size_t)P_XM * PSTRIDE; const bf16* GS = PJ + (size_t)P_GA * PSTRIDE; const bf16* OS = PJ + (size_t)P_OS * PSTRIDE;
    bf16* AO = PJ + (size_t)P_QA * PSTRIDE; bf16* BO = PJ + (size_t)P_LF * PSTRIDE;
    const bf16* HM = PJ + (size_t)P_VA * PSTRIDE; const bf16* XC = (const bf16*)(c.ws + WS_XC);
    f32x4 gna[4], gnm[4], skp[4]; ld_row_f32(c.in[I_HGN] + (size_t)l * D, lane, gna); ld_row_f32(c.in[I_MGN] + (size_t)l * D, lane, gnm); ld_row_f32(c.in[I_MSKIP] + (size_t)l * D, lane, skp);
    for (int slot = gw; slot < M / 16; slot += NGW) {
        for (int r = 0; r < 16; ++r) {
            const size_t ro = (size_t)(slot * 16 + r) * D;
            f32x4 oa[4], gs[4], hm[4], xc[4], os[4], ao[4], bo[4];
            ld_row_bf16(OA + ro, lane, oa); ld_row_bf16(GS + ro, lane, gs); ld_row_bf16(HM + ro, lane, hm); ld_row_bf16(XC + ro, lane, xc); ld_row_bf16(OS + ro, lane, os);
#pragma unroll
            for (int j = 0; j < 4; ++j) {
                const float ss = half_sum((oa[j][0] * oa[j][0] + oa[j][1] * oa[j][1]) + (oa[j][2] * oa[j][2] + oa[j][3] * oa[j][3]));
                const float ra = rsqrtf(ss * (1.0f / 128.0f) + EPS);
                ao[j] = oa[j] * ra * gna[j] * gs[j];
                const float mu = wave_sum((hm[j][0] + hm[j][1]) + (hm[j][2] + hm[j][3])) * (1.0f / 256.0f);
                const f32x4 d = hm[j] - mu;
                const float var = wave_sum((d[0] * d[0] + d[1] * d[1]) + (d[2] * d[2] + d[3] * d[3])) * (1.0f / 256.0f);
                const float rb = rsqrtf(var + EPS);
                bo[j] = os[j] * (d * rb * gnm[j] + skp[j] * xc[j]);
            }
            st_row_bf16(AO + ro, lane, ao); st_row_bf16(BO + ro, lane, bo);
        }
    }
}
typedef short bf16x8 __attribute__((ext_vector_type(8)));
#define MFMA16(a, b, c) __builtin_amdgcn_mfma_f32_16x16x32_bf16(a, b, c, 0, 0, 0)
__device__ __forceinline__ f32x4 mmT(const LAS bf16* X, int ldx, int m0, const LAS bf16* Y, int ldy, int n0, int k0, f32x4 acc, int lane) {
    const bf16x8 a = *(const LAS bf16x8*)(X + (m0 + (lane & 15)) * ldx + k0 + 8 * (lane >> 4));
    const bf16x8 b = *(const LAS bf16x8*)(Y + (n0 + (lane & 15)) * ldy + k0 + 8 * (lane >> 4));
    return MFMA16(b, a, acc);
}
__device__ __forceinline__ f32x4 mmN(const LAS bf16* X, int ldx, int m0, const LAS bf16* Y, int ldy, int n0, int k0, f32x4 acc, int lane) {
    const bf16x8 a = *(const LAS bf16x8*)(X + (m0 + (lane & 15)) * ldx + k0 + 8 * (lane >> 4));
    const bf16x8 b = *(const LAS bf16x8*)(Y + (n0 + (lane & 15)) * ldy + k0 + 8 * (lane >> 4));
    return MFMA16(a, b, acc);
}
__device__ __forceinline__ v2u pack4(const f32x4 v) { v2u w; w.x = pk2(v[0], v[1]); w.y = pk2(v[2], v[3]); return w; }

__device__ __forceinline__ void ph_scan_a(const Ctx& c, LAS unsigned char* lds) {
    const int tid = TID(), lane = tid & 63, wave = __builtin_amdgcn_readfirstlane(tid >> 6);
    bf16* PJ = (bf16*)(c.ws + WS_PROJ);
    const GAS bf16* Q = (const GAS bf16*)(PJ + (size_t)P_QA * PSTRIDE); const GAS bf16* LFp = (const GAS bf16*)(PJ + (size_t)P_LF * PSTRIDE); const bf16* V = PJ + (size_t)P_VA * PSTRIDE; bf16* OA = PJ + (size_t)P_XM * PSTRIDE;
    LAS bf16* LQ = (LAS bf16*)lds;
    LAS bf16* LK = (LAS bf16*)(lds + 17408);
    LAS bf16* LKT = (LAS bf16*)(lds + 34816);
    LAS bf16* LVT = (LAS bf16*)(lds + 53248);
    LAS bf16* LP = (LAS bf16*)(lds + 57856);
    LAS bf16* LST = (LAS bf16*)(lds + 67072);
    LAS float* SEG = (LAS float*)(lds + 75776);
    LAS float* ER = (LAS float*)(lds + 77824);
    LAS float* EB = (LAS float*)(lds + 78336);
    LAS float* EK = (LAS float*)(lds + 78848);
    const int d = tid & 127, seg = tid >> 7;
    for (int u = BID(); u < 256; u += gridDim.x) {
        const int b = u >> 5, h = (u >> 2) & 7, vs = u & 3;
        const size_t rowbase = (size_t)b * SEQ;
        f32x4 S[2]; S[0] = (f32x4){0.f, 0.f, 0.f, 0.f}; S[1] = S[0];
        unsigned short rq[16], rf[16]; v4u rv = {0u, 0u, 0u, 0u};
#define SA_LOAD(ch) do { const size_t o_ = (rowbase + (size_t)(ch) * 64 + seg * 16) * D + h * 128 + d; \
            _Pragma("unroll") for (int i = 0; i < 16; ++i) { rq[i] = Q[o_ + (size_t)i * D]; rf[i] = LFp[o_ + (size_t)i * D]; } \
            if (tid < 256) { const int rr = tid >> 2, c8 = tid & 3; rv = *(const GAS v4u*)(V + (rowbase + (size_t)(ch) * 64 + rr) * D + h * 128 + vs * 32 + c8 * 8); } } while (0)
        SA_LOAD(0);
        for (int ch = 0; ch < 64; ++ch) {
            float qv[16], kv[16], cs[16]; float run = 0.f;
#pragma unroll
            for (int i = 0; i < 16; ++i) { qv[i] = bf2f(rq[i]); const float lf = bf2f(rf[i]); kv[i] = 1.0f - __expf(lf); run += lf; cs[i] = run; }
            SEG[seg * 128 + d] = run;
            __syncthreads();
            const float s0 = SEG[d], s1 = SEG[128 + d], s2 = SEG[256 + d], s3 = SEG[384 + d];
            const float pre = (seg > 0 ? s0 : 0.f) + (seg > 1 ? s1 : 0.f) + (seg > 2 ? s2 : 0.f);
            const float r = s0 + s1, btot = (s0 + s1) + (s2 + s3);
            if (tid < 256) { const int rr = tid >> 2, c8 = tid & 3; const unsigned w4[4] = {rv.x, rv.y, rv.z, rv.w};
#pragma unroll
                for (int j = 0; j < 4; ++j) { LVT[(c8 * 8 + 2 * j) * 72 + rr] = (bf16)(w4[j] & 0xffffu); LVT[(c8 * 8 + 2 * j + 1) * 72 + rr] = (bf16)(w4[j] >> 16); } }
            unsigned kt[8];
#pragma unroll
            for (int i = 0; i < 16; ++i) { const float bt = pre + cs[i]; const unsigned qb = f2bf(qv[i] * __expf(bt - r)), kb = f2bf(kv[i] * __expf(r - bt));
                LQ[(seg * 16 + i) * 136 + d] = (bf16)qb; LK[(seg * 16 + i) * 136 + d] = (bf16)kb;
                if (i & 1) kt[i >> 1] |= kb << 16; else kt[i >> 1] = kb; }
            *(LAS v4u*)(LKT + d * 72 + seg * 16) = (v4u){kt[0], kt[1], kt[2], kt[3]}; *(LAS v4u*)(LKT + d * 72 + seg * 16 + 8) = (v4u){kt[4], kt[5], kt[6], kt[7]};
            if (seg == 0) { ER[d] = __expf(r); EB[d] = __expf(btot); EK[d] = __expf(btot - r); }
            if (ch + 1 < 64) SA_LOAD(ch + 1);
            __syncthreads();
            {
                const int tt = wave >> 1;
#pragma unroll
                for (int jj = 0; jj < 2; ++jj) { const int st = (wave & 1) * 2 + jj; f32x4 acc = {0.f, 0.f, 0.f, 0.f};
                    if (st <= tt) {
#pragma unroll
                        for (int kk = 0; kk < 4; ++kk) acc = mmT(LQ, 136, tt * 16, LK, 136, st * 16, kk * 32, acc, lane);
                        if (st == tt) {
#pragma unroll
                            for (int e = 0; e < 4; ++e) if (4 * (lane >> 4) + e > (lane & 15)) acc[e] = 0.f; } }
                    *(LAS v2u*)(LP + (tt * 16 + (lane & 15)) * 72 + st * 16 + 4 * (lane >> 4)) = pack4(acc); }
#pragma unroll
                for (int j = 0; j < 2; ++j) { const int ti = wave * 2 + j, d0 = (ti >> 1) * 16, e0 = (ti & 1) * 16;
                    const f32x4 er4 = *(const LAS f32x4*)(ER + d0 + 4 * (lane >> 4));
                    *(LAS v2u*)(LST + (e0 + (lane & 15)) * 136 + d0 + 4 * (lane >> 4)) = pack4(S[j] * er4); }
            }
            __syncthreads();
            {
                const int t0 = (wave >> 1) * 16, e0 = (wave & 1) * 16; f32x4 acc = {0.f, 0.f, 0.f, 0.f};
#pragma unroll
                for (int kk = 0; kk < 2; ++kk) acc = mmT(LP, 72, t0, LVT, 72, e0, kk * 32, acc, lane);
#pragma unroll
                for (int kk = 0; kk < 4; ++kk) acc = mmT(LQ, 136, t0, LST, 136, e0, kk * 32, acc, lane);
                *(GAS v2u*)(OA + (rowbase + (size_t)ch * 64 + t0 + (lane & 15)) * D + h * 128 + vs * 32 + e0 + 4 * (lane >> 4)) = pack4(acc);
#pragma unroll
                for (int j = 0; j < 2; ++j) { const int ti = wave * 2 + j, d0 = (ti >> 1) * 16, ee0 = (ti & 1) * 16; f32x4 up = {0.f, 0.f, 0.f, 0.f};
#pragma unroll
                    for (int kk = 0; kk < 2; ++kk) up = mmN(LKT, 72, d0, LVT, 72, ee0, kk * 32, up, lane);
                    const f32x4 eb4 = *(const LAS f32x4*)(EB + d0 + 4 * (lane >> 4)), ek4 = *(const LAS f32x4*)(EK + d0 + 4 * (lane >> 4));
                    S[j] = eb4 * S[j] + ek4 * up; }
            }
        }
#undef SA_LOAD
        __syncthreads();
    }
}

__device__ __forceinline__ bf16x8 tr_frag(const LAS bf16* T, int ld, int k0, int m0, int lane) {
    const int g = lane >> 4, q = (lane & 15) >> 2, p = lane & 3;
    const unsigned a0 = (unsigned)(size_t)(T + (k0 + 8 * g + q) * ld + m0 + 4 * p), a1 = a0 + (unsigned)(4 * ld * 2);
    v2u x, y; asm volatile("ds_read_b64_tr_b16 %0, %2\n\tds_read_b64_tr_b16 %1, %3\n\ts_waitcnt lgkmcnt(0)" : "=&v"(x), "=&v"(y) : "v"(a0), "v"(a1) : "memory");
    const v4u w = {x.x, x.y, y.x, y.y}; return __builtin_bit_cast(bf16x8, w);
}
__device__ __forceinline__ void ph_scan_m(const Ctx& c, LAS unsigned char* lds) {
    const int tid = TID(), lane = tid & 63, wave = __builtin_amdgcn_readfirstlane(tid >> 6);
    const bf16* MQ = (const bf16*)(c.ws + WS_MQ); const bf16* MK = (const bf16*)(c.ws + WS_MK); const bf16* MV = (const bf16*)(c.ws + WS_MV); bf16* HM = (bf16*)(c.ws + WS_PROJ) + (size_t)P_VA * PSTRIDE;
    const GAS float* LI = (const GAS float*)(c.ws + WS_LI); const GAS float* LF = (const GAS float*)(c.ws + WS_LF);
    LAS bf16* LQ = (LAS bf16*)lds;
    LAS bf16* LK = (LAS bf16*)(lds + 33792);
    LAS bf16* LV0 = (LAS bf16*)(lds + 67584);
    LAS bf16* LV1 = (LAS bf16*)(lds + 74496);
    LAS bf16* LP = (LAS bf16*)(lds + 81408);
    LAS bf16* LCT = (LAS bf16*)(lds + 90624);
    LAS float* AS = (LAS float*)(lds + 115968);
    LAS float* MXS = (LAS float*)(lds + 116224);
    LAS float* BS = (LAS float*)(lds + 116480);
    for (int u = BID(); u < 256; u += gridDim.x) {
        const int b = u >> 5, h = (u >> 3) & 3, vs = u & 7;
        const size_t rowbase = (size_t)b * SEQ;
        f32x4 C[2][3];
#pragma unroll
        for (int i = 0; i < 2; ++i)
#pragma unroll
            for (int j = 0; j < 3; ++j) C[i][j] = (f32x4){0.f, 0.f, 0.f, 0.f};
        float m = 0.f;
        __syncthreads();
        for (int i = tid; i < 48 * 72; i += NTHR) { const int row = i / 72; LV0[i] = (bf16)(row == 32 ? 0x3f80u : 0u); LV1[i] = (bf16)0u; }
        v4u rq[4], rk[4], rv = {0u, 0u, 0u, 0u}; float rli = 0.f, rlf = 0.f;
#define SM_LOAD(ch) do { _Pragma("unroll") for (int k2 = 0; k2 < 4; ++k2) { const int p = tid + NTHR * k2, rr = p >> 5, c8 = p & 31; const size_t o_ = (rowbase + (size_t)(ch) * 64 + rr) * D + h * 256 + c8 * 8; \
            rq[k2] = *(const GAS v4u*)(MQ + o_); rk[k2] = *(const GAS v4u*)(MK + o_); } \
            if (tid < 256) { const int rr = tid >> 2, c8 = tid & 3; rv = *(const GAS v4u*)(MV + (rowbase + (size_t)(ch) * 64 + rr) * D + h * 256 + vs * 32 + c8 * 8); } \
            rli = LI[(rowbase + (size_t)(ch) * 64 + lane) * 4 + h]; rlf = LF[(rowbase + (size_t)(ch) * 64 + lane) * 4 + h]; } while (0)
        SM_LOAD(0);
        for (int ch = 0; ch < 64; ++ch) {
            __syncthreads();
            float bb = rlf;
#pragma unroll
            for (int o = 1; o < 64; o <<= 1) { const float t_ = __shfl_up(bb, o); if (lane >= o) bb += t_; }
            const float aa = rli - bb; float pm = aa;
#pragma unroll
            for (int o = 1; o < 64; o <<= 1) { const float t_ = __shfl_up(pm, o); if (lane >= o) pm = fmaxf(pm, t_); }
            const float mx = fmaxf(m, pm);
            const float b63 = __shfl(bb, 63), mx63 = __shfl(mx, 63);
            if (wave == 0) { AS[lane] = aa; MXS[lane] = mx; BS[lane] = bb; }
#pragma unroll
            for (int k2 = 0; k2 < 4; ++k2) { const int p = tid + NTHR * k2, rr = p >> 5, c8 = p & 31; *(LAS v4u*)(LQ + rr * 264 + c8 * 8) = rq[k2]; *(LAS v4u*)(LK + rr * 264 + c8 * 8) = rk[k2]; }
            { const int rr = (tid >> 2) & 63; const float wv = __expf(__shfl(aa, rr) - mx63);
              if (tid < 256) { const int c8 = tid & 3; const unsigned w4[4] = {rv.x, rv.y, rv.z, rv.w};
#pragma unroll
                for (int j = 0; j < 4; ++j) { const unsigned lo = w4[j] & 0xffffu, hi = w4[j] >> 16;
                    LV0[(c8 * 8 + 2 * j) * 72 + rr] = (bf16)lo; LV0[(c8 * 8 + 2 * j + 1) * 72 + rr] = (bf16)hi;
                    LV1[(c8 * 8 + 2 * j) * 72 + rr] = (bf16)f2bf(bflo(w4[j]) * wv); LV1[(c8 * 8 + 2 * j + 1) * 72 + rr] = (bf16)f2bf(bfhi(w4[j]) * wv); } } }
            if (wave == 0) LV1[32 * 72 + lane] = (bf16)f2bf(__expf(aa - mx63));
            const float m_old = m;
            if (ch + 1 < 64) SM_LOAD(ch + 1);
            __syncthreads();
            {
                const int tt = wave >> 1;
#pragma unroll
                for (int jj = 0; jj < 2; ++jj) { const int st = (wave & 1) * 2 + jj; f32x4 acc = {0.f, 0.f, 0.f, 0.f};
                    if (st <= tt) {
#pragma unroll
                        for (int kk = 0; kk < 8; ++kk) acc = mmT(LQ, 264, tt * 16, LK, 264, st * 16, kk * 32, acc, lane);
                        const f32x4 a4 = *(const LAS f32x4*)(AS + st * 16 + 4 * (lane >> 4)); const float mxt = MXS[tt * 16 + (lane & 15)];
#pragma unroll
                        for (int e = 0; e < 4; ++e) acc[e] = (st == tt && 4 * (lane >> 4) + e > (lane & 15)) ? 0.f : acc[e] * __expf(a4[e] - mxt); }
                    *(LAS v2u*)(LP + (tt * 16 + (lane & 15)) * 72 + st * 16 + 4 * (lane >> 4)) = pack4(acc); }
#pragma unroll
                for (int i = 0; i < 2; ++i)
#pragma unroll
                    for (int j = 0; j < 3; ++j) { const int d0 = (wave * 2 + i) * 16, e0 = j * 16;
                        *(LAS v2u*)(LCT + (e0 + (lane & 15)) * 264 + d0 + 4 * (lane >> 4)) = pack4(C[i][j]); }
            }
            __syncthreads();
            {
                const int t0 = (wave >> 1) * 16, e0 = (wave & 1) * 16; f32x4 p1 = {0.f, 0.f, 0.f, 0.f}, p2 = p1, q1 = p1, q2 = p1;
#pragma unroll
                for (int kk = 0; kk < 2; ++kk) { p1 = mmT(LP, 72, t0, LV0, 72, e0, kk * 32, p1, lane); q1 = mmT(LP, 72, t0, LV0, 72, 32, kk * 32, q1, lane); }
#pragma unroll
                for (int kk = 0; kk < 8; ++kk) { p2 = mmT(LQ, 264, t0, LCT, 264, e0, kk * 32, p2, lane); q2 = mmT(LQ, 264, t0, LCT, 264, 32, kk * 32, q2, lane); }
                const float mxt = MXS[t0 + (lane & 15)], bt = BS[t0 + (lane & 15)], wi = __expf(m_old - mxt);
                const float den = __shfl(q1[0] + wi * q2[0], lane & 15);
                const float inv = 1.0f / fmaxf(fabsf(den), __expf(-(bt + mxt)));
                const f32x4 hv = (p1 + p2 * wi) * inv;
                *(GAS v2u*)(HM + (rowbase + (size_t)ch * 64 + t0 + (lane & 15)) * D + h * 256 + vs * 32 + e0 + 4 * (lane >> 4)) = pack4(hv);
                const float dec = __expf(m_old - mx63);
#pragma unroll
                for (int i = 0; i < 2; ++i) { const int d0 = (wave * 2 + i) * 16; f32x4 up[3];
#pragma unroll
                    for (int j = 0; j < 3; ++j) up[j] = (f32x4){0.f, 0.f, 0.f, 0.f};
#pragma unroll
                    for (int kk = 0; kk < 2; ++kk) { const bf16x8 af = tr_frag(LK, 264, kk * 32, d0, lane);
#pragma unroll
                        for (int j = 0; j < 3; ++j) { const bf16x8 bfr = *(const LAS bf16x8*)(LV1 + (j * 16 + (lane & 15)) * 72 + kk * 32 + 8 * (lane >> 4)); up[j] = MFMA16(af, bfr, up[j]); } }
#pragma unroll
                    for (int j = 0; j < 3; ++j) C[i][j] = C[i][j] * dec + up[j]; }
                m = b63 + mx63;
            }
        }
#undef SM_LOAD
        __syncthreads();
    }
}
constexpr int TAB_OFF = MISC_OFF + 256;
__device__ __forceinline__ void moe_tables(const Ctx& c, int jm, LAS unsigned char* lds) {
    LAS int* tab = (LAS int*)(lds + TAB_OFF);
    __syncthreads();
    if (TID() == 0) { unsigned* cnt = (unsigned*)c.ws + CW_CNT + 64 * jm; int accp = 0;
        for (int e = 0; e < 8; ++e) { const int n = (int)__hip_atomic_load(cnt + e, __ATOMIC_RELAXED, __HIP_MEMORY_SCOPE_AGENT); const int p = (n + 255) >> 8; tab[e] = p; tab[8 + e] = accp; accp += p; }
        tab[16] = accp; }
    __syncthreads();
}
__device__ __forceinline__ void ph_res1(const Ctx& c, int l, LAS unsigned char* lds) {
    const int tid = TID(), lane = tid & 63, wave = tid >> 6, gw = BID() * NWAVES + wave, NGW = gridDim.x * NWAVES;
    const bool moe = (l & 1) != 0; const int jm = l >> 1;
    LAS float* rt = (LAS float*)lds;
    if (moe) { const GAS f32x4* src = (const GAS f32x4*)(c.in[I_ROUTER] + (size_t)jm * D * NEXP); for (int i = tid; i < D * NEXP / 4; i += NTHR) ((LAS f32x4*)rt)[i] = src[i]; }
    __syncthreads();
    const float* xin = (l == 0) ? c.in[I_X] : c.out;
    const bf16* Y = (const bf16*)(c.ws + WS_PROJ) + (size_t)P_OS * PSTRIDE; bf16* H = (bf16*)(c.ws + WS_H);
    unsigned* cnt = (unsigned*)c.ws + CW_CNT + 64 * jm;
    int* TOKEP = (int*)(c.ws + WS_TOKEP); float* TOKW = (float*)(c.ws + WS_TOKW);
    for (int slot = gw; slot < M / 16; slot += NGW) {
        const int row0 = slot * 16, b = row0 / SEQ;
        f32x4 gpm[4], gt[4], gpf[4], scf[4], shf[4];
        ld_row_f32(c.in[I_GPOSTMIX] + (size_t)l * D, lane, gpm); ld_row_f32(modp(c, l, b, 2), lane, gt); ld_row_f32(c.in[I_GPREFFN] + (size_t)l * D, lane, gpf);
        ld_row_f32(modp(c, l, b, 4), lane, scf); ld_row_f32(modp(c, l, b, 3), lane, shf);
        for (int r = 0; r < 16; ++r) {
            const int row = row0 + r; const size_t ro = (size_t)row * D;
            f32x4 y[4], x[4], h[4]; ld_row_bf16(Y + ro, lane, y); ld_row_f32(xin + ro, lane, x);
            const float rr = rsqrtf(row_sumsq(y) * (1.0f / 1024.0f) + EPS);
#pragma unroll
            for (int j = 0; j < 4; ++j) { x[j] = x[j] + gt[j] * (y[j] * rr * gpm[j]); *(GAS f32x4*)(c.out + ro + 4 * lane + 256 * j) = x[j]; }
            norm_mod(x, gpf, scf, shf, h); st_row_bf16(H + ro, lane, h);
            if (moe) {
                f32x4 l0 = {0.f, 0.f, 0.f, 0.f}, l1 = l0;
#pragma unroll
                for (int j = 0; j < 4; ++j)
#pragma unroll
                    for (int i = 0; i < 4; ++i) { const int ch = 4 * lane + 256 * j + i; l0 += *(const LAS f32x4*)(rt + ch * 8) * h[j][i]; l1 += *(const LAS f32x4*)(rt + ch * 8 + 4) * h[j][i]; }
                float lg[8];
#pragma unroll
                for (int e = 0; e < 4; ++e) { lg[e] = wave_sum(l0[e]); lg[4 + e] = wave_sum(l1[e]); }
                int i1 = 0; float v1 = lg[0];
#pragma unroll
                for (int e = 1; e < 8; ++e) if (lg[e] > v1) { v1 = lg[e]; i1 = e; }
                int i2 = -1; float v2 = -3.0e38f;
#pragma unroll
                for (int e = 0; e < 8; ++e) if (e != i1 && lg[e] > v2) { v2 = lg[e]; i2 = e; }
                if (lane == 0) { const float w1 = 1.0f / (1.0f + __expf(v2 - v1));
                    const int p1 = (int)atomicAdd(cnt + i1, 1u), p2 = (int)atomicAdd(cnt + i2, 1u);
                    *(GAS i32x4*)(TOKEP + (size_t)row * 4) = (i32x4){i1, p1, i2, p2}; *(GAS f32x2*)(TOKW + (size_t)row * 2) = (f32x2){w1, 1.0f - w1}; }
            }
        }
    }
}
__device__ __forceinline__ void ph_gather(const Ctx& c, int l, LAS unsigned char* lds) {
    const int tid = TID(), lane = tid & 63, wave = tid >> 6, gw = BID() * NWAVES + wave, NGW = gridDim.x * NWAVES;
    moe_tables(c, l >> 1, lds); const LAS int* tab = (const LAS int*)(lds + TAB_OFF);
    const bf16* H = (const bf16*)(c.ws + WS_H); bf16* AG = (bf16*)(c.ws + WS_AG);
    const int* TOKEP = (const int*)(c.ws + WS_TOKEP); int* TOKD = (int*)(c.ws + WS_TOKD);
    for (int row = gw; row < M; row += NGW) {
        const i32x4 ep = *(const GAS i32x4*)(TOKEP + (size_t)row * 4);
        const int d1 = tab[8 + ep.x] * 256 + ep.y, d2 = tab[8 + ep.z] * 256 + ep.w;
        const v4u a = *(const GAS v4u*)(H + (size_t)row * D + lane * 8), b = *(const GAS v4u*)(H + (size_t)row * D + 512 + lane * 8);
        *(GAS v4u*)(AG + (size_t)d1 * D + lane * 8) = a; *(GAS v4u*)(AG + (size_t)d1 * D + 512 + lane * 8) = b;
        *(GAS v4u*)(AG + (size_t)d2 * D + lane * 8) = a; *(GAS v4u*)(AG + (size_t)d2 * D + 512 + lane * 8) = b;
        if (lane == 0) *(GAS i32x2*)(TOKD + (size_t)row * 2) = (i32x2){d1, d2};
    }
}
__device__ __forceinline__ void ph_res2(const Ctx& c, int l) {
    const int tid = TID(), lane = tid & 63, wave = tid >> 6, gw = BID() * NWAVES + wave, NGW = gridDim.x * NWAVES;
    const bool moe = (l & 1) != 0;
    const bf16* Y2 = (const bf16*)(c.ws + WS_PROJ) + (size_t)4 * PSTRIDE; const bf16* YS = (const bf16*)(c.ws + WS_YS); bf16* H = (bf16*)(c.ws + WS_H);
    const int* TOKD = (const int*)(c.ws + WS_TOKD); const float* TOKW = (const float*)(c.ws + WS_TOKW);
    const int ln = (l + 1 < DEPTH) ? l + 1 : l;
    for (int slot = gw; slot < M / 16; slot += NGW) {
        const int row0 = slot * 16, b = row0 / SEQ;
        f32x4 gpo[4], gt[4], gpm[4], scm[4], shm[4];
        ld_row_f32(c.in[I_GPOSTFFN] + (size_t)l * D, lane, gpo); ld_row_f32(modp(c, l, b, 5), lane, gt); ld_row_f32(c.in[I_GPREMIX] + (size_t)ln * D, lane, gpm);
        ld_row_f32(modp(c, ln, b, 1), lane, scm); ld_row_f32(modp(c, ln, b, 0), lane, shm);
        for (int r = 0; r < 16; ++r) {
            const int row = row0 + r; const size_t ro = (size_t)row * D;
            f32x4 y[4], x[4], h[4];
            if (moe) { const i32x2 d = *(const GAS i32x2*)(TOKD + (size_t)row * 2); const f32x2 w = *(const GAS f32x2*)(TOKW + (size_t)row * 2);
                f32x4 ya[4], yb[4]; ld_row_bf16(YS + (size_t)d.x * D, lane, ya); ld_row_bf16(YS + (size_t)d.y * D, lane, yb);
#pragma unroll
                for (int j = 0; j < 4; ++j) y[j] = ya[j] * w.x + yb[j] * w.y; }
            else ld_row_bf16(Y2 + ro, lane, y);
            ld_row_f32(c.out + ro, lane, x);
            const float rr = rsqrtf(row_sumsq(y) * (1.0f / 1024.0f) + EPS);
#pragma unroll
            for (int j = 0; j < 4; ++j) { x[j] = x[j] + gt[j] * (y[j] * rr * gpo[j]); *(GAS f32x4*)(c.out + ro + 4 * lane + 256 * j) = x[j]; }
            if (l + 1 < DEPTH) { norm_mod(x, gpm, scm, shm, h); st_row_bf16(H + ro, lane, h); }
        }
    }
}

constexpr int PH_PER_LAYER = 12, NPH = 2 + DEPTH * PH_PER_LAYER;
__global__ void __launch_bounds__(NTHR, 2) fwd(Ctx c) {
    extern __shared__ __attribute__((aligned(16))) unsigned char lds_raw[];
    LAS unsigned char* lds = (LAS unsigned char*)lds_raw;
    volatile LAS unsigned* MISC = (volatile LAS unsigned*)(lds + MISC_OFF);
    if (threadIdx.x < 64) MISC[threadIdx.x] = 0u;
    __syncthreads();
    const int lo = c.ph_lo, hi = c.ph_hi, G = gridDim.x;
    XcdBarrier bar; bar.bar = (unsigned*)c.ws + CW_BAR; bar.x = 0; bar.st = MISC + 8;
    if (hi - lo > 1) bar = xcd_barrier_post((unsigned*)c.ws + CW_BAR, MISC + 8);
#ifndef PH_MASK
#define PH_MASK 0xFFFF
#endif
#define IN(p) (lo <= (p) && (p) < hi)
#define ON(k) ((PH_MASK >> (k)) & 1)
#ifndef REPMASK
#define REPMASK 0
#endif
#define REP(k) for (int rep_ = 0; rep_ < (((REPMASK >> (k)) & 1) ? opq_s(2) : 1); ++rep_)
#define BAR_AFTER(p) do { if ((p) + 1 < hi) xcd_barrier(bar); } while (0)
    if (ON(12) && IN(0)) { ph_mod(c, lds); ph_lb(c); ph_cvt(c, 0, lds); BAR_AFTER(0); }
    if (ON(13) && IN(1)) { ph_norm0(c); BAR_AFTER(1); }
    for (int l = 0; l < DEPTH; ++l) {
        const int base = 2 + l * PH_PER_LAYER; const bool moe = (l & 1) != 0;
        Ctx cl = c; cl.ws = opq_p(c.ws); cl.out = (float*)opq_p((unsigned char*)c.out);
        unsigned char* ws = cl.ws; bf16* PJ = (bf16*)(ws + WS_PROJ); const int bid = BID();
        int KD = opq_s(D);
        if (ON(0) && IN(base + 0)) {
            pg8::Gemm g{(const bf16*)(ws + WS_H), (const bf16*)(ws + WS_WIN), M, DIN, KD}; pg8::UOrder S; S.init(0, M, DIN, G, bid);
            pg8::EpiWin E{PJ, (const float*)(ws + WS_LB) + l * 1024, PSTRIDE};
            REP(0) pg8::gemm_phase<pg8::EpiWin, pg8::UOrder, true, true>(lds, g, S, E);
            BAR_AFTER(base + 0); }
        if (ON(1) && IN(base + 1)) { REP(1) ph_prep(cl, l); BAR_AFTER(base + 1); }
        if (ON(2) && IN(base + 2)) { REP(2) ph_scan_a(cl, lds); BAR_AFTER(base + 2); }
        if (ON(3) && IN(base + 3)) { REP(3) ph_scan_m(cl, lds); BAR_AFTER(base + 3); }
        if (ON(4) && IN(base + 4)) { REP(4) ph_post(cl, l); BAR_AFTER(base + 4); }
        if (ON(5) && IN(base + 5)) {
            pg8::Gemm g{PJ + (size_t)P_QA * PSTRIDE, (const bf16*)(ws + WS_WAB), M, D, KD}; pg8::UOrder S; S.init(1, M, D, G, bid);
            pg8::EpiProj E{PJ + (size_t)P_GTA * PSTRIDE, PSTRIDE, (float*)(PJ + (size_t)P_GA * PSTRIDE), PJ + (size_t)P_VA * PSTRIDE};
            REP(5) pg8::gemm_phase<pg8::EpiProj, pg8::UOrder, true, true>(lds, g, S, E);
            BAR_AFTER(base + 5); }
        if (ON(6) && IN(base + 6)) {
            pg8::Gemm g{PJ + (size_t)P_VA * PSTRIDE, (const bf16*)(ws + WS_WO), M, D, KD}; pg8::UOrder S; S.init(0, M, D, G, bid);
            pg8::EpiPlain E{PJ + (size_t)P_OS * PSTRIDE, D};
            REP(6) pg8::gemm_phase<pg8::EpiPlain, pg8::UOrder, true, true>(lds, g, S, E);
            BAR_AFTER(base + 6); }
        if (ON(7) && IN(base + 7)) { ph_res1(cl, l, lds); BAR_AFTER(base + 7); }
        if (ON(8) && IN(base + 8) && moe) { ph_gather(cl, l, lds); BAR_AFTER(base + 8); }
        if (ON(9) && IN(base + 9)) {
            pg8::Gemm g{(const bf16*)(ws + (moe ? WS_AG : WS_H)), (const bf16*)(ws + WS_WF), M, 2 * DFF, KD}; pg8::UOrder S; S.init(0, M, 2 * DFF, G, bid);
            pg8::EpiSwi E{PJ, moe ? DFE : DFF, moe ? 28 : 22};
            if (moe) { moe_tables(cl, l >> 1, lds); S.mode = 2; S.NT = 28; S.tab = (const LAS int*)(lds + TAB_OFF); S.nwg = __builtin_amdgcn_readfirstlane(S.tab[16]) * 28; }
            REP(9) pg8::gemm_phase<pg8::EpiSwi, pg8::UOrder, true, true>(lds, g, S, E);
            BAR_AFTER(base + 9); }
        if (ON(10) && IN(base + 10)) {
            pg8::Gemm g{PJ, (const bf16*)(ws + WS_WF + (moe ? WF_W2_MOE : WF_W2_DENSE)), M, D, moe ? DFE : DFF}; pg8::UOrder S; S.init(0, M, D, G, bid);
            pg8::EpiPlain E{moe ? (bf16*)(ws + WS_YS) : PJ + (size_t)4 * PSTRIDE, D};
            if (moe) { moe_tables(cl, l >> 1, lds); S.mode = 2; S.NT = 4; S.tab = (const LAS int*)(lds + TAB_OFF); S.nwg = __builtin_amdgcn_readfirstlane(S.tab[16]) * 4; }
            REP(10) pg8::gemm_phase<pg8::EpiPlain, pg8::UOrder, true, true>(lds, g, S, E);
            BAR_AFTER(base + 10); }
        if (ON(11) && IN(base + 11)) { ph_res2(cl, l); if (l + 1 < DEPTH) ph_cvt(cl, l + 1, lds); BAR_AFTER(base + 11); }
    }
#undef IN
#undef BAR_AFTER
}

#ifndef MK_ONE_LAUNCH
#define MK_ONE_LAUNCH 1
#endif
extern "C" void kernel_launch(void* const* d_in, const int* in_sizes, int n_in, void* d_out, int out_size, void* d_ws, size_t ws_size, hipStream_t stream) {
    static int grid = 0;
    if (grid == 0) {
        if (n_in != 32 || in_sizes[0] != M * D || out_size != M * D || ws_size < WS_END) { fprintf(stderr, "kernel_launch: unexpected shapes / workspace (%d inputs, ws %zu < %zu)\n", n_in, ws_size, (size_t)WS_END); grid = -1; return; }
        int dev = 0, cus = 0;
        if (hipGetDevice(&dev) != hipSuccess || hipDeviceGetAttribute(&cus, hipDeviceAttributeMultiprocessorCount, dev) != hipSuccess) { grid = -1; return; }
        if (hipFuncSetAttribute((const void*)fwd, hipFuncAttributeMaxDynamicSharedMemorySize, LDS_BYTES) != hipSuccess) { fprintf(stderr, "kernel_launch: hipFuncSetAttribute failed\n"); grid = -1; return; }
        (void)hipGetLastError();
        grid = cus;
    }
    if (grid < 0) return;
    if (hipMemsetAsync((char*)d_ws + WS_CTL, 0, CTL_ZERO_BYTES, stream) != hipSuccess) return;
    Ctx c{};
    for (int i = 0; i < 32; ++i) c.in[i] = (const float*)d_in[i];
    c.out = (float*)d_out; c.ws = (unsigned char*)d_ws;
#if MK_ONE_LAUNCH
    c.ph_lo = 0; c.ph_hi = NPH;
    hipLaunchKernelGGL(fwd, dim3(grid), dim3(NTHR), LDS_BYTES, stream, c);
#else
    for (int p = 0; p < NPH; ++p) {
        if (p >= 2) { const int l = (p - 2) / PH_PER_LAYER, k = (p - 2) % PH_PER_LAYER; if (k == 8 && !(l & 1)) continue; }
        c.ph_lo = p; c.ph_hi = p + 1;
        hipLaunchKernelGGL(fwd, dim3(grid), dim3(NTHR), LDS_BYTES, stream, c);
    }
#endif
}
```

```cpp
#include <hip/hip_runtime.h>
#include <cstdio>
#include <cstdint>
namespace pg8 {
#define PG8_LAS __attribute__((address_space(3)))
typedef unsigned short bf16_t;
typedef short bf16x8 __attribute__((ext_vector_type(8)));
typedef float f32x4 __attribute__((ext_vector_type(4)));
typedef unsigned u32x4 __attribute__((ext_vector_type(4)));
constexpr int BM = 256, BK = 64, HALF = 128, HTB = HALF * BK * 2  , STAGE_BYTES = 8 * HTB, NXCD = 8, WGM = 8;

__host__ __device__ __forceinline__ int lds_byte(int r, int c) { const int st = (r >> 4) * 2 + (c >> 5), rr = r & 15, cc = c & 31, ob = rr * 64 + cc * 2; return st * 1024 + (ob ^ (((ob >> 9) & 1) << 5)); }
__host__ __device__ __forceinline__ void stage_rc(int b, int& R, int& C) { const int st = b / 1024, sb = b % 1024, swz = sb ^ (((sb >> 9) & 1) << 5); R = (st >> 1) * 16 + swz / 64; C = (st & 1) * 32 + (swz % 64) / 2; }
__host__ __device__ __forceinline__ int perm32(int rho) { const int n = rho >> 4, i = rho & 15; return 8 * (i >> 2) + 4 * n + (i & 3); }

struct Unit { int pm, pn; };
struct Gemm { const bf16_t* A; const bf16_t* Bt; int M, N, K; };

struct StaticOrder {
    int nM, nN, nwg, G, c;
    __host__ __device__ void init(int M, int N, int G_, int c_) { nM = M / BM; nN = N / BM; nwg = nM * nN; G = G_; c = c_; }
    __host__ __device__ bool next(int i, Unit& u) const {
        const long L = (long)i * G + c; if (L >= nwg) return false;
        int wgid = (int)L; { const int q = nwg / NXCD, r = nwg % NXCD, xcd = wgid % NXCD, off = wgid / NXCD; wgid = (xcd < r ? xcd * (q + 1) : r * (q + 1) + (xcd - r) * q) + off; }
        const int nig = WGM * nN, gid = wgid / nig, fm = gid * WGM, gsz = (nM - fm) < WGM ? (nM - fm) : WGM;
        u.pm = fm + ((wgid % nig) % gsz); u.pn = (wgid % nig) / gsz; return true;
    }
    __device__ __forceinline__ void a_ready(const Unit&) const {}
    __device__ __forceinline__ void done(const Unit&) const {}
};
__device__ __forceinline__ unsigned cvt_pk_bf16(float lo, float hi) { unsigned r; asm volatile("v_cvt_pk_bf16_f32 %0, %1, %2" : "=v"(r) : "v"(lo), "v"(hi)); return r; }
#define PG8_GAS __attribute__((address_space(1)))
struct UOrder {
    int mode, nM, nN, nwg, G, c, NT; const PG8_LAS int* tab;
    __device__ __forceinline__ void init(int mode_, int M, int N, int G_, int c_) { mode = mode_; nM = M / BM; nN = N / BM; nwg = nM * nN; G = G_; c = c_; NT = 1; tab = nullptr; }
    __device__ __forceinline__ bool next(int i, Unit& u) const {
        const int which = (mode == 1) ? (i & 1) : 0; const int ii = (mode == 1) ? (i >> 1) : i;
        const long L = (long)ii * G + c; if (L >= nwg) return false;
        int wgid = (int)L; { const int q = nwg / NXCD, r = nwg % NXCD, xcd = wgid % NXCD, off = wgid / NXCD; wgid = (xcd < r ? xcd * (q + 1) : r * (q + 1) + (xcd - r) * q) + off; }
        if (mode == 2) {
            int r = wgid, E = 0;
#pragma unroll
            for (int k = 0; k < 7; ++k) { const int uk = tab[k] * NT; if (E == k && r >= uk) { r -= uk; E = k + 1; } }
            const int P = tab[E], B = tab[8 + E];
            const int nig = WGM * NT, gid = r / nig, fm = gid * WGM, gsz = (P - fm) < WGM ? (P - fm) : WGM, rr = r - gid * nig;
            u.pm = __builtin_amdgcn_readfirstlane(B + fm + rr % gsz); u.pn = __builtin_amdgcn_readfirstlane(E * NT + rr / gsz); return true;
        }
        const int nig = WGM * nN, gid = wgid / nig, fm = gid * WGM, gsz = (nM - fm) < WGM ? (nM - fm) : WGM;
        u.pm = fm + ((wgid % nig) % gsz); u.pn = (wgid % nig) / gsz;
        if (which) { u.pm += nM; u.pn += nN; }
        return true;
    }
    __device__ __forceinline__ void a_ready(const Unit&) const {}
    __device__ __forceinline__ void done(const Unit&) const {}
};

__device__ __forceinline__ float fsig(float v) { return __builtin_amdgcn_rcpf(1.0f + __expf(-v)); }
__device__ __forceinline__ float bflo(unsigned w) { return __uint_as_float(w << 16); }
__device__ __forceinline__ float bfhi(unsigned w) { return __uint_as_float(w & 0xffff0000u); }
#define PG8_X8(x, ai, bj, m) float x[8]; { const f32x4 _a = acc[ai][bj][m][0], _b = acc[ai][bj][m][1]; x[0] = _a[0]; x[1] = _a[1]; x[2] = _a[2]; x[3] = _a[3]; x[4] = _b[0]; x[5] = _b[1]; x[6] = _b[2]; x[7] = _b[3]; }
#define PG8_PACK8(w, x) u32x4 w; w.x = cvt_pk_bf16(x[0], x[1]); w.y = cvt_pk_bf16(x[2], x[3]); w.z = cvt_pk_bf16(x[4], x[5]); w.w = cvt_pk_bf16(x[6], x[7]);

struct EpiWin {
    static constexpr bool PERM = true, AFTER_DRAIN = false;
    bf16_t* P; const float* lb; size_t pstride;
    __device__ __forceinline__ void operator()(const f32x4 (&acc)[2][2][4][2], const Unit& u, int wr, int wc, int fr, int fq) const {
        const int part = u.pn >> 2;
        const int mode = (part == 0 || part == 3) ? 1 : (part == 1) ? 3 : (part >= 5) ? 2 : 0;
        bf16_t* base = P + (size_t)part * pstride;
        const int row0 = u.pm * BM + wr * 64 + fr, col0 = (u.pn & 3) * BM + wc * 32 + 8 * fq;
        float lbv[2][8];
#pragma unroll
        for (int bj = 0; bj < 2; ++bj)
#pragma unroll
            for (int j = 0; j < 8; ++j) lbv[bj][j] = 0.f;
        if (mode == 3) {
#pragma unroll
            for (int bj = 0; bj < 2; ++bj) { const f32x4 a = *(const PG8_GAS f32x4*)(lb + col0 + bj * HALF), b = *(const PG8_GAS f32x4*)(lb + col0 + bj * HALF + 4);
                lbv[bj][0] = a[0]; lbv[bj][1] = a[1]; lbv[bj][2] = a[2]; lbv[bj][3] = a[3]; lbv[bj][4] = b[0]; lbv[bj][5] = b[1]; lbv[bj][6] = b[2]; lbv[bj][7] = b[3]; }
        }
#pragma unroll
        for (int ai = 0; ai < 2; ++ai)
#pragma unroll
            for (int m = 0; m < 4; ++m) { bf16_t* rowp = base + (size_t)(row0 + ai * HALF + m * 16) * 1024 + col0;
#pragma unroll
                for (int bj = 0; bj < 2; ++bj) { PG8_X8(x, ai, bj, m)
                    if (mode != 0) {
#pragma unroll
                        for (int j = 0; j < 8; ++j) { const float s = fsig(x[j]);
                            if (mode == 1) x[j] = x[j] * s; else if (mode == 2) x[j] = s; else x[j] = fmaxf(__logf(lbv[bj][j] + (1.0f - lbv[bj][j]) * s), -30.0f); } }
                    PG8_PACK8(w, x) *(PG8_GAS u32x4*)(rowp + bj * HALF) = w; } }
    }
};
struct EpiProj {
    static constexpr bool PERM = true, AFTER_DRAIN = false;
    const bf16_t* gates; size_t pstride; float* T1; bf16_t* MX;
    __device__ __forceinline__ void operator()(const f32x4 (&acc)[2][2][4][2], const Unit& u, int wr, int wc, int fr, int fq) const {
        const int which = u.pn >> 2;
        const bf16_t* g = gates + (size_t)which * pstride;
        const int row0 = (u.pm & 127) * BM + wr * 64 + fr, col0 = (u.pn & 3) * BM + wc * 32 + 8 * fq;
#pragma unroll
        for (int ai = 0; ai < 2; ++ai)
#pragma unroll
            for (int m = 0; m < 4; ++m) { const size_t off = (size_t)(row0 + ai * HALF + m * 16) * 1024 + col0;
#pragma unroll
                for (int bj = 0; bj < 2; ++bj) { PG8_X8(x, ai, bj, m)
                    const u32x4 gv = *(const PG8_GAS u32x4*)(g + off + bj * HALF);
                    x[0] *= bflo(gv.x); x[1] *= bfhi(gv.x); x[2] *= bflo(gv.y); x[3] *= bfhi(gv.y); x[4] *= bflo(gv.z); x[5] *= bfhi(gv.z); x[6] *= bflo(gv.w); x[7] *= bfhi(gv.w);
                    float* tp = T1 + off + bj * HALF;
                    if (which == 0) { *(PG8_GAS f32x4*)tp = (f32x4){x[0], x[1], x[2], x[3]}; *(PG8_GAS f32x4*)(tp + 4) = (f32x4){x[4], x[5], x[6], x[7]}; }
                    else { const f32x4 t0 = *(const PG8_GAS f32x4*)tp, t1 = *(const PG8_GAS f32x4*)(tp + 4);
                        x[0] += t0[0]; x[1] += t0[1]; x[2] += t0[2]; x[3] += t0[3]; x[4] += t1[0]; x[5] += t1[1]; x[6] += t1[2]; x[7] += t1[3];
                        PG8_PACK8(w, x) *(PG8_GAS u32x4*)(MX + off + bj * HALF) = w; } } }
    }
};
struct EpiSwi {
    static constexpr bool PERM = true, AFTER_DRAIN = false;
    bf16_t* Gm; int ldg, NT;
    __device__ __forceinline__ void operator()(const f32x4 (&acc)[2][2][4][2], const Unit& u, int wr, int wc, int fr, int fq) const {
        const int pnl = u.pn - (u.pn / NT) * NT;
        const int row0 = u.pm * BM + wr * 64 + fr, col0 = pnl * HALF + wc * 32 + 8 * fq;
#pragma unroll
        for (int ai = 0; ai < 2; ++ai)
#pragma unroll
            for (int m = 0; m < 4; ++m) { bf16_t* rowp = Gm + (size_t)(row0 + ai * HALF + m * 16) * ldg + col0;
                PG8_X8(x, ai, 0, m) PG8_X8(y, ai, 1, m)
#pragma unroll
                for (int j = 0; j < 8; ++j) x[j] = x[j] * fsig(x[j]) * y[j];
                PG8_PACK8(w, x) *(PG8_GAS u32x4*)rowp = w; }
    }
};
struct EpiPlain {
    static constexpr bool PERM = true, AFTER_DRAIN = false;
    bf16_t* O; int ldc;
    __device__ __forceinline__ void operator()(const f32x4 (&acc)[2][2][4][2], const Unit& u, int wr, int wc, int fr, int fq) const {
        const int row0 = u.pm * BM + wr * 64 + fr, col0 = (u.pn & 3) * BM + wc * 32 + 8 * fq;
#pragma unroll
        for (int ai = 0; ai < 2; ++ai)
#pragma unroll
            for (int m = 0; m < 4; ++m) { bf16_t* rowp = O + (size_t)(row0 + ai * HALF + m * 16) * ldc + col0;
#pragma unroll
                for (int bj = 0; bj < 2; ++bj) { PG8_X8(x, ai, bj, m) PG8_PACK8(w, x) *(PG8_GAS u32x4*)(rowp + bj * HALF) = w; } }
    }
};
template <class Epi, class Sched, bool ALIGN_EPI = false, bool SP2 = false>
__device__ __forceinline__ void gemm_phase(PG8_LAS unsigned char* lds, const Gemm g, const Sched& S, const Epi& E) {
    int tid_ = threadIdx.x; asm volatile("" : "+v"(tid_));
    const int tid = tid_, wid = __builtin_amdgcn_readfirstlane(tid >> 6), lane = tid & 63, wr = wid >> 2, wc = wid & 3, fr = lane & 15, fq = lane >> 4;
    const int K = g.K, nt = K / BK;
    unsigned voffA[2], voffB[2];
#pragma unroll
    for (int i = 0; i < 2; ++i) { int R, C; stage_rc(tid * 16 + i * 8192, R, C); const int Rb = Epi::PERM ? ((R & ~31) + perm32(R & 31)) : R;
        voffA[i] = (unsigned)(R * K + C) * 2u; voffB[i] = (unsigned)(Rb * K + C) * 2u; }
    const size_t kstep = (size_t)(BK * 2);
    const size_t hstep = (size_t)HALF * K * 2;
    const size_t tstep = 2 * hstep;
    const unsigned ldsw = (unsigned)wid * 1024u;
    const int aoff = lds_byte(wr * 64 + fr, fq * 8), boff = lds_byte(wc * 32 + fr, fq * 8);
#define PG8_SA(b, h) (((b) * 2 + (h)) * HTB)
#define PG8_SB(b, h) ((4 + (b) * 2 + (h)) * HTB)
#define PG8_STAGE(bufoff, gbase, voff) do { _Pragma("unroll") for (int _i = 0; _i < 2; ++_i) \
        __builtin_amdgcn_global_load_lds((const unsigned*)((const char*)(gbase) + (voff)[_i]), (PG8_LAS unsigned*)(lds + (bufoff) + ldsw + _i * 8192), 16, 0, 0); } while (0)
#define PG8_LDA(dst, b, h) do { _Pragma("unroll") for (int m = 0; m < 4; ++m) _Pragma("unroll") for (int k = 0; k < 2; ++k) dst[m][k] = *(const PG8_LAS bf16x8*)(lds + PG8_SA(b, h) + aoff + m * 2048 + k * 1024); } while (0)
#define PG8_LDB(dst, b, h) do { _Pragma("unroll") for (int n = 0; n < 2; ++n) _Pragma("unroll") for (int k = 0; k < 2; ++k) dst[n][k] = *(const PG8_LAS bf16x8*)(lds + PG8_SB(b, h) + boff + n * 2048 + k * 1024); } while (0)
#define PG8_MMA(ai, bj, At, Bt) do { __builtin_amdgcn_s_setprio(1); _Pragma("unroll") for (int m = 0; m < 4; ++m) _Pragma("unroll") for (int n = 0; n < 2; ++n) _Pragma("unroll") for (int k = 0; k < 2; ++k) \
        acc[ai][bj][m][n] = __builtin_amdgcn_mfma_f32_16x16x32_bf16(Bt[n][k], At[m][k], acc[ai][bj][m][n], 0, 0, 0); __builtin_amdgcn_s_setprio(0); } while (0)
#define PG8_WAIT_V(n) asm volatile("s_waitcnt vmcnt(" #n ")" ::: "memory")
#define PG8_WAIT_L(n) asm volatile("s_waitcnt lgkmcnt(" #n ")" ::: "memory")
#define PG8_BAR __builtin_amdgcn_s_barrier()
#define PG8_SCHED __builtin_amdgcn_sched_barrier(0)
    Unit cur, nxt; int ui = 0;
    if (!S.next(0, cur)) return;
    f32x4 acc[2][2][4][2];
#pragma unroll
    for (int a = 0; a < 2; ++a)
#pragma unroll
        for (int b = 0; b < 2; ++b)
#pragma unroll
            for (int m = 0; m < 4; ++m)
#pragma unroll
                for (int n = 0; n < 2; ++n) acc[a][b][m][n] = (f32x4){0.f, 0.f, 0.f, 0.f};
    bf16x8 At[4][2], B0[2][2], B1[2][2];
    const char* cA = (const char*)g.A + (size_t)cur.pm * tstep; const char* cB = (const char*)g.Bt + (size_t)cur.pn * tstep;
    S.a_ready(cur);
    if constexpr (SP2) {
        PG8_STAGE(PG8_SB(0, 0), cB, voffB); PG8_STAGE(PG8_SB(0, 1), cB + hstep, voffB); PG8_STAGE(PG8_SA(0, 0), cA, voffA); PG8_STAGE(PG8_SA(0, 1), cA + hstep, voffA);
        if (wr == 1) PG8_BAR;
        PG8_WAIT_V(2); PG8_BAR;
        PG8_STAGE(PG8_SB(1, 0), cB + kstep, voffB); PG8_STAGE(PG8_SA(1, 0), cA + kstep, voffA); PG8_STAGE(PG8_SB(1, 1), cB + hstep + kstep, voffB);
        PG8_WAIT_V(6); PG8_BAR;
    } else {
        PG8_STAGE(PG8_SB(0, 0), cB, voffB); PG8_STAGE(PG8_SA(0, 0), cA, voffA); PG8_STAGE(PG8_SB(0, 1), cB + hstep, voffB); PG8_STAGE(PG8_SA(0, 1), cA + hstep, voffA);
        if (wr == 1) PG8_BAR;
        PG8_WAIT_V(4); PG8_BAR;
        PG8_STAGE(PG8_SB(1, 0), cB + kstep, voffB); PG8_STAGE(PG8_SA(1, 0), cA + kstep, voffA); PG8_STAGE(PG8_SB(1, 1), cB + hstep + kstep, voffB);
        PG8_WAIT_V(6); PG8_BAR;
    }
    for (;;) {
        const bool has_next = S.next(ui + 1, nxt);
        const char* nA = has_next ? (const char*)g.A + (size_t)nxt.pm * tstep : cA; const char* nB = has_next ? (const char*)g.Bt + (size_t)nxt.pn * tstep : cB;
        for (int t = 0; t < nt; t += 2) {
            const bool last = (t == nt - 2);
            const char* a1 = cA + (size_t)(t + 1) * kstep;
            const char* a2 = last ? nA : cA + (size_t)(t + 2) * kstep; const char* b2 = last ? nB : cB + (size_t)(t + 2) * kstep;
            const char* a3 = a2 + kstep; const char* b3 = b2 + kstep;
            if (last && has_next) S.a_ready(nxt);
            if constexpr (SP2) {
            PG8_LDB(B0, 0, 0); PG8_LDB(B1, 0, 1); PG8_SCHED; PG8_LDA(At, 0, 0); PG8_STAGE(PG8_SA(1, 1), a1 + hstep, voffA);
            PG8_WAIT_V(8); PG8_WAIT_L(0); PG8_BAR; PG8_MMA(0, 0, At, B0); PG8_MMA(0, 1, At, B1); PG8_BAR; PG8_SCHED;
            PG8_LDA(At, 0, 1); PG8_STAGE(PG8_SB(0, 0), b2, voffB); PG8_STAGE(PG8_SB(0, 1), b2 + hstep, voffB); PG8_STAGE(PG8_SA(0, 0), a2, voffA);
            PG8_WAIT_V(8); PG8_WAIT_L(0); PG8_BAR; PG8_MMA(1, 0, At, B0); PG8_MMA(1, 1, At, B1); PG8_BAR; PG8_SCHED;
            PG8_LDB(B0, 1, 0); PG8_LDB(B1, 1, 1); PG8_SCHED; PG8_LDA(At, 1, 0); PG8_STAGE(PG8_SA(0, 1), a2 + hstep, voffA);
            PG8_WAIT_V(8); PG8_WAIT_L(0); PG8_BAR; PG8_MMA(0, 0, At, B0); PG8_MMA(0, 1, At, B1); PG8_BAR; PG8_SCHED;
            PG8_LDA(At, 1, 1); PG8_STAGE(PG8_SB(1, 0), b3, voffB); PG8_STAGE(PG8_SB(1, 1), b3 + hstep, voffB); PG8_STAGE(PG8_SA(1, 0), a3, voffA);
            PG8_WAIT_V(8); PG8_WAIT_L(0); PG8_BAR; PG8_MMA(1, 0, At, B0); PG8_MMA(1, 1, At, B1); PG8_BAR; PG8_SCHED;
            } else {
            PG8_LDB(B0, 0, 0); PG8_SCHED; PG8_LDA(At, 0, 0); PG8_STAGE(PG8_SA(1, 1), a1 + hstep, voffA);
            PG8_WAIT_L(8); PG8_BAR; PG8_WAIT_L(0); PG8_MMA(0, 0, At, B0); PG8_BAR; PG8_SCHED;
            PG8_LDB(B1, 0, 1); PG8_STAGE(PG8_SB(0, 0), b2, voffB);
            PG8_BAR; PG8_WAIT_L(0); PG8_MMA(0, 1, At, B1); PG8_BAR;
            PG8_LDA(At, 0, 1); PG8_STAGE(PG8_SA(0, 0), a2, voffA);
            PG8_BAR; PG8_WAIT_L(0); PG8_MMA(1, 0, At, B0); PG8_BAR; PG8_SCHED;
            PG8_STAGE(PG8_SB(0, 1), b2 + hstep, voffB);
            PG8_WAIT_V(6); PG8_BAR; PG8_MMA(1, 1, At, B1); PG8_BAR;
            PG8_LDB(B0, 1, 0); PG8_SCHED; PG8_LDA(At, 1, 0); PG8_STAGE(PG8_SA(0, 1), a2 + hstep, voffA);
            PG8_WAIT_L(8); PG8_BAR; PG8_WAIT_L(0); PG8_MMA(0, 0, At, B0); PG8_BAR; PG8_SCHED;
            PG8_LDB(B1, 1, 1); PG8_STAGE(PG8_SB(1, 0), b3, voffB);
            PG8_BAR; PG8_WAIT_L(0); PG8_MMA(0, 1, At, B1); PG8_BAR;
            PG8_LDA(At, 1, 1); PG8_STAGE(PG8_SA(1, 0), a3, voffA);
            PG8_BAR; PG8_WAIT_L(0); PG8_MMA(1, 0, At, B0); PG8_BAR; PG8_SCHED;
            PG8_STAGE(PG8_SB(1, 1), b3 + hstep, voffB);
            PG8_WAIT_V(6); PG8_BAR; PG8_MMA(1, 1, At, B1); PG8_BAR;
            }
        }
        if constexpr (ALIGN_EPI) { if (wr == 0) PG8_BAR; }
        if constexpr (!Epi::AFTER_DRAIN) { E(acc, cur, wr, wc, fr, fq); S.done(cur); }
        if (!has_next) break;
#pragma unroll
        for (int a = 0; a < 2; ++a)
#pragma unroll
            for (int b = 0; b < 2; ++b)
#pragma unroll
                for (int m = 0; m < 4; ++m)
#pragma unroll
                    for (int n = 0; n < 2; ++n) acc[a][b][m][n] = (f32x4){0.f, 0.f, 0.f, 0.f};
        cur = nxt; cA = nA; cB = nB; ++ui;
        if constexpr (ALIGN_EPI) { if (wr == 1) PG8_BAR; }
    }
    PG8_WAIT_V(0);
    if constexpr (!ALIGN_EPI) { if (wr == 0) PG8_BAR; }
    PG8_BAR;
    if constexpr (Epi::AFTER_DRAIN) { E.fused(acc, cur, wr, wc, fr, fq, lds, wid, lane); S.done(cur); }
#undef PG8_SA
#undef PG8_SB
#undef PG8_STAGE
#undef PG8_LDA
#undef PG8_LDB
#undef PG8_MMA
#undef PG8_WAIT_V
#undef PG8_WAIT_L
#undef PG8_BAR
#undef PG8_SCHED
}
}
constexpr int NWAVES = 8, NTHR = 512;
constexpr int D = 1024, NBATCH = 8, SEQ = 4096, M = NBATCH * SEQ, DEPTH = 4;
constexpr int DIN = 8192, DFF = 2816, NEXP = 8, DFE = 3584;
constexpr float EPS = 1e-6f;
constexpr size_t MiB = 1u << 20;
constexpr size_t WS_CTL = 0, CTL_ZERO_BYTES = 2 * MiB;
constexpr size_t WS_MOD = 1 * MiB;
constexpr size_t WS_LB = 2 * MiB;
constexpr size_t WS_LI = 2 * MiB + 64 * 1024, WS_LF = WS_LI + 512 * 1024;
constexpr size_t WS_TOKEP = 4 * MiB;
constexpr size_t WS_TOKW = WS_TOKEP + 512 * 1024;
constexpr size_t WS_TOKD = WS_TOKW + 256 * 1024;
constexpr size_t WS_UZ = 5 * MiB;
constexpr size_t WS_WIN = 6 * MiB, WS_WAB = 22 * MiB, WS_WO = 26 * MiB, WS_WF = 28 * MiB;
constexpr size_t WF_W2_DENSE = 12 * MiB, WF_W2_MOE = 112 * MiB;
constexpr size_t WS_H = 196 * MiB;
constexpr size_t WS_PROJ = 260 * MiB, PART = 64 * MiB;
constexpr size_t WS_MQ = 772 * MiB, WS_MK = 836 * MiB, WS_MV = 900 * MiB, WS_XC = 964 * MiB;
constexpr size_t WS_AG = 772 * MiB, WS_YS = 904 * MiB;
constexpr size_t WS_END = 1036 * MiB;
constexpr size_t PSTRIDE = (size_t)M * 1024;
enum { P_QA = 0, P_LF = 1, P_VA = 2, P_GA = 3, P_XM = 4, P_OS = 5, P_GTA = 6, P_GTB = 7 };
constexpr int CW_BAR = 4096;
constexpr int CW_CNT = 16384;
constexpr int RING_BYTES = 131072, MISC_OFF = RING_BYTES, LDS_BYTES = 147456;

#define GAS __attribute__((address_space(1)))
#define LAS __attribute__((address_space(3)))
typedef unsigned short bf16;
typedef unsigned v4u __attribute__((ext_vector_type(4)));
typedef unsigned v2u __attribute__((ext_vector_type(2)));
typedef float f32x4 __attribute__((ext_vector_type(4)));
typedef float f32x2 __attribute__((ext_vector_type(2)));
typedef int i32x4 __attribute__((ext_vector_type(4)));
typedef int i32x2 __attribute__((ext_vector_type(2)));
#define LDS_WAIT() asm volatile("s_waitcnt lgkmcnt(0)" ::: "memory")
#define VM_WAIT() asm volatile("s_waitcnt vmcnt(0)" ::: "memory")
__device__ __forceinline__ unsigned f2bf(float f) { unsigned u = __builtin_bit_cast(unsigned, f); return (u + 0x7fffu + ((u >> 16) & 1u)) >> 16; }
__device__ __forceinline__ unsigned pk2(float lo, float hi) { return f2bf(lo) | (f2bf(hi) << 16); }
__device__ __forceinline__ float bflo(unsigned w) { return __uint_as_float(w << 16); }
__device__ __forceinline__ float bfhi(unsigned w) { return __uint_as_float(w & 0xffff0000u); }
__device__ __forceinline__ float bf2f(bf16 b) { return __uint_as_float((unsigned)b << 16); }
__device__ __forceinline__ float fsigm(float v) { return 1.0f / (1.0f + __expf(-v)); }
__device__ __forceinline__ float wave_sum(float v) {
#pragma unroll
    for (int o = 1; o < 64; o <<= 1) v += __shfl_xor(v, o);
    return v;
}
__device__ __forceinline__ float half_sum(float v) {
#pragma unroll
    for (int o = 1; o < 32; o <<= 1) v += __shfl_xor(v, o);
    return v;
}
__device__ __forceinline__ float sum16(float v) {
#pragma unroll
    for (int o = 1; o < 16; o <<= 1) v += __shfl_xor(v, o);
    return v;
}

__device__ __forceinline__ int opq_v(int v) { asm volatile("" : "+v"(v)); return v; }
__device__ __forceinline__ int opq_s(int v) { asm volatile("" : "+s"(v)); return v; }
__device__ __forceinline__ unsigned char* opq_p(unsigned char* p) { asm volatile("" : "+s"(p)); return p; }
#define TID() opq_v((int)threadIdx.x)
#define BID() opq_s((int)blockIdx.x)
#define XB_TMO      128
#define XB_XCNT(j)  (256  + 64 * (j))
#define XB_XSUB(j)  (1280 + 64 * (j))
#define XB_XGEN(j)  (2304 + 64 * (j))
#define XB_TOP      3328
#define XB_TOPGEN   3392
#define XCD_BAR_WORDS 3456
#define XB_SPIN_CAP (1u << 18)

__device__ __forceinline__ unsigned xb_ld(unsigned* p)              { return __hip_atomic_load(p, __ATOMIC_RELAXED, __HIP_MEMORY_SCOPE_AGENT); }
__device__ __forceinline__ unsigned xb_add(unsigned* p, unsigned v) { return __hip_atomic_fetch_add(p, v, __ATOMIC_RELAXED, __HIP_MEMORY_SCOPE_AGENT); }
__device__ __forceinline__ unsigned xb_xcc_id() { return (unsigned)__builtin_amdgcn_s_getreg((3 << 11) | 20) & 0xFu; }
#define XB_SPIN(cond, bar) do { unsigned _sp = 0; while (cond) { __builtin_amdgcn_s_sleep(1); \
    if ((++_sp & 255u) == 0u) { if (xb_ld(&(bar)[XB_TMO])) break; if (_sp > XB_SPIN_CAP) { atomicAdd(&(bar)[XB_TMO], 1u); break; } } } } while (0)

struct XcdBarrier {
    unsigned* bar; unsigned x;
    volatile LAS unsigned* st;
};

__device__ __forceinline__ XcdBarrier xcd_barrier_post(unsigned* bar, volatile LAS unsigned* st) {
    XcdBarrier b; b.bar = bar; b.x = xb_xcc_id(); b.st = st;
    if (threadIdx.x == 0) (void)xb_add(&bar[XB_XCNT(b.x)], 1u);
    return b;
}
__device__ __forceinline__ void xcd_barrier_complete(unsigned* bar, unsigned x, unsigned& nloc, unsigned& nx) {
    const unsigned G = gridDim.x * gridDim.y * gridDim.z;
    unsigned sum, cnt, mine, sp = 0u;
    for (;;) {
        sum = 0u; cnt = 0u; mine = 0u;
#pragma unroll
        for (unsigned j = 0; j < 16; ++j) { const unsigned c = xb_ld(&bar[XB_XCNT(j)]); sum += c; cnt += (c > 0u) ? 1u : 0u; mine = (j == x) ? c : mine; }
        if (sum == G) break;
        __builtin_amdgcn_s_sleep(1);
        if ((++sp & 255u) == 0u) { if (xb_ld(&bar[XB_TMO])) break; if (sp > XB_SPIN_CAP) { atomicAdd(&bar[XB_TMO], 1u); break; } }
    }
    nloc = mine > 0u ? mine : 1u; nx = cnt > 0u ? cnt : 1u;
}

__device__ __forceinline__ void xcd_barrier(const XcdBarrier& b) {
    asm volatile("s_waitcnt vmcnt(0)" ::: "memory");
    __syncthreads();
    if (threadIdx.x == 0) {
        unsigned* bar = b.bar;
        __builtin_amdgcn_s_waitcnt(0);
        unsigned nloc = b.st[0], nx = b.st[1];
        if (nloc == 0u) { xcd_barrier_complete(bar, b.x, nloc, nx); b.st[0] = nloc; b.st[1] = nx; }
        const unsigned old = xb_add(&bar[XB_XSUB(b.x)], 1u);
        const unsigned gen = old / nloc;
        if (old + 1u == (gen + 1u) * nloc) {
            __builtin_amdgcn_fence(__ATOMIC_RELEASE, "agent");
            asm volatile("s_waitcnt vmcnt(0)" ::: "memory");
            const unsigned og = xb_add(&bar[XB_TOP], 1u);
            const unsigned tg = og / nx;
            if (og + 1u == (tg + 1u) * nx) xb_add(&bar[XB_TOPGEN], 1u);
            else XB_SPIN(xb_ld(&bar[XB_TOPGEN]) == tg, bar);
            __builtin_amdgcn_fence(__ATOMIC_ACQUIRE, "agent");
            xb_add(&bar[XB_XGEN(b.x)], 1u);
            asm volatile("s_waitcnt vmcnt(0)" ::: "memory");
        } else {
            XB_SPIN(xb_ld(&bar[XB_XGEN(b.x)]) == gen, bar);
            __builtin_amdgcn_fence(__ATOMIC_ACQUIRE, "agent");
            asm volatile("s_waitcnt vmcnt(0)" ::: "memory");
        }
    }
    __syncthreads();
}
struct Ctx { const float* in[32]; float* out; unsigned char* ws; int ph_lo, ph_hi; };
enum { I_X = 0, I_C, I_WADA, I_BADA, I_GPREMIX, I_GPOSTMIX, I_GPREFFN, I_GPOSTFFN, I_WIN, I_HLB, I_HGN, I_CONVW, I_CONVB, I_WQ, I_WK, I_WV, I_WIG, I_BIG, I_WFG, I_BFG,
       I_MGN, I_MSKIP, I_WPA, I_WPB, I_WOUT, I_F1, I_F3, I_F2, I_ROUTER, I_M1, I_M3, I_M2 };

__device__ __forceinline__ void ph_mod(const Ctx& c, LAS unsigned char* lds) {
    LAS float* cact = (LAS float*)lds;
    LAS float* part = (LAS float*)(lds + 32768);
    GAS float* MOD = (GAS float*)(c.ws + WS_MOD);
    const GAS float* cin = (const GAS float*)c.in[I_C]; const GAS float* wada = (const GAS float*)c.in[I_WADA]; const GAS float* bada = (const GAS float*)c.in[I_BADA];
    const int tid = TID(), lane = tid & 63, wave = tid >> 6;
    for (int i = tid; i < 8192; i += NTHR) { const float v = cin[i]; cact[i] = v * fsigm(v); }
    __syncthreads();
    for (int u = BID(); u < 384; u += gridDim.x) {
        const int l = u / 96, jb = u % 96, j = jb * 64 + lane;
        const GAS float* w = wada + ((size_t)l * 1024 + wave * 128) * 6144 + j;
        const LAS float* ca = cact + wave * 128;
        float a0 = 0.f, a1 = 0.f, a2 = 0.f, a3 = 0.f, a4 = 0.f, a5 = 0.f, a6 = 0.f, a7 = 0.f;
#pragma unroll 8
        for (int k = 0; k < 128; ++k) { const float wv = w[(size_t)k * 6144];
            a0 += ca[k] * wv; a1 += ca[1024 + k] * wv; a2 += ca[2048 + k] * wv; a3 += ca[3072 + k] * wv;
            a4 += ca[4096 + k] * wv; a5 += ca[5120 + k] * wv; a6 += ca[6144 + k] * wv; a7 += ca[7168 + k] * wv; }
        LAS float* pw = part + wave * 512 + lane;
        pw[0] = a0; pw[64] = a1; pw[128] = a2; pw[192] = a3; pw[256] = a4; pw[320] = a5; pw[384] = a6; pw[448] = a7;
        __syncthreads();
        { const int b = wave; float s = bada[l * 6144 + j];
#pragma unroll
            for (int ww = 0; ww < 8; ++ww) s += part[ww * 512 + b * 64 + lane];
            MOD[(size_t)(l * 8 + b) * 6144 + j] = s; }
        __syncthreads();
    }
}
__device__ __forceinline__ void ph_lb(const Ctx& c) {
    if (BID() != 0) return;
    GAS float* LB = (GAS float*)(c.ws + WS_LB); const GAS float* raw = (const GAS float*)c.in[I_HLB];
    for (int col = TID(); col < 1024; col += NTHR) {
        const float r0 = raw[col], r1 = raw[1024 + col], r2 = raw[2048 + col], r3 = raw[3072 + col];
        const float mx = fmaxf(fmaxf(r0, r1), fmaxf(r2, r3));
        const float e0 = __expf(r0 - mx), e1 = __expf(r1 - mx), e2 = __expf(r2 - mx), e3 = __expf(r3 - mx), inv = 1.0f / (e0 + e1 + e2 + e3);
        LB[col] = 0.f; LB[1024 + col] = e1 * inv; LB[2048 + col] = (e1 + e2) * inv; LB[3072 + col] = (e1 + e2 + e3) * inv;
    }
}
__device__ __forceinline__ void cvt_item(const float* W, int K, int N, bf16* WT, int rowbase, int mode, LAS float* scr, int item, int lane) {
    const int nblk = N / 32, kb = item / nblk, nb = item % nblk, k0 = 64 * kb, n0 = 32 * nb;
#pragma unroll 8
    for (int i = 0; i < 32; ++i) { const int kk = 2 * i + (lane >> 5); scr[kk * 33 + (lane & 31)] = ((const GAS float*)W)[(size_t)(k0 + kk) * N + n0 + (lane & 31)]; }
    LDS_WAIT(); asm volatile("" ::: "memory");
    const int drow0 = rowbase + (mode ? ((n0 >> 7) * 256 + (n0 & 127)) : n0);
    const int cc = lane & 7;
#pragma unroll
    for (int j = 0; j < 4; ++j) { const int n = (lane >> 3) + 8 * j; const LAS float* s = scr + (8 * cc) * 33 + n;
        v4u o; o.x = pk2(s[0 * 33], s[1 * 33]); o.y = pk2(s[2 * 33], s[3 * 33]); o.z = pk2(s[4 * 33], s[5 * 33]); o.w = pk2(s[6 * 33], s[7 * 33]);
        *(GAS v4u*)(WT + (size_t)(drow0 + n) * K + k0 + 8 * cc) = o; }
    LDS_WAIT(); asm volatile("" ::: "memory");
}
__device__ __forceinline__ void ph_cvt(const Ctx& c, int l, LAS unsigned char* lds) {
    const int tid = TID(), lane = tid & 63, wave = __builtin_amdgcn_readfirstlane(tid >> 6);
    LAS float* scr = (LAS float*)(lds + wave * 16384);
    const int gw = BID() * NWAVES + wave, NGW = gridDim.x * NWAVES;
    bf16* WIN = (bf16*)(c.ws + WS_WIN); bf16* WAB = (bf16*)(c.ws + WS_WAB); bf16* WO = (bf16*)(c.ws + WS_WO); bf16* WF = (bf16*)(c.ws + WS_WF);
    const bool moe = (l & 1) != 0; const int j = l >> 1;
    constexpr int I_IN = 16 * 256, I_SQ = 16 * 32, I_D13 = 16 * 88, I_D2 = 44 * 32, I_M13 = 16 * 112, I_M2E = 56 * 32;
    const int total = I_IN + 3 * I_SQ + (moe ? (2 * NEXP * I_M13 + NEXP * I_M2E) : (2 * I_D13 + I_D2));
    for (int it = gw; it < total; it += NGW) {
        int r = it;
        if (r < I_IN) { cvt_item(c.in[I_WIN] + (size_t)l * D * DIN, D, DIN, WIN, 0, 0, scr, r, lane); continue; } r -= I_IN;
        if (r < I_SQ) { cvt_item(c.in[I_WPA] + (size_t)l * D * D, D, D, WAB, 0, 0, scr, r, lane); continue; } r -= I_SQ;
        if (r < I_SQ) { cvt_item(c.in[I_WPB] + (size_t)l * D * D, D, D, WAB, 1024, 0, scr, r, lane); continue; } r -= I_SQ;
        if (r < I_SQ) { cvt_item(c.in[I_WOUT] + (size_t)l * D * D, D, D, WO, 0, 0, scr, r, lane); continue; } r -= I_SQ;
        if (!moe) {
            if (r < I_D13) { cvt_item(c.in[I_F1] + (size_t)j * D * DFF, D, DFF, WF, 0, 1, scr, r, lane); continue; } r -= I_D13;
            if (r < I_D13) { cvt_item(c.in[I_F3] + (size_t)j * D * DFF, D, DFF, WF, 128, 1, scr, r, lane); continue; } r -= I_D13;
            cvt_item(c.in[I_F2] + (size_t)j * DFF * D, DFF, D, (bf16*)(c.ws + WS_WF + WF_W2_DENSE), 0, 0, scr, r, lane);
        } else {
            if (r < NEXP * I_M13) { const int e = r / I_M13; cvt_item(c.in[I_M1] + ((size_t)j * NEXP + e) * D * DFE, D, DFE, WF, e * 2 * DFE, 1, scr, r - e * I_M13, lane); continue; } r -= NEXP * I_M13;
            if (r < NEXP * I_M13) { const int e = r / I_M13; cvt_item(c.in[I_M3] + ((size_t)j * NEXP + e) * D * DFE, D, DFE, WF, e * 2 * DFE + 128, 1, scr, r - e * I_M13, lane); continue; } r -= NEXP * I_M13;
            { const int e = r / I_M2E; cvt_item(c.in[I_M2] + ((size_t)j * NEXP + e) * DFE * D, DFE, D, (bf16*)(c.ws + WS_WF + WF_W2_MOE), e * D, 0, scr, r - e * I_M2E, lane); }
        }
    }
}

__device__ __forceinline__ void ld_row_f32(const float* p, int lane, f32x4 (&v)[4]) {
#pragma unroll
    for (int j = 0; j < 4; ++j) v[j] = *(const GAS f32x4*)(p + 4 * lane + 256 * j);
}
__device__ __forceinline__ void ld_row_bf16(const bf16* p, int lane, f32x4 (&v)[4]) {
#pragma unroll
    for (int j = 0; j < 4; ++j) { const v2u w = *(const GAS v2u*)(p + 4 * lane + 256 * j); v[j] = (f32x4){bflo(w.x), bfhi(w.x), bflo(w.y), bfhi(w.y)}; }
}
__device__ __forceinline__ void st_row_bf16(bf16* p, int lane, const f32x4 (&v)[4]) {
#pragma unroll
    for (int j = 0; j < 4; ++j) { v2u w; w.x = pk2(v[j][0], v[j][1]); w.y = pk2(v[j][2], v[j][3]); *(GAS v2u*)(p + 4 * lane + 256 * j) = w; }
}
__device__ __forceinline__ float row_sumsq(const f32x4 (&v)[4]) {
    float s = 0.f;
#pragma unroll
    for (int j = 0; j < 4; ++j) s += (v[j][0] * v[j][0] + v[j][1] * v[j][1]) + (v[j][2] * v[j][2] + v[j][3] * v[j][3]);
    return wave_sum(s);
}
__device__ __forceinline__ void norm_mod(const f32x4 (&x)[4], const f32x4 (&g)[4], const f32x4 (&sc)[4], const f32x4 (&sh)[4], f32x4 (&h)[4]) {
    const float r = rsqrtf(row_sumsq(x) * (1.0f / 1024.0f) + EPS);
#pragma unroll
    for (int j = 0; j < 4; ++j) h[j] = (x[j] * r) * g[j] * (sc[j] + 1.0f) + sh[j];
}
__device__ __forceinline__ const float* modp(const Ctx& c, int l, int b, int which) { return (const float*)(c.ws + WS_MOD) + ((size_t)(l * 8 + b) * 6 + which) * 1024; }

__device__ __forceinline__ void ph_norm0(const Ctx& c) {
    const int tid = TID(), lane = tid & 63, wave = tid >> 6, gw = BID() * NWAVES + wave, NGW = gridDim.x * NWAVES;
    bf16* H = (bf16*)(c.ws + WS_H);
    for (int slot = gw; slot < M / 16; slot += NGW) {
        const int row0 = slot * 16, b = row0 / SEQ;
        f32x4 g[4], sc[4], sh[4]; ld_row_f32(c.in[I_GPREMIX], lane, g); ld_row_f32(modp(c, 0, b, 1), lane, sc); ld_row_f32(modp(c, 0, b, 0), lane, sh);
        for (int r = 0; r < 16; ++r) { f32x4 x[4], h[4]; ld_row_f32(c.in[I_X] + (size_t)(row0 + r) * D, lane, x); norm_mod(x, g, sc, sh, h); st_row_bf16(H + (size_t)(row0 + r) * D, lane, h); }
    }
}
__device__ __forceinline__ void ph_uz(const Ctx& c) {
    GAS float* UZ = (GAS float*)(c.ws + WS_UZ);
    const int gt = BID() * NTHR + TID();
    if (gt >= DEPTH * D) return;
    const int l = gt >> 10, ch = gt & 1023, n = ch >> 2, i = ch & 3;
    const GAS float* wq = (const GAS float*)c.in[I_WQ] + (size_t)l * 4096 + n * 16 + i * 4; const GAS float* wk = (const GAS float*)c.in[I_WK] + (size_t)l * 4096 + n * 16 + i * 4; const GAS float* wv = (const GAS float*)c.in[I_WV] + (size_t)l * 4096 + n * 16 + i * 4;
    const GAS float* wig = (const GAS float*)c.in[I_WIG] + (size_t)l * 3072 * 4; const GAS float* wfg = (const GAS float*)c.in[I_WFG] + (size_t)l * 3072 * 4;
    f32x4 ui = {0.f, 0.f, 0.f, 0.f}, uf = ui, zi = ui, zf = ui;
#pragma unroll
    for (int o = 0; o < 4; ++o) { const float q = wq[o], k = wk[o], v = wv[o];
        ui += *(const GAS f32x4*)(wig + (size_t)(4 * n + o) * 4) * q + *(const GAS f32x4*)(wig + (size_t)(1024 + 4 * n + o) * 4) * k; zi += *(const GAS f32x4*)(wig + (size_t)(2048 + 4 * n + o) * 4) * v;
        uf += *(const GAS f32x4*)(wfg + (size_t)(4 * n + o) * 4) * q + *(const GAS f32x4*)(wfg + (size_t)(1024 + 4 * n + o) * 4) * k; zf += *(const GAS f32x4*)(wfg + (size_t)(2048 + 4 * n + o) * 4) * v; }
    GAS f32x4* o4 = (GAS f32x4*)(UZ + (size_t)gt * 16); o4[0] = ui; o4[1] = uf; o4[2] = zi; o4[3] = zf;
}
__device__ __forceinline__ void ph_prep(const Ctx& c, int l) {
    const int tid = TID(), lane = tid & 63, wave = tid >> 6, gw = BID() * NWAVES + wave, NGW = gridDim.x * NWAVES;
    const bf16* XM = (const bf16*)(c.ws + WS_PROJ) + (size_t)P_XM * PSTRIDE;
    bf16* MQ = (bf16*)(c.ws + WS_MQ); bf16* MK = (bf16*)(c.ws + WS_MK); bf16* MV = (bf16*)(c.ws + WS_MV); bf16* XC = (bf16*)(c.ws + WS_XC);
    GAS float* LI = (GAS float*)(c.ws + WS_LI); GAS float* LF = (GAS float*)(c.ws + WS_LF);
    const float* cw = c.in[I_CONVW] + (size_t)l * 4 * D; const float* cb = c.in[I_CONVB] + (size_t)l * D;
    const float* wq = c.in[I_WQ] + (size_t)l * 256 * 16; const float* wk = c.in[I_WK] + (size_t)l * 256 * 16; const float* wv = c.in[I_WV] + (size_t)l * 256 * 16;
    const float* UZ = (const float*)(c.ws + WS_UZ) + (size_t)l * D * 16;
    const int gidx = (lane >> 1) & 7;
    const float gbias = (gidx < 4) ? ((const GAS float*)c.in[I_BIG])[l * 4 + gidx] : ((const GAS float*)c.in[I_BFG])[l * 4 + gidx - 4];
    for (int slot = gw; slot < M / 16; slot += NGW) {
        const int row0 = slot * 16, tq0 = row0 & (SEQ - 1);
#pragma unroll 1
        for (int tb = 0; tb < 4; ++tb) {
            f32x4 gi[4], gf[4];
#pragma unroll
            for (int tt = 0; tt < 4; ++tt) { gi[tt] = (f32x4){0.f, 0.f, 0.f, 0.f}; gf[tt] = gi[tt]; }
#pragma unroll 1
            for (int j = 0; j < 4; ++j) {
                const int ch = 4 * lane + 256 * j, n = lane + 64 * j;
                const f32x4 b4 = *(const GAS f32x4*)(cb + ch);
                f32x4 xcs[4], xts[4];
                {
                    f32x4 w4[4], q4[4], k4[4], v4[4];
#pragma unroll
                    for (int i = 0; i < 4; ++i) { w4[i] = *(const GAS f32x4*)(cw + i * D + ch); q4[i] = *(const GAS f32x4*)(wq + n * 16 + i * 4); k4[i] = *(const GAS f32x4*)(wk + n * 16 + i * 4); v4[i] = *(const GAS f32x4*)(wv + n * 16 + i * 4); }
                    v2u win[7];
#pragma unroll
                    for (int r = 0; r < 7; ++r) { const int rel = tb * 4 - 3 + r; win[r] = (v2u){0u, 0u};
                        if (tq0 + rel >= 0) win[r] = *(const GAS v2u*)(XM + (size_t)(row0 + rel) * D + ch); }
#pragma unroll
                    for (int tt = 0; tt < 4; ++tt) {
                        f32x4 y = b4, xt = {0.f, 0.f, 0.f, 0.f};
#pragma unroll
                        for (int jj = 0; jj < 4; ++jj) { const v2u w = win[tt + jj]; const f32x4 xv = {bflo(w.x), bfhi(w.x), bflo(w.y), bfhi(w.y)}; y += w4[jj] * xv; if (jj == 3) xt = xv; }
                        f32x4 xc; xc[0] = y[0] * fsigm(y[0]); xc[1] = y[1] * fsigm(y[1]); xc[2] = y[2] * fsigm(y[2]); xc[3] = y[3] * fsigm(y[3]);
                        f32x4 q = {0.f, 0.f, 0.f, 0.f}, k = q, v = q;
#pragma unroll
                        for (int i = 0; i < 4; ++i) { q += q4[i] * xc[i]; k += k4[i] * xc[i]; v += v4[i] * xt[i]; }
                        const size_t off = (size_t)(row0 + tb * 4 + tt) * D + ch;
                        { v2u w; w.x = pk2(q[0], q[1]); w.y = pk2(q[2], q[3]); *(GAS v2u*)(MQ + off) = w; }
                        { v2u w; w.x = pk2(k[0] * 0.0625f, k[1] * 0.0625f); w.y = pk2(k[2] * 0.0625f, k[3] * 0.0625f); *(GAS v2u*)(MK + off) = w; }
                        { v2u w; w.x = pk2(v[0], v[1]); w.y = pk2(v[2], v[3]); *(GAS v2u*)(MV + off) = w; }
                        { v2u w; w.x = pk2(xc[0], xc[1]); w.y = pk2(xc[2], xc[3]); *(GAS v2u*)(XC + off) = w; }
                        xcs[tt] = xc; xts[tt] = xt;
                    }
                }
                asm volatile("" ::: "memory");
                {
#pragma unroll
                    for (int i = 0; i < 4; ++i) { const f32x4 u0 = *(const GAS f32x4*)(UZ + (size_t)(ch + i) * 16), u1 = *(const GAS f32x4*)(UZ + (size_t)(ch + i) * 16 + 4), u2 = *(const GAS f32x4*)(UZ + (size_t)(ch + i) * 16 + 8), u3 = *(const GAS f32x4*)(UZ + (size_t)(ch + i) * 16 + 12);
#pragma unroll
                        for (int tt = 0; tt < 4; ++tt) { gi[tt] += u0 * xcs[tt][i] + u2 * xts[tt][i]; gf[tt] += u1 * xcs[tt][i] + u3 * xts[tt][i]; } }
                }
            }
            float v[32];
#pragma unroll
            for (int tt = 0; tt < 4; ++tt)
#pragma unroll
                for (int hh = 0; hh < 4; ++hh) { v[tt * 8 + hh] = gi[tt][hh]; v[tt * 8 + 4 + hh] = gf[tt][hh]; }
#pragma unroll
            for (int st = 0; st < 5; ++st) { const int o = 32 >> st, nn = 32 >> st; const bool up = (lane & o) != 0;
#pragma unroll
                for (int i = 0; i < nn / 2; ++i) { const float lo = v[i], hi = v[i + nn / 2]; const float send = up ? lo : hi, keep = up ? hi : lo; v[i] = keep + __shfl_xor(send, o); } }
            const float tot = v[0] + __shfl_xor(v[0], 1) + gbias;
            if ((lane & 1) == 0) { const int tt = lane >> 4; const size_t row = (size_t)(row0 + tb * 4 + tt);
                if (gidx < 4) LI[row * 4 + gidx] = tot; else LF[row * 4 + gidx - 4] = fminf(tot, 0.f) - __logf(1.0f + __expf(-fabsf(tot))); }
        }
    }
}

__device__ __forceinline__ void ph_scan_a_naive(const Ctx& c, LAS unsigned char* lds) {
    const int tid = TID();
    bf16* PJ = (bf16*)(c.ws + WS_PROJ);
    const bf16* Q = PJ + (size_t)P_QA * PSTRIDE; const bf16* LFp = PJ + (size_t)P_LF * PSTRIDE; bf16* V = PJ + (size_t)P_VA * PSTRIDE;
    LAS bf16* sq = (LAS bf16*)lds;
    LAS bf16* sf = (LAS bf16*)(lds + 32768);
    LAS bf16* sv = (LAS bf16*)(lds + 65536);
    LAS float* so = (LAS float*)(lds + 73728);
    const int dg = tid & 15, vv = tid >> 4;
    for (int u = BID(); u < 256; u += gridDim.x) {
        const int b = u >> 5, h = (u >> 2) & 7, vs = u & 3;
        const size_t rowbase = (size_t)b * SEQ;
        float S[8];
#pragma unroll
        for (int j = 0; j < 8; ++j) S[j] = 0.f;
        v4u rq[2], rf[2], rv = {0u, 0u, 0u, 0u};
#define SA_LOAD(ch) do { _Pragma("unroll") for (int k2 = 0; k2 < 2; ++k2) { const int p = tid + NTHR * k2, rr = p >> 4, c8 = p & 15; const size_t o_ = (rowbase + (size_t)(ch) * 64 + rr) * D + h * 128 + c8 * 8; \
            rq[k2] = *(const GAS v4u*)(Q + o_); rf[k2] = *(const GAS v4u*)(LFp + o_); } \
            if (tid < 256) { const int rr = tid >> 2, c8 = tid & 3; rv = *(const GAS v4u*)(V + (rowbase + (size_t)(ch) * 64 + rr) * D + h * 128 + vs * 32 + c8 * 8); } } while (0)
        SA_LOAD(0);
        for (int ch = 0; ch < 64; ++ch) {
            const int buf = ch & 1;
#pragma unroll
            for (int k2 = 0; k2 < 2; ++k2) { const int p = tid + NTHR * k2; *(LAS v4u*)(sq + buf * 8192 + p * 8) = rq[k2]; *(LAS v4u*)(sf + buf * 8192 + p * 8) = rf[k2]; }
            if (tid < 256) *(LAS v4u*)(sv + buf * 2048 + tid * 8) = rv;
            __syncthreads();
            if (ch + 1 < 64) SA_LOAD(ch + 1);
            for (int i = 0; i < 64; ++i) {
                const v4u qv = *(const LAS v4u*)(sq + buf * 8192 + i * 128 + dg * 8), fv = *(const LAS v4u*)(sf + buf * 8192 + i * 128 + dg * 8);
                const float vt = bf2f(sv[buf * 2048 + i * 32 + vv]);
                const float qq[8] = {bflo(qv.x), bfhi(qv.x), bflo(qv.y), bfhi(qv.y), bflo(qv.z), bfhi(qv.z), bflo(qv.w), bfhi(qv.w)};
                const float ff[8] = {bflo(fv.x), bfhi(fv.x), bflo(fv.y), bfhi(fv.y), bflo(fv.z), bfhi(fv.z), bflo(fv.w), bfhi(fv.w)};
                float o = 0.f;
#pragma unroll
                for (int j = 0; j < 8; ++j) { const float f = __expf(ff[j]); S[j] = f * S[j] + (1.0f - f) * vt; o += S[j] * qq[j]; }
                o = sum16(o);
                if (dg == 0) so[i * 32 + vv] = o;
            }
            __syncthreads();
            { const int rr = tid >> 3, c4 = (tid & 7) * 4; const f32x4 ov = *(const LAS f32x4*)(so + rr * 32 + c4);
                v2u w; w.x = pk2(ov[0], ov[1]); w.y = pk2(ov[2], ov[3]); *(GAS v2u*)(V + (rowbase + (size_t)ch * 64 + rr) * D + h * 128 + vs * 32 + c4) = w; }
        }
#undef SA_LOAD
        __syncthreads();
    }
}

__device__ __forceinline__ void ph_scan_m_naive(const Ctx& c, LAS unsigned char* lds) {
    const int tid = TID();
    const bf16* MQ = (const bf16*)(c.ws + WS_MQ); const bf16* MK = (const bf16*)(c.ws + WS_MK); bf16* MV = (bf16*)(c.ws + WS_MV);
    const float* LI = (const float*)(c.ws + WS_LI); const float* LF = (const float*)(c.ws + WS_LF);
    LAS bf16* sq = (LAS bf16*)lds;
    LAS bf16* sk = (LAS bf16*)(lds + 32768);
    LAS bf16* sv = (LAS bf16*)(lds + 65536);
    LAS float* sli = (LAS float*)(lds + 69632);
    LAS float* slf = (LAS float*)(lds + 69888);
    LAS float* so = (LAS float*)(lds + 70144);
    const int dg = tid & 15, vv = tid >> 4;
    for (int u = BID(); u < 256; u += gridDim.x) {
        const int b = u >> 5, h = (u >> 3) & 3, vs = u & 7;
        const size_t rowbase = (size_t)b * SEQ;
        float C[16], nn[16], m = 0.f;
#pragma unroll
        for (int j = 0; j < 16; ++j) { C[j] = 0.f; nn[j] = 0.f; }
        v4u rq[4], rk[4], rv = {0u, 0u, 0u, 0u}; float rli = 0.f, rlf = 0.f;
#define SM_LOAD(ch) do { _Pragma("unroll") for (int k2 = 0; k2 < 4; ++k2) { const int p = tid + NTHR * k2, rr = p >> 5, c8 = p & 31; const size_t o_ = (rowbase + (size_t)(ch) * 64 + rr) * D + h * 256 + c8 * 8; \
            rq[k2] = *(const GAS v4u*)(MQ + o_); rk[k2] = *(const GAS v4u*)(MK + o_); } \
            if (tid < 256) { const int rr = tid >> 2, c8 = tid & 3; rv = *(const GAS v4u*)(MV + (rowbase + (size_t)(ch) * 64 + rr) * D + h * 256 + vs * 32 + c8 * 8); } \
            if (tid < 64) { rli = LI[(rowbase + (size_t)(ch) * 64 + tid) * 4 + h]; rlf = LF[(rowbase + (size_t)(ch) * 64 + tid) * 4 + h]; } } while (0)
        SM_LOAD(0);
        for (int ch = 0; ch < 64; ++ch) {
#pragma unroll
            for (int k2 = 0; k2 < 4; ++k2) { const int p = tid + NTHR * k2; *(LAS v4u*)(sq + p * 8) = rq[k2]; *(LAS v4u*)(sk + p * 8) = rk[k2]; }
            if (tid < 256) *(LAS v4u*)(sv + tid * 8) = rv;
            if (tid < 64) { sli[tid] = rli; slf[tid] = rlf; }
            __syncthreads();
            if (ch + 1 < 64) SM_LOAD(ch + 1);
            for (int i = 0; i < 64; ++i) {
                const float li = sli[i], lf = slf[i];
                const float mn = fmaxf(lf + m, li), fg = __expf(lf + m - mn), ig = __expf(li - mn); m = mn;
                const float vt = bf2f(sv[i * 32 + vv]) * ig;
                float num = 0.f, den = 0.f;
#pragma unroll
                for (int hh = 0; hh < 2; ++hh) {
                    const v4u qv = *(const LAS v4u*)(sq + i * 256 + dg * 16 + hh * 8), kv = *(const LAS v4u*)(sk + i * 256 + dg * 16 + hh * 8);
                    const float qq[8] = {bflo(qv.x), bfhi(qv.x), bflo(qv.y), bfhi(qv.y), bflo(qv.z), bfhi(qv.z), bflo(qv.w), bfhi(qv.w)};
                    const float kk[8] = {bflo(kv.x), bfhi(kv.x), bflo(kv.y), bfhi(kv.y), bflo(kv.z), bfhi(kv.z), bflo(kv.w), bfhi(kv.w)};
#pragma unroll
                    for (int j = 0; j < 8; ++j) { const int jj = hh * 8 + j; C[jj] = fg * C[jj] + kk[j] * vt; nn[jj] = fg * nn[jj] + ig * kk[j]; num += qq[j] * C[jj]; den += qq[j] * nn[jj]; }
                }
                num = sum16(num); den = sum16(den);
                if (dg == 0) so[i * 32 + vv] = num / fmaxf(fabsf(den), __expf(-m));
            }
            __syncthreads();
            { const int rr = tid >> 3, c4 = (tid & 7) * 4; const f32x4 ov = *(const LAS f32x4*)(so + rr * 32 + c4);
                v2u w; w.x = pk2(ov[0], ov[1]); w.y = pk2(ov[2], ov[3]); *(GAS v2u*)(MV + (rowbase + (size_t)ch * 64 + rr) * D + h * 256 + vs * 32 + c4) = w; }
        }
#undef SM_LOAD
        __syncthreads();
    }
}

__device__ __forceinline__ void ph_post(const Ctx& c, int l) {
    const int tid = TID(), lane = tid & 63, wave = tid >> 6, gw = BID() * NWAVES + wave, NGW = gridDim.x * NWAVES;
    bf16* PJ = (bf16*)(c.ws + WS_PROJ);
    const bf16* OA = PJ + (size_t)P_XM * PSTRIDE; const bf16* GS = PJ + (size_t)P_GA * PSTRIDE; const bf16* OS = PJ + (size_t)P_OS * PSTRIDE;
    bf16* AO = PJ + (size_t)P_QA * PSTRIDE; bf16* BO = PJ + (size_t)P_LF * PSTRIDE;
    const bf16* HM = PJ + (size_t)P_VA * PSTRIDE; const bf16* XC = (const bf16*)(c.ws + WS_XC);
    f32x4 gna[4], gnm[4], skp[4]; ld_row_f32(c.in[I_HGN] + (size_t)l * D, lane, gna); ld_row_f32(c.in[I_MGN] + (size_t)l * D, lane, gnm); ld_row_f32(c.in[I_MSKIP] + (size_t)l * D, lane, skp);
    for (int slot = gw; slot < M / 16; slot += NGW) {
        for (int r = 0; r < 16; ++r) {
            const size_t ro = (size_t)(slot * 16 + r) * D;
            f32x4 oa[4], gs[4], hm[4], xc[4], os[4], ao[4], bo[4];
            ld_row_bf16(OA + ro, lane, oa); ld_row_bf16(GS + ro, lane, gs); ld_row_bf16(HM + ro, lane, hm); ld_row_bf16(XC + ro, lane, xc); ld_row_bf16(OS + ro, lane, os);
#pragma unroll
            for (int j = 0; j < 4; ++j) {
                const float ss = half_sum((oa[j][0] * oa[j][0] + oa[j][1] * oa[j][1]) + (oa[j][2] * oa[j][2] + oa[j][3] * oa[j][3]));
                const float ra = rsqrtf(ss * (1.0f / 128.0f) + EPS);
                ao[j] = oa[j] * ra * gna[j] * gs[j];
                const float mu = wave_sum((hm[j][0] + hm[j][1]) + (hm[j][2] + hm[j][3])) * (1.0f / 256.0f);
                const f32x4 d = hm[j] - mu;
                const float var = wave_sum((d[0] * d[0] + d[1] * d[1]) + (d[2] * d[2] + d[3] * d[3])) * (1.0f / 256.0f);
                const float rb = rsqrtf(var + EPS);
                bo[j] = os[j] * (d * rb * gnm[j] + skp[j] * xc[j]);
            }
            st_row_bf16(AO + ro, lane, ao); st_row_bf16(BO + ro, lane, bo);
        }
    }
}
typedef short bf16x8 __attribute__((ext_vector_type(8)));
#define MFMA16(a, b, c) __builtin_amdgcn_mfma_f32_16x16x32_bf16(a, b, c, 0, 0, 0)
__device__ __forceinline__ f32x4 mmT(const LAS bf16* X, int ldx, int m0, const LAS bf16* Y, int ldy, int n0, int k0, f32x4 acc, int lane) {
    const bf16x8 a = *(const LAS bf16x8*)(X + (m0 + (lane & 15)) * ldx + k0 + 8 * (lane >> 4));
    const bf16x8 b = *(const LAS bf16x8*)(Y + (n0 + (lane & 15)) * ldy + k0 + 8 * (lane >> 4));
    return MFMA16(b, a, acc);
}
__device__ __forceinline__ f32x4 mmN(const LAS bf16* X, int ldx, int m0, const LAS bf16* Y, int ldy, int n0, int k0, f32x4 acc, int lane) {
    const bf16x8 a = *(const LAS bf16x8*)(X + (m0 + (lane & 15)) * ldx + k0 + 8 * (lane >> 4));
    const bf16x8 b = *(const LAS bf16x8*)(Y + (n0 + (lane & 15)) * ldy + k0 + 8 * (lane >> 4));
    return MFMA16(a, b, acc);
}
__device__ __forceinline__ v2u pack4(const f32x4 v) { v2u w; w.x = pk2(v[0], v[1]); w.y = pk2(v[2], v[3]); return w; }

__device__ __forceinline__ void ph_scan_a(const Ctx& c, LAS unsigned char* lds) {
    const int tid = TID(), lane = tid & 63, wave = __builtin_amdgcn_readfirstlane(tid >> 6);
    bf16* PJ = (bf16*)(c.ws + WS_PROJ);
    const GAS bf16* Q = (const GAS bf16*)(PJ + (size_t)P_QA * PSTRIDE); const GAS bf16* LFp = (const GAS bf16*)(PJ + (size_t)P_LF * PSTRIDE); const bf16* V = PJ + (size_t)P_VA * PSTRIDE; bf16* OA = PJ + (size_t)P_XM * PSTRIDE;
    LAS bf16* LQ = (LAS bf16*)lds;
    LAS bf16* LK = (LAS bf16*)(lds + 17408);
    LAS bf16* LKT = (LAS bf16*)(lds + 34816);
    LAS bf16* LVT = (LAS bf16*)(lds + 53248);
    LAS bf16* LP = (LAS bf16*)(lds + 57856);
    LAS bf16* LST = (LAS bf16*)(lds + 67072);
    LAS float* SEG = (LAS float*)(lds + 75776);
    LAS float* ER = (LAS float*)(lds + 77824);
    LAS float* EB = (LAS float*)(lds + 78336);
    LAS float* EK = (LAS float*)(lds + 78848);
    const int d = tid & 127, seg = tid >> 7;
    for (int u = BID(); u < 256; u += gridDim.x) {
        const int b = u >> 5, h = (u >> 2) & 7, vs = u & 3;
        const size_t rowbase = (size_t)b * SEQ;
        f32x4 S[2]; S[0] = (f32x4){0.f, 0.f, 0.f, 0.f}; S[1] = S[0];
        unsigned short rq[16], rf[16]; v4u rv = {0u, 0u, 0u, 0u};
#define SA_LOAD(ch) do { const size_t o_ = (rowbase + (size_t)(ch) * 64 + seg * 16) * D + h * 128 + d; \
            _Pragma("unroll") for (int i = 0; i < 16; ++i) { rq[i] = Q[o_ + (size_t)i * D]; rf[i] = LFp[o_ + (size_t)i * D]; } \
            if (tid < 256) { const int rr = tid >> 2, c8 = tid & 3; rv = *(const GAS v4u*)(V + (rowbase + (size_t)(ch) * 64 + rr) * D + h * 128 + vs * 32 + c8 * 8); } } while (0)
        SA_LOAD(0);
        for (int ch = 0; ch < 64; ++ch) {
            float qv[16], kv[16], cs[16]; float run = 0.f;
#pragma unroll
            for (int i = 0; i < 16; ++i) { qv[i] = bf2f(rq[i]); const float lf = bf2f(rf[i]); kv[i] = 1.0f - __expf(lf); run += lf; cs[i] = run; }
            SEG[seg * 128 + d] = run;
            __syncthreads();
            const float s0 = SEG[d], s1 = SEG[128 + d], s2 = SEG[256 + d], s3 = SEG[384 + d];
            const float pre = (seg > 0 ? s0 : 0.f) + (seg > 1 ? s1 : 0.f) + (seg > 2 ? s2 : 0.f);
            const float r = s0 + s1, btot = (s0 + s1) + (s2 + s3);
            if (tid < 256) { const int rr = tid >> 2, c8 = tid & 3; const unsigned w4[4] = {rv.x, rv.y, rv.z, rv.w};
#pragma unroll
                for (int j = 0; j < 4; ++j) { LVT[(c8 * 8 + 2 * j) * 72 + rr] = (bf16)(w4[j] & 0xffffu); LVT[(c8 * 8 + 2 * j + 1) * 72 + rr] = (bf16)(w4[j] >> 16); } }
            unsigned kt[8];
#pragma unroll
            for (int i = 0; i < 16; ++i) { const float bt = pre + cs[i]; const unsigned qb = f2bf(qv[i] * __expf(bt - r)), kb = f2bf(kv[i] * __expf(r - bt));
                LQ[(seg * 16 + i) * 136 + d] = (bf16)qb; LK[(seg * 16 + i) * 136 + d] = (bf16)kb;
                if (i & 1) kt[i >> 1] |= kb << 16; else kt[i >> 1] = kb; }
            *(LAS v4u*)(LKT + d * 72 + seg * 16) = (v4u){kt[0], kt[1], kt[2], kt[3]}; *(LAS v4u*)(LKT + d * 72 + seg * 16 + 8) = (v4u){kt[4], kt[5], kt[6], kt[7]};
            if (seg == 0) { ER[d] = __expf(r); EB[d] = __expf(btot); EK[d] = __expf(btot - r); }
            if (ch + 1 < 64) SA_LOAD(ch + 1);
            __syncthreads();
            {
                const int tt = wave >> 1;
#pragma unroll
                for (int jj = 0; jj < 2; ++jj) { const int st = (wave & 1) * 2 + jj; f32x4 acc = {0.f, 0.f, 0.f, 0.f};
                    if (st <= tt) {
#pragma unroll
                        for (int kk = 0; kk < 4; ++kk) acc = mmT(LQ, 136, tt * 16, LK, 136, st * 16, kk * 32, acc, lane);
                        if (st == tt) {
#pragma unroll
                            for (int e = 0; e < 4; ++e) if (4 * (lane >> 4) + e > (lane & 15)) acc[e] = 0.f; } }
                    *(LAS v2u*)(LP + (tt * 16 + (lane & 15)) * 72 + st * 16 + 4 * (lane >> 4)) = pack4(acc); }
#pragma unroll
                for (int j = 0; j < 2; ++j) { const int ti = wave * 2 + j, d0 = (ti >> 1) * 16, e0 = (ti & 1) * 16;
                    const f32x4 er4 = *(const LAS f32x4*)(ER + d0 + 4 * (lane >> 4));
                    *(LAS v2u*)(LST + (e0 + (lane & 15)) * 136 + d0 + 4 * (lane >> 4)) = pack4(S[j] * er4); }
            }
            __syncthreads();
            {
                const int t0 = (wave >> 1) * 16, e0 = (wave & 1) * 16; f32x4 acc = {0.f, 0.f, 0.f, 0.f};
#pragma unroll
                for (int kk = 0; kk < 2; ++kk) acc = mmT(LP, 72, t0, LVT, 72, e0, kk * 32, acc, lane);
#pragma unroll
                for (int kk = 0; kk < 4; ++kk) acc = mmT(LQ, 136, t0, LST, 136, e0, kk * 32, acc, lane);
                *(GAS v2u*)(OA + (rowbase + (size_t)ch * 64 + t0 + (lane & 15)) * D + h * 128 + vs * 32 + e0 + 4 * (lane >> 4)) = pack4(acc);
#pragma unroll
                for (int j = 0; j < 2; ++j) { const int ti = wave * 2 + j, d0 = (ti >> 1) * 16, ee0 = (ti & 1) * 16; f32x4 up = {0.f, 0.f, 0.f, 0.f};
#pragma unroll
                    for (int kk = 0; kk < 2; ++kk) up = mmN(LKT, 72, d0, LVT, 72, ee0, kk * 32, up, lane);
                    const f32x4 eb4 = *(const LAS f32x4*)(EB + d0 + 4 * (lane >> 4)), ek4 = *(const LAS f32x4*)(EK + d0 + 4 * (lane >> 4));
                    S[j] = eb4 * S[j] + ek4 * up; }
            }
        }
#undef SA_LOAD
        __syncthreads();
    }
}

__device__ __forceinline__ bf16x8 tr_frag(const LAS bf16* T, int ld, int k0, int m0, int lane) {
    const int g = lane >> 4, q = (lane & 15) >> 2, p = lane & 3;
    const unsigned a0 = (unsigned)(size_t)(T + (k0 + 8 * g + q) * ld + m0 + 4 * p), a1 = a0 + (unsigned)(4 * ld * 2);
    v2u x, y; asm volatile("ds_read_b64_tr_b16 %0, %2\n\tds_read_b64_tr_b16 %1, %3\n\ts_waitcnt lgkmcnt(0)" : "=&v"(x), "=&v"(y) : "v"(a0), "v"(a1) : "memory");
    const v4u w = {x.x, x.y, y.x, y.y}; return __builtin_bit_cast(bf16x8, w);
}
__device__ __forceinline__ void ph_scan_m(const Ctx& c, LAS unsigned char* lds) {
    const int tid = TID(), lane = tid & 63, wave = __builtin_amdgcn_readfirstlane(tid >> 6);
    const bf16* MQ = (const bf16*)(c.ws + WS_MQ); const bf16* MK = (const bf16*)(c.ws + WS_MK); const bf16* MV = (const bf16*)(c.ws + WS_MV); bf16* HM = (bf16*)(c.ws + WS_PROJ) + (size_t)P_VA * PSTRIDE;
    const GAS float* LI = (const GAS float*)(c.ws + WS_LI); const GAS float* LF = (const GAS float*)(c.ws + WS_LF);
    LAS bf16* LQ = (LAS bf16*)lds;
    LAS bf16* LK = (LAS bf16*)(lds + 33792);
    LAS bf16* LV0 = (LAS bf16*)(lds + 67584);
    LAS bf16* LV1 = (LAS bf16*)(lds + 74496);
    LAS bf16* LP = (LAS bf16*)(lds + 81408);
    LAS bf16* LCT = (LAS bf16*)(lds + 90624);
    LAS float* AS = (LAS float*)(lds + 115968);
    LAS float* MXS = (LAS float*)(lds + 116224);
    LAS float* BS = (LAS float*)(lds + 116480);
    for (int u = BID(); u < 256; u += gridDim.x) {
        const int b = u >> 5, h = (u >> 3) & 3, vs = u & 7;
        const size_t rowbase = (size_t)b * SEQ;
        f32x4 C[2][3];
#pragma unroll
        for (int i = 0; i < 2; ++i)
#pragma unroll
            for (int j = 0; j < 3; ++j) C[i][j] = (f32x4){0.f, 0.f, 0.f, 0.f};
        float m = 0.f;
        __syncthreads();
        for (int i = tid; i < 48 * 72; i += NTHR) { const int row = i / 72; LV0[i] = (bf16)(row == 32 ? 0x3f80u : 0u); LV1[i] = (bf16)0u; }
        v4u rq[4], rk[4], rv = {0u, 0u, 0u, 0u}; float rli = 0.f, rlf = 0.f;
#define SM_LOAD(ch) do { _Pragma("unroll") for (int k2 = 0; k2 < 4; ++k2) { const int p = tid + NTHR * k2, rr = p >> 5, c8 = p & 31; const size_t o_ = (rowbase + (size_t)(ch) * 64 + rr) * D + h * 256 + c8 * 8; \
            rq[k2] = *(const GAS v4u*)(MQ + o_); rk[k2] = *(const GAS v4u*)(MK + o_); } \
            if (tid < 256) { const int rr = tid >> 2, c8 = tid & 3; rv = *(const GAS v4u*)(MV + (rowbase + (size_t)(ch) * 64 + rr) * D + h * 256 + vs * 32 + c8 * 8); } \
            rli = LI[(rowbase + (size_t)(ch) * 64 + lane) * 4 + h]; rlf = LF[(rowbase + (size_t)(ch) * 64 + lane) * 4 + h]; } while (0)
        SM_LOAD(0);
        for (int ch = 0; ch < 64; ++ch) {
            __syncthreads();
            float bb = rlf;
#pragma unroll
            for (int o = 1; o < 64; o <<= 1) { const float t_ = __shfl_up(bb, o); if (lane >= o) bb += t_; }
            const float aa = rli - bb; float pm = aa;
#pragma unroll
            for (int o = 1; o < 64; o <<= 1) { const float t_ = __shfl_up(pm, o); if (lane >= o) pm = fmaxf(pm, t_); }
            const float mx = fmaxf(m, pm);
            const float b63 = __shfl(bb, 63), mx63 = __shfl(mx, 63);
            if (wave == 0) { AS[lane] = aa; MXS[lane] = mx; BS[lane] = bb; }
#pragma unroll
            for (int k2 = 0; k2 < 4; ++k2) { const int p = tid + NTHR * k2, rr = p >> 5, c8 = p & 31; *(LAS v4u*)(LQ + rr * 264 + c8 * 8) = rq[k2]; *(LAS v4u*)(LK + rr * 264 + c8 * 8) = rk[k2]; }
            { const int rr = (tid >> 2) & 63; const float wv = __expf(__shfl(aa, rr) - mx63);
              if (tid < 256) { const int c8 = tid & 3; const unsigned w4[4] = {rv.x, rv.y, rv.z, rv.w};
#pragma unroll
                for (int j = 0; j < 4; ++j) { const unsigned lo = w4[j] & 0xffffu, hi = w4[j] >> 16;
                    LV0[(c8 * 8 + 2 * j) * 72 + rr] = (bf16)lo; LV0[(c8 * 8 + 2 * j + 1) * 72 + rr] = (bf16)hi;
                    LV1[(c8 * 8 + 2 * j) * 72 + rr] = (bf16)f2bf(bflo(w4[j]) * wv); LV1[(c8 * 8 + 2 * j + 1) * 72 + rr] = (bf16)f2bf(bfhi(w4[j]) * wv); } } }
            if (wave == 0) LV1[32 * 72 + lane] = (bf16)f2bf(__expf(aa - mx63));
            const float m_old = m;
            if (ch + 1 < 64) SM_LOAD(ch + 1);
            __syncthreads();
            {
                const int tt = wave >> 1;
#pragma unroll
                for (int jj = 0; jj < 2; ++jj) { const int st = (wave & 1) * 2 + jj; f32x4 acc = {0.f, 0.f, 0.f, 0.f};
                    if (st <= tt) {
#pragma unroll
                        for (int kk = 0; kk < 8; ++kk) acc = mmT(LQ, 264, tt * 16, LK, 264, st * 16, kk * 32, acc, lane);
                        const f32x4 a4 = *(const LAS f32x4*)(AS + st * 16 + 4 * (lane >> 4)); const float mxt = MXS[tt * 16 + (lane & 15)];
#pragma unroll
                        for (int e = 0; e < 4; ++e) acc[e] = (st == tt && 4 * (lane >> 4) + e > (lane & 15)) ? 0.f : acc[e] * __expf(a4[e] - mxt); }
                    *(LAS v2u*)(LP + (tt * 16 + (lane & 15)) * 72 + st * 16 + 4 * (lane >> 4)) = pack4(acc); }
#pragma unroll
                for (int i = 0; i < 2; ++i)
#pragma unroll
                    for (int j = 0; j < 3; ++j) { const int d0 = (wave * 2 + i) * 16, e0 = j * 16;
                        *(LAS v2u*)(LCT + (e0 + (lane & 15)) * 264 + d0 + 4 * (lane >> 4)) = pack4(C[i][j]); }
            }
            __syncthreads();
            {
                const int t0 = (wave >> 1) * 16, e0 = (wave & 1) * 16; f32x4 p1 = {0.f, 0.f, 0.f, 0.f}, p2 = p1, q1 = p1, q2 = p1;
#pragma unroll
                for (int kk = 0; kk < 2; ++kk) { p1 = mmT(LP, 72, t0, LV0, 72, e0, kk * 32, p1, lane); q1 = mmT(LP, 72, t0, LV0, 72, 32, kk * 32, q1, lane); }
#pragma unroll
                for (int kk = 0; kk < 8; ++kk) { p2 = mmT(LQ, 264, t0, LCT, 264, e0, kk * 32, p2, lane); q2 = mmT(LQ, 264, t0, LCT, 264, 32, kk * 32, q2, lane); }
                const float mxt = MXS[t0 + (lane & 15)], bt = BS[t0 + (lane & 15)], wi = __expf(m_old - mxt);
                const float den = __shfl(q1[0] + wi * q2[0], lane & 15);
                const float inv = 1.0f / fmaxf(fabsf(den), __expf(-(bt + mxt)));
                const f32x4 hv = (p1 + p2 * wi) * inv;
                *(GAS v2u*)(HM + (rowbase + (size_t)ch * 64 + t0 + (lane & 15)) * D + h * 256 + vs * 32 + e0 + 4 * (lane >> 4)) = pack4(hv);
                const float dec = __expf(m_old - mx63);
#pragma unroll
                for (int i = 0; i < 2; ++i) { const int d0 = (wave * 2 + i) * 16; f32x4 up[3];
#pragma unroll
                    for (int j = 0; j < 3; ++j) up[j] = (f32x4){0.f, 0.f, 0.f, 0.f};
#pragma unroll
                    for (int kk = 0; kk < 2; ++kk) { const bf16x8 af = tr_frag(LK, 264, kk * 32, d0, lane);
#pragma unroll
                        for (int j = 0; j < 3; ++j) { const bf16x8 bfr = *(const LAS bf16x8*)(LV1 + (j * 16 + (lane & 15)) * 72 + kk * 32 + 8 * (lane >> 4)); up[j] = MFMA16(af, bfr, up[j]); } }
#pragma unroll
                    for (int j = 0; j < 3; ++j) C[i][j] = C[i][j] * dec + up[j]; }
                m = b63 + mx63;
            }
        }
#undef SM_LOAD
        __syncthreads();
    }
}
constexpr int TAB_OFF = MISC_OFF + 256;
__device__ __forceinline__ void moe_tables(const Ctx& c, int jm, LAS unsigned char* lds) {
    LAS int* tab = (LAS int*)(lds + TAB_OFF);
    __syncthreads();
    if (TID() == 0) { unsigned* cnt = (unsigned*)c.ws + CW_CNT + 64 * jm; int accp = 0;
        for (int e = 0; e < 8; ++e) { const int n = (int)__hip_atomic_load(cnt + e, __ATOMIC_RELAXED, __HIP_MEMORY_SCOPE_AGENT); const int p = (n + 255) >> 8; tab[e] = p; tab[8 + e] = accp; accp += p; }
        tab[16] = accp; }
    __syncthreads();
}
__device__ __forceinline__ void ph_res1(const Ctx& c, int l, LAS unsigned char* lds, int dry = 0) {
    const int tid = TID(), lane = tid & 63, wave = tid >> 6, gw = BID() * NWAVES + wave, NGW = gridDim.x * NWAVES;
    const bool moe = (l & 1) != 0; const int jm = l >> 1;
    LAS float* rt = (LAS float*)lds;
    if (moe) { const GAS f32x4* src = (const GAS f32x4*)(c.in[I_ROUTER] + (size_t)jm * D * NEXP); for (int i = tid; i < D * NEXP / 4; i += NTHR) ((LAS f32x4*)rt)[i] = src[i]; }
    __syncthreads();
    const float* xin = (l == 0) ? c.in[I_X] : c.out;
    const bf16* Y = (const bf16*)(c.ws + WS_PROJ) + (size_t)P_OS * PSTRIDE; bf16* H = (bf16*)(c.ws + WS_H);
    unsigned* cnt = (unsigned*)c.ws + CW_CNT + 64 * jm;
    int* TOKEP = (int*)(c.ws + WS_TOKEP); float* TOKW = (float*)(c.ws + WS_TOKW);
    for (int slot = gw; slot < M / 16; slot += NGW) {
        const int row0 = slot * 16, b = row0 / SEQ;
        f32x4 gpm[4], gt[4], gpf[4], scf[4], shf[4];
        ld_row_f32(c.in[I_GPOSTMIX] + (size_t)l * D, lane, gpm); ld_row_f32(modp(c, l, b, 2), lane, gt); ld_row_f32(c.in[I_GPREFFN] + (size_t)l * D, lane, gpf);
        ld_row_f32(modp(c, l, b, 4), lane, scf); ld_row_f32(modp(c, l, b, 3), lane, shf);
        for (int r = 0; r < 16; ++r) {
            const int row = row0 + r; const size_t ro = (size_t)row * D;
            f32x4 y[4], x[4], h[4]; ld_row_bf16(Y + ro, lane, y); ld_row_f32(xin + ro, lane, x);
            const float rr = rsqrtf(row_sumsq(y) * (1.0f / 1024.0f) + EPS);
#pragma unroll
            for (int j = 0; j < 4; ++j) { x[j] = x[j] + gt[j] * (y[j] * rr * gpm[j]); if (!dry) *(GAS f32x4*)(c.out + ro + 4 * lane + 256 * j) = x[j]; }
            norm_mod(x, gpf, scf, shf, h); if (!dry) st_row_bf16(H + ro, lane, h);
            if (moe) {
                f32x4 l0 = {0.f, 0.f, 0.f, 0.f}, l1 = l0;
#pragma unroll
                for (int j = 0; j < 4; ++j)
#pragma unroll
                    for (int i = 0; i < 4; ++i) { const int ch = 4 * lane + 256 * j + i; l0 += *(const LAS f32x4*)(rt + ch * 8) * h[j][i]; l1 += *(const LAS f32x4*)(rt + ch * 8 + 4) * h[j][i]; }
                float lg[8];
#pragma unroll
                for (int e = 0; e < 4; ++e) { lg[e] = wave_sum(l0[e]); lg[4 + e] = wave_sum(l1[e]); }
                int i1 = 0; float v1 = lg[0];
#pragma unroll
                for (int e = 1; e < 8; ++e) if (lg[e] > v1) { v1 = lg[e]; i1 = e; }
                int i2 = -1; float v2 = -3.0e38f;
#pragma unroll
                for (int e = 0; e < 8; ++e) if (e != i1 && lg[e] > v2) { v2 = lg[e]; i2 = e; }
                if (lane == 0 && !dry) { const float w1 = 1.0f / (1.0f + __expf(v2 - v1));
                    const int p1 = (int)atomicAdd(cnt + i1, 1u), p2 = (int)atomicAdd(cnt + i2, 1u);
                    *(GAS i32x4*)(TOKEP + (size_t)row * 4) = (i32x4){i1, p1, i2, p2}; *(GAS f32x2*)(TOKW + (size_t)row * 2) = (f32x2){w1, 1.0f - w1}; }
            }
        }
    }
}
__device__ __forceinline__ void ph_gather(const Ctx& c, int l, LAS unsigned char* lds) {
    const int tid = TID(), lane = tid & 63, wave = tid >> 6, gw = BID() * NWAVES + wave, NGW = gridDim.x * NWAVES;
    moe_tables(c, l >> 1, lds); const LAS int* tab = (const LAS int*)(lds + TAB_OFF);
    const bf16* H = (const bf16*)(c.ws + WS_H); bf16* AG = (bf16*)(c.ws + WS_AG);
    const int* TOKEP = (const int*)(c.ws + WS_TOKEP); int* TOKD = (int*)(c.ws + WS_TOKD);
    for (int row = gw; row < M; row += NGW) {
        const i32x4 ep = *(const GAS i32x4*)(TOKEP + (size_t)row * 4);
        const int d1 = tab[8 + ep.x] * 256 + ep.y, d2 = tab[8 + ep.z] * 256 + ep.w;
        const v4u a = *(const GAS v4u*)(H + (size_t)row * D + lane * 8), b = *(const GAS v4u*)(H + (size_t)row * D + 512 + lane * 8);
        *(GAS v4u*)(AG + (size_t)d1 * D + lane * 8) = a; *(GAS v4u*)(AG + (size_t)d1 * D + 512 + lane * 8) = b;
        *(GAS v4u*)(AG + (size_t)d2 * D + lane * 8) = a; *(GAS v4u*)(AG + (size_t)d2 * D + 512 + lane * 8) = b;
        if (lane == 0) *(GAS i32x2*)(TOKD + (size_t)row * 2) = (i32x2){d1, d2};
    }
}
__device__ __forceinline__ void ph_res2(const Ctx& c, int l, int dry = 0) {
    const int tid = TID(), lane = tid & 63, wave = tid >> 6, gw = BID() * NWAVES + wave, NGW = gridDim.x * NWAVES;
    const bool moe = (l & 1) != 0;
    const bf16* Y2 = (const bf16*)(c.ws + WS_PROJ) + (size_t)4 * PSTRIDE; const bf16* YS = (const bf16*)(c.ws + WS_YS); bf16* H = (bf16*)(c.ws + WS_H);
    const int* TOKD = (const int*)(c.ws + WS_TOKD); const float* TOKW = (const float*)(c.ws + WS_TOKW);
    const int ln = (l + 1 < DEPTH) ? l + 1 : l;
    for (int slot = gw; slot < M / 16; slot += NGW) {
        const int row0 = slot * 16, b = row0 / SEQ;
        f32x4 gpo[4], gt[4], gpm[4], scm[4], shm[4];
        ld_row_f32(c.in[I_GPOSTFFN] + (size_t)l * D, lane, gpo); ld_row_f32(modp(c, l, b, 5), lane, gt); ld_row_f32(c.in[I_GPREMIX] + (size_t)ln * D, lane, gpm);
        ld_row_f32(modp(c, ln, b, 1), lane, scm); ld_row_f32(modp(c, ln, b, 0), lane, shm);
        for (int r = 0; r < 16; ++r) {
            const int row = row0 + r; const size_t ro = (size_t)row * D;
            f32x4 y[4], x[4], h[4];
            if (moe) { const i32x2 d = *(const GAS i32x2*)(TOKD + (size_t)row * 2); const f32x2 w = *(const GAS f32x2*)(TOKW + (size_t)row * 2);
                f32x4 ya[4], yb[4]; ld_row_bf16(YS + (size_t)d.x * D, lane, ya); ld_row_bf16(YS + (size_t)d.y * D, lane, yb);
#pragma unroll
                for (int j = 0; j < 4; ++j) y[j] = ya[j] * w.x + yb[j] * w.y; }
            else ld_row_bf16(Y2 + ro, lane, y);
            ld_row_f32(c.out + ro, lane, x);
            const float rr = rsqrtf(row_sumsq(y) * (1.0f / 1024.0f) + EPS);
#pragma unroll
            for (int j = 0; j < 4; ++j) { x[j] = x[j] + gt[j] * (y[j] * rr * gpo[j]); if (!dry) *(GAS f32x4*)(c.out + ro + 4 * lane + 256 * j) = x[j]; }
            if (l + 1 < DEPTH) { norm_mod(x, gpm, scm, shm, h); if (!dry) st_row_bf16(H + ro, lane, h); }
        }
    }
}

constexpr int PH_PER_LAYER = 12, NPH = 2 + DEPTH * PH_PER_LAYER;
__global__ void __launch_bounds__(NTHR, 2) fwd(Ctx c) {
    extern __shared__ __attribute__((aligned(16))) unsigned char lds_raw[];
    LAS unsigned char* lds = (LAS unsigned char*)lds_raw;
    volatile LAS unsigned* MISC = (volatile LAS unsigned*)(lds + MISC_OFF);
    if (threadIdx.x < 64) MISC[threadIdx.x] = 0u;
    __syncthreads();
    const int lo = c.ph_lo, hi = c.ph_hi, G = gridDim.x;
    XcdBarrier bar; bar.bar = (unsigned*)c.ws + CW_BAR; bar.x = 0; bar.st = MISC + 8;
    if (hi - lo > 1) bar = xcd_barrier_post((unsigned*)c.ws + CW_BAR, MISC + 8);
#ifndef PH_MASK
#define PH_MASK 0xFFFF
#endif
#define IN(p) (lo <= (p) && (p) < hi)
#define ON(k) ((PH_MASK >> (k)) & 1)
#ifndef REPMASK
#define REPMASK 0
#endif
#define REP(k) for (int rep_ = 0; rep_ < (((REPMASK >> (k)) & 1) ? opq_s(2) : 1); ++rep_)
#define BAR_AFTER(p) do { if ((p) + 1 < hi) xcd_barrier(bar); } while (0)
    if (ON(12) && IN(0)) { ph_mod(c, lds); ph_lb(c); ph_uz(c); REP(14) ph_cvt(c, 0, lds); BAR_AFTER(0); }
    if (ON(13) && IN(1)) { ph_norm0(c); BAR_AFTER(1); }
    for (int l = 0; l < DEPTH; ++l) {
        const int base = 2 + l * PH_PER_LAYER; const bool moe = (l & 1) != 0;
        Ctx cl = c; cl.ws = opq_p(c.ws); cl.out = (float*)opq_p((unsigned char*)c.out);
        unsigned char* ws = cl.ws; bf16* PJ = (bf16*)(ws + WS_PROJ); const int bid = BID();
        int KD = opq_s(D);
        if (ON(0) && IN(base + 0)) {
            pg8::Gemm g{(const bf16*)(ws + WS_H), (const bf16*)(ws + WS_WIN), M, DIN, KD}; pg8::UOrder S; S.init(0, M, DIN, G, bid);
            pg8::EpiWin E{PJ, (const float*)(ws + WS_LB) + l * 1024, PSTRIDE};
            REP(0) pg8::gemm_phase<pg8::EpiWin, pg8::UOrder, true, true>(lds, g, S, E);
            BAR_AFTER(base + 0); }
        if (ON(1) && IN(base + 1)) { REP(1) ph_prep(cl, l); BAR_AFTER(base + 1); }
        if (ON(2) && IN(base + 2)) { REP(2) ph_scan_a(cl, lds); BAR_AFTER(base + 2); }
        if (ON(3) && IN(base + 3)) { REP(3) ph_scan_m(cl, lds); BAR_AFTER(base + 3); }
        if (ON(4) && IN(base + 4)) { REP(4) ph_post(cl, l); BAR_AFTER(base + 4); }
        if (ON(5) && IN(base + 5)) {
            pg8::Gemm g{PJ + (size_t)P_QA * PSTRIDE, (const bf16*)(ws + WS_WAB), M, D, KD}; pg8::UOrder S; S.init(1, M, D, G, bid);
            pg8::EpiProj E{PJ + (size_t)P_GTA * PSTRIDE, PSTRIDE, (float*)(PJ + (size_t)P_GA * PSTRIDE), PJ + (size_t)P_VA * PSTRIDE};
            REP(5) pg8::gemm_phase<pg8::EpiProj, pg8::UOrder, true, true>(lds, g, S, E);
            BAR_AFTER(base + 5); }
        if (ON(6) && IN(base + 6)) {
            pg8::Gemm g{PJ + (size_t)P_VA * PSTRIDE, (const bf16*)(ws + WS_WO), M, D, KD}; pg8::UOrder S; S.init(0, M, D, G, bid);
            pg8::EpiPlain E{PJ + (size_t)P_OS * PSTRIDE, D};
            REP(6) pg8::gemm_phase<pg8::EpiPlain, pg8::UOrder, true, true>(lds, g, S, E);
            BAR_AFTER(base + 6); }
        if (ON(7) && IN(base + 7)) { if ((REPMASK >> 7) & 1) ph_res1(cl, l, lds, opq_s(1)); ph_res1(cl, l, lds); BAR_AFTER(base + 7); }
        if (ON(8) && IN(base + 8) && moe) { ph_gather(cl, l, lds); BAR_AFTER(base + 8); }
        if (ON(9) && IN(base + 9)) {
            pg8::Gemm g{(const bf16*)(ws + (moe ? WS_AG : WS_H)), (const bf16*)(ws + WS_WF), M, 2 * DFF, KD}; pg8::UOrder S; S.init(0, M, 2 * DFF, G, bid);
            pg8::EpiSwi E{PJ, moe ? DFE : DFF, moe ? 28 : 22};
            if (moe) { moe_tables(cl, l >> 1, lds); S.mode = 2; S.NT = 28; S.tab = (const LAS int*)(lds + TAB_OFF); S.nwg = __builtin_amdgcn_readfirstlane(S.tab[16]) * 28; }
            REP(9) pg8::gemm_phase<pg8::EpiSwi, pg8::UOrder, true, true>(lds, g, S, E);
            BAR_AFTER(base + 9); }
        if (ON(10) && IN(base + 10)) {
            pg8::Gemm g{PJ, (const bf16*)(ws + WS_WF + (moe ? WF_W2_MOE : WF_W2_DENSE)), M, D, moe ? DFE : DFF}; pg8::UOrder S; S.init(0, M, D, G, bid);
            pg8::EpiPlain E{moe ? (bf16*)(ws + WS_YS) : PJ + (size_t)4 * PSTRIDE, D};
            if (moe) { moe_tables(cl, l >> 1, lds); S.mode = 2; S.NT = 4; S.tab = (const LAS int*)(lds + TAB_OFF); S.nwg = __builtin_amdgcn_readfirstlane(S.tab[16]) * 4; }
            REP(10) pg8::gemm_phase<pg8::EpiPlain, pg8::UOrder, true, true>(lds, g, S, E);
            BAR_AFTER(base + 10); }
        if (ON(11) && IN(base + 11)) { if ((REPMASK >> 11) & 1) ph_res2(cl, l, opq_s(1)); ph_res2(cl, l); if (l + 1 < DEPTH) REP(14) ph_cvt(cl, l + 1, lds); BAR_AFTER(base + 11); }
    }
#undef IN
#undef BAR_AFTER
}

#ifndef MK_ONE_LAUNCH
#define MK_ONE_LAUNCH 1
#endif
extern "C" void kernel_launch(void* const* d_in, const int* in_sizes, int n_in, void* d_out, int out_size, void* d_ws, size_t ws_size, hipStream_t stream) {
    static int grid = 0;
    if (grid == 0) {
        if (n_in != 32 || in_sizes[0] != M * D || out_size != M * D || ws_size < WS_END) { fprintf(stderr, "kernel_launch: unexpected shapes / workspace (%d inputs, ws %zu < %zu)\n", n_in, ws_size, (size_t)WS_END); grid = -1; return; }
        int dev = 0, cus = 0;
        if (hipGetDevice(&dev) != hipSuccess || hipDeviceGetAttribute(&cus, hipDeviceAttributeMultiprocessorCount, dev) != hipSuccess) { grid = -1; return; }
        if (hipFuncSetAttribute((const void*)fwd, hipFuncAttributeMaxDynamicSharedMemorySize, LDS_BYTES) != hipSuccess) { fprintf(stderr, "kernel_launch: hipFuncSetAttribute failed\n"); grid = -1; return; }
        (void)hipGetLastError();
        grid = cus;
    }
    if (grid < 0) return;
    if (hipMemsetAsync((char*)d_ws + WS_CTL, 0, CTL_ZERO_BYTES, stream) != hipSuccess) return;
    Ctx c{};
    for (int i = 0; i < 32; ++i) c.in[i] = (const float*)d_in[i];
    c.out = (float*)d_out; c.ws = (unsigned char*)d_ws;
#if MK_ONE_LAUNCH
    c.ph_lo = 0; c.ph_hi = NPH;
    hipLaunchKernelGGL(fwd, dim3(grid), dim3(NTHR), LDS_BYTES, stream, c);
#else
    for (int p = 0; p < NPH; ++p) {
        if (p >= 2) { const int l = (p - 2) / PH_PER_LAYER, k = (p - 2) % PH_PER_LAYER; if (k == 8 && !(l & 1)) continue; }
        c.ph_lo = p; c.ph_hi = p + 1;
        hipLaunchKernelGGL(fwd, dim3(grid), dim3(NTHR), LDS_BYTES, stream, c);
    }
#endif
}
```

```cpp
#include <hip/hip_runtime.h>
#include <cstdio>
#include <cstdint>
#ifndef TPROBE
#define TPROBE -1
#endif
namespace pg8 {
#define PG8_LAS __attribute__((address_space(3)))
typedef unsigned short bf16_t;
typedef short bf16x8 __attribute__((ext_vector_type(8)));
typedef float f32x4 __attribute__((ext_vector_type(4)));
typedef unsigned u32x4 __attribute__((ext_vector_type(4)));
constexpr int BM = 256, BK = 64, HALF = 128, HTB = HALF * BK * 2  , STAGE_BYTES = 8 * HTB, NXCD = 8, WGM = 4;

__host__ __device__ __forceinline__ int lds_byte(int r, int c) { const int st = (r >> 4) * 2 + (c >> 5), rr = r & 15, cc = c & 31, ob = rr * 64 + cc * 2; return st * 1024 + (ob ^ (((ob >> 9) & 1) << 5)); }
__host__ __device__ __forceinline__ void stage_rc(int b, int& R, int& C) { const int st = b / 1024, sb = b % 1024, swz = sb ^ (((sb >> 9) & 1) << 5); R = (st >> 1) * 16 + swz / 64; C = (st & 1) * 32 + (swz % 64) / 2; }
__host__ __device__ __forceinline__ int perm32(int rho) { const int n = rho >> 4, i = rho & 15; return 8 * (i >> 2) + 4 * n + (i & 3); }

struct Unit { int pm, pn; };
struct Gemm { const bf16_t* A; const bf16_t* Bt; int M, N, K; };

struct StaticOrder {
    int nM, nN, nwg, G, c;
    __host__ __device__ void init(int M, int N, int G_, int c_) { nM = M / BM; nN = N / BM; nwg = nM * nN; G = G_; c = c_; }
    __host__ __device__ bool next(int i, Unit& u) const {
        const long L = (long)i * G + c; if (L >= nwg) return false;
        int wgid = (int)L; { const int q = nwg / NXCD, r = nwg % NXCD, xcd = wgid % NXCD, off = wgid / NXCD; wgid = (xcd < r ? xcd * (q + 1) : r * (q + 1) + (xcd - r) * q) + off; }
        const int nig = WGM * nN, gid = wgid / nig, fm = gid * WGM, gsz = (nM - fm) < WGM ? (nM - fm) : WGM;
        u.pm = fm + ((wgid % nig) % gsz); u.pn = (wgid % nig) / gsz; return true;
    }
    __device__ __forceinline__ void a_ready(const Unit&) const {}
    __device__ __forceinline__ void done(const Unit&) const {}
};
typedef float f32x2c __attribute__((ext_vector_type(2)));
typedef __bf16 bf16x2c __attribute__((ext_vector_type(2)));
__device__ __forceinline__ unsigned cvt_pk_bf16(float lo, float hi) { const f32x2c v = {lo, hi}; return __builtin_bit_cast(unsigned, __builtin_convertvector(v, bf16x2c)); }
#define PG8_GAS __attribute__((address_space(1)))
struct UOrder {
    int mode, nM, nN, nwg, G, c, NT; const PG8_LAS int* tab;
    __device__ __forceinline__ void init(int mode_, int M, int N, int G_, int c_) { mode = mode_; nM = M / BM; nN = N / BM; nwg = nM * nN; G = G_; c = c_; NT = 1; tab = nullptr; }
    __device__ __forceinline__ bool next_raw(int i, Unit& u) const {
        const int which = (mode == 1) ? (i & 1) : 0; const int ii = (mode == 1) ? (i >> 1) : i;
        const long L = (long)ii * G + c; if (L >= nwg) return false;
        int wgid = (int)L; { const int q = nwg / NXCD, r = nwg % NXCD, xcd = wgid % NXCD, off = wgid / NXCD; wgid = (xcd < r ? xcd * (q + 1) : r * (q + 1) + (xcd - r) * q) + off; }
        if (mode == 2) {
            int r = wgid, E = 0;
#pragma unroll
            for (int k = 0; k < 7; ++k) { const int uk = tab[k] * NT; if (E == k && r >= uk) { r -= uk; E = k + 1; } }
            const int P = tab[E], B = tab[8 + E];
            const int nig = WGM * NT, gid = r / nig, fm = gid * WGM, gsz = (P - fm) < WGM ? (P - fm) : WGM, rr = r - gid * nig;
            u.pm = B + fm + rr % gsz; u.pn = E * NT + rr / gsz; return true;
        }
        const int nig = WGM * nN, gid = wgid / nig, fm = gid * WGM, gsz = (nM - fm) < WGM ? (nM - fm) : WGM;
        u.pm = fm + ((wgid % nig) % gsz); u.pn = (wgid % nig) / gsz;
        if (which) { u.pm += nM; u.pn += nN; }
        return true;
    }
    __device__ __forceinline__ void a_ready(const Unit&) const {}
    __device__ __forceinline__ void done(const Unit&) const {}
};
struct TOrder {
    const PG8_LAS int* ut; int n;
    __device__ __forceinline__ void build(const UOrder& S, PG8_LAS int* tabl) {
        const int t = threadIdx.x;
        if (t == 0) tabl[512] = 0;
        __syncthreads();
        if (t < 256) { Unit u; u.pm = 0; u.pn = 0; if (S.next_raw(t, u)) { tabl[2 * t] = u.pm; tabl[2 * t + 1] = u.pn; __hip_atomic_fetch_max(tabl + 512, t + 1, __ATOMIC_RELAXED, __HIP_MEMORY_SCOPE_WORKGROUP); } }
        __syncthreads();
        ut = tabl; n = __builtin_amdgcn_readfirstlane(tabl[512]);
    }
    __device__ __forceinline__ bool next(int i, Unit& u) const { if (i >= n) return false; u.pm = __builtin_amdgcn_readfirstlane(ut[2 * i]); u.pn = __builtin_amdgcn_readfirstlane(ut[2 * i + 1]); return true; }
    __device__ __forceinline__ void a_ready(const Unit&) const {}
    __device__ __forceinline__ void done(const Unit&) const {}
};

__device__ __forceinline__ float fsig(float v) { return __builtin_amdgcn_rcpf(1.0f + __expf(-v)); }
__device__ __forceinline__ float bflo(unsigned w) { return __uint_as_float(w << 16); }
__device__ __forceinline__ float bfhi(unsigned w) { return __uint_as_float(w & 0xffff0000u); }
#define PG8_X8(x, ai, bj, m) float x[8]; { const f32x4 _a = acc[ai][bj][m][0], _b = acc[ai][bj][m][1]; x[0] = _a[0]; x[1] = _a[1]; x[2] = _a[2]; x[3] = _a[3]; x[4] = _b[0]; x[5] = _b[1]; x[6] = _b[2]; x[7] = _b[3]; }
#define PG8_PACK8(w, x) u32x4 w; w.x = cvt_pk_bf16(x[0], x[1]); w.y = cvt_pk_bf16(x[2], x[3]); w.z = cvt_pk_bf16(x[4], x[5]); w.w = cvt_pk_bf16(x[6], x[7]);

struct EpiWin {
    static constexpr bool PERM = true, AFTER_DRAIN = false; static constexpr int NST = 16;
    bf16_t* P; const float* lb; size_t pstride;
    __device__ __forceinline__ void operator()(const f32x4 (&acc)[2][2][4][2], const Unit& u, int wr, int wc, int fr, int fq) const {
        const int part = u.pn >> 2;
        const int mode = (part == 0 || part == 3) ? 1 : (part == 1) ? 3 : (part >= 6) ? 2 : 0;
        bf16_t* base = P + (size_t)part * pstride;
        const int row0 = u.pm * BM + wr * 64 + fr, col0 = (u.pn & 3) * BM + wc * 32 + 8 * fq;
        float lbv[2][8];
#pragma unroll
        for (int bj = 0; bj < 2; ++bj)
#pragma unroll
            for (int j = 0; j < 8; ++j) lbv[bj][j] = 0.f;
        if (mode == 3) {
#pragma unroll
            for (int bj = 0; bj < 2; ++bj) { const f32x4 a = *(const PG8_GAS f32x4*)(lb + col0 + bj * HALF), b = *(const PG8_GAS f32x4*)(lb + col0 + bj * HALF + 4);
                lbv[bj][0] = a[0]; lbv[bj][1] = a[1]; lbv[bj][2] = a[2]; lbv[bj][3] = a[3]; lbv[bj][4] = b[0]; lbv[bj][5] = b[1]; lbv[bj][6] = b[2]; lbv[bj][7] = b[3]; }
        }
#pragma unroll
        for (int ai = 0; ai < 2; ++ai)
#pragma unroll
            for (int m = 0; m < 4; ++m) { bf16_t* rowp = base + (size_t)(row0 + ai * HALF + m * 16) * 1024 + col0;
#pragma unroll
                for (int bj = 0; bj < 2; ++bj) { PG8_X8(x, ai, bj, m)
                    if (mode == 1) {
#pragma unroll
                        for (int j = 0; j < 8; ++j) x[j] = x[j] * fsig(x[j]);
                    } else if (mode == 2) {
#pragma unroll
                        for (int j = 0; j < 8; ++j) x[j] = fsig(x[j]);
                    } else if (mode == 3) {
#pragma unroll
                        for (int j = 0; j < 8; ++j) x[j] = fmaxf(__builtin_amdgcn_logf(lbv[bj][j] + (1.0f - lbv[bj][j]) * fsig(x[j])), -43.28f);
                    }
                    PG8_PACK8(w, x) *(PG8_GAS u32x4*)(rowp + bj * HALF) = w; } }
    }
};
struct EpiProj {
    static constexpr bool PERM = true, AFTER_DRAIN = false; static constexpr int NST = 0;
    const bf16_t* gates; size_t pstride; bf16_t* T1; bf16_t* MX;
    __device__ __forceinline__ void operator()(const f32x4 (&acc)[2][2][4][2], const Unit& u, int wr, int wc, int fr, int fq) const {
        const int which = u.pn >> 2;
        const bf16_t* g = gates + (size_t)which * pstride;
        const int row0 = (u.pm & 127) * BM + wr * 64 + fr, col0 = (u.pn & 3) * BM + wc * 32 + 8 * fq;
#pragma unroll
        for (int ai = 0; ai < 2; ++ai)
#pragma unroll
            for (int m = 0; m < 4; ++m) { const size_t off = (size_t)(row0 + ai * HALF + m * 16) * 1024 + col0;
#pragma unroll
                for (int bj = 0; bj < 2; ++bj) { PG8_X8(x, ai, bj, m)
                    const u32x4 gv = *(const PG8_GAS u32x4*)(g + off + bj * HALF);
                    x[0] *= bflo(gv.x); x[1] *= bfhi(gv.x); x[2] *= bflo(gv.y); x[3] *= bfhi(gv.y); x[4] *= bflo(gv.z); x[5] *= bfhi(gv.z); x[6] *= bflo(gv.w); x[7] *= bfhi(gv.w);
                    if (which == 0) { PG8_PACK8(w, x) *(PG8_GAS u32x4*)(T1 + off + bj * HALF) = w; }
                    else { const u32x4 t = *(const PG8_GAS u32x4*)(T1 + off + bj * HALF);
                        x[0] += bflo(t.x); x[1] += bfhi(t.x); x[2] += bflo(t.y); x[3] += bfhi(t.y); x[4] += bflo(t.z); x[5] += bfhi(t.z); x[6] += bflo(t.w); x[7] += bfhi(t.w);
                        PG8_PACK8(w, x) *(PG8_GAS u32x4*)(MX + off + bj * HALF) = w; } } }
    }
};
struct EpiSwi {
    static constexpr bool PERM = true, AFTER_DRAIN = false; static constexpr int NST = 8;
    bf16_t* Gm; int ldg, NT;
    __device__ __forceinline__ void operator()(const f32x4 (&acc)[2][2][4][2], const Unit& u, int wr, int wc, int fr, int fq) const {
        const int pnl = u.pn - (u.pn / NT) * NT;
        const int row0 = u.pm * BM + wr * 64 + fr, col0 = pnl * HALF + wc * 32 + 8 * fq;
#pragma unroll
        for (int ai = 0; ai < 2; ++ai)
#pragma unroll
            for (int m = 0; m < 4; ++m) { bf16_t* rowp = Gm + (size_t)(row0 + ai * HALF + m * 16) * ldg + col0;
                PG8_X8(x, ai, 0, m) PG8_X8(y, ai, 1, m)
#pragma unroll
                for (int j = 0; j < 8; ++j) x[j] = x[j] * fsig(x[j]) * y[j];
                PG8_PACK8(w, x) *(PG8_GAS u32x4*)rowp = w; }
    }
};
struct EpiPlain {
    static constexpr bool PERM = true, AFTER_DRAIN = false; static constexpr int NST = 16;
    bf16_t* O; int ldc;
    __device__ __forceinline__ void operator()(const f32x4 (&acc)[2][2][4][2], const Unit& u, int wr, int wc, int fr, int fq) const {
        const int row0 = u.pm * BM + wr * 64 + fr, col0 = (u.pn & 3) * BM + wc * 32 + 8 * fq;
#pragma unroll
        for (int ai = 0; ai < 2; ++ai)
#pragma unroll
            for (int m = 0; m < 4; ++m) { bf16_t* rowp = O + (size_t)(row0 + ai * HALF + m * 16) * ldc + col0;
#pragma unroll
                for (int bj = 0; bj < 2; ++bj) { PG8_X8(x, ai, bj, m) PG8_PACK8(w, x) *(PG8_GAS u32x4*)(rowp + bj * HALF) = w; } }
    }
};
template <class Epi, class Sched, bool ALIGN_EPI = false, bool SP2 = false>
__device__ __forceinline__ void gemm_phase(PG8_LAS unsigned char* lds, const Gemm g, const Sched& S, const Epi& E) {
    int tid_ = threadIdx.x; asm volatile("" : "+v"(tid_));
    const int tid = tid_, wid = __builtin_amdgcn_readfirstlane(tid >> 6), lane = tid & 63, wr = wid >> 2, wc = wid & 3, fr = lane & 15, fq = lane >> 4;
    const int K = g.K, nt = K / BK;
    unsigned voffA[2], voffB[2];
#pragma unroll
    for (int i = 0; i < 2; ++i) { int R, C; stage_rc(tid * 16 + i * 8192, R, C); const int Rb = Epi::PERM ? ((R & ~31) + perm32(R & 31)) : R;
        voffA[i] = (unsigned)(R * K + C) * 2u; voffB[i] = (unsigned)(Rb * K + C) * 2u; }
    const size_t kstep = (size_t)(BK * 2);
    const size_t hstep = (size_t)HALF * K * 2;
    const size_t tstep = 2 * hstep;
    const unsigned ldsw = (unsigned)wid * 1024u;
    const int aoff = lds_byte(wr * 64 + fr, fq * 8), boff = lds_byte(wc * 32 + fr, fq * 8);
#define PG8_SA(b, h) (((b) * 2 + (h)) * HTB)
#define PG8_SB(b, h) ((4 + (b) * 2 + (h)) * HTB)
#define PG8_STAGE(bufoff, gbase, voff) do { _Pragma("unroll") for (int _i = 0; _i < 2; ++_i) \
        __builtin_amdgcn_global_load_lds((const unsigned*)((const char*)(gbase) + (voff)[_i]), (PG8_LAS unsigned*)(lds + (bufoff) + ldsw + _i * 8192), 16, 0, 0); } while (0)
#define PG8_LDA(dst, b, h) do { _Pragma("unroll") for (int m = 0; m < 4; ++m) _Pragma("unroll") for (int k = 0; k < 2; ++k) dst[m][k] = *(const PG8_LAS bf16x8*)(lds + PG8_SA(b, h) + aoff + m * 2048 + k * 1024); } while (0)
#define PG8_LDB(dst, b, h) do { _Pragma("unroll") for (int n = 0; n < 2; ++n) _Pragma("unroll") for (int k = 0; k < 2; ++k) dst[n][k] = *(const PG8_LAS bf16x8*)(lds + PG8_SB(b, h) + boff + n * 2048 + k * 1024); } while (0)
#define PG8_MMA(ai, bj, At, Bt) do { __builtin_amdgcn_s_setprio(1); _Pragma("unroll") for (int m = 0; m < 4; ++m) _Pragma("unroll") for (int n = 0; n < 2; ++n) _Pragma("unroll") for (int k = 0; k < 2; ++k) \
        acc[ai][bj][m][n] = __builtin_amdgcn_mfma_f32_16x16x32_bf16(Bt[n][k], At[m][k], acc[ai][bj][m][n], 0, 0, 0); __builtin_amdgcn_s_setprio(0); } while (0)
#define PG8_WAIT_V(n) asm volatile("s_waitcnt vmcnt(" #n ")" ::: "memory")
#define PG8_WAIT_L(n) asm volatile("s_waitcnt lgkmcnt(" #n ")" ::: "memory")
#define PG8_BAR __builtin_amdgcn_s_barrier()
#define PG8_SCHED __builtin_amdgcn_sched_barrier(0)
    Unit cur, nxt; int ui = 0;
    if (!S.next(0, cur)) return;
    f32x4 acc[2][2][4][2];
#pragma unroll
    for (int a = 0; a < 2; ++a)
#pragma unroll
        for (int b = 0; b < 2; ++b)
#pragma unroll
            for (int m = 0; m < 4; ++m)
#pragma unroll
                for (int n = 0; n < 2; ++n) acc[a][b][m][n] = (f32x4){0.f, 0.f, 0.f, 0.f};
    bf16x8 At[4][2], B0[2][2], B1[2][2];
    const char* cA = (const char*)g.A + (size_t)cur.pm * tstep; const char* cB = (const char*)g.Bt + (size_t)cur.pn * tstep;
    S.a_ready(cur);
    if constexpr (SP2) {
        PG8_STAGE(PG8_SB(0, 0), cB, voffB); PG8_STAGE(PG8_SB(0, 1), cB + hstep, voffB); PG8_STAGE(PG8_SA(0, 0), cA, voffA); PG8_STAGE(PG8_SA(0, 1), cA + hstep, voffA);
        if (wr == 1) PG8_BAR;
        PG8_WAIT_V(2); PG8_BAR;
        PG8_STAGE(PG8_SB(1, 0), cB + kstep, voffB); PG8_STAGE(PG8_SA(1, 0), cA + kstep, voffA); PG8_STAGE(PG8_SB(1, 1), cB + hstep + kstep, voffB);
        PG8_WAIT_V(6); PG8_BAR;
    } else {
        PG8_STAGE(PG8_SB(0, 0), cB, voffB); PG8_STAGE(PG8_SA(0, 0), cA, voffA); PG8_STAGE(PG8_SB(0, 1), cB + hstep, voffB); PG8_STAGE(PG8_SA(0, 1), cA + hstep, voffA);
        if (wr == 1) PG8_BAR;
        PG8_WAIT_V(4); PG8_BAR;
        PG8_STAGE(PG8_SB(1, 0), cB + kstep, voffB); PG8_STAGE(PG8_SA(1, 0), cA + kstep, voffA); PG8_STAGE(PG8_SB(1, 1), cB + hstep + kstep, voffB);
        PG8_WAIT_V(6); PG8_BAR;
    }
    for (;;) {
        const bool has_next = S.next(ui + 1, nxt);
        const char* nA = has_next ? (const char*)g.A + (size_t)nxt.pm * tstep : cA; const char* nB = has_next ? (const char*)g.Bt + (size_t)nxt.pn * tstep : cB;
        for (int t = 0; t < nt; t += 2) {
            const bool last = (t == nt - 2);
            const char* a1 = cA + (size_t)(t + 1) * kstep;
            const char* a2 = last ? nA : cA + (size_t)(t + 2) * kstep; const char* b2 = last ? nB : cB + (size_t)(t + 2) * kstep;
            const char* a3 = a2 + kstep; const char* b3 = b2 + kstep;
            if (last && has_next) S.a_ready(nxt);
            if constexpr (SP2) {
            PG8_LDB(B0, 0, 0); PG8_LDB(B1, 0, 1); PG8_SCHED; PG8_LDA(At, 0, 0); PG8_STAGE(PG8_SA(1, 1), a1 + hstep, voffA);
            PG8_WAIT_V(8); PG8_WAIT_L(0); PG8_BAR; PG8_MMA(0, 0, At, B0); PG8_MMA(0, 1, At, B1); PG8_BAR; PG8_SCHED;
            PG8_LDA(At, 0, 1); PG8_STAGE(PG8_SB(0, 0), b2, voffB); PG8_STAGE(PG8_SB(0, 1), b2 + hstep, voffB); PG8_STAGE(PG8_SA(0, 0), a2, voffA);
            PG8_WAIT_V(8); PG8_WAIT_L(0); PG8_BAR; PG8_MMA(1, 0, At, B0); PG8_MMA(1, 1, At, B1); PG8_BAR; PG8_SCHED;
            PG8_LDB(B0, 1, 0); PG8_LDB(B1, 1, 1); PG8_SCHED; PG8_LDA(At, 1, 0); PG8_STAGE(PG8_SA(0, 1), a2 + hstep, voffA);
            PG8_WAIT_V(8); PG8_WAIT_L(0); PG8_BAR; PG8_MMA(0, 0, At, B0); PG8_MMA(0, 1, At, B1); PG8_BAR; PG8_SCHED;
            PG8_LDA(At, 1, 1); PG8_STAGE(PG8_SB(1, 0), b3, voffB); PG8_STAGE(PG8_SB(1, 1), b3 + hstep, voffB); PG8_STAGE(PG8_SA(1, 0), a3, voffA);
            PG8_WAIT_V(8); PG8_WAIT_L(0); PG8_BAR; PG8_MMA(1, 0, At, B0); PG8_MMA(1, 1, At, B1); PG8_BAR; PG8_SCHED;
            } else {
            PG8_LDB(B0, 0, 0); PG8_SCHED; PG8_LDA(At, 0, 0); PG8_STAGE(PG8_SA(1, 1), a1 + hstep, voffA);
            PG8_WAIT_L(8); PG8_BAR; PG8_WAIT_L(0); PG8_MMA(0, 0, At, B0); PG8_BAR; PG8_SCHED;
            PG8_LDB(B1, 0, 1); PG8_STAGE(PG8_SB(0, 0), b2, voffB);
            PG8_BAR; PG8_WAIT_L(0); PG8_MMA(0, 1, At, B1); PG8_BAR;
            PG8_LDA(At, 0, 1); PG8_STAGE(PG8_SA(0, 0), a2, voffA);
            PG8_BAR; PG8_WAIT_L(0); PG8_MMA(1, 0, At, B0); PG8_BAR; PG8_SCHED;
            PG8_STAGE(PG8_SB(0, 1), b2 + hstep, voffB);
            PG8_WAIT_V(6); PG8_BAR; PG8_MMA(1, 1, At, B1); PG8_BAR;
            PG8_LDB(B0, 1, 0); PG8_SCHED; PG8_LDA(At, 1, 0); PG8_STAGE(PG8_SA(0, 1), a2 + hstep, voffA);
            PG8_WAIT_L(8); PG8_BAR; PG8_WAIT_L(0); PG8_MMA(0, 0, At, B0); PG8_BAR; PG8_SCHED;
            PG8_LDB(B1, 1, 1); PG8_STAGE(PG8_SB(1, 0), b3, voffB);
            PG8_BAR; PG8_WAIT_L(0); PG8_MMA(0, 1, At, B1); PG8_BAR;
            PG8_LDA(At, 1, 1); PG8_STAGE(PG8_SA(1, 0), a3, voffA);
            PG8_BAR; PG8_WAIT_L(0); PG8_MMA(1, 0, At, B0); PG8_BAR; PG8_SCHED;
            PG8_STAGE(PG8_SB(1, 1), b3 + hstep, voffB);
            PG8_WAIT_V(6); PG8_BAR; PG8_MMA(1, 1, At, B1); PG8_BAR;
            }
        }
        if constexpr (ALIGN_EPI) { if (wr == 0) PG8_BAR; }
#if TPROBE == 23
        if (blockIdx.x == 0 && threadIdx.x == 0) { volatile PG8_LAS unsigned* mp_ = (volatile PG8_LAS unsigned*)(lds + 131072); mp_[48] = (unsigned)wall_clock64(); }
#endif
        if constexpr (!Epi::AFTER_DRAIN) { E(acc, cur, wr, wc, fr, fq); S.done(cur); }
#if TPROBE == 23
        if (blockIdx.x == 0 && threadIdx.x == 0) { volatile PG8_LAS unsigned* mp_ = (volatile PG8_LAS unsigned*)(lds + 131072); mp_[16] += (unsigned)wall_clock64() - mp_[48]; }
#endif
        if (!has_next) break;
#pragma unroll
        for (int a = 0; a < 2; ++a)
#pragma unroll
            for (int b = 0; b < 2; ++b)
#pragma unroll
                for (int m = 0; m < 4; ++m)
#pragma unroll
                    for (int n = 0; n < 2; ++n) acc[a][b][m][n] = (f32x4){0.f, 0.f, 0.f, 0.f};
        cur = nxt; cA = nA; cB = nB; ++ui;
        if constexpr (ALIGN_EPI) { if (wr == 1) PG8_BAR; }
    }
    PG8_WAIT_V(0);
    if constexpr (!ALIGN_EPI) { if (wr == 0) PG8_BAR; }
    PG8_BAR;
    if constexpr (Epi::AFTER_DRAIN) { E.fused(acc, cur, wr, wc, fr, fq, lds, wid, lane); S.done(cur); }
#undef PG8_SA
#undef PG8_SB
#undef PG8_STAGE
#undef PG8_LDA
#undef PG8_LDB
#undef PG8_MMA
#undef PG8_WAIT_V
#undef PG8_WAIT_L
#undef PG8_BAR
#undef PG8_SCHED
}
}
constexpr int NWAVES = 8, NTHR = 512;
constexpr int D = 1024, NBATCH = 8, SEQ = 4096, M = NBATCH * SEQ, DEPTH = 4;
constexpr int DIN = 8192, DFF = 2816, NEXP = 8, DFE = 3584;
constexpr float EPS = 1e-6f;
constexpr size_t MiB = 1u << 20;
constexpr size_t WS_CTL = 0, CTL_ZERO_BYTES = 2 * MiB;
constexpr size_t WS_MOD = 1 * MiB;
constexpr size_t WS_LB = 2 * MiB;
constexpr size_t WS_LI = 2 * MiB + 64 * 1024, WS_LF = WS_LI + 512 * 1024;
constexpr size_t WS_TOKEP = 4 * MiB;
constexpr size_t WS_TOKW = WS_TOKEP + 512 * 1024;
constexpr size_t WS_TOKD = WS_TOKW + 256 * 1024;
constexpr size_t WS_UZ = 5 * MiB;
constexpr size_t WS_WIN = 6 * MiB;
constexpr size_t WS_WAB = 22 * MiB, WAB_STEP = 4 * MiB;
constexpr size_t WS_WO = 30 * MiB, WO_STEP = 2 * MiB;
constexpr size_t WS_WFD = 34 * MiB, WF_W2_DENSE = 12 * MiB;
constexpr size_t WS_WFM = 52 * MiB, WF_W2_MOE = 112 * MiB;
constexpr size_t WS_H = 220 * MiB;
constexpr size_t WS_PROJ = 284 * MiB, PART = 64 * MiB;
constexpr size_t WS_MQ = 796 * MiB, WS_MK = 860 * MiB, WS_MV = 924 * MiB, WS_XC = 988 * MiB;
constexpr size_t WS_AG = 796 * MiB, WS_YS = 928 * MiB;
constexpr size_t WS_XB = 1060 * MiB;
constexpr size_t WS_END = 1124 * MiB;
constexpr size_t PSTRIDE = (size_t)M * 1024;
enum { P_QA = 0, P_LF = 1, P_VA = 2, P_GA = 3, P_XM = 4, P_OS = 5, P_GTA = 6, P_GTB = 7 };
constexpr int CW_BAR = 4096;
constexpr int CW_CNT = 16384;
constexpr int RING_BYTES = 131072, MISC_OFF = RING_BYTES, LDS_BYTES = 147456;

#define GAS __attribute__((address_space(1)))
#define LAS __attribute__((address_space(3)))
typedef unsigned short bf16;
typedef unsigned v4u __attribute__((ext_vector_type(4)));
typedef unsigned v2u __attribute__((ext_vector_type(2)));
typedef float f32x4 __attribute__((ext_vector_type(4)));
typedef float f32x2 __attribute__((ext_vector_type(2)));
typedef int i32x4 __attribute__((ext_vector_type(4)));
typedef int i32x2 __attribute__((ext_vector_type(2)));
#define LDS_WAIT() asm volatile("s_waitcnt lgkmcnt(0)" ::: "memory")
#define VM_WAIT() asm volatile("s_waitcnt vmcnt(0)" ::: "memory")
__device__ __forceinline__ unsigned f2bf(float f) { unsigned u = __builtin_bit_cast(unsigned, f); return (u + 0x7fffu + ((u >> 16) & 1u)) >> 16; }
typedef __bf16 bf16x2_t __attribute__((ext_vector_type(2)));
__device__ __forceinline__ unsigned pk2(float lo, float hi) { const f32x2 v = {lo, hi}; return __builtin_bit_cast(unsigned, __builtin_convertvector(v, bf16x2_t)); }
__device__ __forceinline__ float bflo(unsigned w) { return __uint_as_float(w << 16); }
__device__ __forceinline__ float bfhi(unsigned w) { return __uint_as_float(w & 0xffff0000u); }
__device__ __forceinline__ float bf2f(bf16 b) { return __uint_as_float((unsigned)b << 16); }
__device__ __forceinline__ float fsigm(float v) { return 1.0f / (1.0f + __expf(-v)); }
__device__ __forceinline__ float fsigr(float v) { return __builtin_amdgcn_rcpf(1.0f + __expf(-v)); }
template <int CTRL> __device__ __forceinline__ float dpp_f(float old, float src) { return __builtin_bit_cast(float, __builtin_amdgcn_update_dpp(__builtin_bit_cast(int, old), __builtin_bit_cast(int, src), CTRL, 0xf, 0xf, false)); }
__device__ __forceinline__ float rdlane_f(float v, int l) { return __builtin_bit_cast(float, __builtin_amdgcn_readlane(__builtin_bit_cast(int, v), l)); }
__device__ __forceinline__ float row_allsum(float v) { v += dpp_f<0x128>(0.f, v); v += dpp_f<0x124>(0.f, v); v += dpp_f<0x122>(0.f, v); v += dpp_f<0x121>(0.f, v); return v; }
__device__ __forceinline__ float wave_sum(float v) { const float r = row_allsum(v); return (rdlane_f(r, 0) + rdlane_f(r, 16)) + (rdlane_f(r, 32) + rdlane_f(r, 48)); }
__device__ __forceinline__ float half_sum(float v) {
    const float r = row_allsum(v); const float lo = rdlane_f(r, 0) + rdlane_f(r, 16), hi = rdlane_f(r, 32) + rdlane_f(r, 48);
    return (threadIdx.x & 32) ? hi : lo; }
__device__ __forceinline__ float sum16(float v) {
#pragma unroll
    for (int o = 1; o < 16; o <<= 1) v += __shfl_xor(v, o);
    return v;
}

__device__ __forceinline__ int opq_v(int v) { asm volatile("" : "+v"(v)); return v; }
__device__ __forceinline__ int opq_s(int v) { asm volatile("" : "+s"(v)); return v; }
__device__ __forceinline__ unsigned char* opq_p(unsigned char* p) { asm volatile("" : "+s"(p)); return p; }
#define TID() opq_v((int)threadIdx.x)
#define BID() opq_s((int)blockIdx.x)
#define XB_TMO      128
#define XB_XCNT(j)  (256  + 64 * (j))
#define XB_XSUB(j)  (1280 + 64 * (j))
#define XB_XGEN(j)  (2304 + 64 * (j))
#define XB_TOP      3328
#define XB_TOPGEN   3392
#define XCD_BAR_WORDS 3456
#define XB_SPIN_CAP (1u << 18)

__device__ __forceinline__ unsigned xb_ld(unsigned* p)              { return __hip_atomic_load(p, __ATOMIC_RELAXED, __HIP_MEMORY_SCOPE_AGENT); }
__device__ __forceinline__ unsigned xb_add(unsigned* p, unsigned v) { return __hip_atomic_fetch_add(p, v, __ATOMIC_RELAXED, __HIP_MEMORY_SCOPE_AGENT); }
__device__ __forceinline__ unsigned xb_xcc_id() { return (unsigned)__builtin_amdgcn_s_getreg((3 << 11) | 20) & 0xFu; }
#define XB_SPIN(cond, bar) do { unsigned _sp = 0; while (cond) { __builtin_amdgcn_s_sleep(1); \
    if ((++_sp & 255u) == 0u) { if (xb_ld(&(bar)[XB_TMO])) break; if (_sp > XB_SPIN_CAP) { atomicAdd(&(bar)[XB_TMO], 1u); break; } } } } while (0)

struct XcdBarrier {
    unsigned* bar; unsigned x;
    volatile LAS unsigned* st;
};

__device__ __forceinline__ XcdBarrier xcd_barrier_post(unsigned* bar, volatile LAS unsigned* st) {
    XcdBarrier b; b.bar = bar; b.x = xb_xcc_id(); b.st = st;
    if (threadIdx.x == 0) (void)xb_add(&bar[XB_XCNT(b.x)], 1u);
    return b;
}
__device__ __forceinline__ void xcd_barrier_complete(unsigned* bar, unsigned x, unsigned& nloc, unsigned& nx) {
    const unsigned G = gridDim.x * gridDim.y * gridDim.z;
    unsigned sum, cnt, mine, sp = 0u;
    for (;;) {
        sum = 0u; cnt = 0u; mine = 0u;
#pragma unroll
        for (unsigned j = 0; j < 16; ++j) { const unsigned c = xb_ld(&bar[XB_XCNT(j)]); sum += c; cnt += (c > 0u) ? 1u : 0u; mine = (j == x) ? c : mine; }
        if (sum == G) break;
        __builtin_amdgcn_s_sleep(1);
        if ((++sp & 255u) == 0u) { if (xb_ld(&bar[XB_TMO])) break; if (sp > XB_SPIN_CAP) { atomicAdd(&bar[XB_TMO], 1u); break; } }
    }
    nloc = mine > 0u ? mine : 1u; nx = cnt > 0u ? cnt : 1u;
}

__device__ __forceinline__ void xcd_barrier(const XcdBarrier& b) {
    asm volatile("s_waitcnt vmcnt(0)" ::: "memory");
    __syncthreads();
    if (threadIdx.x == 0) {
        unsigned* bar = b.bar;
        __builtin_amdgcn_s_waitcnt(0);
        unsigned nloc = b.st[0], nx = b.st[1];
        if (nloc == 0u) { xcd_barrier_complete(bar, b.x, nloc, nx); b.st[0] = nloc; b.st[1] = nx; }
        const unsigned old = xb_add(&bar[XB_XSUB(b.x)], 1u);
        const unsigned gen = old / nloc;
        if (old + 1u == (gen + 1u) * nloc) {
            __builtin_amdgcn_fence(__ATOMIC_RELEASE, "agent");
            asm volatile("s_waitcnt vmcnt(0)" ::: "memory");
            const unsigned og = xb_add(&bar[XB_TOP], 1u);
            const unsigned tg = og / nx;
            if (og + 1u == (tg + 1u) * nx) xb_add(&bar[XB_TOPGEN], 1u);
            else XB_SPIN(xb_ld(&bar[XB_TOPGEN]) == tg, bar);
            __builtin_amdgcn_fence(__ATOMIC_ACQUIRE, "agent");
            xb_add(&bar[XB_XGEN(b.x)], 1u);
            asm volatile("s_waitcnt vmcnt(0)" ::: "memory");
        } else {
            XB_SPIN(xb_ld(&bar[XB_XGEN(b.x)]) == gen, bar);
            __builtin_amdgcn_fence(__ATOMIC_ACQUIRE, "agent");
            asm volatile("s_waitcnt vmcnt(0)" ::: "memory");
        }
    }
    __syncthreads();
}
struct Ctx { const float* in[32]; float* out; unsigned char* ws; int ph_lo, ph_hi; };
enum { I_X = 0, I_C, I_WADA, I_BADA, I_GPREMIX, I_GPOSTMIX, I_GPREFFN, I_GPOSTFFN, I_WIN, I_HLB, I_HGN, I_CONVW, I_CONVB, I_WQ, I_WK, I_WV, I_WIG, I_BIG, I_WFG, I_BFG,
       I_MGN, I_MSKIP, I_WPA, I_WPB, I_WOUT, I_F1, I_F3, I_F2, I_ROUTER, I_M1, I_M3, I_M2 };

__device__ __forceinline__ void ph_mod(const Ctx& c, LAS unsigned char* lds) {
    LAS float* cact = (LAS float*)lds;
    LAS float* part = (LAS float*)(lds + 32768);
    GAS float* MOD = (GAS float*)(c.ws + WS_MOD);
    const GAS float* cin = (const GAS float*)c.in[I_C]; const GAS float* wada = (const GAS float*)c.in[I_WADA]; const GAS float* bada = (const GAS float*)c.in[I_BADA];
    const int tid = TID(), lane = tid & 63, wave = tid >> 6;
    for (int i = tid; i < 8192; i += NTHR) { const float v = cin[i]; cact[i] = v * fsigm(v); }
    __syncthreads();
    for (int u = BID(); u < 384; u += gridDim.x) {
        const int l = u / 96, jb = u % 96, j = jb * 64 + lane;
        const GAS float* w = wada + ((size_t)l * 1024 + wave * 128) * 6144 + j;
        const LAS float* ca = cact + wave * 128;
        float a0 = 0.f, a1 = 0.f, a2 = 0.f, a3 = 0.f, a4 = 0.f, a5 = 0.f, a6 = 0.f, a7 = 0.f;
#pragma unroll 8
        for (int k = 0; k < 128; ++k) { const float wv = w[(size_t)k * 6144];
            a0 += ca[k] * wv; a1 += ca[1024 + k] * wv; a2 += ca[2048 + k] * wv; a3 += ca[3072 + k] * wv;
            a4 += ca[4096 + k] * wv; a5 += ca[5120 + k] * wv; a6 += ca[6144 + k] * wv; a7 += ca[7168 + k] * wv; }
        LAS float* pw = part + wave * 512 + lane;
        pw[0] = a0; pw[64] = a1; pw[128] = a2; pw[192] = a3; pw[256] = a4; pw[320] = a5; pw[384] = a6; pw[448] = a7;
        __syncthreads();
        { const int b = wave; float s = bada[l * 6144 + j];
#pragma unroll
            for (int ww = 0; ww < 8; ++ww) s += part[ww * 512 + b * 64 + lane];
            MOD[(size_t)(l * 8 + b) * 6144 + j] = s; }
        __syncthreads();
    }
}
__device__ __forceinline__ void ph_lb(const Ctx& c) {
    if (BID() != 0) return;
    GAS float* LB = (GAS float*)(c.ws + WS_LB); const GAS float* raw = (const GAS float*)c.in[I_HLB];
    for (int col = TID(); col < 1024; col += NTHR) {
        const float r0 = raw[col], r1 = raw[1024 + col], r2 = raw[2048 + col], r3 = raw[3072 + col];
        const float mx = fmaxf(fmaxf(r0, r1), fmaxf(r2, r3));
        const float e0 = __expf(r0 - mx), e1 = __expf(r1 - mx), e2 = __expf(r2 - mx), e3 = __expf(r3 - mx), inv = 1.0f / (e0 + e1 + e2 + e3);
        LB[col] = 0.f; LB[1024 + col] = e1 * inv; LB[2048 + col] = (e1 + e2) * inv; LB[3072 + col] = (e1 + e2 + e3) * inv;
    }
}
struct CvtJob { const float* W; bf16* WT; int K, N, rowbase, mode, item, pad_; };
__device__ __forceinline__ void cvt_load(const CvtJob& j, int lane, f32x4 (&r)[8]) {
    const int nblk = j.N / 32, kb = j.item / nblk, nb = j.item % nblk;
    const GAS float* p = (const GAS float*)j.W + (size_t)(64 * kb + (lane >> 3)) * j.N + 32 * nb + (lane & 7) * 4;
#pragma unroll
    for (int i = 0; i < 8; ++i) r[i] = *(const GAS f32x4*)(p + (size_t)(8 * i) * j.N);
}
__device__ __forceinline__ void cvt_store(const CvtJob& j, int lane, const f32x4 (&r)[8], LAS float* scr) {
    const int nblk = j.N / 32, kb = j.item / nblk, nb = j.item % nblk, k0 = 64 * kb, n0 = 32 * nb;
#pragma unroll
    for (int i = 0; i < 8; ++i) { LAS float* s = scr + (8 * i + (lane >> 3)) * 33 + (lane & 7) * 4; s[0] = r[i][0]; s[1] = r[i][1]; s[2] = r[i][2]; s[3] = r[i][3]; }
    LDS_WAIT(); asm volatile("" ::: "memory");
    const int drow0 = j.rowbase + (j.mode ? ((n0 >> 7) * 256 + (n0 & 127)) : n0);
    const int cc = lane & 7;
#pragma unroll
    for (int jj = 0; jj < 4; ++jj) { const int n = (lane >> 3) + 8 * jj; const LAS float* s = scr + (8 * cc) * 33 + n;
        v4u o; o.x = pk2(s[0 * 33], s[1 * 33]); o.y = pk2(s[2 * 33], s[3 * 33]); o.z = pk2(s[4 * 33], s[5 * 33]); o.w = pk2(s[6 * 33], s[7 * 33]);
        *(GAS v4u*)(j.WT + (size_t)(drow0 + n) * j.K + k0 + 8 * cc) = o; }
    LDS_WAIT(); asm volatile("" ::: "memory");
}
__device__ __forceinline__ CvtJob cvt_decode(const Ctx& c, int l, int it) {
    bf16* WIN = (bf16*)(c.ws + WS_WIN); bf16* WAB = (bf16*)(c.ws + WS_WAB + (size_t)(l & 1) * WAB_STEP); bf16* WO = (bf16*)(c.ws + WS_WO + (size_t)(l & 1) * WO_STEP); bf16* WF = (bf16*)(c.ws + ((l & 1) ? WS_WFM : WS_WFD));
    const bool moe = (l & 1) != 0; const int j = l >> 1;
    constexpr int I_IN = 16 * 256, I_SQ = 16 * 32, I_D13 = 16 * 88, I_M13 = 16 * 112, I_M2E = 56 * 32;
    CvtJob q; q.pad_ = 0; q.mode = 0; q.rowbase = 0; q.K = D; q.N = D;
    int r = it;
    if (r < I_IN) { q.W = c.in[I_WIN] + (size_t)l * D * DIN; q.N = DIN; q.WT = WIN; q.item = r; return q; } r -= I_IN;
    if (r < I_SQ) { q.W = c.in[I_WPA] + (size_t)l * D * D; q.WT = WAB; q.item = r; return q; } r -= I_SQ;
    if (r < I_SQ) { q.W = c.in[I_WPB] + (size_t)l * D * D; q.WT = WAB; q.rowbase = 1024; q.item = r; return q; } r -= I_SQ;
    if (r < I_SQ) { q.W = c.in[I_WOUT] + (size_t)l * D * D; q.WT = WO; q.item = r; return q; } r -= I_SQ;
    if (!moe) {
        if (r < I_D13) { q.W = c.in[I_F1] + (size_t)j * D * DFF; q.N = DFF; q.WT = WF; q.mode = 1; q.item = r; return q; } r -= I_D13;
        if (r < I_D13) { q.W = c.in[I_F3] + (size_t)j * D * DFF; q.N = DFF; q.WT = WF; q.mode = 1; q.rowbase = 128; q.item = r; return q; } r -= I_D13;
        q.W = c.in[I_F2] + (size_t)j * DFF * D; q.K = DFF; q.WT = (bf16*)(c.ws + WS_WFD + WF_W2_DENSE); q.item = r; return q;
    }
    if (r < NEXP * I_M13) { const int e = r / I_M13; q.W = c.in[I_M1] + ((size_t)j * NEXP + e) * D * DFE; q.N = DFE; q.WT = WF; q.mode = 1; q.rowbase = e * 2 * DFE; q.item = r - e * I_M13; return q; } r -= NEXP * I_M13;
    if (r < NEXP * I_M13) { const int e = r / I_M13; q.W = c.in[I_M3] + ((size_t)j * NEXP + e) * D * DFE; q.N = DFE; q.WT = WF; q.mode = 1; q.rowbase = e * 2 * DFE + 128; q.item = r - e * I_M13; return q; } r -= NEXP * I_M13;
    { const int e = r / I_M2E; q.W = c.in[I_M2] + ((size_t)j * NEXP + e) * DFE * D; q.K = DFE; q.WT = (bf16*)(c.ws + WS_WFM + WF_W2_MOE); q.rowbase = e * D; q.item = r - e * I_M2E; return q; }
}
__device__ __forceinline__ void ph_cvt(const Ctx& c, int l, LAS unsigned char* lds, int wg, int nwg, int part) {
    const int tid = TID(), lane = tid & 63, wave = __builtin_amdgcn_readfirstlane(tid >> 6);
    LAS float* scr = (LAS float*)(lds + wave * 16384);
    const int gw = wg * NWAVES + wave, NGW = nwg * NWAVES;
    const bool moe = (l & 1) != 0;
    const int total = 16 * 256 + 3 * 16 * 32 + (moe ? (2 * NEXP * 16 * 112 + NEXP * 56 * 32) : (2 * 16 * 88 + 44 * 32));
    const int first = (part == 1) ? 16 * 256 : 0, last = (part == 0) ? 16 * 256 : total;
    int it = first + gw; if (it >= last) return;
    CvtJob job = cvt_decode(c, l, it); f32x4 ra[8], rb[8]; cvt_load(job, lane, ra);
    for (;;) {
        const int nit = it + NGW; const bool more = nit < last; CvtJob jn = job;
        if (more) { jn = cvt_decode(c, l, nit); cvt_load(jn, lane, rb); }
        cvt_store(job, lane, ra, scr);
        if (!more) break;
#pragma unroll
        for (int i = 0; i < 8; ++i) ra[i] = rb[i];
        job = jn; it = nit;
    }
}

__device__ __forceinline__ void ld_row_f32(const float* p, int lane, f32x4 (&v)[4]) {
#pragma unroll
    for (int j = 0; j < 4; ++j) v[j] = *(const GAS f32x4*)(p + 4 * lane + 256 * j);
}
__device__ __forceinline__ void ld_row_bf16(const bf16* p, int lane, f32x4 (&v)[4]) {
#pragma unroll
    for (int j = 0; j < 4; ++j) { const v2u w = *(const GAS v2u*)(p + 4 * lane + 256 * j); v[j] = (f32x4){bflo(w.x), bfhi(w.x), bflo(w.y), bfhi(w.y)}; }
}
__device__ __forceinline__ void st_row_bf16(bf16* p, int lane, const f32x4 (&v)[4]) {
#pragma unroll
    for (int j = 0; j < 4; ++j) { v2u w; w.x = pk2(v[j][0], v[j][1]); w.y = pk2(v[j][2], v[j][3]); *(GAS v2u*)(p + 4 * lane + 256 * j) = w; }
}
__device__ __forceinline__ float row_sumsq(const f32x4 (&v)[4]) {
    float s = 0.f;
#pragma unroll
    for (int j = 0; j < 4; ++j) s += (v[j][0] * v[j][0] + v[j][1] * v[j][1]) + (v[j][2] * v[j][2] + v[j][3] * v[j][3]);
    return wave_sum(s);
}
__device__ __forceinline__ void norm_mod(const f32x4 (&x)[4], const f32x4 (&g)[4], const f32x4 (&sc)[4], const f32x4 (&sh)[4], f32x4 (&h)[4]) {
    const float r = rsqrtf(row_sumsq(x) * (1.0f / 1024.0f) + EPS);
#pragma unroll
    for (int j = 0; j < 4; ++j) h[j] = (x[j] * r) * g[j] * (sc[j] + 1.0f) + sh[j];
}
__device__ __forceinline__ const float* modp(const Ctx& c, int l, int b, int which) { return (const float*)(c.ws + WS_MOD) + ((size_t)(l * 8 + b) * 6 + which) * 1024; }

__device__ __forceinline__ void ph_norm0(const Ctx& c) {
    const int tid = TID(), lane = tid & 63, wave = tid >> 6, gw = BID() * NWAVES + wave, NGW = gridDim.x * NWAVES;
    bf16* H = (bf16*)(c.ws + WS_H);
    for (int slot = gw; slot < M / 16; slot += NGW) {
        const int row0 = slot * 16, b = row0 / SEQ;
        f32x4 g[4], sc[4], sh[4]; ld_row_f32(c.in[I_GPREMIX], lane, g); ld_row_f32(modp(c, 0, b, 1), lane, sc); ld_row_f32(modp(c, 0, b, 0), lane, sh);
        for (int r = 0; r < 16; ++r) { f32x4 x[4], h[4]; ld_row_f32(c.in[I_X] + (size_t)(row0 + r) * D, lane, x); norm_mod(x, g, sc, sh, h); st_row_bf16(H + (size_t)(row0 + r) * D, lane, h); }
    }
}
__device__ __forceinline__ void ph_uz(const Ctx& c) {
    GAS float* UZ = (GAS float*)(c.ws + WS_UZ);
    const int gt = BID() * NTHR + TID();
    if (gt >= DEPTH * D) return;
    const int l = gt >> 10, ch = gt & 1023, n = ch >> 2, i = ch & 3;
    const GAS float* wq = (const GAS float*)c.in[I_WQ] + (size_t)l * 4096 + n * 16 + i * 4; const GAS float* wk = (const GAS float*)c.in[I_WK] + (size_t)l * 4096 + n * 16 + i * 4; const GAS float* wv = (const GAS float*)c.in[I_WV] + (size_t)l * 4096 + n * 16 + i * 4;
    const GAS float* wig = (const GAS float*)c.in[I_WIG] + (size_t)l * 3072 * 4; const GAS float* wfg = (const GAS float*)c.in[I_WFG] + (size_t)l * 3072 * 4;
    f32x4 ui = {0.f, 0.f, 0.f, 0.f}, uf = ui, zi = ui, zf = ui;
#pragma unroll
    for (int o = 0; o < 4; ++o) { const float q = wq[o], k = wk[o], v = wv[o];
        ui += *(const GAS f32x4*)(wig + (size_t)(4 * n + o) * 4) * q + *(const GAS f32x4*)(wig + (size_t)(1024 + 4 * n + o) * 4) * k; zi += *(const GAS f32x4*)(wig + (size_t)(2048 + 4 * n + o) * 4) * v;
        uf += *(const GAS f32x4*)(wfg + (size_t)(4 * n + o) * 4) * q + *(const GAS f32x4*)(wfg + (size_t)(1024 + 4 * n + o) * 4) * k; zf += *(const GAS f32x4*)(wfg + (size_t)(2048 + 4 * n + o) * 4) * v; }
    GAS f32x4* UP = (GAS f32x4*)(UZ + (size_t)DEPTH * D * 16 + (size_t)l * 16 * D);
    UP[(i * 4 + 0) * 256 + n] = ui; UP[(i * 4 + 1) * 256 + n] = uf; UP[(i * 4 + 2) * 256 + n] = zi; UP[(i * 4 + 3) * 256 + n] = zf;
}
__device__ __forceinline__ void ph_prep(const Ctx& c, int l, LAS unsigned char* lds) {
    const int tid = TID(), lane = tid & 63, wave = tid >> 6, gw = BID() * NWAVES + wave, NGW = gridDim.x * NWAVES;
    LAS f32x4* UZL = (LAS f32x4*)lds;
    LAS f32x4* WTL = (LAS f32x4*)(lds + 65536);
    LAS f32x4* CWL = (LAS f32x4*)(lds + 114688);
    LAS f32x4* CBL = (LAS f32x4*)(lds + 135168);
    {   const GAS f32x4* ut = (const GAS f32x4*)((const float*)(c.ws + WS_UZ) + (size_t)DEPTH * D * 16 + (size_t)l * 16 * D);
        for (int i = tid; i < 4096; i += NTHR) UZL[i] = ut[i];
        for (int i = tid; i < 1024; i += NTHR) { const int ii = i >> 8, n = i & 255; const size_t so = (size_t)l * 4096 + n * 16 + ii * 4;
            WTL[i] = *(const GAS f32x4*)(c.in[I_WQ] + so); WTL[1024 + i] = *(const GAS f32x4*)(c.in[I_WK] + so); WTL[2048 + i] = *(const GAS f32x4*)(c.in[I_WV] + so); }
        for (int i = tid; i < 1024; i += NTHR) CWL[i] = *(const GAS f32x4*)(c.in[I_CONVW] + (size_t)l * 4 * D + i * 4);
        if (tid < 256) CBL[tid] = *(const GAS f32x4*)(c.in[I_CONVB] + (size_t)l * D + tid * 4);
        __syncthreads(); }
    const bf16* XM = (const bf16*)(c.ws + WS_PROJ) + (size_t)P_XM * PSTRIDE;
    bf16* MQ = (bf16*)(c.ws + WS_MQ); bf16* MK = (bf16*)(c.ws + WS_MK); bf16* MV = (bf16*)(c.ws + WS_MV); bf16* XC = (bf16*)(c.ws + WS_XC);
    GAS float* LI = (GAS float*)(c.ws + WS_LI); GAS float* LF = (GAS float*)(c.ws + WS_LF);
    const float* cw = c.in[I_CONVW] + (size_t)l * 4 * D; const float* cb = c.in[I_CONVB] + (size_t)l * D;
    const float* wq = c.in[I_WQ] + (size_t)l * 256 * 16; const float* wk = c.in[I_WK] + (size_t)l * 256 * 16; const float* wv = c.in[I_WV] + (size_t)l * 256 * 16;
    const float* UZ = (const float*)(c.ws + WS_UZ) + (size_t)l * D * 16;
    const int gidx = (lane >> 1) & 7;
    const float gbias = (gidx < 4) ? ((const GAS float*)c.in[I_BIG])[l * 4 + gidx] : ((const GAS float*)c.in[I_BFG])[l * 4 + gidx - 4];
    for (int slot = gw; slot < M / 16; slot += NGW) {
        const int row0 = slot * 16, tq0 = row0 & (SEQ - 1);
#define PREP_WIN(W_, TB_, J_) do { _Pragma("unroll") for (int r = 0; r < 7; ++r) { const int rel_ = (TB_) * 4 - 3 + r; const int rr_ = (tq0 + rel_ >= 0) ? rel_ : 0; \
            W_[r] = *(const GAS v2u*)(XM + (size_t)(row0 + rr_) * D + 4 * lane + 256 * (J_)); } } while (0)
        v2u wn[7]; PREP_WIN(wn, 0, 0);
#pragma unroll 1
        for (int tb = 0; tb < 4; ++tb) {
            f32x4 gi[4], gf[4];
#pragma unroll
            for (int tt = 0; tt < 4; ++tt) { gi[tt] = (f32x4){0.f, 0.f, 0.f, 0.f}; gf[tt] = gi[tt]; }
#pragma unroll 1
            for (int j = 0; j < 4; ++j) {
                const int ch = 4 * lane + 256 * j, n = lane + 64 * j;
                const f32x4 b4 = CBL[n];
                f32x4 xcs[4], xts[4];
                {
                    f32x4 w4[4];
#pragma unroll
                    for (int i = 0; i < 4; ++i) w4[i] = CWL[i * 256 + n];
                    v2u win[7];
#pragma unroll
                    for (int r = 0; r < 7; ++r) { const int rel = tb * 4 - 3 + r; win[r] = (tq0 + rel >= 0) ? wn[r] : (v2u){0u, 0u}; }
                    { const int itn = (tb * 4 + j + 1 < 16) ? tb * 4 + j + 1 : 15; PREP_WIN(wn, itn >> 2, itn & 3); }
#pragma unroll
                    for (int tt = 0; tt < 4; ++tt) {
                        f32x4 y = b4, xt = {0.f, 0.f, 0.f, 0.f};
#pragma unroll
                        for (int jj = 0; jj < 4; ++jj) { const v2u w = win[tt + jj]; const f32x4 xv = {bflo(w.x), bfhi(w.x), bflo(w.y), bfhi(w.y)}; y += w4[jj] * xv; if (jj == 3) xt = xv; }
                        f32x4 xc; xc[0] = y[0] * fsigr(y[0]); xc[1] = y[1] * fsigr(y[1]); xc[2] = y[2] * fsigr(y[2]); xc[3] = y[3] * fsigr(y[3]);
                        xcs[tt] = xc; xts[tt] = xt;
                        { v2u w; w.x = pk2(xc[0], xc[1]); w.y = pk2(xc[2], xc[3]); *(GAS v2u*)(XC + (size_t)(row0 + tb * 4 + tt) * D + ch) = w; }
                    }
                }
                asm volatile("" ::: "memory");
                {
                    f32x4 q4[4], k4[4], v4[4];
#pragma unroll
                    for (int i = 0; i < 4; ++i) { q4[i] = WTL[i * 256 + n]; k4[i] = WTL[1024 + i * 256 + n]; v4[i] = WTL[2048 + i * 256 + n]; }
#pragma unroll
                    for (int tt = 0; tt < 4; ++tt) {
                        f32x4 q = {0.f, 0.f, 0.f, 0.f}, k = q, v = q;
#pragma unroll
                        for (int i = 0; i < 4; ++i) { q += q4[i] * xcs[tt][i]; k += k4[i] * xcs[tt][i]; v += v4[i] * xts[tt][i]; }
                        const size_t off = (size_t)(row0 + tb * 4 + tt) * D + ch;
                        { v2u w; w.x = pk2(q[0], q[1]); w.y = pk2(q[2], q[3]); *(GAS v2u*)(MQ + off) = w; }
                        { v2u w; w.x = pk2(k[0] * 0.0625f, k[1] * 0.0625f); w.y = pk2(k[2] * 0.0625f, k[3] * 0.0625f); *(GAS v2u*)(MK + off) = w; }
                        { v2u w; w.x = pk2(v[0], v[1]); w.y = pk2(v[2], v[3]); *(GAS v2u*)(MV + off) = w; }
                    }
                }
                asm volatile("" ::: "memory");
                {
#pragma unroll
                    for (int i = 0; i < 4; ++i) { const f32x4 u0 = UZL[(i * 4 + 0) * 256 + n], u1 = UZL[(i * 4 + 1) * 256 + n], u2 = UZL[(i * 4 + 2) * 256 + n], u3 = UZL[(i * 4 + 3) * 256 + n];
#pragma unroll
                        for (int tt = 0; tt < 4; ++tt) { gi[tt] += u0 * xcs[tt][i] + u2 * xts[tt][i]; gf[tt] += u1 * xcs[tt][i] + u3 * xts[tt][i]; }
                        __builtin_amdgcn_sched_barrier(0); }
                }
            }
            float v[32];
#pragma unroll
            for (int tt = 0; tt < 4; ++tt)
#pragma unroll
                for (int hh = 0; hh < 4; ++hh) { v[tt * 8 + hh] = gi[tt][hh]; v[tt * 8 + 4 + hh] = gf[tt][hh]; }
#pragma unroll
            for (int st = 0; st < 5; ++st) { const int o = 32 >> st, nn = 32 >> st; const bool up = (lane & o) != 0;
#pragma unroll
                for (int i = 0; i < nn / 2; ++i) { const float lo = v[i], hi = v[i + nn / 2]; const float send = up ? lo : hi, keep = up ? hi : lo; v[i] = keep + __shfl_xor(send, o); } }
            const float tot = v[0] + __shfl_xor(v[0], 1) + gbias;
            if ((lane & 1) == 0) { const int tt = lane >> 4; const size_t row = (size_t)(row0 + tb * 4 + tt);
                if (gidx < 4) LI[row * 4 + gidx] = tot; else LF[row * 4 + gidx - 4] = fminf(tot, 0.f) - __logf(1.0f + __expf(-fabsf(tot))); }
        }
    }
#undef PREP_WIN
}

__device__ __forceinline__ void ph_scan_a_naive(const Ctx& c, LAS unsigned char* lds) {
    const int tid = TID();
    bf16* PJ = (bf16*)(c.ws + WS_PROJ);
    const bf16* Q = PJ + (size_t)P_QA * PSTRIDE; const bf16* LFp = PJ + (size_t)P_LF * PSTRIDE; bf16* V = PJ + (size_t)P_VA * PSTRIDE;
    LAS bf16* sq = (LAS bf16*)lds;
    LAS bf16* sf = (LAS bf16*)(lds + 32768);
    LAS bf16* sv = (LAS bf16*)(lds + 65536);
    LAS float* so = (LAS float*)(lds + 73728);
    const int dg = tid & 15, vv = tid >> 4;
    for (int u = BID(); u < 256; u += gridDim.x) {
        const int b = u >> 5, h = (u >> 2) & 7, vs = u & 3;
        const size_t rowbase = (size_t)b * SEQ;
        float S[8];
#pragma unroll
        for (int j = 0; j < 8; ++j) S[j] = 0.f;
        v4u rq[2], rf[2], rv = {0u, 0u, 0u, 0u};
#define SA_LOAD(ch) do { _Pragma("unroll") for (int k2 = 0; k2 < 2; ++k2) { const int p = tid + NTHR * k2, rr = p >> 4, c8 = p & 15; const size_t o_ = (rowbase + (size_t)(ch) * 64 + rr) * D + h * 128 + c8 * 8; \
            rq[k2] = *(const GAS v4u*)(Q + o_); rf[k2] = *(const GAS v4u*)(LFp + o_); } \
            if (tid < 256) { const int rr = tid >> 2, c8 = tid & 3; rv = *(const GAS v4u*)(V + (rowbase + (size_t)(ch) * 64 + rr) * D + h * 128 + vs * 32 + c8 * 8); } } while (0)
        SA_LOAD(0);
        for (int ch = 0; ch < 64; ++ch) {
            const int buf = ch & 1;
#pragma unroll
            for (int k2 = 0; k2 < 2; ++k2) { const int p = tid + NTHR * k2; *(LAS v4u*)(sq + buf * 8192 + p * 8) = rq[k2]; *(LAS v4u*)(sf + buf * 8192 + p * 8) = rf[k2]; }
            if (tid < 256) *(LAS v4u*)(sv + buf * 2048 + tid * 8) = rv;
            __syncthreads();
            if (ch + 1 < 64) SA_LOAD(ch + 1);
            for (int i = 0; i < 64; ++i) {
                const v4u qv = *(const LAS v4u*)(sq + buf * 8192 + i * 128 + dg * 8), fv = *(const LAS v4u*)(sf + buf * 8192 + i * 128 + dg * 8);
                const float vt = bf2f(sv[buf * 2048 + i * 32 + vv]);
                const float qq[8] = {bflo(qv.x), bfhi(qv.x), bflo(qv.y), bfhi(qv.y), bflo(qv.z), bfhi(qv.z), bflo(qv.w), bfhi(qv.w)};
                const float ff[8] = {bflo(fv.x), bfhi(fv.x), bflo(fv.y), bfhi(fv.y), bflo(fv.z), bfhi(fv.z), bflo(fv.w), bfhi(fv.w)};
                float o = 0.f;
#pragma unroll
                for (int j = 0; j < 8; ++j) { const float f = __expf(ff[j]); S[j] = f * S[j] + (1.0f - f) * vt; o += S[j] * qq[j]; }
                o = sum16(o);
                if (dg == 0) so[i * 32 + vv] = o;
            }
            __syncthreads();
            { const int rr = tid >> 3, c4 = (tid & 7) * 4; const f32x4 ov = *(const LAS f32x4*)(so + rr * 32 + c4);
                v2u w; w.x = pk2(ov[0], ov[1]); w.y = pk2(ov[2], ov[3]); *(GAS v2u*)(V + (rowbase + (size_t)ch * 64 + rr) * D + h * 128 + vs * 32 + c4) = w; }
        }
#undef SA_LOAD
        __syncthreads();
    }
}

__device__ __forceinline__ void ph_scan_m_naive(const Ctx& c, LAS unsigned char* lds) {
    const int tid = TID();
    const bf16* MQ = (const bf16*)(c.ws + WS_MQ); const bf16* MK = (const bf16*)(c.ws + WS_MK); bf16* MV = (bf16*)(c.ws + WS_MV);
    const float* LI = (const float*)(c.ws + WS_LI); const float* LF = (const float*)(c.ws + WS_LF);
    LAS bf16* sq = (LAS bf16*)lds;
    LAS bf16* sk = (LAS bf16*)(lds + 32768);
    LAS bf16* sv = (LAS bf16*)(lds + 65536);
    LAS float* sli = (LAS float*)(lds + 69632);
    LAS float* slf = (LAS float*)(lds + 69888);
    LAS float* so = (LAS float*)(lds + 70144);
    const int dg = tid & 15, vv = tid >> 4;
    for (int u = BID(); u < 256; u += gridDim.x) {
        const int b = u >> 5, h = (u >> 3) & 3, vs = u & 7;
        const size_t rowbase = (size_t)b * SEQ;
        float C[16], nn[16], m = 0.f;
#pragma unroll
        for (int j = 0; j < 16; ++j) { C[j] = 0.f; nn[j] = 0.f; }
        v4u rq[4], rk[4], rv = {0u, 0u, 0u, 0u}; float rli = 0.f, rlf = 0.f;
#define SM_LOAD(ch) do { _Pragma("unroll") for (int k2 = 0; k2 < 4; ++k2) { const int p = tid + NTHR * k2, rr = p >> 5, c8 = p & 31; const size_t o_ = (rowbase + (size_t)(ch) * 64 + rr) * D + h * 256 + c8 * 8; \
            rq[k2] = *(const GAS v4u*)(MQ + o_); rk[k2] = *(const GAS v4u*)(MK + o_); } \
            if (tid < 256) { const int rr = tid >> 2, c8 = tid & 3; rv = *(const GAS v4u*)(MV + (rowbase + (size_t)(ch) * 64 + rr) * D + h * 256 + vs * 32 + c8 * 8); } \
            if (tid < 64) { rli = LI[(rowbase + (size_t)(ch) * 64 + tid) * 4 + h]; rlf = LF[(rowbase + (size_t)(ch) * 64 + tid) * 4 + h]; } } while (0)
        SM_LOAD(0);
        for (int ch = 0; ch < 64; ++ch) {
#pragma unroll
            for (int k2 = 0; k2 < 4; ++k2) { const int p = tid + NTHR * k2; *(LAS v4u*)(sq + p * 8) = rq[k2]; *(LAS v4u*)(sk + p * 8) = rk[k2]; }
            if (tid < 256) *(LAS v4u*)(sv + tid * 8) = rv;
            if (tid < 64) { sli[tid] = rli; slf[tid] = rlf; }
            __syncthreads();
            if (ch + 1 < 64) SM_LOAD(ch + 1);
            for (int i = 0; i < 64; ++i) {
                const float li = sli[i], lf = slf[i];
                const float mn = fmaxf(lf + m, li), fg = __expf(lf + m - mn), ig = __expf(li - mn); m = mn;
                const float vt = bf2f(sv[i * 32 + vv]) * ig;
                float num = 0.f, den = 0.f;
#pragma unroll
                for (int hh = 0; hh < 2; ++hh) {
                    const v4u qv = *(const LAS v4u*)(sq + i * 256 + dg * 16 + hh * 8), kv = *(const LAS v4u*)(sk + i * 256 + dg * 16 + hh * 8);
                    const float qq[8] = {bflo(qv.x), bfhi(qv.x), bflo(qv.y), bfhi(qv.y), bflo(qv.z), bfhi(qv.z), bflo(qv.w), bfhi(qv.w)};
                    const float kk[8] = {bflo(kv.x), bfhi(kv.x), bflo(kv.y), bfhi(kv.y), bflo(kv.z), bfhi(kv.z), bflo(kv.w), bfhi(kv.w)};
#pragma unroll
                    for (int j = 0; j < 8; ++j) { const int jj = hh * 8 + j; C[jj] = fg * C[jj] + kk[j] * vt; nn[jj] = fg * nn[jj] + ig * kk[j]; num += qq[j] * C[jj]; den += qq[j] * nn[jj]; }
                }
                num = sum16(num); den = sum16(den);
                if (dg == 0) so[i * 32 + vv] = num / fmaxf(fabsf(den), __expf(-m));
            }
            __syncthreads();
            { const int rr = tid >> 3, c4 = (tid & 7) * 4; const f32x4 ov = *(const LAS f32x4*)(so + rr * 32 + c4);
                v2u w; w.x = pk2(ov[0], ov[1]); w.y = pk2(ov[2], ov[3]); *(GAS v2u*)(MV + (rowbase + (size_t)ch * 64 + rr) * D + h * 256 + vs * 32 + c4) = w; }
        }
#undef SM_LOAD
        __syncthreads();
    }
}

__device__ __forceinline__ void ph_post(const Ctx& c, int l) {
    const int tid = TID(), lane = tid & 63, wave = tid >> 6, gw = BID() * NWAVES + wave, NGW = gridDim.x * NWAVES;
    bf16* PJ = (bf16*)(c.ws + WS_PROJ);
    const bf16* OS = PJ + (size_t)P_OS * PSTRIDE; bf16* BO = PJ + (size_t)P_LF * PSTRIDE;
    const bf16* HM = (const bf16*)(c.ws + WS_H); const bf16* XC = (const bf16*)(c.ws + WS_XC);
    float gnm[2][8], skp[2][8];
#pragma unroll
    for (int j = 0; j < 2; ++j) { const int c0 = 8 * lane + 512 * j;
        const f32x4 b0 = *(const GAS f32x4*)(c.in[I_MGN] + (size_t)l * D + c0), b1 = *(const GAS f32x4*)(c.in[I_MGN] + (size_t)l * D + c0 + 4);
        const f32x4 s0 = *(const GAS f32x4*)(c.in[I_MSKIP] + (size_t)l * D + c0), s1 = *(const GAS f32x4*)(c.in[I_MSKIP] + (size_t)l * D + c0 + 4);
#pragma unroll
        for (int e = 0; e < 4; ++e) { gnm[j][e] = b0[e]; gnm[j][4 + e] = b1[e]; skp[j][e] = s0[e]; skp[j][4 + e] = s1[e]; } }
#define POST_LOAD(R, ro_) do { _Pragma("unroll") for (int j = 0; j < 2; ++j) { const size_t o_ = (ro_) + 8 * lane + 512 * j; R[0][j] = *(const GAS v4u*)(HM + o_); R[1][j] = *(const GAS v4u*)(XC + o_); R[2][j] = *(const GAS v4u*)(OS + o_); } } while (0)
#define UNPK8(F_, W_) do { const v4u q_ = (W_); F_[0] = bflo(q_.x); F_[1] = bfhi(q_.x); F_[2] = bflo(q_.y); F_[3] = bfhi(q_.y); F_[4] = bflo(q_.z); F_[5] = bfhi(q_.z); F_[6] = bflo(q_.w); F_[7] = bfhi(q_.w); } while (0)
    for (int slot = gw; slot < M / 16; slot += NGW) {
        v4u ra[3][2], rb[3][2], rc[3][2];
        POST_LOAD(ra, (size_t)(slot * 16) * D); POST_LOAD(rb, (size_t)(slot * 16 + 1) * D);
        for (int r = 0; r < 16; ++r) {
            const size_t ro = (size_t)(slot * 16 + r) * D;
            if (r + 2 < 16) POST_LOAD(rc, ro + 2 * D);
#pragma unroll
            for (int j = 0; j < 2; ++j) {
                float hm[8], xc[8], orw[8], bo[8];
                UNPK8(hm, ra[0][j]); UNPK8(xc, ra[1][j]); UNPK8(orw, ra[2][j]);
                float sm = 0.f;
#pragma unroll
                for (int e = 0; e < 8; ++e) sm += hm[e];
                const float mu = half_sum(sm) * (1.0f / 256.0f);
                float vs_ = 0.f;
#pragma unroll
                for (int e = 0; e < 8; ++e) { hm[e] -= mu; vs_ += hm[e] * hm[e]; }
                const float rsb = rsqrtf(half_sum(vs_) * (1.0f / 256.0f) + EPS);
#pragma unroll
                for (int e = 0; e < 8; ++e) bo[e] = fsigm(orw[e]) * (hm[e] * rsb * gnm[j][e] + skp[j][e] * xc[e]);
                *(GAS v4u*)(BO + ro + 8 * lane + 512 * j) = (v4u){pk2(bo[0], bo[1]), pk2(bo[2], bo[3]), pk2(bo[4], bo[5]), pk2(bo[6], bo[7])};
            }
#pragma unroll
            for (int s = 0; s < 3; ++s)
#pragma unroll
                for (int j = 0; j < 2; ++j) { ra[s][j] = rb[s][j]; rb[s][j] = rc[s][j]; }
        }
    }
#undef POST_LOAD
#undef UNPK8
}
typedef short bf16x8 __attribute__((ext_vector_type(8)));
#define MFMA16(a, b, c) __builtin_amdgcn_mfma_f32_16x16x32_bf16(a, b, c, 0, 0, 0)
__device__ __forceinline__ f32x4 mmT(const LAS bf16* X, int ldx, int m0, const LAS bf16* Y, int ldy, int n0, int k0, f32x4 acc, int lane) {
    const bf16x8 a = *(const LAS bf16x8*)(X + (m0 + (lane & 15)) * ldx + k0 + 8 * (lane >> 4));
    const bf16x8 b = *(const LAS bf16x8*)(Y + (n0 + (lane & 15)) * ldy + k0 + 8 * (lane >> 4));
    return MFMA16(b, a, acc);
}
__device__ __forceinline__ f32x4 mmN(const LAS bf16* X, int ldx, int m0, const LAS bf16* Y, int ldy, int n0, int k0, f32x4 acc, int lane) {
    const bf16x8 a = *(const LAS bf16x8*)(X + (m0 + (lane & 15)) * ldx + k0 + 8 * (lane >> 4));
    const bf16x8 b = *(const LAS bf16x8*)(Y + (n0 + (lane & 15)) * ldy + k0 + 8 * (lane >> 4));
    return MFMA16(a, b, acc);
}
__device__ __forceinline__ v2u pack4(const f32x4 v) { v2u w; w.x = pk2(v[0], v[1]); w.y = pk2(v[2], v[3]); return w; }

__device__ __forceinline__ bf16x8 tr_frag(const LAS bf16* T, int ld, int k0, int m0, int lane) {
    const int g = lane >> 4, q = (lane & 15) >> 2, p = lane & 3;
    const unsigned a0 = (unsigned)(size_t)(T + (k0 + 8 * g + q) * ld + m0 + 4 * p), a1 = a0 + (unsigned)(4 * ld * 2);
    v2u x, y; asm volatile("ds_read_b64_tr_b16 %0, %2\n\tds_read_b64_tr_b16 %1, %3\n\ts_waitcnt lgkmcnt(0)" : "=&v"(x), "=&v"(y) : "v"(a0), "v"(a1) : "memory");
    const v4u w = {x.x, x.y, y.x, y.y}; return __builtin_bit_cast(bf16x8, w);
}
struct Frag2 { bf16x8 a, b; };
__device__ __forceinline__ Frag2 tr_frag2(const LAS bf16* Ta, int lda, int k0a, int m0a, const LAS bf16* Tb, int ldb, int k0b, int m0b, int lane) {
    const int g = lane >> 4, q = (lane & 15) >> 2, p = lane & 3;
    const unsigned a0 = (unsigned)(size_t)(Ta + (k0a + 8 * g + q) * lda + m0a + 4 * p), a1 = a0 + (unsigned)(4 * lda * 2);
    const unsigned b0 = (unsigned)(size_t)(Tb + (k0b + 8 * g + q) * ldb + m0b + 4 * p), b1 = b0 + (unsigned)(4 * ldb * 2);
    v2u x, y, z, w; asm volatile("ds_read_b64_tr_b16 %0, %4\n\tds_read_b64_tr_b16 %1, %5\n\tds_read_b64_tr_b16 %2, %6\n\tds_read_b64_tr_b16 %3, %7\n\ts_waitcnt lgkmcnt(0)"
        : "=&v"(x), "=&v"(y), "=&v"(z), "=&v"(w) : "v"(a0), "v"(a1), "v"(b0), "v"(b1) : "memory");
    const v4u wa = {x.x, x.y, y.x, y.y}, wb = {z.x, z.y, w.x, w.y}; Frag2 r; r.a = __builtin_bit_cast(bf16x8, wa); r.b = __builtin_bit_cast(bf16x8, wb); return r;
}
#define TRH(P_, Q_) __builtin_bit_cast(bf16x8, (v4u){(P_).x, (P_).y, (Q_).x, (Q_).y})
__device__ __forceinline__ void tr_hgrn(const LAS bf16* LV, const LAS bf16* LK, int wave, int lane, bf16x8 (&vf)[4][2], bf16x8 (&kf)[2]) {
    const int g = lane >> 4, q = (lane & 15) >> 2, p = lane & 3;
    const unsigned av = (unsigned)(size_t)(LV + (8 * g + q) * 72 + 4 * p), ak = (unsigned)(size_t)(LK + (8 * g + q) * 136 + 4 * p + wave * 16);
    v2u a0, a1, a2, a3, a4, a5, a6, a7, b0, b1, b2, b3, b4, b5, b6, b7, k0, k1, k2, k3;
    asm volatile(
        "ds_read_b64_tr_b16 %0, %20\n\tds_read_b64_tr_b16 %1, %20 offset:576\n\tds_read_b64_tr_b16 %2, %20 offset:32\n\tds_read_b64_tr_b16 %3, %20 offset:608\n\t"
        "ds_read_b64_tr_b16 %4, %20 offset:64\n\tds_read_b64_tr_b16 %5, %20 offset:640\n\tds_read_b64_tr_b16 %6, %20 offset:96\n\tds_read_b64_tr_b16 %7, %20 offset:672\n\t"
        "ds_read_b64_tr_b16 %8, %20 offset:4608\n\tds_read_b64_tr_b16 %9, %20 offset:5184\n\tds_read_b64_tr_b16 %10, %20 offset:4640\n\tds_read_b64_tr_b16 %11, %20 offset:5216\n\t"
        "ds_read_b64_tr_b16 %12, %20 offset:4672\n\tds_read_b64_tr_b16 %13, %20 offset:5248\n\tds_read_b64_tr_b16 %14, %20 offset:4704\n\tds_read_b64_tr_b16 %15, %20 offset:5280\n\t"
        "ds_read_b64_tr_b16 %16, %21\n\tds_read_b64_tr_b16 %17, %21 offset:1088\n\tds_read_b64_tr_b16 %18, %21 offset:8704\n\tds_read_b64_tr_b16 %19, %21 offset:9792\n\t"
        "s_waitcnt lgkmcnt(0)"
        : "=&v"(a0), "=&v"(a1), "=&v"(a2), "=&v"(a3), "=&v"(a4), "=&v"(a5), "=&v"(a6), "=&v"(a7), "=&v"(b0), "=&v"(b1), "=&v"(b2), "=&v"(b3), "=&v"(b4), "=&v"(b5), "=&v"(b6), "=&v"(b7),
          "=&v"(k0), "=&v"(k1), "=&v"(k2), "=&v"(k3)
        : "v"(av), "v"(ak) : "memory");
    vf[0][0] = TRH(a0, a1); vf[1][0] = TRH(a2, a3); vf[2][0] = TRH(a4, a5); vf[3][0] = TRH(a6, a7);
    vf[0][1] = TRH(b0, b1); vf[1][1] = TRH(b2, b3); vf[2][1] = TRH(b4, b5); vf[3][1] = TRH(b6, b7);
    kf[0] = TRH(k0, k1); kf[1] = TRH(k2, k3);
}
__device__ __forceinline__ void tr_mnum(const LAS bf16* LV0, int e0, int lane, bf16x8 (&f)[3][2]) {
    const int g = lane >> 4, q = (lane & 15) >> 2, p = lane & 3;
    const unsigned av = (unsigned)(size_t)(LV0 + (8 * g + q) * 88 + 4 * p + e0), ad = (unsigned)(size_t)(LV0 + (8 * g + q) * 88 + 4 * p + 64);
    v2u a0, a1, a2, a3, a4, a5, b0, b1, b2, b3, b4, b5;
    asm volatile(
        "ds_read_b64_tr_b16 %0, %12\n\tds_read_b64_tr_b16 %1, %12 offset:704\n\tds_read_b64_tr_b16 %2, %12 offset:32\n\tds_read_b64_tr_b16 %3, %12 offset:736\n\tds_read_b64_tr_b16 %4, %13\n\tds_read_b64_tr_b16 %5, %13 offset:704\n\t"
        "ds_read_b64_tr_b16 %6, %12 offset:5632\n\tds_read_b64_tr_b16 %7, %12 offset:6336\n\tds_read_b64_tr_b16 %8, %12 offset:5664\n\tds_read_b64_tr_b16 %9, %12 offset:6368\n\tds_read_b64_tr_b16 %10, %13 offset:5632\n\tds_read_b64_tr_b16 %11, %13 offset:6336\n\t"
        "s_waitcnt lgkmcnt(0)"
        : "=&v"(a0), "=&v"(a1), "=&v"(a2), "=&v"(a3), "=&v"(a4), "=&v"(a5), "=&v"(b0), "=&v"(b1), "=&v"(b2), "=&v"(b3), "=&v"(b4), "=&v"(b5)
        : "v"(av), "v"(ad) : "memory");
    f[0][0] = TRH(a0, a1); f[1][0] = TRH(a2, a3); f[2][0] = TRH(a4, a5); f[0][1] = TRH(b0, b1); f[1][1] = TRH(b2, b3); f[2][1] = TRH(b4, b5);
}
template <int KS> __device__ __forceinline__ void tr_mupd(const LAS bf16* LK, const LAS bf16* LV1, int wave, int lane, bf16x8 (&af)[2], bf16x8 (&wf)[5]) {
    const int g = lane >> 4, q = (lane & 15) >> 2, p = lane & 3;
    const unsigned ak = (unsigned)(size_t)(LK + (KS * 32 + 8 * g + q) * 264 + 4 * p + wave * 32), av = (unsigned)(size_t)(LV1 + (KS * 32 + 8 * g + q) * 88 + 4 * p);
    v2u k0, k1, k2, k3, a0, a1, a2, a3, a4, a5, a6, a7, a8, a9;
    asm volatile(
        "ds_read_b64_tr_b16 %0, %14\n\tds_read_b64_tr_b16 %1, %14 offset:2112\n\tds_read_b64_tr_b16 %2, %14 offset:32\n\tds_read_b64_tr_b16 %3, %14 offset:2144\n\t"
        "ds_read_b64_tr_b16 %4, %15\n\tds_read_b64_tr_b16 %5, %15 offset:704\n\tds_read_b64_tr_b16 %6, %15 offset:32\n\tds_read_b64_tr_b16 %7, %15 offset:736\n\t"
        "ds_read_b64_tr_b16 %8, %15 offset:64\n\tds_read_b64_tr_b16 %9, %15 offset:768\n\tds_read_b64_tr_b16 %10, %15 offset:96\n\tds_read_b64_tr_b16 %11, %15 offset:800\n\t"
        "ds_read_b64_tr_b16 %12, %15 offset:128\n\tds_read_b64_tr_b16 %13, %15 offset:832\n\t"
        "s_waitcnt lgkmcnt(0)"
        : "=&v"(k0), "=&v"(k1), "=&v"(k2), "=&v"(k3), "=&v"(a0), "=&v"(a1), "=&v"(a2), "=&v"(a3), "=&v"(a4), "=&v"(a5), "=&v"(a6), "=&v"(a7), "=&v"(a8), "=&v"(a9)
        : "v"(ak), "v"(av) : "memory");
    af[0] = TRH(k0, k1); af[1] = TRH(k2, k3); wf[0] = TRH(a0, a1); wf[1] = TRH(a2, a3); wf[2] = TRH(a4, a5); wf[3] = TRH(a6, a7); wf[4] = TRH(a8, a9);
}
__device__ __forceinline__ float wave_scan_sum(float v, int lane) {
    v += dpp_f<0x111>(0.f, v); v += dpp_f<0x112>(0.f, v); v += dpp_f<0x114>(0.f, v); v += dpp_f<0x118>(0.f, v);
    const float r0 = rdlane_f(v, 15), r1 = rdlane_f(v, 31), r2 = rdlane_f(v, 47); const int row = lane >> 4;
    return v + (row == 1 ? r0 : row == 2 ? r0 + r1 : row == 3 ? (r0 + r1) + r2 : 0.f);
}
__device__ __forceinline__ float wave_scan_max(float v, int lane) {
    const float NI = -3.0e38f;
    v = fmaxf(v, dpp_f<0x111>(NI, v)); v = fmaxf(v, dpp_f<0x112>(NI, v)); v = fmaxf(v, dpp_f<0x114>(NI, v)); v = fmaxf(v, dpp_f<0x118>(NI, v));
    const float r0 = rdlane_f(v, 15), r1 = rdlane_f(v, 31), r2 = rdlane_f(v, 47); const int row = lane >> 4;
    return fmaxf(v, row == 1 ? r0 : row == 2 ? fmaxf(r0, r1) : row == 3 ? fmaxf(fmaxf(r0, r1), r2) : NI);
}
__device__ __forceinline__ void scan_a_unit(const Ctx& c, LAS unsigned char* lds, int u, int tid, int lane, int wave) {
    bf16* PJ = (bf16*)(c.ws + WS_PROJ);
    const bf16* Q = PJ + (size_t)P_QA * PSTRIDE; const bf16* LFp = PJ + (size_t)P_LF * PSTRIDE; const bf16* V = PJ + (size_t)P_VA * PSTRIDE; bf16* OA = PJ + (size_t)P_XM * PSTRIDE;
    LAS bf16* LQ = (LAS bf16*)lds;
    LAS bf16* LK = (LAS bf16*)(lds + 17408);
    LAS bf16* LV = (LAS bf16*)(lds + 34816);
    LAS bf16* LP = (LAS bf16*)(lds + 44032);
    LAS bf16* LST = (LAS bf16*)(lds + 53248);
    LAS float* SEG = (LAS float*)(lds + 70656);
    LAS float* ER = (LAS float*)(lds + 74752);
    LAS float* EB = (LAS float*)(lds + 75264);
    LAS float* EK = (LAS float*)(lds + 75776);
    const int ux = u & 7, uk = u >> 3, bh_ = ux * 8 + (uk >> 1), vs = uk & 1, b = bh_ >> 3, h = bh_ & 7;
    const size_t rowbase = (size_t)b * SEQ;
    f32x4 S[4];
#pragma unroll
    for (int j = 0; j < 4; ++j) S[j] = (f32x4){0.f, 0.f, 0.f, 0.f};
    unsigned rq[8], rf[8]; v4u rv;
#define SA_LOAD(ch) do { const int lo_ = opq_v(wave * 8 * D + h * 128 + 2 * lane), lv_ = opq_v((tid >> 3) * D + h * 128 + vs * 64 + (tid & 7) * 8); const size_t cb_ = (rowbase + (size_t)(ch) * 64) * D; \
        const GAS bf16* qp_ = (const GAS bf16*)Q + cb_ + lo_; const GAS bf16* fp_ = (const GAS bf16*)LFp + cb_ + lo_; \
        _Pragma("unroll") for (int i = 0; i < 8; ++i) { rq[i] = *(const GAS unsigned*)(qp_ + (size_t)i * D); rf[i] = *(const GAS unsigned*)(fp_ + (size_t)i * D); } \
        rv = *(const GAS v4u*)((const GAS bf16*)V + cb_ + lv_); } while (0)
    SA_LOAD(0);
    for (int ch = 0; ch < 64; ++ch) {
        float f0[8], f1[8], q0[8], q1[8]; float run0 = 0.f, run1 = 0.f;
#pragma unroll
        for (int i = 0; i < 8; ++i) { const float a0 = bflo(rf[i]), a1 = bfhi(rf[i]); f0[i] = __expf(a0); f1[i] = __expf(a1); run0 += a0; run1 += a1; q0[i] = bflo(rq[i]); q1[i] = bfhi(rq[i]); }
        *(LAS f32x2*)(SEG + wave * 128 + 2 * lane) = (f32x2){run0, run1};
        const v4u rvc = rv;
        if (ch + 1 < 64) SA_LOAD(ch + 1);
        __syncthreads();
        float pre0 = 0.f, pre1 = 0.f, r0 = 0.f, r1 = 0.f, t0_ = 0.f, t1_ = 0.f;
#pragma unroll
        for (int w = 0; w < 8; ++w) { const f32x2 sg = *(const LAS f32x2*)(SEG + w * 128 + 2 * lane); if (w < wave) { pre0 += sg.x; pre1 += sg.y; } if (w < 4) { r0 += sg.x; r1 += sg.y; } t0_ += sg.x; t1_ += sg.y; }
        *(LAS v4u*)(LV + (tid >> 3) * 72 + (tid & 7) * 8) = rvc;
        {   float g0 = __expf(pre0 - r0), g1 = __expf(pre1 - r1), e0 = __expf(r0 - (pre0 + run0)), e1 = __expf(r1 - (pre1 + run1));
            unsigned kq[8];
#pragma unroll
            for (int i = 0; i < 8; ++i) { g0 *= f0[i]; g1 *= f1[i]; *(LAS unsigned*)(LQ + (wave * 8 + i) * 136 + 2 * lane) = pk2(q0[i] * g0, q1[i] * g1); }
#pragma unroll
            for (int i = 7; i >= 0; --i) { kq[i] = pk2((1.0f - f0[i]) * e0, (1.0f - f1[i]) * e1); e0 *= f0[i]; e1 *= f1[i]; }
#pragma unroll
            for (int i = 0; i < 8; ++i) *(LAS unsigned*)(LK + (wave * 8 + i) * 136 + 2 * lane) = kq[i];
        }
        if (wave == 0) { *(LAS f32x2*)(ER + 2 * lane) = (f32x2){__expf(r0), __expf(r1)}; *(LAS f32x2*)(EB + 2 * lane) = (f32x2){__expf(t0_), __expf(t1_)}; *(LAS f32x2*)(EK + 2 * lane) = (f32x2){__expf(t0_ - r0), __expf(t1_ - r1)}; }
        __syncthreads();
        {
            const int tt = wave >> 1;
#pragma unroll
            for (int jj = 0; jj < 2; ++jj) { const int st = (wave & 1) * 2 + jj; f32x4 acc = {0.f, 0.f, 0.f, 0.f};
                if (st <= tt) {
#pragma unroll
                    for (int kk = 0; kk < 4; ++kk) acc = mmT(LQ, 136, tt * 16, LK, 136, st * 16, kk * 32, acc, lane);
                    if (st == tt) {
#pragma unroll
                        for (int e = 0; e < 4; ++e) if (4 * (lane >> 4) + e > (lane & 15)) acc[e] = 0.f; } }
                *(LAS v2u*)(LP + (tt * 16 + (lane & 15)) * 72 + st * 16 + 4 * (lane >> 4)) = pack4(acc); }
            const f32x4 er4 = *(const LAS f32x4*)(ER + wave * 16 + 4 * (lane >> 4));
#pragma unroll
            for (int j = 0; j < 4; ++j) *(LAS v2u*)(LST + (j * 16 + (lane & 15)) * 136 + wave * 16 + 4 * (lane >> 4)) = pack4(S[j] * er4);
        }
        __syncthreads();
        {
            bf16x8 vfr[4][2], kfv[2]; tr_hgrn(LV, LK, wave, lane, vfr, kfv);
            const bf16x8 vf00 = vfr[0][0], vf10 = vfr[1][0], vf20 = vfr[2][0], vf30 = vfr[3][0], vf01 = vfr[0][1], vf11 = vfr[1][1], vf21 = vfr[2][1], vf31 = vfr[3][1];
            struct { bf16x8 a, b; } kfr; kfr.a = kfv[0]; kfr.b = kfv[1];
            const int t0 = (wave >> 1) * 16; const bool hi = (wave & 1) != 0;
            const bf16x8 pf0 = *(const LAS bf16x8*)(LP + (t0 + (lane & 15)) * 72 + 8 * (lane >> 4)), pf1 = *(const LAS bf16x8*)(LP + (t0 + (lane & 15)) * 72 + 32 + 8 * (lane >> 4));
            f32x4 o0 = {0.f, 0.f, 0.f, 0.f}, o1 = o0;
            o0 = MFMA16(hi ? vf20 : vf00, pf0, o0); o0 = MFMA16(hi ? vf21 : vf01, pf1, o0);
            o1 = MFMA16(hi ? vf30 : vf10, pf0, o1); o1 = MFMA16(hi ? vf31 : vf11, pf1, o1);
            const int e0 = hi ? 32 : 0;
#pragma unroll
            for (int kk = 0; kk < 4; ++kk) { const bf16x8 qf = *(const LAS bf16x8*)(LQ + (t0 + (lane & 15)) * 136 + kk * 32 + 8 * (lane >> 4));
                const bf16x8 s0f = *(const LAS bf16x8*)(LST + (e0 + (lane & 15)) * 136 + kk * 32 + 8 * (lane >> 4)), s1f = *(const LAS bf16x8*)(LST + (e0 + 16 + (lane & 15)) * 136 + kk * 32 + 8 * (lane >> 4));
                o0 = MFMA16(s0f, qf, o0); o1 = MFMA16(s1f, qf, o1); }
            GAS bf16* op = (GAS bf16*)OA + (rowbase + (size_t)ch * 64) * D + opq_v((t0 + (lane & 15)) * D + h * 128 + vs * 64 + e0 + 4 * (lane >> 4));
            *(GAS v2u*)op = pack4(o0); *(GAS v2u*)(op + 16) = pack4(o1);
            const f32x4 eb4 = *(const LAS f32x4*)(EB + wave * 16 + 4 * (lane >> 4)), ek4 = *(const LAS f32x4*)(EK + wave * 16 + 4 * (lane >> 4));
            f32x4 up;
            up = (f32x4){0.f, 0.f, 0.f, 0.f}; up = MFMA16(kfr.a, vf00, up); up = MFMA16(kfr.b, vf01, up); S[0] = eb4 * S[0] + ek4 * up;
            up = (f32x4){0.f, 0.f, 0.f, 0.f}; up = MFMA16(kfr.a, vf10, up); up = MFMA16(kfr.b, vf11, up); S[1] = eb4 * S[1] + ek4 * up;
            up = (f32x4){0.f, 0.f, 0.f, 0.f}; up = MFMA16(kfr.a, vf20, up); up = MFMA16(kfr.b, vf21, up); S[2] = eb4 * S[2] + ek4 * up;
            up = (f32x4){0.f, 0.f, 0.f, 0.f}; up = MFMA16(kfr.a, vf30, up); up = MFMA16(kfr.b, vf31, up); S[3] = eb4 * S[3] + ek4 * up;
        }
    }
#undef SA_LOAD
    __syncthreads();
}

__device__ __forceinline__ void tr_v4(const LAS bf16* LVe, int lane, bf16x8 (&vf)[4][2]) {
    const int g = lane >> 4, q = (lane & 15) >> 2, p = lane & 3;
    const unsigned av = (unsigned)(size_t)(LVe + (8 * g + q) * 136 + 4 * p);
    v2u a0, a1, a2, a3, a4, a5, a6, a7, b0, b1, b2, b3, b4, b5, b6, b7;
    asm volatile(
        "ds_read_b64_tr_b16 %0, %16\n\tds_read_b64_tr_b16 %1, %16 offset:1088\n\tds_read_b64_tr_b16 %2, %16 offset:32\n\tds_read_b64_tr_b16 %3, %16 offset:1120\n\t"
        "ds_read_b64_tr_b16 %4, %16 offset:64\n\tds_read_b64_tr_b16 %5, %16 offset:1152\n\tds_read_b64_tr_b16 %6, %16 offset:96\n\tds_read_b64_tr_b16 %7, %16 offset:1184\n\t"
        "ds_read_b64_tr_b16 %8, %16 offset:8704\n\tds_read_b64_tr_b16 %9, %16 offset:9792\n\tds_read_b64_tr_b16 %10, %16 offset:8736\n\tds_read_b64_tr_b16 %11, %16 offset:9824\n\t"
        "ds_read_b64_tr_b16 %12, %16 offset:8768\n\tds_read_b64_tr_b16 %13, %16 offset:9856\n\tds_read_b64_tr_b16 %14, %16 offset:8800\n\tds_read_b64_tr_b16 %15, %16 offset:9888\n\t"
        "s_waitcnt lgkmcnt(0)"
        : "=&v"(a0), "=&v"(a1), "=&v"(a2), "=&v"(a3), "=&v"(a4), "=&v"(a5), "=&v"(a6), "=&v"(a7), "=&v"(b0), "=&v"(b1), "=&v"(b2), "=&v"(b3), "=&v"(b4), "=&v"(b5), "=&v"(b6), "=&v"(b7)
        : "v"(av) : "memory");
    vf[0][0] = TRH(a0, a1); vf[1][0] = TRH(a2, a3); vf[2][0] = TRH(a4, a5); vf[3][0] = TRH(a6, a7);
    vf[0][1] = TRH(b0, b1); vf[1][1] = TRH(b2, b3); vf[2][1] = TRH(b4, b5); vf[3][1] = TRH(b6, b7);
}
__device__ __forceinline__ void tr_k2(const LAS bf16* LK, int wave, int lane, bf16x8 (&kf)[2]) {
    const int g = lane >> 4, q = (lane & 15) >> 2, p = lane & 3;
    const unsigned ak = (unsigned)(size_t)(LK + (8 * g + q) * 136 + 4 * p + wave * 16);
    v2u k0, k1, k2, k3;
    asm volatile("ds_read_b64_tr_b16 %0, %4\n\tds_read_b64_tr_b16 %1, %4 offset:1088\n\tds_read_b64_tr_b16 %2, %4 offset:8704\n\tds_read_b64_tr_b16 %3, %4 offset:9792\n\ts_waitcnt lgkmcnt(0)"
        : "=&v"(k0), "=&v"(k1), "=&v"(k2), "=&v"(k3) : "v"(ak) : "memory");
    kf[0] = TRH(k0, k1); kf[1] = TRH(k2, k3);
}
#ifndef TPROBE
#define TPROBE -1
#endif
#ifndef TPS
#define TPS 0
#endif
#ifndef TPB
#define TPB 0
#endif
#define TS_MARK(UN_, K_) do { if (TPROBE == (UN_) && blockIdx.x == TPB && threadIdx.x == 0) { volatile LAS unsigned* mp_ = (volatile LAS unsigned*)(lds + MISC_OFF); const unsigned now_ = (unsigned)wall_clock64(); if (TPS == (K_)) mp_[16] += now_ - mp_[48]; mp_[48] = now_; } } while (0)
__device__ __forceinline__ void rd_sc12(unsigned aq, unsigned ak, v4u (&q)[4], v4u (&k0)[4], v4u (&k1)[4]) {
    asm volatile(
        "ds_read_b128 %0, %12\n\tds_read_b128 %1, %12 offset:64\n\tds_read_b128 %2, %12 offset:128\n\tds_read_b128 %3, %12 offset:192\n\t"
        "ds_read_b128 %4, %13\n\tds_read_b128 %5, %13 offset:64\n\tds_read_b128 %6, %13 offset:128\n\tds_read_b128 %7, %13 offset:192\n\t"
        "ds_read_b128 %8, %13 offset:4352\n\tds_read_b128 %9, %13 offset:4416\n\tds_read_b128 %10, %13 offset:4480\n\tds_read_b128 %11, %13 offset:4544\n\t"
        "s_waitcnt lgkmcnt(0)"
        : "=&v"(q[0]), "=&v"(q[1]), "=&v"(q[2]), "=&v"(q[3]), "=&v"(k0[0]), "=&v"(k0[1]), "=&v"(k0[2]), "=&v"(k0[3]), "=&v"(k1[0]), "=&v"(k1[1]), "=&v"(k1[2]), "=&v"(k1[3])
        : "v"(aq), "v"(ak) : "memory");
}
__device__ __forceinline__ void rd_qs10(unsigned aq, unsigned as, v4u (&q)[2], v4u (&x)[2][4]) {
    asm volatile(
        "ds_read_b128 %0, %10\n\tds_read_b128 %1, %10 offset:64\n\t"
        "ds_read_b128 %2, %11\n\tds_read_b128 %3, %11 offset:4352\n\tds_read_b128 %4, %11 offset:8704\n\tds_read_b128 %5, %11 offset:13056\n\t"
        "ds_read_b128 %6, %11 offset:64\n\tds_read_b128 %7, %11 offset:4416\n\tds_read_b128 %8, %11 offset:8768\n\tds_read_b128 %9, %11 offset:13120\n\t"
        "s_waitcnt lgkmcnt(0)"
        : "=&v"(q[0]), "=&v"(q[1]), "=&v"(x[0][0]), "=&v"(x[0][1]), "=&v"(x[0][2]), "=&v"(x[0][3]), "=&v"(x[1][0]), "=&v"(x[1][1]), "=&v"(x[1][2]), "=&v"(x[1][3])
        : "v"(aq), "v"(as) : "memory");
}
__device__ __forceinline__ void scan_a_full_unit(const Ctx& c, LAS unsigned char* lds, int u, int l, int tid, int lane, int wave) {
    bf16* PJ = (bf16*)(c.ws + WS_PROJ);
    const bf16* Q = PJ + (size_t)P_QA * PSTRIDE; const bf16* LFp = PJ + (size_t)P_LF * PSTRIDE; const bf16* V = PJ + (size_t)P_VA * PSTRIDE; const bf16* GR = PJ + (size_t)P_GA * PSTRIDE;
    bf16* AO = PJ + (size_t)P_QA * PSTRIDE;
    const float* GN = c.in[I_HGN] + (size_t)l * D;
    LAS bf16* LQ0 = (LAS bf16*)lds;
    LAS bf16* LK0 = (LAS bf16*)(lds + 34816);
    LAS bf16* LV = (LAS bf16*)(lds + 69632);
    LAS bf16* LP = (LAS bf16*)(lds + 87040);
    LAS bf16* LST = (LAS bf16*)(lds + 96256);
    LAS float* SEG = (LAS float*)(lds + 131328);
    LAS float* E0 = (LAS float*)(lds + 135424);
    LAS float* SS = (LAS float*)(lds + 138496);
    LAS float* GNL = (LAS float*)(lds + 139008);
    const int b = u >> 3, h = u & 7;
    const size_t rowbase = (size_t)b * SEQ;
    const int t0 = (wave >> 1) * 16, eh = (wave & 1) * 64;
    f32x4 S[8], po[4]; v2u pg[4];
#pragma unroll
    for (int j = 0; j < 8; ++j) S[j] = (f32x4){0.f, 0.f, 0.f, 0.f};
#pragma unroll
    for (int j = 0; j < 4; ++j) { po[j] = (f32x4){0.f, 0.f, 0.f, 0.f}; pg[j] = (v2u){0u, 0u}; }
    if (tid < 128) GNL[tid] = GN[h * 128 + tid];
    unsigned rq[8], rf[8]; v4u rv0, rv1;
    float f0[8], f1[8], q0[8], q1[8]; float run0 = 0.f, run1 = 0.f;
#define SF_LOADQF(ch) do { const unsigned lo_ = (unsigned)opq_v((wave * 8 * D + h * 128 + 2 * lane) * 2); const size_t cb_ = (rowbase + (size_t)(ch) * 64) * D; \
        const GAS char* qb_ = (const GAS char*)((const GAS bf16*)Q + cb_); const GAS char* fb_ = (const GAS char*)((const GAS bf16*)LFp + cb_);     \
        _Pragma("unroll") for (int i = 0; i < 8; ++i) { rq[i] = *(const GAS unsigned*)(qb_ + (lo_ + (unsigned)(i * D * 2))); rf[i] = *(const GAS unsigned*)(fb_ + (lo_ + (unsigned)(i * D * 2))); } } while (0)
#define SF_LOADV(ch) do { const unsigned lv_ = (unsigned)opq_v(((tid >> 4) * D + h * 128 + (tid & 15) * 8) * 2); const GAS char* vb_ = (const GAS char*)((const GAS bf16*)V + (rowbase + (size_t)(ch) * 64) * D); \
        rv0 = *(const GAS v4u*)(vb_ + lv_); rv1 = *(const GAS v4u*)(vb_ + (lv_ + (unsigned)(32 * D * 2))); } while (0)
#define SF_T() do { run0 = 0.f; run1 = 0.f; \
        _Pragma("unroll") for (int i = 0; i < 8; ++i) { const float a0 = bflo(rf[i]), a1 = bfhi(rf[i]); f0[i] = __builtin_amdgcn_exp2f(a0); f1[i] = __builtin_amdgcn_exp2f(a1); run0 += a0; run1 += a1; q0[i] = bflo(rq[i]); q1[i] = bfhi(rq[i]); } \
        *(LAS f32x2*)(SEG + wave * 128 + 2 * lane) = (f32x2){run0, run1}; } while (0)
#define SF_A(PAR_) do { LAS bf16* LQn_ = LQ0 + (PAR_) * 8704; LAS bf16* LKn_ = LK0 + (PAR_) * 8704; LAS float* En_ = E0 + (PAR_) * 384; \
        float pre0 = 0.f, pre1 = 0.f, r0 = 0.f, r1 = 0.f, t0_ = 0.f, t1_ = 0.f; \
        _Pragma("unroll") for (int w = 0; w < 8; ++w) { const f32x2 sg = *(const LAS f32x2*)(SEG + w * 128 + 2 * lane); if (w < wave) { pre0 += sg.x; pre1 += sg.y; } if (w < 4) { r0 += sg.x; r1 += sg.y; } t0_ += sg.x; t1_ += sg.y; } \
        float g0 = __builtin_amdgcn_exp2f(pre0 - r0), g1 = __builtin_amdgcn_exp2f(pre1 - r1), e0 = __builtin_amdgcn_exp2f(r0 - (pre0 + run0)), e1 = __builtin_amdgcn_exp2f(r1 - (pre1 + run1)); unsigned kq[8]; \
        _Pragma("unroll") for (int i = 0; i < 8; ++i) { g0 *= f0[i]; g1 *= f1[i]; *(LAS unsigned*)(LQn_ + (wave * 8 + i) * 136 + 2 * lane) = pk2(q0[i] * g0, q1[i] * g1); } \
        _Pragma("unroll") for (int i = 7; i >= 0; --i) { kq[i] = pk2((1.0f - f0[i]) * e0, (1.0f - f1[i]) * e1); e0 *= f0[i]; e1 *= f1[i]; } \
        _Pragma("unroll") for (int i = 0; i < 8; ++i) *(LAS unsigned*)(LKn_ + (wave * 8 + i) * 136 + 2 * lane) = kq[i]; \
        if (wave == 0) { *(LAS f32x2*)(En_ + 2 * lane) = (f32x2){__builtin_amdgcn_exp2f(r0), __builtin_amdgcn_exp2f(r1)}; *(LAS f32x2*)(En_ + 128 + 2 * lane) = (f32x2){__builtin_amdgcn_exp2f(t0_), __builtin_amdgcn_exp2f(t1_)}; *(LAS f32x2*)(En_ + 256 + 2 * lane) = (f32x2){__builtin_amdgcn_exp2f(t0_ - r0), __builtin_amdgcn_exp2f(t1_ - r1)}; } } while (0)
#define SF_FINAL(cp) do { const int lr_ = opq_v(lane & 15), lg_ = opq_v(lane >> 4); const f32x2 s2_ = *(const LAS f32x2*)(SS + 2 * (t0 + lr_)); \
        const float rs_ = rsqrtf((s2_.x + s2_.y) * (1.0f / 128.0f) + EPS); \
        _Pragma("unroll") for (int jj = 0; jj < 4; ++jj) { const int col_ = h * 128 + eh + 16 * jj + 4 * lg_; const f32x4 gn_ = *(const LAS f32x4*)(GNL + eh + 16 * jj + 4 * lg_); \
            const f32x4 gr_ = {bflo(pg[jj].x), bfhi(pg[jj].x), bflo(pg[jj].y), bfhi(pg[jj].y)}; f32x4 a_; \
            _Pragma("unroll") for (int e = 0; e < 4; ++e) a_[e] = po[jj][e] * rs_ * gn_[e] * gr_[e]; \
            *(GAS v2u*)((GAS char*)((GAS bf16*)AO + (rowbase + (size_t)(cp) * 64) * D) + (unsigned)(((t0 + lr_) * D + col_) * 2)) = pack4(a_); } } while (0)
    SF_LOADQF(0); SF_LOADV(0);
    SF_T(); SF_LOADQF(1);
    __syncthreads();
    SF_A(0);
    __syncthreads();
    for (int ch = 0; ch < 64; ++ch) {
        const int par = ch & 1;
        const LAS bf16* LQ = LQ0 + par * 8704; const LAS bf16* LK = LK0 + par * 8704; const LAS float* EC = E0 + par * 384;
        {
            const int tt = wave >> 1; f32x4 acc0 = {0.f, 0.f, 0.f, 0.f}, acc1 = acc0;
            if ((wave & 1) * 2 <= tt) {
                v4u qa[4], ka[4], kb[4];
                rd_sc12((unsigned)(size_t)(LQ + (tt * 16 + (lane & 15)) * 136 + 8 * (lane >> 4)), (unsigned)(size_t)(LK + ((wave & 1) * 32 + (lane & 15)) * 136 + 8 * (lane >> 4)), qa, ka, kb);
#pragma unroll
                for (int kk = 0; kk < 4; ++kk) { acc0 = MFMA16(__builtin_bit_cast(bf16x8, ka[kk]), __builtin_bit_cast(bf16x8, qa[kk]), acc0); acc1 = MFMA16(__builtin_bit_cast(bf16x8, kb[kk]), __builtin_bit_cast(bf16x8, qa[kk]), acc1); }
            }
#pragma unroll
            for (int jj = 0; jj < 2; ++jj) { const int st = (wave & 1) * 2 + jj; f32x4 acc = jj ? acc1 : acc0;
                if (st > tt) acc = (f32x4){0.f, 0.f, 0.f, 0.f};
                if (st == tt) {
#pragma unroll
                    for (int e = 0; e < 4; ++e) if (4 * (lane >> 4) + e > (lane & 15)) acc[e] = 0.f; }
                *(LAS v2u*)(LP + (tt * 16 + (lane & 15)) * 72 + st * 16 + 4 * (lane >> 4)) = pack4(acc); }
            const f32x4 er4 = *(const LAS f32x4*)(EC + wave * 16 + 4 * (lane >> 4));
#pragma unroll
            for (int j = 0; j < 8; ++j) *(LAS v2u*)(LST + (j * 16 + (lane & 15)) * 136 + wave * 16 + 4 * (lane >> 4)) = pack4(S[j] * er4);
        }
        __builtin_amdgcn_sched_barrier(0);
        if (ch > 0) SF_FINAL(ch - 1);
        __builtin_amdgcn_sched_barrier(0);
        { const GAS char* gb_ = (const GAS char*)((const GAS bf16*)GR + (rowbase + (size_t)ch * 64) * D); const unsigned go_ = (unsigned)opq_v(((t0 + (lane & 15)) * D + h * 128 + eh + 4 * (lane >> 4)) * 2);
#pragma unroll
          for (int jj = 0; jj < 4; ++jj) pg[jj] = *(const GAS v2u*)(gb_ + (go_ + (unsigned)(32 * jj))); }
        SF_T(); __builtin_amdgcn_sched_barrier(0);
        { const int c2 = (ch + 2 < 64) ? ch + 2 : 63; SF_LOADQF(c2); }
        __builtin_amdgcn_sched_barrier(0);
        *(LAS v4u*)(LV + (tid >> 4) * 136 + (tid & 15) * 8) = rv0; *(LAS v4u*)(LV + (32 + (tid >> 4)) * 136 + (tid & 15) * 8) = rv1;
        __syncthreads();
        TS_MARK(22, 0);
        { const int c1 = (ch + 1 < 64) ? ch + 1 : 63; SF_LOADV(c1); }
        {
            bf16x8 kf[2]; tr_k2(LK, wave, lane, kf);
            const f32x4 eb4 = *(const LAS f32x4*)(EC + 128 + wave * 16 + 4 * (lane >> 4)), ek4 = *(const LAS f32x4*)(EC + 256 + wave * 16 + 4 * (lane >> 4));
            const bf16x8 pf0 = *(const LAS bf16x8*)(LP + (t0 + (lane & 15)) * 72 + 8 * (lane >> 4)), pf1 = *(const LAS bf16x8*)(LP + (t0 + (lane & 15)) * 72 + 32 + 8 * (lane >> 4));
#pragma unroll
            for (int jj = 0; jj < 4; ++jj) po[jj] = (f32x4){0.f, 0.f, 0.f, 0.f};
#pragma unroll
            for (int hb = 0; hb < 2; ++hb) {
                bf16x8 vf[4][2]; tr_v4(LV + hb * 64, lane, vf);
                if (hb == (wave & 1)) {
#pragma unroll
                    for (int jj = 0; jj < 4; ++jj) { po[jj] = MFMA16(vf[jj][0], pf0, po[jj]); po[jj] = MFMA16(vf[jj][1], pf1, po[jj]); }
                }
#pragma unroll
                for (int jj = 0; jj < 4; ++jj) { f32x4 up = {0.f, 0.f, 0.f, 0.f}; up = MFMA16(kf[0], vf[jj][0], up); up = MFMA16(kf[1], vf[jj][1], up); S[hb * 4 + jj] = eb4 * S[hb * 4 + jj] + ek4 * up; }
            }
#pragma unroll
            for (int k2 = 0; k2 < 2; ++k2) { v4u qf[2], sf[2][4];
                rd_qs10((unsigned)(size_t)(LQ + (t0 + (lane & 15)) * 136 + k2 * 64 + 8 * (lane >> 4)), (unsigned)(size_t)(LST + (eh + (lane & 15)) * 136 + k2 * 64 + 8 * (lane >> 4)), qf, sf);
#pragma unroll
                for (int kk = 0; kk < 2; ++kk)
#pragma unroll
                    for (int jj = 0; jj < 4; ++jj) po[jj] = MFMA16(__builtin_bit_cast(bf16x8, sf[kk][jj]), __builtin_bit_cast(bf16x8, qf[kk]), po[jj]); }
            float ssq = 0.f;
#pragma unroll
            for (int jj = 0; jj < 4; ++jj) ssq += (po[jj][0] * po[jj][0] + po[jj][1] * po[jj][1]) + (po[jj][2] * po[jj][2] + po[jj][3] * po[jj][3]);
            ssq += __shfl_xor(ssq, 16); ssq += __shfl_xor(ssq, 32);
            if (lane < 16) SS[2 * (t0 + lane) + (wave & 1)] = ssq;
        }
        __builtin_amdgcn_sched_barrier(0);
        SF_A(par ^ 1);
        __syncthreads();
        TS_MARK(22, 1);
    }
    SF_FINAL(63);
#undef SF_LOADQF
#undef SF_LOADV
#undef SF_T
#undef SF_A
#undef SF_FINAL
    __syncthreads();
}

__device__ __forceinline__ void scan_m_unit(const Ctx& c, LAS unsigned char* lds, int u, int tid, int lane, int wave) {
    const bf16* MQ = (const bf16*)(c.ws + WS_MQ); const bf16* MK = (const bf16*)(c.ws + WS_MK); const bf16* MV = (const bf16*)(c.ws + WS_MV); bf16* HM = (bf16*)(c.ws + WS_H);
    const GAS float* LI = (const GAS float*)(c.ws + WS_LI); const GAS float* LF = (const GAS float*)(c.ws + WS_LF);
    LAS bf16* LK = (LAS bf16*)lds;
    LAS bf16* LV0 = (LAS bf16*)(lds + 33792);
    LAS bf16* LV1 = (LAS bf16*)(lds + 45056);
    LAS bf16* LP = (LAS bf16*)(lds + 56320);
    LAS bf16* LCT = (LAS bf16*)(lds + 65536);
    LAS float* AS = (LAS float*)(lds + 107776);
    LAS float* MXS = (LAS float*)(lds + 108032);
    LAS float* BS = (LAS float*)(lds + 108288);
    const int ux = u & 7, uk = u >> 3, bh_ = ux * 4 + (uk >> 2), vs = uk & 3, b = bh_ >> 2, h = bh_ & 3;
    const size_t rowbase = (size_t)b * SEQ;
    const int t0 = (wave >> 1) * 16;
    f32x4 C[2][5];
#pragma unroll
    for (int i = 0; i < 2; ++i)
#pragma unroll
        for (int j = 0; j < 5; ++j) C[i][j] = (f32x4){0.f, 0.f, 0.f, 0.f};
    float m = 0.f;
    for (int i = tid; i < 64 * 24; i += NTHR) { const int row = i / 24, col = 64 + i % 24; LV0[row * 88 + col] = (bf16)(col == 64 ? 0x3f80u : 0u); LV1[row * 88 + col] = (bf16)0u; }
    v4u qf[8], rk[4], rv; float rli, rlf;
#define SM_LOAD(ch) do { const int lk_ = opq_v((tid >> 5) * D + h * 256 + (tid & 31) * 8), lv_ = opq_v((tid >> 3) * D + h * 256 + vs * 64 + (tid & 7) * 8), lg_ = opq_v(lane * 4 + h); \
        const GAS bf16* kp_ = (const GAS bf16*)MK + (rowbase + (size_t)(ch) * 64) * D + lk_; \
        _Pragma("unroll") for (int k2 = 0; k2 < 4; ++k2) rk[k2] = *(const GAS v4u*)(kp_ + (size_t)k2 * 16 * D); \
        rv = *(const GAS v4u*)((const GAS bf16*)MV + (rowbase + (size_t)(ch) * 64) * D + lv_); \
        rli = LI[(rowbase + (size_t)(ch) * 64) * 4 + lg_]; rlf = LF[(rowbase + (size_t)(ch) * 64) * 4 + lg_]; } while (0)
#define SM_LOADQ(ch) do { const int lq_ = opq_v((t0 + (lane & 15)) * D + h * 256 + 8 * (lane >> 4)); const GAS bf16* qp_ = (const GAS bf16*)MQ + (rowbase + (size_t)(ch) * 64) * D + lq_; \
        _Pragma("unroll") for (int kk = 0; kk < 8; ++kk) qf[kk] = *(const GAS v4u*)(qp_ + kk * 32); } while (0)
    SM_LOAD(0); SM_LOADQ(0);
    float nbb = wave_scan_sum(rlf, lane), naa = rli - nbb, npm = wave_scan_max(naa, lane);
    for (int ch = 0; ch < 64; ++ch) {
        const int lane0 = lane; const int lane = opq_v(lane0), tid = opq_v((wave << 6) | lane0);
        const int lr = lane & 15, lq4 = lane >> 4, bK = lr * 264 + 8 * lq4, bC = lr * 264 + 4 * lq4, bP8 = lr * 72 + 8 * lq4, bP4 = lr * 72 + 4 * lq4;
        __syncthreads();
        TS_MARK(21, 0);
        const float bb = nbb, aa = naa, pm = npm;
        const float mx = fmaxf(m, pm);
        const float b63 = rdlane_f(bb, 63), mx63 = rdlane_f(mx, 63);
        if (wave == 0) { AS[lane] = aa; MXS[lane] = mx; BS[lane] = bb; LV1[lane * 88 + 64] = (bf16)f2bf(__expf(aa - mx63)); }
        { const int p = tid; *(LAS v4u*)(LK + (p >> 5) * 264 + (p & 31) * 8) = rk[0]; *(LAS v4u*)(LK + ((p + 512) >> 5) * 264 + (p & 31) * 8) = rk[1]; *(LAS v4u*)(LK + ((p + 1024) >> 5) * 264 + (p & 31) * 8) = rk[2]; *(LAS v4u*)(LK + ((p + 1536) >> 5) * 264 + (p & 31) * 8) = rk[3]; }
        { const int rr = tid >> 3; const float wv = __expf(__shfl(aa, rr) - mx63); const v4u rvc = rv;
          *(LAS v4u*)(LV0 + rr * 88 + (tid & 7) * 8) = rvc;
          v4u sv; sv.x = pk2(bflo(rvc.x) * wv, bfhi(rvc.x) * wv); sv.y = pk2(bflo(rvc.y) * wv, bfhi(rvc.y) * wv); sv.z = pk2(bflo(rvc.z) * wv, bfhi(rvc.z) * wv); sv.w = pk2(bflo(rvc.w) * wv, bfhi(rvc.w) * wv);
          *(LAS v4u*)(LV1 + rr * 88 + (tid & 7) * 8) = sv; }
        const float m_old = m;
        if (ch + 1 < 64) SM_LOAD(ch + 1);
        __syncthreads();
        TS_MARK(21, 1);
        {
            const int tt = wave >> 1;
#pragma unroll
            for (int jj = 0; jj < 2; ++jj) { const int st = (wave & 1) * 2 + jj; f32x4 acc = {0.f, 0.f, 0.f, 0.f};
                if (st <= tt) {
#pragma unroll
                    for (int kk = 0; kk < 8; ++kk) { const bf16x8 kfr = *(const LAS bf16x8*)(LK + bK + st * (16 * 264) + kk * 32); acc = MFMA16(kfr, __builtin_bit_cast(bf16x8, qf[kk]), acc); if ((kk & 3) == 3) __builtin_amdgcn_sched_barrier(0); }
                    const f32x4 a4 = *(const LAS f32x4*)(AS + st * 16 + 4 * lq4); const float mxt = MXS[tt * 16 + lr];
#pragma unroll
                    for (int e = 0; e < 4; ++e) acc[e] = (st == tt && 4 * lq4 + e > lr) ? 0.f : acc[e] * __expf(a4[e] - mxt); }
                *(LAS v2u*)(LP + bP4 + tt * (16 * 72) + st * 16) = pack4(acc); }
#pragma unroll
            for (int i = 0; i < 2; ++i)
#pragma unroll
                for (int j = 0; j < 5; ++j) *(LAS v2u*)(LCT + bC + j * (16 * 264) + (wave * 2 + i) * 16) = pack4(C[i][j]);
        }
        __syncthreads();
        TS_MARK(21, 2);
        {
            const int e0 = (wave & 1) * 32; f32x4 p0 = {0.f, 0.f, 0.f, 0.f}, p1 = p0, pd = p0, c0 = p0, c1 = p0, cd = p0;
            { bf16x8 vn[3][2]; tr_mnum(LV0, e0, lane, vn);
#pragma unroll
              for (int kk = 0; kk < 2; ++kk) { const bf16x8 pf = *(const LAS bf16x8*)(LP + bP8 + t0 * 72 + kk * 32);
                p0 = MFMA16(vn[0][kk], pf, p0); p1 = MFMA16(vn[1][kk], pf, p1); pd = MFMA16(vn[2][kk], pf, pd); } }
#pragma unroll
            for (int kk = 0; kk < 8; ++kk) { const bf16x8 q8 = __builtin_bit_cast(bf16x8, qf[kk]);
                const LAS bf16* xb_ = LCT + bK + e0 * 264 + kk * 32; const bf16x8 x0 = *(const LAS bf16x8*)xb_, x1 = *(const LAS bf16x8*)(xb_ + 16 * 264), xd = *(const LAS bf16x8*)(LCT + bK + 64 * 264 + kk * 32);
                c0 = MFMA16(x0, q8, c0); c1 = MFMA16(x1, q8, c1); cd = MFMA16(xd, q8, cd); if (kk & 1) __builtin_amdgcn_sched_barrier(0); }
            const float mxt = MXS[t0 + lr], bt = BS[t0 + lr], wi = __expf(m_old - mxt);
            const float den = __shfl(pd[0] + wi * cd[0], lr);
            const float inv = 1.0f / fmaxf(fabsf(den), __expf(-(bt + mxt)));
            GAS bf16* hp = (GAS bf16*)HM + (rowbase + (size_t)ch * 64) * D + opq_v((t0 + (lane & 15)) * D + h * 256 + vs * 64 + e0 + 4 * (lane >> 4));
            *(GAS v2u*)hp = pack4((p0 + c0 * wi) * inv); *(GAS v2u*)(hp + 16) = pack4((p1 + c1 * wi) * inv);
            const float dec = __expf(m_old - mx63);
#pragma unroll
            for (int i = 0; i < 2; ++i)
#pragma unroll
                for (int j = 0; j < 5; ++j) C[i][j] = C[i][j] * dec;
            { bf16x8 af[2], wf[5];
              tr_mupd<0>(LK, LV1, wave, lane, af, wf);
#pragma unroll
              for (int j = 0; j < 5; ++j) { C[0][j] = MFMA16(af[0], wf[j], C[0][j]); C[1][j] = MFMA16(af[1], wf[j], C[1][j]); }
              tr_mupd<1>(LK, LV1, wave, lane, af, wf);
#pragma unroll
              for (int j = 0; j < 5; ++j) { C[0][j] = MFMA16(af[0], wf[j], C[0][j]); C[1][j] = MFMA16(af[1], wf[j], C[1][j]); } }
            m = b63 + mx63;
            if (ch + 1 < 64) SM_LOADQ(ch + 1);
            nbb = wave_scan_sum(rlf, lane); naa = rli - nbb; npm = wave_scan_max(naa, lane);
        }
    }
#undef SM_LOAD
#undef SM_LOADQ
    __syncthreads();
}
#ifndef DLY_A
#define DLY_A 0
#define DLY_M 0
#define DLY_C 0
#endif
__device__ __forceinline__ void ph_scans(const Ctx& c, LAS unsigned char* lds, int l) {
    const int tid = TID(), lane = tid & 63, wave = __builtin_amdgcn_readfirstlane(tid >> 6);
    for (int u = BID(); u < 256; u += gridDim.x) {
#if DLY_A || DLY_M || DLY_C
        { const int dl = (u < 64) ? DLY_A : (u < 192) ? DLY_M : DLY_C; for (int i = 0; i < dl; ++i) { __builtin_amdgcn_s_sleep(127); asm volatile("" ::: "memory"); } }
#endif
        if (u < 64) scan_a_full_unit(c, lds, u, l, tid, lane, wave);
        else if (u < 192) scan_m_unit(c, lds, u - 64, tid, lane, wave);
        else { if (l + 1 < DEPTH) { ph_cvt(c, l + 1, lds, u - 192, 64, 2); __syncthreads(); } }
    }
}
constexpr int TAB_OFF = MISC_OFF + 256, UT_OFF = MISC_OFF + 512;
__device__ __forceinline__ void moe_tables(const Ctx& c, int jm, LAS unsigned char* lds) {
    LAS int* tab = (LAS int*)(lds + TAB_OFF);
    __syncthreads();
    const int t = TID();
    if (t < 64) {
        unsigned* cnt = (unsigned*)c.ws + CW_CNT + 64 * jm;
        const int n = (t < 8) ? (int)__hip_atomic_load(cnt + t, __ATOMIC_RELAXED, __HIP_MEMORY_SCOPE_AGENT) : 0;
        const int p = (n + 255) >> 8; int accp = 0, mine = 0;
#pragma unroll
        for (int e = 0; e < 8; ++e) { const int pe_ = __builtin_amdgcn_readlane(p, e); if (t == e) mine = accp; accp += pe_; }
        if (t < 8) { tab[t] = p; tab[8 + t] = mine; }
        if (t == 0) tab[16] = accp;
    }
    __syncthreads();
}
__device__ __forceinline__ void ph_res1(const Ctx& c, int l, LAS unsigned char* lds, int dry = 0) {
    const int tid = TID(), lane = tid & 63, wave = tid >> 6, gw = BID() * NWAVES + wave, NGW = gridDim.x * NWAVES;
    const bool moe = (l & 1) != 0; const int jm = l >> 1;
    LAS f32x4* rt = (LAS f32x4*)lds;
    if (moe) { const GAS f32x4* src = (const GAS f32x4*)(c.in[I_ROUTER] + (size_t)jm * D * NEXP); for (int i = tid; i < D * NEXP / 4; i += NTHR) { const int ch = i >> 1; rt[((ch & 3) * 2 + (i & 1)) * 256 + (ch >> 2)] = src[i]; } }
    __syncthreads();
    const float* xin = c.in[I_X]; bf16* XB = (bf16*)(c.ws + WS_XB);
    const bf16* Y = (const bf16*)(c.ws + WS_PROJ) + (size_t)P_OS * PSTRIDE; bf16* H = (bf16*)(c.ws + WS_H);
    unsigned* cnt = (unsigned*)c.ws + CW_CNT + 64 * jm;
    int* TOKEP = (int*)(c.ws + WS_TOKEP); float* TOKW = (float*)(c.ws + WS_TOKW);
    for (int slot = gw; slot < M / 16; slot += NGW) {
        const int row0 = slot * 16, b = row0 / SEQ;
        f32x4 gpm[4], gt[4], gpf[4], scf[4], shf[4];
        ld_row_f32(c.in[I_GPOSTMIX] + (size_t)l * D, lane, gpm); ld_row_f32(modp(c, l, b, 2), lane, gt); ld_row_f32(c.in[I_GPREFFN] + (size_t)l * D, lane, gpf);
        ld_row_f32(modp(c, l, b, 4), lane, scf); ld_row_f32(modp(c, l, b, 3), lane, shf);
        int my1 = 0, my2 = 0; float myw = 0.f;
        v2u ya[4], yb[4]; f32x4 xa[4], xb[4];
#define R1_LOAD(YR, XR, ro_) do { _Pragma("unroll") for (int j = 0; j < 4; ++j) { YR[j] = *(const GAS v2u*)(Y + (ro_) + 4 * lane + 256 * j); if (l == 0) XR[j] = *(const GAS f32x4*)(xin + (ro_) + 4 * lane + 256 * j); else { const v2u w_ = *(const GAS v2u*)(XB + (ro_) + 4 * lane + 256 * j); XR[j] = (f32x4){bflo(w_.x), bfhi(w_.x), bflo(w_.y), bfhi(w_.y)}; } } } while (0)
        R1_LOAD(ya, xa, (size_t)row0 * D);
        for (int r = 0; r < 16; ++r) {
            const int row = row0 + r; const size_t ro = (size_t)row * D;
            if (r + 1 < 16) R1_LOAD(yb, xb, ro + D);
            f32x4 y[4], x[4], h[4];
#pragma unroll
            for (int j = 0; j < 4; ++j) { y[j] = (f32x4){bflo(ya[j].x), bfhi(ya[j].x), bflo(ya[j].y), bfhi(ya[j].y)}; x[j] = xa[j]; ya[j] = yb[j]; xa[j] = xb[j]; }
            const float rr = rsqrtf(row_sumsq(y) * (1.0f / 1024.0f) + EPS);
#pragma unroll
            for (int j = 0; j < 4; ++j) x[j] = x[j] + gt[j] * (y[j] * rr * gpm[j]);
            if (!dry) st_row_bf16(XB + ro, lane, x);
            norm_mod(x, gpf, scf, shf, h); if (!dry) st_row_bf16(H + ro, lane, h);
            if (moe) {
                f32x4 l0 = {0.f, 0.f, 0.f, 0.f}, l1 = l0;
#pragma unroll
                for (int j = 0; j < 4; ++j)
#pragma unroll
                    for (int i = 0; i < 4; ++i) { const int n = lane + 64 * j; l0 += rt[(i * 2) * 256 + n] * h[j][i]; l1 += rt[(i * 2 + 1) * 256 + n] * h[j][i]; }
                float lg[8];
#pragma unroll
                for (int e = 0; e < 4; ++e) { lg[e] = wave_sum(l0[e]); lg[4 + e] = wave_sum(l1[e]); }
                int i1 = 0; float v1 = lg[0];
#pragma unroll
                for (int e = 1; e < 8; ++e) if (lg[e] > v1) { v1 = lg[e]; i1 = e; }
                int i2 = -1; float v2 = -3.0e38f;
#pragma unroll
                for (int e = 0; e < 8; ++e) if (e != i1 && lg[e] > v2) { v2 = lg[e]; i2 = e; }
                if (lane == r) { my1 = i1; my2 = i2; myw = 1.0f / (1.0f + __expf(v2 - v1)); }
            }
        }
        if (moe && !dry) {
            const bool act = lane < 16; const unsigned long long below = (1ull << lane) - 1ull;
            int p1 = 0, p2 = 0;
            unsigned long long m1[8], m2[8]; int cn = 0;
#pragma unroll
            for (int e = 0; e < 8; ++e) { m1[e] = __ballot(act && my1 == e); m2[e] = __ballot(act && my2 == e); if (lane == e) cn = __popcll(m1[e]) + __popcll(m2[e]); }
            int basev = 0; if (lane < 8 && cn > 0) basev = (int)atomicAdd(cnt + lane, (unsigned)cn);
#pragma unroll
            for (int e = 0; e < 8; ++e) { const int be = __builtin_amdgcn_readlane(basev, e);
                if (my1 == e) p1 = be + __popcll(m1[e] & below);
                if (my2 == e) p2 = be + __popcll(m1[e]) + __popcll(m2[e] & below); }
            if (act) { *(GAS i32x4*)(TOKEP + (size_t)(row0 + lane) * 4) = (i32x4){my1, p1, my2, p2}; *(GAS f32x2*)(TOKW + (size_t)(row0 + lane) * 2) = (f32x2){myw, 1.0f - myw}; }
        }
    }
}
__device__ __forceinline__ void ph_gather(const Ctx& c, int l, LAS unsigned char* lds) {
    const int tid = TID(), lane = tid & 63, wave = tid >> 6, gw = BID() * NWAVES + wave, NGW = gridDim.x * NWAVES;
    moe_tables(c, l >> 1, lds); const LAS int* tab = (const LAS int*)(lds + TAB_OFF);
    const bf16* H = (const bf16*)(c.ws + WS_H); bf16* AG = (bf16*)(c.ws + WS_AG);
    const int* TOKEP = (const int*)(c.ws + WS_TOKEP); int* TOKD = (int*)(c.ws + WS_TOKD);
    for (int row0 = gw; row0 < M; row0 += 4 * NGW) {
        i32x4 ep[4]; v4u ra[4], rb[4];
#pragma unroll
        for (int k = 0; k < 4; ++k) { const int row = (row0 + k * NGW < M) ? row0 + k * NGW : row0; ep[k] = *(const GAS i32x4*)(TOKEP + (size_t)row * 4);
            ra[k] = *(const GAS v4u*)(H + (size_t)row * D + lane * 8); rb[k] = *(const GAS v4u*)(H + (size_t)row * D + 512 + lane * 8); }
#pragma unroll
        for (int k = 0; k < 4; ++k) { const int row = row0 + k * NGW; if (row >= M) continue;
            const int d1 = tab[8 + ep[k].x] * 256 + ep[k].y, d2 = tab[8 + ep[k].z] * 256 + ep[k].w;
            *(GAS v4u*)(AG + (size_t)d1 * D + lane * 8) = ra[k]; *(GAS v4u*)(AG + (size_t)d1 * D + 512 + lane * 8) = rb[k];
            *(GAS v4u*)(AG + (size_t)d2 * D + lane * 8) = ra[k]; *(GAS v4u*)(AG + (size_t)d2 * D + 512 + lane * 8) = rb[k];
            if (lane == 0) *(GAS i32x2*)(TOKD + (size_t)row * 2) = (i32x2){d1, d2}; }
    }
}
__device__ __forceinline__ void ph_res2(const Ctx& c, int l, int dry = 0) {
    const int tid = TID(), lane = tid & 63, wave = tid >> 6, gw = BID() * NWAVES + wave, NGW = gridDim.x * NWAVES;
    const bool moe = (l & 1) != 0;
    const bf16* Y2 = (const bf16*)(c.ws + WS_PROJ) + (size_t)4 * PSTRIDE; const bf16* YS = (const bf16*)(c.ws + WS_YS); bf16* H = (bf16*)(c.ws + WS_H); bf16* XB = (bf16*)(c.ws + WS_XB);
    const int* TOKD = (const int*)(c.ws + WS_TOKD); const float* TOKW = (const float*)(c.ws + WS_TOKW);
    const int ln = (l + 1 < DEPTH) ? l + 1 : l;
    for (int slot = gw; slot < M / 16; slot += NGW) {
        const int row0 = slot * 16, b = row0 / SEQ;
        f32x4 gpo[4], gt[4], gpm[4], scm[4], shm[4];
        ld_row_f32(c.in[I_GPOSTFFN] + (size_t)l * D, lane, gpo); ld_row_f32(modp(c, l, b, 5), lane, gt); ld_row_f32(c.in[I_GPREMIX] + (size_t)ln * D, lane, gpm);
        ld_row_f32(modp(c, ln, b, 1), lane, scm); ld_row_f32(modp(c, ln, b, 0), lane, shm);
        v2u ya[4], yb[4], za[4], zb[4]; f32x4 xa[4], xb[4]; f32x2 wa = {1.f, 0.f}, wb = wa;
#define R2_LOAD(YR, ZR, XR, WR, row_) do { const size_t ro_ = (size_t)(row_) * D; \
            if (moe) { const i32x2 d_ = *(const GAS i32x2*)(TOKD + (size_t)(row_) * 2); WR = *(const GAS f32x2*)(TOKW + (size_t)(row_) * 2); \
                _Pragma("unroll") for (int j = 0; j < 4; ++j) { YR[j] = *(const GAS v2u*)(YS + (size_t)d_.x * D + 4 * lane + 256 * j); ZR[j] = *(const GAS v2u*)(YS + (size_t)d_.y * D + 4 * lane + 256 * j); } } \
            else { _Pragma("unroll") for (int j = 0; j < 4; ++j) { YR[j] = *(const GAS v2u*)(Y2 + ro_ + 4 * lane + 256 * j); ZR[j] = (v2u){0u, 0u}; } } \
            _Pragma("unroll") for (int j = 0; j < 4; ++j) { const v2u w_ = *(const GAS v2u*)(XB + ro_ + 4 * lane + 256 * j); XR[j] = (f32x4){bflo(w_.x), bfhi(w_.x), bflo(w_.y), bfhi(w_.y)}; } } while (0)
        R2_LOAD(ya, za, xa, wa, row0);
        for (int r = 0; r < 16; ++r) {
            const int row = row0 + r; const size_t ro = (size_t)row * D;
            if (r + 1 < 16) R2_LOAD(yb, zb, xb, wb, row + 1);
            f32x4 y[4], x[4], h[4];
#pragma unroll
            for (int j = 0; j < 4; ++j) { const f32x4 p = {bflo(ya[j].x), bfhi(ya[j].x), bflo(ya[j].y), bfhi(ya[j].y)}, q = {bflo(za[j].x), bfhi(za[j].x), bflo(za[j].y), bfhi(za[j].y)};
                y[j] = p * wa.x + q * wa.y; x[j] = xa[j]; ya[j] = yb[j]; za[j] = zb[j]; xa[j] = xb[j]; }
            wa = wb;
            const float rr = rsqrtf(row_sumsq(y) * (1.0f / 1024.0f) + EPS);
#pragma unroll
            for (int j = 0; j < 4; ++j) { x[j] = x[j] + gt[j] * (y[j] * rr * gpo[j]); if (!dry && l + 1 == DEPTH) *(GAS f32x4*)(c.out + ro + 4 * lane + 256 * j) = x[j]; }
            if (!dry && l + 1 < DEPTH) st_row_bf16(XB + ro, lane, x);
            if (l + 1 < DEPTH) { norm_mod(x, gpm, scm, shm, h); if (!dry) st_row_bf16(H + ro, lane, h); }
        }
    }
}

constexpr int PH_PER_LAYER = 12, NPH = 2 + DEPTH * PH_PER_LAYER;
__global__ void __launch_bounds__(NTHR, 2) fwd(Ctx c) {
    extern __shared__ __attribute__((aligned(16))) unsigned char lds_raw[];
    LAS unsigned char* lds = (LAS unsigned char*)lds_raw;
    volatile LAS unsigned* MISC = (volatile LAS unsigned*)(lds + MISC_OFF);
    if (threadIdx.x < 64) MISC[threadIdx.x] = 0u;
    __syncthreads();
    const int lo = c.ph_lo, hi = c.ph_hi, G = gridDim.x;
    XcdBarrier bar; bar.bar = (unsigned*)c.ws + CW_BAR; bar.x = 0; bar.st = MISC + 8;
    if (hi - lo > 1) bar = xcd_barrier_post((unsigned*)c.ws + CW_BAR, MISC + 8);
#ifndef PH_MASK
#define PH_MASK 0xFFFF
#endif
#define IN(p) (lo <= (p) && (p) < hi)
#define ON(k) ((PH_MASK >> (k)) & 1)
#ifndef REPMASK
#define REPMASK 0
#endif
#define REP(k) for (int rep_ = 0; rep_ < (((REPMASK >> (k)) & 1) ? opq_s(2) : 1); ++rep_)
#ifndef TPROBE
#define TPROBE -1
#endif
#ifndef TPL
#define TPL -1
#define TPMUL 1
#endif
    int tp_layer = -1;
#ifndef TPB
#define TPB 0
#endif
#define TP_SEL(ty) (TPROBE == (ty) && blockIdx.x == TPB && threadIdx.x == 0 && (TPL < 0 || tp_layer == TPL))
#define TPU_BEGIN() do { if (TP_SEL(20)) MISC[48] = (unsigned)wall_clock64(); } while (0)
#define TPU_END() do { if (TP_SEL(20)) MISC[16] += (unsigned)wall_clock64() - MISC[48]; } while (0)
#define TP_BEGIN(ty) do { if (TP_SEL(ty)) MISC[48] = (unsigned)wall_clock64(); } while (0)
#define BAR_AFTER(p, ty) do { if ((p) + 1 < hi) xcd_barrier(bar); if (TP_SEL(ty)) MISC[16] += (unsigned)wall_clock64() - MISC[48]; } while (0)
    if (ON(12) && IN(0)) { TP_BEGIN(12); ph_mod(c, lds); ph_lb(c); ph_uz(c); REP(14) ph_cvt(c, 0, lds, BID(), (int)gridDim.x, 2); BAR_AFTER(0, 12); }
    if (ON(13) && IN(1)) { TP_BEGIN(13); ph_norm0(c); BAR_AFTER(1, 13); }
    for (int l = 0; l < DEPTH; ++l) {
        const int base = 2 + l * PH_PER_LAYER; const bool moe = (l & 1) != 0; tp_layer = l;
        Ctx cl = c; cl.ws = opq_p(c.ws); cl.out = (float*)opq_p((unsigned char*)c.out);
        unsigned char* ws = cl.ws; bf16* PJ = (bf16*)(ws + WS_PROJ); const int bid = BID();
        int KD = opq_s(D);
        if (ON(0) && IN(base + 0)) { TP_BEGIN(0);
            pg8::Gemm g{(const bf16*)(ws + WS_H), (const bf16*)(ws + WS_WIN), M, DIN, KD}; pg8::UOrder S; S.init(0, M, DIN, G, bid);
            pg8::EpiWin E{PJ, (const float*)(ws + WS_LB) + l * 1024, PSTRIDE};
            REP(0) { pg8::TOrder T; T.build(S, (LAS int*)(lds + UT_OFF)); pg8::gemm_phase<pg8::EpiWin, pg8::TOrder, true, true>(lds, g, T, E); }
            BAR_AFTER(base + 0, 0); }
        if (ON(1) && IN(base + 1)) { TP_BEGIN(1); REP(1) ph_prep(cl, l, lds); BAR_AFTER(base + 1, 1); }
        if (ON(2) && IN(base + 2)) { TP_BEGIN(2); TPU_BEGIN(); REP(2) ph_scans(cl, lds, l); TPU_END(); BAR_AFTER(base + 2, 2); }
        if (ON(4) && IN(base + 4)) { TP_BEGIN(4); REP(4) ph_post(cl, l); BAR_AFTER(base + 4, 4); }
        if (ON(5) && IN(base + 5)) { TP_BEGIN(5);
            pg8::Gemm g{PJ + (size_t)P_QA * PSTRIDE, (const bf16*)(ws + WS_WAB + (size_t)(l & 1) * WAB_STEP), M, D, KD}; pg8::UOrder S; S.init(1, M, D, G, bid);
            pg8::EpiProj E{PJ + (size_t)P_GTA * PSTRIDE, PSTRIDE, PJ + (size_t)P_GA * PSTRIDE, PJ + (size_t)P_VA * PSTRIDE};
            REP(5) { pg8::TOrder T; T.build(S, (LAS int*)(lds + UT_OFF)); pg8::gemm_phase<pg8::EpiProj, pg8::TOrder, true, true>(lds, g, T, E); }
            BAR_AFTER(base + 5, 5); }
        if (ON(6) && IN(base + 6)) { TP_BEGIN(6);
            pg8::Gemm g{PJ + (size_t)P_VA * PSTRIDE, (const bf16*)(ws + WS_WO + (size_t)(l & 1) * WO_STEP), M, D, KD}; pg8::UOrder S; S.init(0, M, D, G, bid);
            pg8::EpiPlain E{PJ + (size_t)P_OS * PSTRIDE, D};
            REP(6) { pg8::TOrder T; T.build(S, (LAS int*)(lds + UT_OFF)); pg8::gemm_phase<pg8::EpiPlain, pg8::TOrder, true, true>(lds, g, T, E); }
            BAR_AFTER(base + 6, 6); }
        if (ON(7) && IN(base + 7)) { TP_BEGIN(7); if ((REPMASK >> 7) & 1) ph_res1(cl, l, lds, opq_s(1)); ph_res1(cl, l, lds); BAR_AFTER(base + 7, 7); }
        if (ON(8) && IN(base + 8) && moe) { TP_BEGIN(8); ph_gather(cl, l, lds); BAR_AFTER(base + 8, 8); }
        if (ON(9) && IN(base + 9)) { TP_BEGIN(9);
            pg8::Gemm g{(const bf16*)(ws + (moe ? WS_AG : WS_H)), (const bf16*)(ws + (moe ? WS_WFM : WS_WFD)), M, 2 * DFF, KD}; pg8::UOrder S; S.init(0, M, 2 * DFF, G, bid);
            pg8::EpiSwi E{PJ, moe ? DFE : DFF, moe ? 28 : 22};
            if (moe) { moe_tables(cl, l >> 1, lds); S.mode = 2; S.NT = 28; S.tab = (const LAS int*)(lds + TAB_OFF); S.nwg = __builtin_amdgcn_readfirstlane(S.tab[16]) * 28; }
            REP(9) { pg8::TOrder T; T.build(S, (LAS int*)(lds + UT_OFF)); pg8::gemm_phase<pg8::EpiSwi, pg8::TOrder, true, true>(lds, g, T, E); }
            BAR_AFTER(base + 9, 9); }
        if (ON(10) && IN(base + 10)) { TP_BEGIN(10);
            pg8::Gemm g{PJ, (const bf16*)(ws + (moe ? WS_WFM + WF_W2_MOE : WS_WFD + WF_W2_DENSE)), M, D, moe ? DFE : DFF}; pg8::UOrder S; S.init(0, M, D, G, bid);
            pg8::EpiPlain E{moe ? (bf16*)(ws + WS_YS) : PJ + (size_t)4 * PSTRIDE, D};
            if (moe) { moe_tables(cl, l >> 1, lds); S.mode = 2; S.NT = 4; S.tab = (const LAS int*)(lds + TAB_OFF); S.nwg = __builtin_amdgcn_readfirstlane(S.tab[16]) * 4; }
            REP(10) { pg8::TOrder T; T.build(S, (LAS int*)(lds + UT_OFF)); pg8::gemm_phase<pg8::EpiPlain, pg8::TOrder, true, true>(lds, g, T, E); }
            BAR_AFTER(base + 10, 10); }
        if (ON(11) && IN(base + 11)) { TP_BEGIN(11); if ((REPMASK >> 11) & 1) ph_res2(cl, l, opq_s(1)); ph_res2(cl, l);  BAR_AFTER(base + 11, 11); }
    }
    if (TPROBE >= 0) { __syncthreads(); if (blockIdx.x == TPB && threadIdx.x == 0) { const unsigned tt = MISC[16] * (unsigned)TPMUL; const unsigned s0 = (unsigned)wall_clock64(); while ((unsigned)wall_clock64() - s0 < tt) __builtin_amdgcn_s_sleep(8); } }
#undef IN
#undef BAR_AFTER
}

#ifndef MK_ONE_LAUNCH
#define MK_ONE_LAUNCH 1
#endif
extern "C" void kernel_launch(void* const* d_in, const int* in_sizes, int n_in, void* d_out, int out_size, void* d_ws, size_t ws_size, hipStream_t stream) {
    static int grid = 0;
    if (grid == 0) {
        if (n_in != 32 || in_sizes[0] != M * D || out_size != M * D || ws_size < WS_END) { fprintf(stderr, "kernel_launch: unexpected shapes / workspace (%d inputs, ws %zu < %zu)\n", n_in, ws_size, (size_t)WS_END); grid = -1; return; }
        int dev = 0, cus = 0;
        if (hipGetDevice(&dev) != hipSuccess || hipDeviceGetAttribute(&cus, hipDeviceAttributeMultiprocessorCount, dev) != hipSuccess) { grid = -1; return; }
        if (hipFuncSetAttribute((const void*)fwd, hipFuncAttributeMaxDynamicSharedMemorySize, LDS_BYTES) != hipSuccess) { fprintf(stderr, "kernel_launch: hipFuncSetAttribute failed\n"); grid = -1; return; }
        (void)hipGetLastError();
        grid = cus;
    }
    if (grid < 0) return;
    if (hipMemsetAsync((char*)d_ws + WS_CTL, 0, CTL_ZERO_BYTES, stream) != hipSuccess) return;
    Ctx c{};
    for (int i = 0; i < 32; ++i) c.in[i] = (const float*)d_in[i];
    c.out = (float*)d_out; c.ws = (unsigned char*)d_ws;
#if MK_ONE_LAUNCH
    c.ph_lo = 0; c.ph_hi = NPH;
    hipLaunchKernelGGL(fwd, dim3(grid), dim3(NTHR), LDS_BYTES, stream, c);
#else
    for (int p = 0; p < NPH; ++p) {
        if (p >= 2) { const int l = (p - 2) / PH_PER_LAYER, k = (p - 2) % PH_PER_LAYER; if (k == 8 && !(l & 1)) continue; }
        c.ph_lo = p; c.ph_hi = p + 1;
        hipLaunchKernelGGL(fwd, dim3(grid), dim3(NTHR), LDS_BYTES, stream, c);
    }
#endif
}
```

```cpp
#include <hip/hip_runtime.h>
#include <cstdio>
#include <cstdint>
#ifndef TPROBE
#define TPROBE -1
#endif
namespace pg8 {
#define PG8_LAS __attribute__((address_space(3)))
typedef unsigned short bf16_t;
typedef short bf16x8 __attribute__((ext_vector_type(8)));
typedef float f32x4 __attribute__((ext_vector_type(4)));
typedef unsigned u32x4 __attribute__((ext_vector_type(4)));
constexpr int BM = 256, BK = 64, HALF = 128, HTB = HALF * BK * 2  , STAGE_BYTES = 8 * HTB, NXCD = 8, WGM = 4;

__host__ __device__ __forceinline__ int lds_byte(int r, int c) { const int st = (r >> 4) * 2 + (c >> 5), rr = r & 15, cc = c & 31, ob = rr * 64 + cc * 2; return st * 1024 + (ob ^ (((ob >> 9) & 1) << 5)); }
__host__ __device__ __forceinline__ void stage_rc(int b, int& R, int& C) { const int st = b / 1024, sb = b % 1024, swz = sb ^ (((sb >> 9) & 1) << 5); R = (st >> 1) * 16 + swz / 64; C = (st & 1) * 32 + (swz % 64) / 2; }
__host__ __device__ __forceinline__ int perm32(int rho) { const int n = rho >> 4, i = rho & 15; return 8 * (i >> 2) + 4 * n + (i & 3); }

struct Unit { int pm, pn; };
struct Gemm { const bf16_t* A; const bf16_t* Bt; int M, N, K; };

struct StaticOrder {
    int nM, nN, nwg, G, c;
    __host__ __device__ void init(int M, int N, int G_, int c_) { nM = M / BM; nN = N / BM; nwg = nM * nN; G = G_; c = c_; }
    __host__ __device__ bool next(int i, Unit& u) const {
        const long L = (long)i * G + c; if (L >= nwg) return false;
        int wgid = (int)L; { const int q = nwg / NXCD, r = nwg % NXCD, xcd = wgid % NXCD, off = wgid / NXCD; wgid = (xcd < r ? xcd * (q + 1) : r * (q + 1) + (xcd - r) * q) + off; }
        const int nig = WGM * nN, gid = wgid / nig, fm = gid * WGM, gsz = (nM - fm) < WGM ? (nM - fm) : WGM;
        u.pm = fm + ((wgid % nig) % gsz); u.pn = (wgid % nig) / gsz; return true;
    }
    __device__ __forceinline__ void a_ready(const Unit&) const {}
    __device__ __forceinline__ void done(const Unit&) const {}
};
typedef float f32x2c __attribute__((ext_vector_type(2)));
typedef __bf16 bf16x2c __attribute__((ext_vector_type(2)));
__device__ __forceinline__ unsigned cvt_pk_bf16(float lo, float hi) { const f32x2c v = {lo, hi}; return __builtin_bit_cast(unsigned, __builtin_convertvector(v, bf16x2c)); }
#define PG8_GAS __attribute__((address_space(1)))
struct UOrder {
    int mode, nM, nN, nwg, G, c, NT; const PG8_LAS int* tab;
    __device__ __forceinline__ void init(int mode_, int M, int N, int G_, int c_) { mode = mode_; nM = M / BM; nN = N / BM; nwg = nM * nN; G = G_; c = c_; NT = 1; tab = nullptr; }
    __device__ __forceinline__ bool next_raw(int i, Unit& u) const {
        const int which = (mode == 1) ? (i & 1) : 0; const int ii = (mode == 1) ? (i >> 1) : i;
        const long L = (long)ii * G + c; if (L >= nwg) return false;
        int wgid = (int)L; { const int q = nwg / NXCD, r = nwg % NXCD, xcd = wgid % NXCD, off = wgid / NXCD; wgid = (xcd < r ? xcd * (q + 1) : r * (q + 1) + (xcd - r) * q) + off; }
        if (mode == 2) {
            int r = wgid, E = 0;
#pragma unroll
            for (int k = 0; k < 7; ++k) { const int uk = tab[k] * NT; if (E == k && r >= uk) { r -= uk; E = k + 1; } }
            const int P = tab[E], B = tab[8 + E];
            const int nig = WGM * NT, gid = r / nig, fm = gid * WGM, gsz = (P - fm) < WGM ? (P - fm) : WGM, rr = r - gid * nig;
            u.pm = B + fm + rr % gsz; u.pn = E * NT + rr / gsz; return true;
        }
        const int nig = WGM * nN, gid = wgid / nig, fm = gid * WGM, gsz = (nM - fm) < WGM ? (nM - fm) : WGM;
        u.pm = fm + ((wgid % nig) % gsz); u.pn = (wgid % nig) / gsz;
        if (which) { u.pm += nM; u.pn += nN; }
        return true;
    }
    __device__ __forceinline__ void a_ready(const Unit&) const {}
    __device__ __forceinline__ void done(const Unit&) const {}
};
struct TOrder {
    const PG8_LAS int* ut; int n;
    __device__ __forceinline__ void build(const UOrder& S, PG8_LAS int* tabl) {
        const int t = threadIdx.x;
        if (t == 0) tabl[512] = 0;
        __syncthreads();
        if (t < 256) { Unit u; u.pm = 0; u.pn = 0; if (S.next_raw(t, u)) { tabl[2 * t] = u.pm; tabl[2 * t + 1] = u.pn; __hip_atomic_fetch_max(tabl + 512, t + 1, __ATOMIC_RELAXED, __HIP_MEMORY_SCOPE_WORKGROUP); } }
        __syncthreads();
        ut = tabl; n = __builtin_amdgcn_readfirstlane(tabl[512]);
    }
    __device__ __forceinline__ bool next(int i, Unit& u) const { if (i >= n) return false; u.pm = __builtin_amdgcn_readfirstlane(ut[2 * i]); u.pn = __builtin_amdgcn_readfirstlane(ut[2 * i + 1]); return true; }
    __device__ __forceinline__ void a_ready(const Unit&) const {}
    __device__ __forceinline__ void done(const Unit&) const {}
};

__device__ __forceinline__ float fsig(float v) { return __builtin_amdgcn_rcpf(1.0f + __expf(-v)); }
__device__ __forceinline__ float bflo(unsigned w) { return __uint_as_float(w << 16); }
__device__ __forceinline__ float bfhi(unsigned w) { return __uint_as_float(w & 0xffff0000u); }
#define PG8_X8(x, ai, bj, m) float x[8]; { const f32x4 _a = acc[ai][bj][m][0], _b = acc[ai][bj][m][1]; x[0] = _a[0]; x[1] = _a[1]; x[2] = _a[2]; x[3] = _a[3]; x[4] = _b[0]; x[5] = _b[1]; x[6] = _b[2]; x[7] = _b[3]; }
#define PG8_PACK8(w, x) u32x4 w; w.x = cvt_pk_bf16(x[0], x[1]); w.y = cvt_pk_bf16(x[2], x[3]); w.z = cvt_pk_bf16(x[4], x[5]); w.w = cvt_pk_bf16(x[6], x[7]);

struct EpiWin {
    static constexpr bool PERM = true, AFTER_DRAIN = false; static constexpr int NST = 16;
    bf16_t* P; const float* lb; size_t pstride;
    __device__ __forceinline__ void operator()(const f32x4 (&acc)[2][2][4][2], const Unit& u, int wr, int wc, int fr, int fq) const {
        const int part = u.pn >> 2;
        const int mode = (part == 0 || part == 3) ? 1 : (part == 1) ? 3 : (part >= 6) ? 2 : 0;
        bf16_t* base = P + (size_t)part * pstride;
        const int row0 = u.pm * BM + wr * 64 + fr, col0 = (u.pn & 3) * BM + wc * 32 + 8 * fq;
        float lbv[2][8];
#pragma unroll
        for (int bj = 0; bj < 2; ++bj)
#pragma unroll
            for (int j = 0; j < 8; ++j) lbv[bj][j] = 0.f;
        if (mode == 3) {
#pragma unroll
            for (int bj = 0; bj < 2; ++bj) { const f32x4 a = *(const PG8_GAS f32x4*)(lb + col0 + bj * HALF), b = *(const PG8_GAS f32x4*)(lb + col0 + bj * HALF + 4);
                lbv[bj][0] = a[0]; lbv[bj][1] = a[1]; lbv[bj][2] = a[2]; lbv[bj][3] = a[3]; lbv[bj][4] = b[0]; lbv[bj][5] = b[1]; lbv[bj][6] = b[2]; lbv[bj][7] = b[3]; }
        }
#pragma unroll
        for (int ai = 0; ai < 2; ++ai)
#pragma unroll
            for (int m = 0; m < 4; ++m) { bf16_t* rowp = base + (size_t)(row0 + ai * HALF + m * 16) * 1024 + col0;
#pragma unroll
                for (int bj = 0; bj < 2; ++bj) { PG8_X8(x, ai, bj, m)
                    if (mode == 1) {
#pragma unroll
                        for (int j = 0; j < 8; ++j) x[j] = x[j] * fsig(x[j]);
                    } else if (mode == 2) {
#pragma unroll
                        for (int j = 0; j < 8; ++j) x[j] = fsig(x[j]);
                    } else if (mode == 3) {
#pragma unroll
                        for (int j = 0; j < 8; ++j) x[j] = fmaxf(__builtin_amdgcn_logf(lbv[bj][j] + (1.0f - lbv[bj][j]) * fsig(x[j])), -43.28f);
                    }
                    PG8_PACK8(w, x) *(PG8_GAS u32x4*)(rowp + bj * HALF) = w; } }
    }
};
struct EpiProj {
    static constexpr bool PERM = true, AFTER_DRAIN = false; static constexpr int NST = 0;
    const bf16_t* gates; size_t pstride; bf16_t* T1; bf16_t* MX;
    __device__ __forceinline__ void operator()(const f32x4 (&acc)[2][2][4][2], const Unit& u, int wr, int wc, int fr, int fq) const {
        const int which = u.pn >> 2;
        const bf16_t* g = gates + (size_t)which * pstride;
        const int row0 = (u.pm & 127) * BM + wr * 64 + fr, col0 = (u.pn & 3) * BM + wc * 32 + 8 * fq;
#pragma unroll
        for (int ai = 0; ai < 2; ++ai)
#pragma unroll
            for (int m = 0; m < 4; ++m) { const size_t off = (size_t)(row0 + ai * HALF + m * 16) * 1024 + col0;
#pragma unroll
                for (int bj = 0; bj < 2; ++bj) { PG8_X8(x, ai, bj, m)
                    const u32x4 gv = *(const PG8_GAS u32x4*)(g + off + bj * HALF);
                    x[0] *= bflo(gv.x); x[1] *= bfhi(gv.x); x[2] *= bflo(gv.y); x[3] *= bfhi(gv.y); x[4] *= bflo(gv.z); x[5] *= bfhi(gv.z); x[6] *= bflo(gv.w); x[7] *= bfhi(gv.w);
                    if (which == 0) { PG8_PACK8(w, x) *(PG8_GAS u32x4*)(T1 + off + bj * HALF) = w; }
                    else { const u32x4 t = *(const PG8_GAS u32x4*)(T1 + off + bj * HALF);
                        x[0] += bflo(t.x); x[1] += bfhi(t.x); x[2] += bflo(t.y); x[3] += bfhi(t.y); x[4] += bflo(t.z); x[5] += bfhi(t.z); x[6] += bflo(t.w); x[7] += bfhi(t.w);
                        PG8_PACK8(w, x) *(PG8_GAS u32x4*)(MX + off + bj * HALF) = w; } } }
    }
};
struct EpiSwi {
    static constexpr bool PERM = true, AFTER_DRAIN = false; static constexpr int NST = 8;
    bf16_t* Gm; int ldg, NT;
    __device__ __forceinline__ void operator()(const f32x4 (&acc)[2][2][4][2], const Unit& u, int wr, int wc, int fr, int fq) const {
        const int pnl = u.pn - (u.pn / NT) * NT;
        const int row0 = u.pm * BM + wr * 64 + fr, col0 = pnl * HALF + wc * 32 + 8 * fq;
#pragma unroll
        for (int ai = 0; ai < 2; ++ai)
#pragma unroll
            for (int m = 0; m < 4; ++m) { bf16_t* rowp = Gm + (size_t)(row0 + ai * HALF + m * 16) * ldg + col0;
                PG8_X8(x, ai, 0, m) PG8_X8(y, ai, 1, m)
#pragma unroll
                for (int j = 0; j < 8; ++j) x[j] = x[j] * fsig(x[j]) * y[j];
                PG8_PACK8(w, x) *(PG8_GAS u32x4*)rowp = w; }
    }
};
struct EpiPlain {
    static constexpr bool PERM = true, AFTER_DRAIN = false; static constexpr int NST = 16;
    bf16_t* O; int ldc;
    __device__ __forceinline__ void operator()(const f32x4 (&acc)[2][2][4][2], const Unit& u, int wr, int wc, int fr, int fq) const {
        const int row0 = u.pm * BM + wr * 64 + fr, col0 = (u.pn & 3) * BM + wc * 32 + 8 * fq;
#pragma unroll
        for (int ai = 0; ai < 2; ++ai)
#pragma unroll
            for (int m = 0; m < 4; ++m) { bf16_t* rowp = O + (size_t)(row0 + ai * HALF + m * 16) * ldc + col0;
#pragma unroll
                for (int bj = 0; bj < 2; ++bj) { PG8_X8(x, ai, bj, m) PG8_PACK8(w, x) *(PG8_GAS u32x4*)(rowp + bj * HALF) = w; } }
    }
};
template <class Epi, class Sched, bool ALIGN_EPI = false, bool SP2 = false>
__device__ __forceinline__ void gemm_phase(PG8_LAS unsigned char* lds, const Gemm g, const Sched& S, const Epi& E) {
    int tid_ = threadIdx.x; asm volatile("" : "+v"(tid_));
    const int tid = tid_, wid = __builtin_amdgcn_readfirstlane(tid >> 6), lane = tid & 63, wr = wid >> 2, wc = wid & 3, fr = lane & 15, fq = lane >> 4;
    const int K = g.K, nt = K / BK;
    unsigned voffA[2], voffB[2];
#pragma unroll
    for (int i = 0; i < 2; ++i) { int R, C; stage_rc(tid * 16 + i * 8192, R, C); const int Rb = Epi::PERM ? ((R & ~31) + perm32(R & 31)) : R;
        voffA[i] = (unsigned)(R * K + C) * 2u; voffB[i] = (unsigned)(Rb * K + C) * 2u; }
    const size_t kstep = (size_t)(BK * 2);
    const size_t hstep = (size_t)HALF * K * 2;
    const size_t tstep = 2 * hstep;
    const unsigned ldsw = (unsigned)wid * 1024u;
    const int aoff = lds_byte(wr * 64 + fr, fq * 8), boff = lds_byte(wc * 32 + fr, fq * 8);
#define PG8_SA(b, h) (((b) * 2 + (h)) * HTB)
#define PG8_SB(b, h) ((4 + (b) * 2 + (h)) * HTB)
#define PG8_STAGE(bufoff, gbase, voff) do { _Pragma("unroll") for (int _i = 0; _i < 2; ++_i) \
        __builtin_amdgcn_global_load_lds((const unsigned*)((const char*)(gbase) + (voff)[_i]), (PG8_LAS unsigned*)(lds + (bufoff) + ldsw + _i * 8192), 16, 0, 0); } while (0)
#define PG8_LDA(dst, b, h) do { _Pragma("unroll") for (int m = 0; m < 4; ++m) _Pragma("unroll") for (int k = 0; k < 2; ++k) dst[m][k] = *(const PG8_LAS bf16x8*)(lds + PG8_SA(b, h) + aoff + m * 2048 + k * 1024); } while (0)
#define PG8_LDB(dst, b, h) do { _Pragma("unroll") for (int n = 0; n < 2; ++n) _Pragma("unroll") for (int k = 0; k < 2; ++k) dst[n][k] = *(const PG8_LAS bf16x8*)(lds + PG8_SB(b, h) + boff + n * 2048 + k * 1024); } while (0)
#define PG8_MMA(ai, bj, At, Bt) do { __builtin_amdgcn_s_setprio(1); _Pragma("unroll") for (int m = 0; m < 4; ++m) _Pragma("unroll") for (int n = 0; n < 2; ++n) _Pragma("unroll") for (int k = 0; k < 2; ++k) \
        acc[ai][bj][m][n] = __builtin_amdgcn_mfma_f32_16x16x32_bf16(Bt[n][k], At[m][k], acc[ai][bj][m][n], 0, 0, 0); __builtin_amdgcn_s_setprio(0); } while (0)
#define PG8_WAIT_V(n) asm volatile("s_waitcnt vmcnt(" #n ")" ::: "memory")
#define PG8_WAIT_L(n) asm volatile("s_waitcnt lgkmcnt(" #n ")" ::: "memory")
#define PG8_BAR __builtin_amdgcn_s_barrier()
#define PG8_SCHED __builtin_amdgcn_sched_barrier(0)
    Unit cur, nxt; int ui = 0;
    if (!S.next(0, cur)) return;
    f32x4 acc[2][2][4][2];
#pragma unroll
    for (int a = 0; a < 2; ++a)
#pragma unroll
        for (int b = 0; b < 2; ++b)
#pragma unroll
            for (int m = 0; m < 4; ++m)
#pragma unroll
                for (int n = 0; n < 2; ++n) acc[a][b][m][n] = (f32x4){0.f, 0.f, 0.f, 0.f};
    bf16x8 At[4][2], B0[2][2], B1[2][2];
    const char* cA = (const char*)g.A + (size_t)cur.pm * tstep; const char* cB = (const char*)g.Bt + (size_t)cur.pn * tstep;
    S.a_ready(cur);
    if constexpr (SP2) {
        PG8_STAGE(PG8_SB(0, 0), cB, voffB); PG8_STAGE(PG8_SB(0, 1), cB + hstep, voffB); PG8_STAGE(PG8_SA(0, 0), cA, voffA); PG8_STAGE(PG8_SA(0, 1), cA + hstep, voffA);
        if (wr == 1) PG8_BAR;
        PG8_WAIT_V(2); PG8_BAR;
        PG8_STAGE(PG8_SB(1, 0), cB + kstep, voffB); PG8_STAGE(PG8_SA(1, 0), cA + kstep, voffA); PG8_STAGE(PG8_SB(1, 1), cB + hstep + kstep, voffB);
        PG8_WAIT_V(6); PG8_BAR;
    } else {
        PG8_STAGE(PG8_SB(0, 0), cB, voffB); PG8_STAGE(PG8_SA(0, 0), cA, voffA); PG8_STAGE(PG8_SB(0, 1), cB + hstep, voffB); PG8_STAGE(PG8_SA(0, 1), cA + hstep, voffA);
        if (wr == 1) PG8_BAR;
        PG8_WAIT_V(4); PG8_BAR;
        PG8_STAGE(PG8_SB(1, 0), cB + kstep, voffB); PG8_STAGE(PG8_SA(1, 0), cA + kstep, voffA); PG8_STAGE(PG8_SB(1, 1), cB + hstep + kstep, voffB);
        PG8_WAIT_V(6); PG8_BAR;
    }
    for (;;) {
        const bool has_next = S.next(ui + 1, nxt);
        const char* nA = has_next ? (const char*)g.A + (size_t)nxt.pm * tstep : cA; const char* nB = has_next ? (const char*)g.Bt + (size_t)nxt.pn * tstep : cB;
        for (int t = 0; t < nt; t += 2) {
            const bool last = (t == nt - 2);
            const char* a1 = cA + (size_t)(t + 1) * kstep;
            const char* a2 = last ? nA : cA + (size_t)(t + 2) * kstep; const char* b2 = last ? nB : cB + (size_t)(t + 2) * kstep;
            const char* a3 = a2 + kstep; const char* b3 = b2 + kstep;
            if (last && has_next) S.a_ready(nxt);
            if constexpr (SP2) {
            PG8_LDB(B0, 0, 0); PG8_LDB(B1, 0, 1); PG8_SCHED; PG8_LDA(At, 0, 0); PG8_STAGE(PG8_SA(1, 1), a1 + hstep, voffA);
            PG8_WAIT_V(8); PG8_WAIT_L(0); PG8_BAR; PG8_MMA(0, 0, At, B0); PG8_MMA(0, 1, At, B1); PG8_BAR; PG8_SCHED;
            PG8_LDA(At, 0, 1); PG8_STAGE(PG8_SB(0, 0), b2, voffB); PG8_STAGE(PG8_SB(0, 1), b2 + hstep, voffB); PG8_STAGE(PG8_SA(0, 0), a2, voffA);
            PG8_WAIT_V(8); PG8_WAIT_L(0); PG8_BAR; PG8_MMA(1, 0, At, B0); PG8_MMA(1, 1, At, B1); PG8_BAR; PG8_SCHED;
            PG8_LDB(B0, 1, 0); PG8_LDB(B1, 1, 1); PG8_SCHED; PG8_LDA(At, 1, 0); PG8_STAGE(PG8_SA(0, 1), a2 + hstep, voffA);
            PG8_WAIT_V(8); PG8_WAIT_L(0); PG8_BAR; PG8_MMA(0, 0, At, B0); PG8_MMA(0, 1, At, B1); PG8_BAR; PG8_SCHED;
            PG8_LDA(At, 1, 1); PG8_STAGE(PG8_SB(1, 0), b3, voffB); PG8_STAGE(PG8_SB(1, 1), b3 + hstep, voffB); PG8_STAGE(PG8_SA(1, 0), a3, voffA);
            PG8_WAIT_V(8); PG8_WAIT_L(0); PG8_BAR; PG8_MMA(1, 0, At, B0); PG8_MMA(1, 1, At, B1); PG8_BAR; PG8_SCHED;
            } else {
            PG8_LDB(B0, 0, 0); PG8_SCHED; PG8_LDA(At, 0, 0); PG8_STAGE(PG8_SA(1, 1), a1 + hstep, voffA);
            PG8_WAIT_L(8); PG8_BAR; PG8_WAIT_L(0); PG8_MMA(0, 0, At, B0); PG8_BAR; PG8_SCHED;
            PG8_LDB(B1, 0, 1); PG8_STAGE(PG8_SB(0, 0), b2, voffB);
            PG8_BAR; PG8_WAIT_L(0); PG8_MMA(0, 1, At, B1); PG8_BAR;
            PG8_LDA(At, 0, 1); PG8_STAGE(PG8_SA(0, 0), a2, voffA);
            PG8_BAR; PG8_WAIT_L(0); PG8_MMA(1, 0, At, B0); PG8_BAR; PG8_SCHED;
            PG8_STAGE(PG8_SB(0, 1), b2 + hstep, voffB);
            PG8_WAIT_V(6); PG8_BAR; PG8_MMA(1, 1, At, B1); PG8_BAR;
            PG8_LDB(B0, 1, 0); PG8_SCHED; PG8_LDA(At, 1, 0); PG8_STAGE(PG8_SA(0, 1), a2 + hstep, voffA);
            PG8_WAIT_L(8); PG8_BAR; PG8_WAIT_L(0); PG8_MMA(0, 0, At, B0); PG8_BAR; PG8_SCHED;
            PG8_LDB(B1, 1, 1); PG8_STAGE(PG8_SB(1, 0), b3, voffB);
            PG8_BAR; PG8_WAIT_L(0); PG8_MMA(0, 1, At, B1); PG8_BAR;
            PG8_LDA(At, 1, 1); PG8_STAGE(PG8_SA(1, 0), a3, voffA);
            PG8_BAR; PG8_WAIT_L(0); PG8_MMA(1, 0, At, B0); PG8_BAR; PG8_SCHED;
            PG8_STAGE(PG8_SB(1, 1), b3 + hstep, voffB);
            PG8_WAIT_V(6); PG8_BAR; PG8_MMA(1, 1, At, B1); PG8_BAR;
            }
        }
        if constexpr (ALIGN_EPI) { if (wr == 0) PG8_BAR; }
#if TPROBE == 23
        if (blockIdx.x == 0 && threadIdx.x == 0) { volatile PG8_LAS unsigned* mp_ = (volatile PG8_LAS unsigned*)(lds + 131072); mp_[48] = (unsigned)wall_clock64(); }
#endif
        if constexpr (!Epi::AFTER_DRAIN) { E(acc, cur, wr, wc, fr, fq); S.done(cur); }
#if TPROBE == 23
        if (blockIdx.x == 0 && threadIdx.x == 0) { volatile PG8_LAS unsigned* mp_ = (volatile PG8_LAS unsigned*)(lds + 131072); mp_[16] += (unsigned)wall_clock64() - mp_[48]; }
#endif
        if (!has_next) break;
#pragma unroll
        for (int a = 0; a < 2; ++a)
#pragma unroll
            for (int b = 0; b < 2; ++b)
#pragma unroll
                for (int m = 0; m < 4; ++m)
#pragma unroll
                    for (int n = 0; n < 2; ++n) acc[a][b][m][n] = (f32x4){0.f, 0.f, 0.f, 0.f};
        cur = nxt; cA = nA; cB = nB; ++ui;
        if constexpr (ALIGN_EPI) { if (wr == 1) PG8_BAR; }
    }
    PG8_WAIT_V(0);
    if constexpr (!ALIGN_EPI) { if (wr == 0) PG8_BAR; }
    PG8_BAR;
    if constexpr (Epi::AFTER_DRAIN) { E.fused(acc, cur, wr, wc, fr, fq, lds, wid, lane); S.done(cur); }
#undef PG8_SA
#undef PG8_SB
#undef PG8_STAGE
#undef PG8_LDA
#undef PG8_LDB
#undef PG8_MMA
#undef PG8_WAIT_V
#undef PG8_WAIT_L
#undef PG8_BAR
#undef PG8_SCHED
}
}
constexpr int NWAVES = 8, NTHR = 512;
constexpr int D = 1024, NBATCH = 8, SEQ = 4096, M = NBATCH * SEQ, DEPTH = 4;
constexpr int DIN = 8192, DFF = 2816, NEXP = 8, DFE = 3584;
constexpr float EPS = 1e-6f;
constexpr size_t MiB = 1u << 20;
constexpr size_t WS_CTL = 0, CTL_ZERO_BYTES = 2 * MiB;
constexpr size_t WS_MOD = 1 * MiB;
constexpr size_t WS_LB = 2 * MiB;
constexpr size_t WS_LI = 2 * MiB + 64 * 1024, WS_LF = WS_LI + 512 * 1024;
constexpr size_t WS_TOKEP = 4 * MiB;
constexpr size_t WS_TOKW = WS_TOKEP + 512 * 1024;
constexpr size_t WS_TOKD = WS_TOKW + 256 * 1024;
constexpr size_t WS_UZ = 5 * MiB;
constexpr size_t WS_WIN = 6 * MiB;
constexpr size_t WS_WAB = 22 * MiB, WAB_STEP = 4 * MiB;
constexpr size_t WS_WO = 30 * MiB, WO_STEP = 2 * MiB;
constexpr size_t WS_WFD = 34 * MiB, WF_W2_DENSE = 12 * MiB;
constexpr size_t WS_WFM = 52 * MiB, WF_W2_MOE = 112 * MiB;
constexpr size_t WS_H = 220 * MiB;
constexpr size_t WS_PROJ = 284 * MiB, PART = 64 * MiB;
constexpr size_t WS_MQ = 796 * MiB, WS_MK = 860 * MiB, WS_MV = 924 * MiB, WS_XC = 988 * MiB;
constexpr size_t WS_AG = 796 * MiB, WS_YS = 928 * MiB;
constexpr size_t WS_XB = 1060 * MiB;
constexpr size_t WS_END = 1124 * MiB;
constexpr size_t PSTRIDE = (size_t)M * 1024;
enum { P_QA = 0, P_LF = 1, P_VA = 2, P_GA = 3, P_XM = 4, P_OS = 5, P_GTA = 6, P_GTB = 7 };
constexpr int CW_BAR = 4096;
constexpr int CW_CNT = 16384;
constexpr int RING_BYTES = 131072, MISC_OFF = RING_BYTES, LDS_BYTES = 147456;

#define GAS __attribute__((address_space(1)))
#define LAS __attribute__((address_space(3)))
typedef unsigned short bf16;
typedef unsigned v4u __attribute__((ext_vector_type(4)));
typedef unsigned v2u __attribute__((ext_vector_type(2)));
typedef float f32x4 __attribute__((ext_vector_type(4)));
typedef float f32x2 __attribute__((ext_vector_type(2)));
typedef int i32x4 __attribute__((ext_vector_type(4)));
typedef int i32x2 __attribute__((ext_vector_type(2)));
#define LDS_WAIT() asm volatile("s_waitcnt lgkmcnt(0)" ::: "memory")
#define VM_WAIT() asm volatile("s_waitcnt vmcnt(0)" ::: "memory")
__device__ __forceinline__ unsigned f2bf(float f) { unsigned u = __builtin_bit_cast(unsigned, f); return (u + 0x7fffu + ((u >> 16) & 1u)) >> 16; }
typedef __bf16 bf16x2_t __attribute__((ext_vector_type(2)));
__device__ __forceinline__ unsigned pk2(float lo, float hi) { const f32x2 v = {lo, hi}; return __builtin_bit_cast(unsigned, __builtin_convertvector(v, bf16x2_t)); }
__device__ __forceinline__ float bflo(unsigned w) { return __uint_as_float(w << 16); }
__device__ __forceinline__ float bfhi(unsigned w) { return __uint_as_float(w & 0xffff0000u); }
__device__ __forceinline__ float bf2f(bf16 b) { return __uint_as_float((unsigned)b << 16); }
__device__ __forceinline__ float fsigm(float v) { return 1.0f / (1.0f + __expf(-v)); }
__device__ __forceinline__ float fsigr(float v) { return __builtin_amdgcn_rcpf(1.0f + __expf(-v)); }
template <int CTRL> __device__ __forceinline__ float dpp_f(float old, float src) { return __builtin_bit_cast(float, __builtin_amdgcn_update_dpp(__builtin_bit_cast(int, old), __builtin_bit_cast(int, src), CTRL, 0xf, 0xf, false)); }
__device__ __forceinline__ float rdlane_f(float v, int l) { return __builtin_bit_cast(float, __builtin_amdgcn_readlane(__builtin_bit_cast(int, v), l)); }
__device__ __forceinline__ float row_allsum(float v) { v += dpp_f<0x128>(0.f, v); v += dpp_f<0x124>(0.f, v); v += dpp_f<0x122>(0.f, v); v += dpp_f<0x121>(0.f, v); return v; }
__device__ __forceinline__ float wave_sum(float v) { const float r = row_allsum(v); return (rdlane_f(r, 0) + rdlane_f(r, 16)) + (rdlane_f(r, 32) + rdlane_f(r, 48)); }
__device__ __forceinline__ float half_sum(float v) {
    const float r = row_allsum(v); const float lo = rdlane_f(r, 0) + rdlane_f(r, 16), hi = rdlane_f(r, 32) + rdlane_f(r, 48);
    return (threadIdx.x & 32) ? hi : lo; }
__device__ __forceinline__ float sum16(float v) {
#pragma unroll
    for (int o = 1; o < 16; o <<= 1) v += __shfl_xor(v, o);
    return v;
}

__device__ __forceinline__ int opq_v(int v) { asm volatile("" : "+v"(v)); return v; }
__device__ __forceinline__ int opq_s(int v) { asm volatile("" : "+s"(v)); return v; }
__device__ __forceinline__ unsigned char* opq_p(unsigned char* p) { asm volatile("" : "+s"(p)); return p; }
#define TID() opq_v((int)threadIdx.x)
#define BID() opq_s((int)blockIdx.x)
#define XB_TMO      128
#define XB_XCNT(j)  (256  + 64 * (j))
#define XB_XSUB(j)  (1280 + 64 * (j))
#define XB_XGEN(j)  (2304 + 64 * (j))
#define XB_TOP      3328
#define XB_TOPGEN   3392
#define XCD_BAR_WORDS 3456
#define XB_SPIN_CAP (1u << 18)

__device__ __forceinline__ unsigned xb_ld(unsigned* p)              { return __hip_atomic_load(p, __ATOMIC_RELAXED, __HIP_MEMORY_SCOPE_AGENT); }
__device__ __forceinline__ unsigned xb_add(unsigned* p, unsigned v) { return __hip_atomic_fetch_add(p, v, __ATOMIC_RELAXED, __HIP_MEMORY_SCOPE_AGENT); }
__device__ __forceinline__ unsigned xb_xcc_id() { return (unsigned)__builtin_amdgcn_s_getreg((3 << 11) | 20) & 0xFu; }
#define XB_SPIN(cond, bar) do { unsigned _sp = 0; while (cond) { __builtin_amdgcn_s_sleep(1); \
    if ((++_sp & 255u) == 0u) { if (xb_ld(&(bar)[XB_TMO])) break; if (_sp > XB_SPIN_CAP) { atomicAdd(&(bar)[XB_TMO], 1u); break; } } } } while (0)

struct XcdBarrier {
    unsigned* bar; unsigned x;
    volatile LAS unsigned* st;
};

__device__ __forceinline__ XcdBarrier xcd_barrier_post(unsigned* bar, volatile LAS unsigned* st) {
    XcdBarrier b; b.bar = bar; b.x = xb_xcc_id(); b.st = st;
    if (threadIdx.x == 0) (void)xb_add(&bar[XB_XCNT(b.x)], 1u);
    return b;
}
__device__ __forceinline__ void xcd_barrier_complete(unsigned* bar, unsigned x, unsigned& nloc, unsigned& nx) {
    const unsigned G = gridDim.x * gridDim.y * gridDim.z;
    unsigned sum, cnt, mine, sp = 0u;
    for (;;) {
        sum = 0u; cnt = 0u; mine = 0u;
#pragma unroll
        for (unsigned j = 0; j < 16; ++j) { const unsigned c = xb_ld(&bar[XB_XCNT(j)]); sum += c; cnt += (c > 0u) ? 1u : 0u; mine = (j == x) ? c : mine; }
        if (sum == G) break;
        __builtin_amdgcn_s_sleep(1);
        if ((++sp & 255u) == 0u) { if (xb_ld(&bar[XB_TMO])) break; if (sp > XB_SPIN_CAP) { atomicAdd(&bar[XB_TMO], 1u); break; } }
    }
    nloc = mine > 0u ? mine : 1u; nx = cnt > 0u ? cnt : 1u;
}

__device__ __forceinline__ void xcd_barrier(const XcdBarrier& b) {
    asm volatile("s_waitcnt vmcnt(0)" ::: "memory");
    __syncthreads();
    if (threadIdx.x == 0) {
        unsigned* bar = b.bar;
        __builtin_amdgcn_s_waitcnt(0);
        unsigned nloc = b.st[0], nx = b.st[1];
        if (nloc == 0u) { xcd_barrier_complete(bar, b.x, nloc, nx); b.st[0] = nloc; b.st[1] = nx; }
        const unsigned old = xb_add(&bar[XB_XSUB(b.x)], 1u);
        const unsigned gen = old / nloc;
        if (old + 1u == (gen + 1u) * nloc) {
            __builtin_amdgcn_fence(__ATOMIC_RELEASE, "agent");
            asm volatile("s_waitcnt vmcnt(0)" ::: "memory");
            const unsigned og = xb_add(&bar[XB_TOP], 1u);
            const unsigned tg = og / nx;
            if (og + 1u == (tg + 1u) * nx) xb_add(&bar[XB_TOPGEN], 1u);
            else XB_SPIN(xb_ld(&bar[XB_TOPGEN]) == tg, bar);
            __builtin_amdgcn_fence(__ATOMIC_ACQUIRE, "agent");
            xb_add(&bar[XB_XGEN(b.x)], 1u);
            asm volatile("s_waitcnt vmcnt(0)" ::: "memory");
        } else {
            XB_SPIN(xb_ld(&bar[XB_XGEN(b.x)]) == gen, bar);
            __builtin_amdgcn_fence(__ATOMIC_ACQUIRE, "agent");
            asm volatile("s_waitcnt vmcnt(0)" ::: "memory");
        }
    }
    __syncthreads();
}
struct Ctx { const float* in[32]; float* out; unsigned char* ws; int ph_lo, ph_hi; };
enum { I_X = 0, I_C, I_WADA, I_BADA, I_GPREMIX, I_GPOSTMIX, I_GPREFFN, I_GPOSTFFN, I_WIN, I_HLB, I_HGN, I_CONVW, I_CONVB, I_WQ, I_WK, I_WV, I_WIG, I_BIG, I_WFG, I_BFG,
       I_MGN, I_MSKIP, I_WPA, I_WPB, I_WOUT, I_F1, I_F3, I_F2, I_ROUTER, I_M1, I_M3, I_M2 };

__device__ __forceinline__ void ph_mod(const Ctx& c, LAS unsigned char* lds) {
    LAS float* cact = (LAS float*)lds;
    LAS float* part = (LAS float*)(lds + 32768);
    GAS float* MOD = (GAS float*)(c.ws + WS_MOD);
    const GAS float* cin = (const GAS float*)c.in[I_C]; const GAS float* wada = (const GAS float*)c.in[I_WADA]; const GAS float* bada = (const GAS float*)c.in[I_BADA];
    const int tid = TID(), lane = tid & 63, wave = tid >> 6;
    for (int i = tid; i < 8192; i += NTHR) { const float v = cin[i]; cact[i] = v * fsigm(v); }
    __syncthreads();
    for (int u = BID(); u < 384; u += gridDim.x) {
        const int l = u / 96, jb = u % 96, j = jb * 64 + lane;
        const GAS float* w = wada + ((size_t)l * 1024 + wave * 128) * 6144 + j;
        const LAS float* ca = cact + wave * 128;
        float a0 = 0.f, a1 = 0.f, a2 = 0.f, a3 = 0.f, a4 = 0.f, a5 = 0.f, a6 = 0.f, a7 = 0.f;
#pragma unroll 8
        for (int k = 0; k < 128; ++k) { const float wv = w[(size_t)k * 6144];
            a0 += ca[k] * wv; a1 += ca[1024 + k] * wv; a2 += ca[2048 + k] * wv; a3 += ca[3072 + k] * wv;
            a4 += ca[4096 + k] * wv; a5 += ca[5120 + k] * wv; a6 += ca[6144 + k] * wv; a7 += ca[7168 + k] * wv; }
        LAS float* pw = part + wave * 512 + lane;
        pw[0] = a0; pw[64] = a1; pw[128] = a2; pw[192] = a3; pw[256] = a4; pw[320] = a5; pw[384] = a6; pw[448] = a7;
        __syncthreads();
        { const int b = wave; float s = bada[l * 6144 + j];
#pragma unroll
            for (int ww = 0; ww < 8; ++ww) s += part[ww * 512 + b * 64 + lane];
            MOD[(size_t)(l * 8 + b) * 6144 + j] = s; }
        __syncthreads();
    }
}
__device__ __forceinline__ void ph_lb(const Ctx& c) {
    if (BID() != 0) return;
    GAS float* LB = (GAS float*)(c.ws + WS_LB); const GAS float* raw = (const GAS float*)c.in[I_HLB];
    for (int col = TID(); col < 1024; col += NTHR) {
        const float r0 = raw[col], r1 = raw[1024 + col], r2 = raw[2048 + col], r3 = raw[3072 + col];
        const float mx = fmaxf(fmaxf(r0, r1), fmaxf(r2, r3));
        const float e0 = __expf(r0 - mx), e1 = __expf(r1 - mx), e2 = __expf(r2 - mx), e3 = __expf(r3 - mx), inv = 1.0f / (e0 + e1 + e2 + e3);
        LB[col] = 0.f; LB[1024 + col] = e1 * inv; LB[2048 + col] = (e1 + e2) * inv; LB[3072 + col] = (e1 + e2 + e3) * inv;
    }
}
struct CvtJob { const float* W; bf16* WT; int K, N, rowbase, mode, item, pad_; };
__device__ __forceinline__ void cvt_load(const CvtJob& j, int lane, f32x4 (&r)[8]) {
    const int nblk = j.N / 32, kb = j.item / nblk, nb = j.item % nblk;
    const GAS float* p = (const GAS float*)j.W + (size_t)(64 * kb + (lane >> 3)) * j.N + 32 * nb + (lane & 7) * 4;
#pragma unroll
    for (int i = 0; i < 8; ++i) r[i] = *(const GAS f32x4*)(p + (size_t)(8 * i) * j.N);
}
__device__ __forceinline__ void cvt_store(const CvtJob& j, int lane, const f32x4 (&r)[8], LAS float* scr) {
    const int nblk = j.N / 32, kb = j.item / nblk, nb = j.item % nblk, k0 = 64 * kb, n0 = 32 * nb;
#pragma unroll
    for (int i = 0; i < 8; ++i) { LAS float* s = scr + (8 * i + (lane >> 3)) * 33 + (lane & 7) * 4; s[0] = r[i][0]; s[1] = r[i][1]; s[2] = r[i][2]; s[3] = r[i][3]; }
    LDS_WAIT(); asm volatile("" ::: "memory");
    const int drow0 = j.rowbase + (j.mode ? ((n0 >> 7) * 256 + (n0 & 127)) : n0);
    const int cc = lane & 7;
#pragma unroll
    for (int jj = 0; jj < 4; ++jj) { const int n = (lane >> 3) + 8 * jj; const LAS float* s = scr + (8 * cc) * 33 + n;
        v4u o; o.x = pk2(s[0 * 33], s[1 * 33]); o.y = pk2(s[2 * 33], s[3 * 33]); o.z = pk2(s[4 * 33], s[5 * 33]); o.w = pk2(s[6 * 33], s[7 * 33]);
        *(GAS v4u*)(j.WT + (size_t)(drow0 + n) * j.K + k0 + 8 * cc) = o; }
    LDS_WAIT(); asm volatile("" ::: "memory");
}
__device__ __forceinline__ CvtJob cvt_decode(const Ctx& c, int l, int it) {
    bf16* WIN = (bf16*)(c.ws + WS_WIN); bf16* WAB = (bf16*)(c.ws + WS_WAB + (size_t)(l & 1) * WAB_STEP); bf16* WO = (bf16*)(c.ws + WS_WO + (size_t)(l & 1) * WO_STEP); bf16* WF = (bf16*)(c.ws + ((l & 1) ? WS_WFM : WS_WFD));
    const bool moe = (l & 1) != 0; const int j = l >> 1;
    constexpr int I_IN = 16 * 256, I_SQ = 16 * 32, I_D13 = 16 * 88, I_M13 = 16 * 112, I_M2E = 56 * 32;
    CvtJob q; q.pad_ = 0; q.mode = 0; q.rowbase = 0; q.K = D; q.N = D;
    int r = it;
    if (r < I_IN) { q.W = c.in[I_WIN] + (size_t)l * D * DIN; q.N = DIN; q.WT = WIN; q.item = r; return q; } r -= I_IN;
    if (r < I_SQ) { q.W = c.in[I_WPA] + (size_t)l * D * D; q.WT = WAB; q.item = r; return q; } r -= I_SQ;
    if (r < I_SQ) { q.W = c.in[I_WPB] + (size_t)l * D * D; q.WT = WAB; q.rowbase = 1024; q.item = r; return q; } r -= I_SQ;
    if (r < I_SQ) { q.W = c.in[I_WOUT] + (size_t)l * D * D; q.WT = WO; q.item = r; return q; } r -= I_SQ;
    if (!moe) {
        if (r < I_D13) { q.W = c.in[I_F1] + (size_t)j * D * DFF; q.N = DFF; q.WT = WF; q.mode = 1; q.item = r; return q; } r -= I_D13;
        if (r < I_D13) { q.W = c.in[I_F3] + (size_t)j * D * DFF; q.N = DFF; q.WT = WF; q.mode = 1; q.rowbase = 128; q.item = r; return q; } r -= I_D13;
        q.W = c.in[I_F2] + (size_t)j * DFF * D; q.K = DFF; q.WT = (bf16*)(c.ws + WS_WFD + WF_W2_DENSE); q.item = r; return q;
    }
    if (r < NEXP * I_M13) { const int e = r / I_M13; q.W = c.in[I_M1] + ((size_t)j * NEXP + e) * D * DFE; q.N = DFE; q.WT = WF; q.mode = 1; q.rowbase = e * 2 * DFE; q.item = r - e * I_M13; return q; } r -= NEXP * I_M13;
    if (r < NEXP * I_M13) { const int e = r / I_M13; q.W = c.in[I_M3] + ((size_t)j * NEXP + e) * D * DFE; q.N = DFE; q.WT = WF; q.mode = 1; q.rowbase = e * 2 * DFE + 128; q.item = r - e * I_M13; return q; } r -= NEXP * I_M13;
    { const int e = r / I_M2E; q.W = c.in[I_M2] + ((size_t)j * NEXP + e) * DFE * D; q.K = DFE; q.WT = (bf16*)(c.ws + WS_WFM + WF_W2_MOE); q.rowbase = e * D; q.item = r - e * I_M2E; return q; }
}
__device__ __forceinline__ void ph_cvt(const Ctx& c, int l, LAS unsigned char* lds, int wg, int nwg, int part, int nap = 0) {
    const int tid = TID(), lane = tid & 63, wave = __builtin_amdgcn_readfirstlane(tid >> 6);
    LAS float* scr = (LAS float*)(lds + wave * 16384);
    const int gw = wg * NWAVES + wave, NGW = nwg * NWAVES;
    const bool moe = (l & 1) != 0;
    const int total = 16 * 256 + 3 * 16 * 32 + (moe ? (2 * NEXP * 16 * 112 + NEXP * 56 * 32) : (2 * 16 * 88 + 44 * 32));
    const int first = (part == 1) ? 16 * 256 : 0, last = (part == 0) ? 16 * 256 : total;
    int it = first + gw; if (it >= last) return;
    CvtJob job = cvt_decode(c, l, it); f32x4 ra[8], rb[8]; cvt_load(job, lane, ra);
    for (;;) {
        const int nit = it + NGW; const bool more = nit < last; CvtJob jn = job;
        if (more) { jn = cvt_decode(c, l, nit); cvt_load(jn, lane, rb); }
        cvt_store(job, lane, ra, scr);
        if (!more) break;
        if (nap) __builtin_amdgcn_s_sleep(32);
#pragma unroll
        for (int i = 0; i < 8; ++i) ra[i] = rb[i];
        job = jn; it = nit;
    }
}

__device__ __forceinline__ void ld_row_f32(const float* p, int lane, f32x4 (&v)[4]) {
#pragma unroll
    for (int j = 0; j < 4; ++j) v[j] = *(const GAS f32x4*)(p + 4 * lane + 256 * j);
}
__device__ __forceinline__ void ld_row_bf16(const bf16* p, int lane, f32x4 (&v)[4]) {
#pragma unroll
    for (int j = 0; j < 4; ++j) { const v2u w = *(const GAS v2u*)(p + 4 * lane + 256 * j); v[j] = (f32x4){bflo(w.x), bfhi(w.x), bflo(w.y), bfhi(w.y)}; }
}
__device__ __forceinline__ void st_row_bf16(bf16* p, int lane, const f32x4 (&v)[4]) {
#pragma unroll
    for (int j = 0; j < 4; ++j) { v2u w; w.x = pk2(v[j][0], v[j][1]); w.y = pk2(v[j][2], v[j][3]); *(GAS v2u*)(p + 4 * lane + 256 * j) = w; }
}
__device__ __forceinline__ float row_sumsq(const f32x4 (&v)[4]) {
    float s = 0.f;
#pragma unroll
    for (int j = 0; j < 4; ++j) s += (v[j][0] * v[j][0] + v[j][1] * v[j][1]) + (v[j][2] * v[j][2] + v[j][3] * v[j][3]);
    return wave_sum(s);
}
__device__ __forceinline__ void norm_mod(const f32x4 (&x)[4], const f32x4 (&g)[4], const f32x4 (&sc)[4], const f32x4 (&sh)[4], f32x4 (&h)[4]) {
    const float r = rsqrtf(row_sumsq(x) * (1.0f / 1024.0f) + EPS);
#pragma unroll
    for (int j = 0; j < 4; ++j) h[j] = (x[j] * r) * g[j] * (sc[j] + 1.0f) + sh[j];
}
__device__ __forceinline__ const float* modp(const Ctx& c, int l, int b, int which) { return (const float*)(c.ws + WS_MOD) + ((size_t)(l * 8 + b) * 6 + which) * 1024; }

__device__ __forceinline__ void ph_norm0(const Ctx& c) {
    const int tid = TID(), lane = tid & 63, wave = tid >> 6, gw = BID() * NWAVES + wave, NGW = gridDim.x * NWAVES;
    bf16* H = (bf16*)(c.ws + WS_H);
    for (int slot = gw; slot < M / 16; slot += NGW) {
        const int row0 = slot * 16, b = row0 / SEQ;
        f32x4 g[4], sc[4], sh[4]; ld_row_f32(c.in[I_GPREMIX], lane, g); ld_row_f32(modp(c, 0, b, 1), lane, sc); ld_row_f32(modp(c, 0, b, 0), lane, sh);
        for (int r = 0; r < 16; ++r) { f32x4 x[4], h[4]; ld_row_f32(c.in[I_X] + (size_t)(row0 + r) * D, lane, x); norm_mod(x, g, sc, sh, h); st_row_bf16(H + (size_t)(row0 + r) * D, lane, h); }
    }
}
__device__ __forceinline__ void ph_uz(const Ctx& c) {
    GAS float* UZ = (GAS float*)(c.ws + WS_UZ);
    const int gt = BID() * NTHR + TID();
    if (gt >= DEPTH * D) return;
    const int l = gt >> 10, ch = gt & 1023, n = ch >> 2, i = ch & 3;
    const GAS float* wq = (const GAS float*)c.in[I_WQ] + (size_t)l * 4096 + n * 16 + i * 4; const GAS float* wk = (const GAS float*)c.in[I_WK] + (size_t)l * 4096 + n * 16 + i * 4; const GAS float* wv = (const GAS float*)c.in[I_WV] + (size_t)l * 4096 + n * 16 + i * 4;
    const GAS float* wig = (const GAS float*)c.in[I_WIG] + (size_t)l * 3072 * 4; const GAS float* wfg = (const GAS float*)c.in[I_WFG] + (size_t)l * 3072 * 4;
    f32x4 ui = {0.f, 0.f, 0.f, 0.f}, uf = ui, zi = ui, zf = ui;
#pragma unroll
    for (int o = 0; o < 4; ++o) { const float q = wq[o], k = wk[o], v = wv[o];
        ui += *(const GAS f32x4*)(wig + (size_t)(4 * n + o) * 4) * q + *(const GAS f32x4*)(wig + (size_t)(1024 + 4 * n + o) * 4) * k; zi += *(const GAS f32x4*)(wig + (size_t)(2048 + 4 * n + o) * 4) * v;
        uf += *(const GAS f32x4*)(wfg + (size_t)(4 * n + o) * 4) * q + *(const GAS f32x4*)(wfg + (size_t)(1024 + 4 * n + o) * 4) * k; zf += *(const GAS f32x4*)(wfg + (size_t)(2048 + 4 * n + o) * 4) * v; }
    GAS f32x4* UP = (GAS f32x4*)(UZ + (size_t)DEPTH * D * 16 + (size_t)l * 16 * D);
    UP[(i * 4 + 0) * 256 + n] = ui; UP[(i * 4 + 1) * 256 + n] = uf; UP[(i * 4 + 2) * 256 + n] = zi; UP[(i * 4 + 3) * 256 + n] = zf;
}
__device__ __forceinline__ void ph_prep(const Ctx& c, int l, LAS unsigned char* lds) {
    const int tid = TID(), lane = tid & 63, wave = tid >> 6, gw = BID() * NWAVES + wave, NGW = gridDim.x * NWAVES;
    LAS f32x4* UZL = (LAS f32x4*)lds;
    LAS f32x4* WTL = (LAS f32x4*)(lds + 65536);
    LAS f32x4* CWL = (LAS f32x4*)(lds + 114688);
    LAS f32x4* CBL = (LAS f32x4*)(lds + 135168);
    {   const GAS f32x4* ut = (const GAS f32x4*)((const float*)(c.ws + WS_UZ) + (size_t)DEPTH * D * 16 + (size_t)l * 16 * D);
        for (int i = tid; i < 4096; i += NTHR) UZL[i] = ut[i];
        for (int i = tid; i < 1024; i += NTHR) { const int ii = i >> 8, n = i & 255; const size_t so = (size_t)l * 4096 + n * 16 + ii * 4;
            WTL[i] = *(const GAS f32x4*)(c.in[I_WQ] + so); WTL[1024 + i] = *(const GAS f32x4*)(c.in[I_WK] + so); WTL[2048 + i] = *(const GAS f32x4*)(c.in[I_WV] + so); }
        for (int i = tid; i < 1024; i += NTHR) CWL[i] = *(const GAS f32x4*)(c.in[I_CONVW] + (size_t)l * 4 * D + i * 4);
        if (tid < 256) CBL[tid] = *(const GAS f32x4*)(c.in[I_CONVB] + (size_t)l * D + tid * 4);
        __syncthreads(); }
    const bf16* XM = (const bf16*)(c.ws + WS_PROJ) + (size_t)P_XM * PSTRIDE;
    bf16* MQ = (bf16*)(c.ws + WS_MQ); bf16* MK = (bf16*)(c.ws + WS_MK); bf16* MV = (bf16*)(c.ws + WS_MV); bf16* XC = (bf16*)(c.ws + WS_XC);
    GAS float* LI = (GAS float*)(c.ws + WS_LI); GAS float* LF = (GAS float*)(c.ws + WS_LF);
    const float* cw = c.in[I_CONVW] + (size_t)l * 4 * D; const float* cb = c.in[I_CONVB] + (size_t)l * D;
    const float* wq = c.in[I_WQ] + (size_t)l * 256 * 16; const float* wk = c.in[I_WK] + (size_t)l * 256 * 16; const float* wv = c.in[I_WV] + (size_t)l * 256 * 16;
    const float* UZ = (const float*)(c.ws + WS_UZ) + (size_t)l * D * 16;
    const int gidx = (lane >> 1) & 7;
    const float gbias = (gidx < 4) ? ((const GAS float*)c.in[I_BIG])[l * 4 + gidx] : ((const GAS float*)c.in[I_BFG])[l * 4 + gidx - 4];
    for (int slot = gw; slot < M / 16; slot += NGW) {
        const int row0 = slot * 16, tq0 = row0 & (SEQ - 1);
#define PREP_WIN(W_, TB_, J_) do { _Pragma("unroll") for (int r = 0; r < 7; ++r) { const int rel_ = (TB_) * 4 - 3 + r; const int rr_ = (tq0 + rel_ >= 0) ? rel_ : 0; \
            W_[r] = *(const GAS v2u*)(XM + (size_t)(row0 + rr_) * D + 4 * lane + 256 * (J_)); } } while (0)
        v2u wn[7]; PREP_WIN(wn, 0, 0);
#pragma unroll 1
        for (int tb = 0; tb < 4; ++tb) {
            f32x4 gi[4], gf[4];
#pragma unroll
            for (int tt = 0; tt < 4; ++tt) { gi[tt] = (f32x4){0.f, 0.f, 0.f, 0.f}; gf[tt] = gi[tt]; }
#pragma unroll 1
            for (int j = 0; j < 4; ++j) {
                const int ch = 4 * lane + 256 * j, n = lane + 64 * j;
                const f32x4 b4 = CBL[n];
                f32x4 xcs[4], xts[4];
                {
                    f32x4 w4[4];
#pragma unroll
                    for (int i = 0; i < 4; ++i) w4[i] = CWL[i * 256 + n];
                    v2u win[7];
#pragma unroll
                    for (int r = 0; r < 7; ++r) { const int rel = tb * 4 - 3 + r; win[r] = (tq0 + rel >= 0) ? wn[r] : (v2u){0u, 0u}; }
                    { const int itn = (tb * 4 + j + 1 < 16) ? tb * 4 + j + 1 : 15; PREP_WIN(wn, itn >> 2, itn & 3); }
#pragma unroll
                    for (int tt = 0; tt < 4; ++tt) {
                        f32x4 y = b4, xt = {0.f, 0.f, 0.f, 0.f};
#pragma unroll
                        for (int jj = 0; jj < 4; ++jj) { const v2u w = win[tt + jj]; const f32x4 xv = {bflo(w.x), bfhi(w.x), bflo(w.y), bfhi(w.y)}; y += w4[jj] * xv; if (jj == 3) xt = xv; }
                        f32x4 xc; xc[0] = y[0] * fsigr(y[0]); xc[1] = y[1] * fsigr(y[1]); xc[2] = y[2] * fsigr(y[2]); xc[3] = y[3] * fsigr(y[3]);
                        xcs[tt] = xc; xts[tt] = xt;
                        { v2u w; w.x = pk2(xc[0], xc[1]); w.y = pk2(xc[2], xc[3]); *(GAS v2u*)(XC + (size_t)(row0 + tb * 4 + tt) * D + ch) = w; }
                    }
                }
                asm volatile("" ::: "memory");
                {
                    f32x4 q4[4], k4[4], v4[4];
#pragma unroll
                    for (int i = 0; i < 4; ++i) { q4[i] = WTL[i * 256 + n]; k4[i] = WTL[1024 + i * 256 + n]; v4[i] = WTL[2048 + i * 256 + n]; }
#pragma unroll
                    for (int tt = 0; tt < 4; ++tt) {
                        f32x4 q = {0.f, 0.f, 0.f, 0.f}, k = q, v = q;
#pragma unroll
                        for (int i = 0; i < 4; ++i) { q += q4[i] * xcs[tt][i]; k += k4[i] * xcs[tt][i]; v += v4[i] * xts[tt][i]; }
                        const size_t off = (size_t)(row0 + tb * 4 + tt) * D + ch;
                        { v2u w; w.x = pk2(q[0], q[1]); w.y = pk2(q[2], q[3]); *(GAS v2u*)(MQ + off) = w; }
                        { v2u w; w.x = pk2(k[0] * 0.0625f, k[1] * 0.0625f); w.y = pk2(k[2] * 0.0625f, k[3] * 0.0625f); *(GAS v2u*)(MK + off) = w; }
                        { v2u w; w.x = pk2(v[0], v[1]); w.y = pk2(v[2], v[3]); *(GAS v2u*)(MV + off) = w; }
                    }
                }
                asm volatile("" ::: "memory");
                {
#pragma unroll
                    for (int i = 0; i < 4; ++i) { const f32x4 u0 = UZL[(i * 4 + 0) * 256 + n], u1 = UZL[(i * 4 + 1) * 256 + n], u2 = UZL[(i * 4 + 2) * 256 + n], u3 = UZL[(i * 4 + 3) * 256 + n];
#pragma unroll
                        for (int tt = 0; tt < 4; ++tt) { gi[tt] += u0 * xcs[tt][i] + u2 * xts[tt][i]; gf[tt] += u1 * xcs[tt][i] + u3 * xts[tt][i]; }
                        __builtin_amdgcn_sched_barrier(0); }
                }
            }
            float v[32];
#pragma unroll
            for (int tt = 0; tt < 4; ++tt)
#pragma unroll
                for (int hh = 0; hh < 4; ++hh) { v[tt * 8 + hh] = gi[tt][hh]; v[tt * 8 + 4 + hh] = gf[tt][hh]; }
#pragma unroll
            for (int st = 0; st < 5; ++st) { const int o = 32 >> st, nn = 32 >> st; const bool up = (lane & o) != 0;
#pragma unroll
                for (int i = 0; i < nn / 2; ++i) { const float lo = v[i], hi = v[i + nn / 2]; const float send = up ? lo : hi, keep = up ? hi : lo; v[i] = keep + __shfl_xor(send, o); } }
            const float tot = v[0] + __shfl_xor(v[0], 1) + gbias;
            if ((lane & 1) == 0) { const int tt = lane >> 4; const size_t row = (size_t)(row0 + tb * 4 + tt);
                if (gidx < 4) LI[row * 4 + gidx] = tot; else LF[row * 4 + gidx - 4] = fminf(tot, 0.f) - __logf(1.0f + __expf(-fabsf(tot))); }
        }
    }
#undef PREP_WIN
}

__device__ __forceinline__ void ph_scan_a_naive(const Ctx& c, LAS unsigned char* lds) {
    const int tid = TID();
    bf16* PJ = (bf16*)(c.ws + WS_PROJ);
    const bf16* Q = PJ + (size_t)P_QA * PSTRIDE; const bf16* LFp = PJ + (size_t)P_LF * PSTRIDE; bf16* V = PJ + (size_t)P_VA * PSTRIDE;
    LAS bf16* sq = (LAS bf16*)lds;
    LAS bf16* sf = (LAS bf16*)(lds + 32768);
    LAS bf16* sv = (LAS bf16*)(lds + 65536);
    LAS float* so = (LAS float*)(lds + 73728);
    const int dg = tid & 15, vv = tid >> 4;
    for (int u = BID(); u < 256; u += gridDim.x) {
        const int b = u >> 5, h = (u >> 2) & 7, vs = u & 3;
        const size_t rowbase = (size_t)b * SEQ;
        float S[8];
#pragma unroll
        for (int j = 0; j < 8; ++j) S[j] = 0.f;
        v4u rq[2], rf[2], rv = {0u, 0u, 0u, 0u};
#define SA_LOAD(ch) do { _Pragma("unroll") for (int k2 = 0; k2 < 2; ++k2) { const int p = tid + NTHR * k2, rr = p >> 4, c8 = p & 15; const size_t o_ = (rowbase + (size_t)(ch) * 64 + rr) * D + h * 128 + c8 * 8; \
            rq[k2] = *(const GAS v4u*)(Q + o_); rf[k2] = *(const GAS v4u*)(LFp + o_); } \
            if (tid < 256) { const int rr = tid >> 2, c8 = tid & 3; rv = *(const GAS v4u*)(V + (rowbase + (size_t)(ch) * 64 + rr) * D + h * 128 + vs * 32 + c8 * 8); } } while (0)
        SA_LOAD(0);
        for (int ch = 0; ch < 64; ++ch) {
            const int buf = ch & 1;
#pragma unroll
            for (int k2 = 0; k2 < 2; ++k2) { const int p = tid + NTHR * k2; *(LAS v4u*)(sq + buf * 8192 + p * 8) = rq[k2]; *(LAS v4u*)(sf + buf * 8192 + p * 8) = rf[k2]; }
            if (tid < 256) *(LAS v4u*)(sv + buf * 2048 + tid * 8) = rv;
            __syncthreads();
            if (ch + 1 < 64) SA_LOAD(ch + 1);
            for (int i = 0; i < 64; ++i) {
                const v4u qv = *(const LAS v4u*)(sq + buf * 8192 + i * 128 + dg * 8), fv = *(const LAS v4u*)(sf + buf * 8192 + i * 128 + dg * 8);
                const float vt = bf2f(sv[buf * 2048 + i * 32 + vv]);
                const float qq[8] = {bflo(qv.x), bfhi(qv.x), bflo(qv.y), bfhi(qv.y), bflo(qv.z), bfhi(qv.z), bflo(qv.w), bfhi(qv.w)};
                const float ff[8] = {bflo(fv.x), bfhi(fv.x), bflo(fv.y), bfhi(fv.y), bflo(fv.z), bfhi(fv.z), bflo(fv.w), bfhi(fv.w)};
                float o = 0.f;
#pragma unroll
                for (int j = 0; j < 8; ++j) { const float f = __expf(ff[j]); S[j] = f * S[j] + (1.0f - f) * vt; o += S[j] * qq[j]; }
                o = sum16(o);
                if (dg == 0) so[i * 32 + vv] = o;
            }
            __syncthreads();
            { const int rr = tid >> 3, c4 = (tid & 7) * 4; const f32x4 ov = *(const LAS f32x4*)(so + rr * 32 + c4);
                v2u w; w.x = pk2(ov[0], ov[1]); w.y = pk2(ov[2], ov[3]); *(GAS v2u*)(V + (rowbase + (size_t)ch * 64 + rr) * D + h * 128 + vs * 32 + c4) = w; }
        }
#undef SA_LOAD
        __syncthreads();
    }
}

__device__ __forceinline__ void ph_scan_m_naive(const Ctx& c, LAS unsigned char* lds) {
    const int tid = TID();
    const bf16* MQ = (const bf16*)(c.ws + WS_MQ); const bf16* MK = (const bf16*)(c.ws + WS_MK); bf16* MV = (bf16*)(c.ws + WS_MV);
    const float* LI = (const float*)(c.ws + WS_LI); const float* LF = (const float*)(c.ws + WS_LF);
    LAS bf16* sq = (LAS bf16*)lds;
    LAS bf16* sk = (LAS bf16*)(lds + 32768);
    LAS bf16* sv = (LAS bf16*)(lds + 65536);
    LAS float* sli = (LAS float*)(lds + 69632);
    LAS float* slf = (LAS float*)(lds + 69888);
    LAS float* so = (LAS float*)(lds + 70144);
    const int dg = tid & 15, vv = tid >> 4;
    for (int u = BID(); u < 256; u += gridDim.x) {
        const int b = u >> 5, h = (u >> 3) & 3, vs = u & 7;
        const size_t rowbase = (size_t)b * SEQ;
        float C[16], nn[16], m = 0.f;
#pragma unroll
        for (int j = 0; j < 16; ++j) { C[j] = 0.f; nn[j] = 0.f; }
        v4u rq[4], rk[4], rv = {0u, 0u, 0u, 0u}; float rli = 0.f, rlf = 0.f;
#define SM_LOAD(ch) do { _Pragma("unroll") for (int k2 = 0; k2 < 4; ++k2) { const int p = tid + NTHR * k2, rr = p >> 5, c8 = p & 31; const size_t o_ = (rowbase + (size_t)(ch) * 64 + rr) * D + h * 256 + c8 * 8; \
            rq[k2] = *(const GAS v4u*)(MQ + o_); rk[k2] = *(const GAS v4u*)(MK + o_); } \
            if (tid < 256) { const int rr = tid >> 2, c8 = tid & 3; rv = *(const GAS v4u*)(MV + (rowbase + (size_t)(ch) * 64 + rr) * D + h * 256 + vs * 32 + c8 * 8); } \
            if (tid < 64) { rli = LI[(rowbase + (size_t)(ch) * 64 + tid) * 4 + h]; rlf = LF[(rowbase + (size_t)(ch) * 64 + tid) * 4 + h]; } } while (0)
        SM_LOAD(0);
        for (int ch = 0; ch < 64; ++ch) {
#pragma unroll
            for (int k2 = 0; k2 < 4; ++k2) { const int p = tid + NTHR * k2; *(LAS v4u*)(sq + p * 8) = rq[k2]; *(LAS v4u*)(sk + p * 8) = rk[k2]; }
            if (tid < 256) *(LAS v4u*)(sv + tid * 8) = rv;
            if (tid < 64) { sli[tid] = rli; slf[tid] = rlf; }
            __syncthreads();
            if (ch + 1 < 64) SM_LOAD(ch + 1);
            for (int i = 0; i < 64; ++i) {
                const float li = sli[i], lf = slf[i];
                const float mn = fmaxf(lf + m, li), fg = __expf(lf + m - mn), ig = __expf(li - mn); m = mn;
                const float vt = bf2f(sv[i * 32 + vv]) * ig;
                float num = 0.f, den = 0.f;
#pragma unroll
                for (int hh = 0; hh < 2; ++hh) {
                    const v4u qv = *(const LAS v4u*)(sq + i * 256 + dg * 16 + hh * 8), kv = *(const LAS v4u*)(sk + i * 256 + dg * 16 + hh * 8);
                    const float qq[8] = {bflo(qv.x), bfhi(qv.x), bflo(qv.y), bfhi(qv.y), bflo(qv.z), bfhi(qv.z), bflo(qv.w), bfhi(qv.w)};
                    const float kk[8] = {bflo(kv.x), bfhi(kv.x), bflo(kv.y), bfhi(kv.y), bflo(kv.z), bfhi(kv.z), bflo(kv.w), bfhi(kv.w)};
#pragma unroll
                    for (int j = 0; j < 8; ++j) { const int jj = hh * 8 + j; C[jj] = fg * C[jj] + kk[j] * vt; nn[jj] = fg * nn[jj] + ig * kk[j]; num += qq[j] * C[jj]; den += qq[j] * nn[jj]; }
                }
                num = sum16(num); den = sum16(den);
                if (dg == 0) so[i * 32 + vv] = num / fmaxf(fabsf(den), __expf(-m));
            }
            __syncthreads();
            { const int rr = tid >> 3, c4 = (tid & 7) * 4; const f32x4 ov = *(const LAS f32x4*)(so + rr * 32 + c4);
                v2u w; w.x = pk2(ov[0], ov[1]); w.y = pk2(ov[2], ov[3]); *(GAS v2u*)(MV + (rowbase + (size_t)ch * 64 + rr) * D + h * 256 + vs * 32 + c4) = w; }
        }
#undef SM_LOAD
        __syncthreads();
    }
}

__device__ __forceinline__ void ph_post(const Ctx& c, int l) {
    const int tid = TID(), lane = tid & 63, wave = tid >> 6, gw = BID() * NWAVES + wave, NGW = gridDim.x * NWAVES;
    bf16* PJ = (bf16*)(c.ws + WS_PROJ);
    const bf16* OS = PJ + (size_t)P_OS * PSTRIDE; bf16* BO = PJ + (size_t)P_LF * PSTRIDE;
    const bf16* HM = (const bf16*)(c.ws + WS_H); const bf16* XC = (const bf16*)(c.ws + WS_XC);
    float gnm[2][8], skp[2][8];
#pragma unroll
    for (int j = 0; j < 2; ++j) { const int c0 = 8 * lane + 512 * j;
        const f32x4 b0 = *(const GAS f32x4*)(c.in[I_MGN] + (size_t)l * D + c0), b1 = *(const GAS f32x4*)(c.in[I_MGN] + (size_t)l * D + c0 + 4);
        const f32x4 s0 = *(const GAS f32x4*)(c.in[I_MSKIP] + (size_t)l * D + c0), s1 = *(const GAS f32x4*)(c.in[I_MSKIP] + (size_t)l * D + c0 + 4);
#pragma unroll
        for (int e = 0; e < 4; ++e) { gnm[j][e] = b0[e]; gnm[j][4 + e] = b1[e]; skp[j][e] = s0[e]; skp[j][4 + e] = s1[e]; } }
#define POST_LOAD(R, ro_) do { _Pragma("unroll") for (int j = 0; j < 2; ++j) { const size_t o_ = (ro_) + 8 * lane + 512 * j; R[0][j] = *(const GAS v4u*)(HM + o_); R[1][j] = *(const GAS v4u*)(XC + o_); R[2][j] = *(const GAS v4u*)(OS + o_); } } while (0)
#define UNPK8(F_, W_) do { const v4u q_ = (W_); F_[0] = bflo(q_.x); F_[1] = bfhi(q_.x); F_[2] = bflo(q_.y); F_[3] = bfhi(q_.y); F_[4] = bflo(q_.z); F_[5] = bfhi(q_.z); F_[6] = bflo(q_.w); F_[7] = bfhi(q_.w); } while (0)
    for (int slot = gw; slot < M / 16; slot += NGW) {
        v4u ra[3][2], rb[3][2], rc[3][2];
        POST_LOAD(ra, (size_t)(slot * 16) * D); POST_LOAD(rb, (size_t)(slot * 16 + 1) * D);
        for (int r = 0; r < 16; ++r) {
            const size_t ro = (size_t)(slot * 16 + r) * D;
            if (r + 2 < 16) POST_LOAD(rc, ro + 2 * D);
#pragma unroll
            for (int j = 0; j < 2; ++j) {
                float hm[8], xc[8], orw[8], bo[8];
                UNPK8(hm, ra[0][j]); UNPK8(xc, ra[1][j]); UNPK8(orw, ra[2][j]);
                float sm = 0.f;
#pragma unroll
                for (int e = 0; e < 8; ++e) sm += hm[e];
                const float mu = half_sum(sm) * (1.0f / 256.0f);
                float vs_ = 0.f;
#pragma unroll
                for (int e = 0; e < 8; ++e) { hm[e] -= mu; vs_ += hm[e] * hm[e]; }
                const float rsb = rsqrtf(half_sum(vs_) * (1.0f / 256.0f) + EPS);
#pragma unroll
                for (int e = 0; e < 8; ++e) bo[e] = fsigm(orw[e]) * (hm[e] * rsb * gnm[j][e] + skp[j][e] * xc[e]);
                *(GAS v4u*)(BO + ro + 8 * lane + 512 * j) = (v4u){pk2(bo[0], bo[1]), pk2(bo[2], bo[3]), pk2(bo[4], bo[5]), pk2(bo[6], bo[7])};
            }
#pragma unroll
            for (int s = 0; s < 3; ++s)
#pragma unroll
                for (int j = 0; j < 2; ++j) { ra[s][j] = rb[s][j]; rb[s][j] = rc[s][j]; }
        }
    }
#undef POST_LOAD
#undef UNPK8
}
typedef short bf16x8 __attribute__((ext_vector_type(8)));
#define MFMA16(a, b, c) __builtin_amdgcn_mfma_f32_16x16x32_bf16(a, b, c, 0, 0, 0)
__device__ __forceinline__ f32x4 mmT(const LAS bf16* X, int ldx, int m0, const LAS bf16* Y, int ldy, int n0, int k0, f32x4 acc, int lane) {
    const bf16x8 a = *(const LAS bf16x8*)(X + (m0 + (lane & 15)) * ldx + k0 + 8 * (lane >> 4));
    const bf16x8 b = *(const LAS bf16x8*)(Y + (n0 + (lane & 15)) * ldy + k0 + 8 * (lane >> 4));
    return MFMA16(b, a, acc);
}
__device__ __forceinline__ f32x4 mmN(const LAS bf16* X, int ldx, int m0, const LAS bf16* Y, int ldy, int n0, int k0, f32x4 acc, int lane) {
    const bf16x8 a = *(const LAS bf16x8*)(X + (m0 + (lane & 15)) * ldx + k0 + 8 * (lane >> 4));
    const bf16x8 b = *(const LAS bf16x8*)(Y + (n0 + (lane & 15)) * ldy + k0 + 8 * (lane >> 4));
    return MFMA16(a, b, acc);
}
__device__ __forceinline__ v2u pack4(const f32x4 v) { v2u w; w.x = pk2(v[0], v[1]); w.y = pk2(v[2], v[3]); return w; }

__device__ __forceinline__ bf16x8 tr_frag(const LAS bf16* T, int ld, int k0, int m0, int lane) {
    const int g = lane >> 4, q = (lane & 15) >> 2, p = lane & 3;
    const unsigned a0 = (unsigned)(size_t)(T + (k0 + 8 * g + q) * ld + m0 + 4 * p), a1 = a0 + (unsigned)(4 * ld * 2);
    v2u x, y; asm volatile("ds_read_b64_tr_b16 %0, %2\n\tds_read_b64_tr_b16 %1, %3\n\ts_waitcnt lgkmcnt(0)" : "=&v"(x), "=&v"(y) : "v"(a0), "v"(a1) : "memory");
    const v4u w = {x.x, x.y, y.x, y.y}; return __builtin_bit_cast(bf16x8, w);
}
struct Frag2 { bf16x8 a, b; };
__device__ __forceinline__ Frag2 tr_frag2(const LAS bf16* Ta, int lda, int k0a, int m0a, const LAS bf16* Tb, int ldb, int k0b, int m0b, int lane) {
    const int g = lane >> 4, q = (lane & 15) >> 2, p = lane & 3;
    const unsigned a0 = (unsigned)(size_t)(Ta + (k0a + 8 * g + q) * lda + m0a + 4 * p), a1 = a0 + (unsigned)(4 * lda * 2);
    const unsigned b0 = (unsigned)(size_t)(Tb + (k0b + 8 * g + q) * ldb + m0b + 4 * p), b1 = b0 + (unsigned)(4 * ldb * 2);
    v2u x, y, z, w; asm volatile("ds_read_b64_tr_b16 %0, %4\n\tds_read_b64_tr_b16 %1, %5\n\tds_read_b64_tr_b16 %2, %6\n\tds_read_b64_tr_b16 %3, %7\n\ts_waitcnt lgkmcnt(0)"
        : "=&v"(x), "=&v"(y), "=&v"(z), "=&v"(w) : "v"(a0), "v"(a1), "v"(b0), "v"(b1) : "memory");
    const v4u wa = {x.x, x.y, y.x, y.y}, wb = {z.x, z.y, w.x, w.y}; Frag2 r; r.a = __builtin_bit_cast(bf16x8, wa); r.b = __builtin_bit_cast(bf16x8, wb); return r;
}
#define TRH(P_, Q_) __builtin_bit_cast(bf16x8, (v4u){(P_).x, (P_).y, (Q_).x, (Q_).y})
__device__ __forceinline__ void tr_hgrn(const LAS bf16* LV, const LAS bf16* LK, int wave, int lane, bf16x8 (&vf)[4][2], bf16x8 (&kf)[2]) {
    const int g = lane >> 4, q = (lane & 15) >> 2, p = lane & 3;
    const unsigned av = (unsigned)(size_t)(LV + (8 * g + q) * 72 + 4 * p), ak = (unsigned)(size_t)(LK + (8 * g + q) * 136 + 4 * p + wave * 16);
    v2u a0, a1, a2, a3, a4, a5, a6, a7, b0, b1, b2, b3, b4, b5, b6, b7, k0, k1, k2, k3;
    asm volatile(
        "ds_read_b64_tr_b16 %0, %20\n\tds_read_b64_tr_b16 %1, %20 offset:576\n\tds_read_b64_tr_b16 %2, %20 offset:32\n\tds_read_b64_tr_b16 %3, %20 offset:608\n\t"
        "ds_read_b64_tr_b16 %4, %20 offset:64\n\tds_read_b64_tr_b16 %5, %20 offset:640\n\tds_read_b64_tr_b16 %6, %20 offset:96\n\tds_read_b64_tr_b16 %7, %20 offset:672\n\t"
        "ds_read_b64_tr_b16 %8, %20 offset:4608\n\tds_read_b64_tr_b16 %9, %20 offset:5184\n\tds_read_b64_tr_b16 %10, %20 offset:4640\n\tds_read_b64_tr_b16 %11, %20 offset:5216\n\t"
        "ds_read_b64_tr_b16 %12, %20 offset:4672\n\tds_read_b64_tr_b16 %13, %20 offset:5248\n\tds_read_b64_tr_b16 %14, %20 offset:4704\n\tds_read_b64_tr_b16 %15, %20 offset:5280\n\t"
        "ds_read_b64_tr_b16 %16, %21\n\tds_read_b64_tr_b16 %17, %21 offset:1088\n\tds_read_b64_tr_b16 %18, %21 offset:8704\n\tds_read_b64_tr_b16 %19, %21 offset:9792\n\t"
        "s_waitcnt lgkmcnt(0)"
        : "=&v"(a0), "=&v"(a1), "=&v"(a2), "=&v"(a3), "=&v"(a4), "=&v"(a5), "=&v"(a6), "=&v"(a7), "=&v"(b0), "=&v"(b1), "=&v"(b2), "=&v"(b3), "=&v"(b4), "=&v"(b5), "=&v"(b6), "=&v"(b7),
          "=&v"(k0), "=&v"(k1), "=&v"(k2), "=&v"(k3)
        : "v"(av), "v"(ak) : "memory");
    vf[0][0] = TRH(a0, a1); vf[1][0] = TRH(a2, a3); vf[2][0] = TRH(a4, a5); vf[3][0] = TRH(a6, a7);
    vf[0][1] = TRH(b0, b1); vf[1][1] = TRH(b2, b3); vf[2][1] = TRH(b4, b5); vf[3][1] = TRH(b6, b7);
    kf[0] = TRH(k0, k1); kf[1] = TRH(k2, k3);
}
__device__ __forceinline__ void tr_mnum(const LAS bf16* LV0, int e0, int lane, bf16x8 (&f)[3][2]) {
    const int g = lane >> 4, q = (lane & 15) >> 2, p = lane & 3;
    const unsigned av = (unsigned)(size_t)(LV0 + (8 * g + q) * 88 + 4 * p + e0), ad = (unsigned)(size_t)(LV0 + (8 * g + q) * 88 + 4 * p + 64);
    v2u a0, a1, a2, a3, a4, a5, b0, b1, b2, b3, b4, b5;
    asm volatile(
        "ds_read_b64_tr_b16 %0, %12\n\tds_read_b64_tr_b16 %1, %12 offset:704\n\tds_read_b64_tr_b16 %2, %12 offset:32\n\tds_read_b64_tr_b16 %3, %12 offset:736\n\tds_read_b64_tr_b16 %4, %13\n\tds_read_b64_tr_b16 %5, %13 offset:704\n\t"
        "ds_read_b64_tr_b16 %6, %12 offset:5632\n\tds_read_b64_tr_b16 %7, %12 offset:6336\n\tds_read_b64_tr_b16 %8, %12 offset:5664\n\tds_read_b64_tr_b16 %9, %12 offset:6368\n\tds_read_b64_tr_b16 %10, %13 offset:5632\n\tds_read_b64_tr_b16 %11, %13 offset:6336\n\t"
        "s_waitcnt lgkmcnt(0)"
        : "=&v"(a0), "=&v"(a1), "=&v"(a2), "=&v"(a3), "=&v"(a4), "=&v"(a5), "=&v"(b0), "=&v"(b1), "=&v"(b2), "=&v"(b3), "=&v"(b4), "=&v"(b5)
        : "v"(av), "v"(ad) : "memory");
    f[0][0] = TRH(a0, a1); f[1][0] = TRH(a2, a3); f[2][0] = TRH(a4, a5); f[0][1] = TRH(b0, b1); f[1][1] = TRH(b2, b3); f[2][1] = TRH(b4, b5);
}
template <int KS> __device__ __forceinline__ void tr_mupd(const LAS bf16* LK, const LAS bf16* LV1, int wave, int lane, bf16x8 (&af)[2], bf16x8 (&wf)[5]) {
    const int g = lane >> 4, q = (lane & 15) >> 2, p = lane & 3;
    const unsigned ak = (unsigned)(size_t)(LK + (KS * 32 + 8 * g + q) * 264 + 4 * p + wave * 32), av = (unsigned)(size_t)(LV1 + (KS * 32 + 8 * g + q) * 88 + 4 * p);
    v2u k0, k1, k2, k3, a0, a1, a2, a3, a4, a5, a6, a7, a8, a9;
    asm volatile(
        "ds_read_b64_tr_b16 %0, %14\n\tds_read_b64_tr_b16 %1, %14 offset:2112\n\tds_read_b64_tr_b16 %2, %14 offset:32\n\tds_read_b64_tr_b16 %3, %14 offset:2144\n\t"
        "ds_read_b64_tr_b16 %4, %15\n\tds_read_b64_tr_b16 %5, %15 offset:704\n\tds_read_b64_tr_b16 %6, %15 offset:32\n\tds_read_b64_tr_b16 %7, %15 offset:736\n\t"
        "ds_read_b64_tr_b16 %8, %15 offset:64\n\tds_read_b64_tr_b16 %9, %15 offset:768\n\tds_read_b64_tr_b16 %10, %15 offset:96\n\tds_read_b64_tr_b16 %11, %15 offset:800\n\t"
        "ds_read_b64_tr_b16 %12, %15 offset:128\n\tds_read_b64_tr_b16 %13, %15 offset:832\n\t"
        "s_waitcnt lgkmcnt(0)"
        : "=&v"(k0), "=&v"(k1), "=&v"(k2), "=&v"(k3), "=&v"(a0), "=&v"(a1), "=&v"(a2), "=&v"(a3), "=&v"(a4), "=&v"(a5), "=&v"(a6), "=&v"(a7), "=&v"(a8), "=&v"(a9)
        : "v"(ak), "v"(av) : "memory");
    af[0] = TRH(k0, k1); af[1] = TRH(k2, k3); wf[0] = TRH(a0, a1); wf[1] = TRH(a2, a3); wf[2] = TRH(a4, a5); wf[3] = TRH(a6, a7); wf[4] = TRH(a8, a9);
}
__device__ __forceinline__ float wave_scan_sum(float v, int lane) {
    v += dpp_f<0x111>(0.f, v); v += dpp_f<0x112>(0.f, v); v += dpp_f<0x114>(0.f, v); v += dpp_f<0x118>(0.f, v);
    const float r0 = rdlane_f(v, 15), r1 = rdlane_f(v, 31), r2 = rdlane_f(v, 47); const int row = lane >> 4;
    return v + (row == 1 ? r0 : row == 2 ? r0 + r1 : row == 3 ? (r0 + r1) + r2 : 0.f);
}
__device__ __forceinline__ float wave_scan_max(float v, int lane) {
    const float NI = -3.0e38f;
    v = fmaxf(v, dpp_f<0x111>(NI, v)); v = fmaxf(v, dpp_f<0x112>(NI, v)); v = fmaxf(v, dpp_f<0x114>(NI, v)); v = fmaxf(v, dpp_f<0x118>(NI, v));
    const float r0 = rdlane_f(v, 15), r1 = rdlane_f(v, 31), r2 = rdlane_f(v, 47); const int row = lane >> 4;
    return fmaxf(v, row == 1 ? r0 : row == 2 ? fmaxf(r0, r1) : row == 3 ? fmaxf(fmaxf(r0, r1), r2) : NI);
}
__device__ __forceinline__ void scan_a_unit(const Ctx& c, LAS unsigned char* lds, int u, int tid, int lane, int wave) {
    bf16* PJ = (bf16*)(c.ws + WS_PROJ);
    const bf16* Q = PJ + (size_t)P_QA * PSTRIDE; const bf16* LFp = PJ + (size_t)P_LF * PSTRIDE; const bf16* V = PJ + (size_t)P_VA * PSTRIDE; bf16* OA = PJ + (size_t)P_XM * PSTRIDE;
    LAS bf16* LQ = (LAS bf16*)lds;
    LAS bf16* LK = (LAS bf16*)(lds + 17408);
    LAS bf16* LV = (LAS bf16*)(lds + 34816);
    LAS bf16* LP = (LAS bf16*)(lds + 44032);
    LAS bf16* LST = (LAS bf16*)(lds + 53248);
    LAS float* SEG = (LAS float*)(lds + 70656);
    LAS float* ER = (LAS float*)(lds + 74752);
    LAS float* EB = (LAS float*)(lds + 75264);
    LAS float* EK = (LAS float*)(lds + 75776);
    const int ux = u & 7, uk = u >> 3, bh_ = ux * 8 + (uk >> 1), vs = uk & 1, b = bh_ >> 3, h = bh_ & 7;
    const size_t rowbase = (size_t)b * SEQ;
    f32x4 S[4];
#pragma unroll
    for (int j = 0; j < 4; ++j) S[j] = (f32x4){0.f, 0.f, 0.f, 0.f};
    unsigned rq[8], rf[8]; v4u rv;
#define SA_LOAD(ch) do { const int lo_ = opq_v(wave * 8 * D + h * 128 + 2 * lane), lv_ = opq_v((tid >> 3) * D + h * 128 + vs * 64 + (tid & 7) * 8); const size_t cb_ = (rowbase + (size_t)(ch) * 64) * D; \
        const GAS bf16* qp_ = (const GAS bf16*)Q + cb_ + lo_; const GAS bf16* fp_ = (const GAS bf16*)LFp + cb_ + lo_; \
        _Pragma("unroll") for (int i = 0; i < 8; ++i) { rq[i] = *(const GAS unsigned*)(qp_ + (size_t)i * D); rf[i] = *(const GAS unsigned*)(fp_ + (size_t)i * D); } \
        rv = *(const GAS v4u*)((const GAS bf16*)V + cb_ + lv_); } while (0)
    SA_LOAD(0);
    for (int ch = 0; ch < 64; ++ch) {
        float f0[8], f1[8], q0[8], q1[8]; float run0 = 0.f, run1 = 0.f;
#pragma unroll
        for (int i = 0; i < 8; ++i) { const float a0 = bflo(rf[i]), a1 = bfhi(rf[i]); f0[i] = __expf(a0); f1[i] = __expf(a1); run0 += a0; run1 += a1; q0[i] = bflo(rq[i]); q1[i] = bfhi(rq[i]); }
        *(LAS f32x2*)(SEG + wave * 128 + 2 * lane) = (f32x2){run0, run1};
        const v4u rvc = rv;
        if (ch + 1 < 64) SA_LOAD(ch + 1);
        __syncthreads();
        float pre0 = 0.f, pre1 = 0.f, r0 = 0.f, r1 = 0.f, t0_ = 0.f, t1_ = 0.f;
#pragma unroll
        for (int w = 0; w < 8; ++w) { const f32x2 sg = *(const LAS f32x2*)(SEG + w * 128 + 2 * lane); if (w < wave) { pre0 += sg.x; pre1 += sg.y; } if (w < 4) { r0 += sg.x; r1 += sg.y; } t0_ += sg.x; t1_ += sg.y; }
        *(LAS v4u*)(LV + (tid >> 3) * 72 + (tid & 7) * 8) = rvc;
        {   float g0 = __expf(pre0 - r0), g1 = __expf(pre1 - r1), e0 = __expf(r0 - (pre0 + run0)), e1 = __expf(r1 - (pre1 + run1));
            unsigned kq[8];
#pragma unroll
            for (int i = 0; i < 8; ++i) { g0 *= f0[i]; g1 *= f1[i]; *(LAS unsigned*)(LQ + (wave * 8 + i) * 136 + 2 * lane) = pk2(q0[i] * g0, q1[i] * g1); }
#pragma unroll
            for (int i = 7; i >= 0; --i) { kq[i] = pk2((1.0f - f0[i]) * e0, (1.0f - f1[i]) * e1); e0 *= f0[i]; e1 *= f1[i]; }
#pragma unroll
            for (int i = 0; i < 8; ++i) *(LAS unsigned*)(LK + (wave * 8 + i) * 136 + 2 * lane) = kq[i];
        }
        if (wave == 0) { *(LAS f32x2*)(ER + 2 * lane) = (f32x2){__expf(r0), __expf(r1)}; *(LAS f32x2*)(EB + 2 * lane) = (f32x2){__expf(t0_), __expf(t1_)}; *(LAS f32x2*)(EK + 2 * lane) = (f32x2){__expf(t0_ - r0), __expf(t1_ - r1)}; }
        __syncthreads();
        {
            const int tt = wave >> 1;
#pragma unroll
            for (int jj = 0; jj < 2; ++jj) { const int st = (wave & 1) * 2 + jj; f32x4 acc = {0.f, 0.f, 0.f, 0.f};
                if (st <= tt) {
#pragma unroll
                    for (int kk = 0; kk < 4; ++kk) acc = mmT(LQ, 136, tt * 16, LK, 136, st * 16, kk * 32, acc, lane);
                    if (st == tt) {
#pragma unroll
                        for (int e = 0; e < 4; ++e) if (4 * (lane >> 4) + e > (lane & 15)) acc[e] = 0.f; } }
                *(LAS v2u*)(LP + (tt * 16 + (lane & 15)) * 72 + st * 16 + 4 * (lane >> 4)) = pack4(acc); }
            const f32x4 er4 = *(const LAS f32x4*)(ER + wave * 16 + 4 * (lane >> 4));
#pragma unroll
            for (int j = 0; j < 4; ++j) *(LAS v2u*)(LST + (j * 16 + (lane & 15)) * 136 + wave * 16 + 4 * (lane >> 4)) = pack4(S[j] * er4);
        }
        __syncthreads();
        {
            bf16x8 vfr[4][2], kfv[2]; tr_hgrn(LV, LK, wave, lane, vfr, kfv);
            const bf16x8 vf00 = vfr[0][0], vf10 = vfr[1][0], vf20 = vfr[2][0], vf30 = vfr[3][0], vf01 = vfr[0][1], vf11 = vfr[1][1], vf21 = vfr[2][1], vf31 = vfr[3][1];
            struct { bf16x8 a, b; } kfr; kfr.a = kfv[0]; kfr.b = kfv[1];
            const int t0 = (wave >> 1) * 16; const bool hi = (wave & 1) != 0;
            const bf16x8 pf0 = *(const LAS bf16x8*)(LP + (t0 + (lane & 15)) * 72 + 8 * (lane >> 4)), pf1 = *(const LAS bf16x8*)(LP + (t0 + (lane & 15)) * 72 + 32 + 8 * (lane >> 4));
            f32x4 o0 = {0.f, 0.f, 0.f, 0.f}, o1 = o0;
            o0 = MFMA16(hi ? vf20 : vf00, pf0, o0); o0 = MFMA16(hi ? vf21 : vf01, pf1, o0);
            o1 = MFMA16(hi ? vf30 : vf10, pf0, o1); o1 = MFMA16(hi ? vf31 : vf11, pf1, o1);
            const int e0 = hi ? 32 : 0;
#pragma unroll
            for (int kk = 0; kk < 4; ++kk) { const bf16x8 qf = *(const LAS bf16x8*)(LQ + (t0 + (lane & 15)) * 136 + kk * 32 + 8 * (lane >> 4));
                const bf16x8 s0f = *(const LAS bf16x8*)(LST + (e0 + (lane & 15)) * 136 + kk * 32 + 8 * (lane >> 4)), s1f = *(const LAS bf16x8*)(LST + (e0 + 16 + (lane & 15)) * 136 + kk * 32 + 8 * (lane >> 4));
                o0 = MFMA16(s0f, qf, o0); o1 = MFMA16(s1f, qf, o1); }
            GAS bf16* op = (GAS bf16*)OA + (rowbase + (size_t)ch * 64) * D + opq_v((t0 + (lane & 15)) * D + h * 128 + vs * 64 + e0 + 4 * (lane >> 4));
            *(GAS v2u*)op = pack4(o0); *(GAS v2u*)(op + 16) = pack4(o1);
            const f32x4 eb4 = *(const LAS f32x4*)(EB + wave * 16 + 4 * (lane >> 4)), ek4 = *(const LAS f32x4*)(EK + wave * 16 + 4 * (lane >> 4));
            f32x4 up;
            up = (f32x4){0.f, 0.f, 0.f, 0.f}; up = MFMA16(kfr.a, vf00, up); up = MFMA16(kfr.b, vf01, up); S[0] = eb4 * S[0] + ek4 * up;
            up = (f32x4){0.f, 0.f, 0.f, 0.f}; up = MFMA16(kfr.a, vf10, up); up = MFMA16(kfr.b, vf11, up); S[1] = eb4 * S[1] + ek4 * up;
            up = (f32x4){0.f, 0.f, 0.f, 0.f}; up = MFMA16(kfr.a, vf20, up); up = MFMA16(kfr.b, vf21, up); S[2] = eb4 * S[2] + ek4 * up;
            up = (f32x4){0.f, 0.f, 0.f, 0.f}; up = MFMA16(kfr.a, vf30, up); up = MFMA16(kfr.b, vf31, up); S[3] = eb4 * S[3] + ek4 * up;
        }
    }
#undef SA_LOAD
    __syncthreads();
}

__device__ __forceinline__ void tr_v4(const LAS bf16* LVe, int lane, bf16x8 (&vf)[4][2]) {
    const int g = lane >> 4, q = (lane & 15) >> 2, p = lane & 3;
    const unsigned av = (unsigned)(size_t)(LVe + (8 * g + q) * 136 + 4 * p);
    v2u a0, a1, a2, a3, a4, a5, a6, a7, b0, b1, b2, b3, b4, b5, b6, b7;
    asm volatile(
        "ds_read_b64_tr_b16 %0, %16\n\tds_read_b64_tr_b16 %1, %16 offset:1088\n\tds_read_b64_tr_b16 %2, %16 offset:32\n\tds_read_b64_tr_b16 %3, %16 offset:1120\n\t"
        "ds_read_b64_tr_b16 %4, %16 offset:64\n\tds_read_b64_tr_b16 %5, %16 offset:1152\n\tds_read_b64_tr_b16 %6, %16 offset:96\n\tds_read_b64_tr_b16 %7, %16 offset:1184\n\t"
        "ds_read_b64_tr_b16 %8, %16 offset:8704\n\tds_read_b64_tr_b16 %9, %16 offset:9792\n\tds_read_b64_tr_b16 %10, %16 offset:8736\n\tds_read_b64_tr_b16 %11, %16 offset:9824\n\t"
        "ds_read_b64_tr_b16 %12, %16 offset:8768\n\tds_read_b64_tr_b16 %13, %16 offset:9856\n\tds_read_b64_tr_b16 %14, %16 offset:8800\n\tds_read_b64_tr_b16 %15, %16 offset:9888\n\t"
        "s_waitcnt lgkmcnt(0)"
        : "=&v"(a0), "=&v"(a1), "=&v"(a2), "=&v"(a3), "=&v"(a4), "=&v"(a5), "=&v"(a6), "=&v"(a7), "=&v"(b0), "=&v"(b1), "=&v"(b2), "=&v"(b3), "=&v"(b4), "=&v"(b5), "=&v"(b6), "=&v"(b7)
        : "v"(av) : "memory");
    vf[0][0] = TRH(a0, a1); vf[1][0] = TRH(a2, a3); vf[2][0] = TRH(a4, a5); vf[3][0] = TRH(a6, a7);
    vf[0][1] = TRH(b0, b1); vf[1][1] = TRH(b2, b3); vf[2][1] = TRH(b4, b5); vf[3][1] = TRH(b6, b7);
}
__device__ __forceinline__ void tr_k2(const LAS bf16* LK, int wave, int lane, bf16x8 (&kf)[2]) {
    const int g = lane >> 4, q = (lane & 15) >> 2, p = lane & 3;
    const unsigned ak = (unsigned)(size_t)(LK + (8 * g + q) * 136 + 4 * p + wave * 16);
    v2u k0, k1, k2, k3;
    asm volatile("ds_read_b64_tr_b16 %0, %4\n\tds_read_b64_tr_b16 %1, %4 offset:1088\n\tds_read_b64_tr_b16 %2, %4 offset:8704\n\tds_read_b64_tr_b16 %3, %4 offset:9792\n\ts_waitcnt lgkmcnt(0)"
        : "=&v"(k0), "=&v"(k1), "=&v"(k2), "=&v"(k3) : "v"(ak) : "memory");
    kf[0] = TRH(k0, k1); kf[1] = TRH(k2, k3);
}
#ifndef TPROBE
#define TPROBE -1
#endif
#ifndef TPS
#define TPS 0
#endif
#ifndef TPB
#define TPB 0
#endif
#define TS_MARK(UN_, K_) do { if (TPROBE == (UN_) && blockIdx.x == TPB && threadIdx.x == 0) { volatile LAS unsigned* mp_ = (volatile LAS unsigned*)(lds + MISC_OFF); const unsigned now_ = (unsigned)wall_clock64(); if (TPS == (K_)) mp_[16] += now_ - mp_[48]; mp_[48] = now_; } } while (0)
__device__ __forceinline__ void rd_sc12(unsigned aq, unsigned ak, v4u (&q)[4], v4u (&k0)[4], v4u (&k1)[4]) {
    asm volatile(
        "ds_read_b128 %0, %12\n\tds_read_b128 %1, %12 offset:64\n\tds_read_b128 %2, %12 offset:128\n\tds_read_b128 %3, %12 offset:192\n\t"
        "ds_read_b128 %4, %13\n\tds_read_b128 %5, %13 offset:64\n\tds_read_b128 %6, %13 offset:128\n\tds_read_b128 %7, %13 offset:192\n\t"
        "ds_read_b128 %8, %13 offset:4352\n\tds_read_b128 %9, %13 offset:4416\n\tds_read_b128 %10, %13 offset:4480\n\tds_read_b128 %11, %13 offset:4544\n\t"
        "s_waitcnt lgkmcnt(0)"
        : "=&v"(q[0]), "=&v"(q[1]), "=&v"(q[2]), "=&v"(q[3]), "=&v"(k0[0]), "=&v"(k0[1]), "=&v"(k0[2]), "=&v"(k0[3]), "=&v"(k1[0]), "=&v"(k1[1]), "=&v"(k1[2]), "=&v"(k1[3])
        : "v"(aq), "v"(ak) : "memory");
}
__device__ __forceinline__ void rd_qs10(unsigned aq, unsigned as, v4u (&q)[2], v4u (&x)[2][4]) {
    asm volatile(
        "ds_read_b128 %0, %10\n\tds_read_b128 %1, %10 offset:64\n\t"
        "ds_read_b128 %2, %11\n\tds_read_b128 %3, %11 offset:4352\n\tds_read_b128 %4, %11 offset:8704\n\tds_read_b128 %5, %11 offset:13056\n\t"
        "ds_read_b128 %6, %11 offset:64\n\tds_read_b128 %7, %11 offset:4416\n\tds_read_b128 %8, %11 offset:8768\n\tds_read_b128 %9, %11 offset:13120\n\t"
        "s_waitcnt lgkmcnt(0)"
        : "=&v"(q[0]), "=&v"(q[1]), "=&v"(x[0][0]), "=&v"(x[0][1]), "=&v"(x[0][2]), "=&v"(x[0][3]), "=&v"(x[1][0]), "=&v"(x[1][1]), "=&v"(x[1][2]), "=&v"(x[1][3])
        : "v"(aq), "v"(as) : "memory");
}
__device__ __forceinline__ void scan_a_full_unit(const Ctx& c, LAS unsigned char* lds, int u, int l, int tid, int lane, int wave) {
    bf16* PJ = (bf16*)(c.ws + WS_PROJ);
    const bf16* Q = PJ + (size_t)P_QA * PSTRIDE; const bf16* LFp = PJ + (size_t)P_LF * PSTRIDE; const bf16* V = PJ + (size_t)P_VA * PSTRIDE; const bf16* GR = PJ + (size_t)P_GA * PSTRIDE;
    bf16* AO = PJ + (size_t)P_QA * PSTRIDE;
    const float* GN = c.in[I_HGN] + (size_t)l * D;
    LAS bf16* LQ0 = (LAS bf16*)lds;
    LAS bf16* LK0 = (LAS bf16*)(lds + 34816);
    LAS bf16* LV = (LAS bf16*)(lds + 69632);
    LAS bf16* LP = (LAS bf16*)(lds + 87040);
    LAS bf16* LST = (LAS bf16*)(lds + 96256);
    LAS float* SEG = (LAS float*)(lds + 131328);
    LAS float* E0 = (LAS float*)(lds + 135424);
    LAS float* SS = (LAS float*)(lds + 138496);
    LAS float* GNL = (LAS float*)(lds + 139008);
    const int b = u >> 3, h = u & 7;
    const size_t rowbase = (size_t)b * SEQ;
    const int t0 = (wave >> 1) * 16, eh = (wave & 1) * 64;
    f32x4 S[8], po[4]; v2u pg[4];
#pragma unroll
    for (int j = 0; j < 8; ++j) S[j] = (f32x4){0.f, 0.f, 0.f, 0.f};
#pragma unroll
    for (int j = 0; j < 4; ++j) { po[j] = (f32x4){0.f, 0.f, 0.f, 0.f}; pg[j] = (v2u){0u, 0u}; }
    if (tid < 128) GNL[tid] = GN[h * 128 + tid];
    unsigned rq[8], rf[8]; v4u rv0, rv1;
    float f0[8], f1[8], q0[8], q1[8]; float run0 = 0.f, run1 = 0.f;
#define SF_LOADQF(ch) do { const unsigned lo_ = (unsigned)opq_v((wave * 8 * D + h * 128 + 2 * lane) * 2); const size_t cb_ = (rowbase + (size_t)(ch) * 64) * D; \
        const GAS char* qb_ = (const GAS char*)((const GAS bf16*)Q + cb_); const GAS char* fb_ = (const GAS char*)((const GAS bf16*)LFp + cb_);     \
        _Pragma("unroll") for (int i = 0; i < 8; ++i) { rq[i] = *(const GAS unsigned*)(qb_ + (lo_ + (unsigned)(i * D * 2))); rf[i] = *(const GAS unsigned*)(fb_ + (lo_ + (unsigned)(i * D * 2))); } } while (0)
#define SF_LOADV(ch) do { const unsigned lv_ = (unsigned)opq_v(((tid >> 4) * D + h * 128 + (tid & 15) * 8) * 2); const GAS char* vb_ = (const GAS char*)((const GAS bf16*)V + (rowbase + (size_t)(ch) * 64) * D); \
        rv0 = *(const GAS v4u*)(vb_ + lv_); rv1 = *(const GAS v4u*)(vb_ + (lv_ + (unsigned)(32 * D * 2))); } while (0)
#define SF_T() do { run0 = 0.f; run1 = 0.f; \
        _Pragma("unroll") for (int i = 0; i < 8; ++i) { const float a0 = bflo(rf[i]), a1 = bfhi(rf[i]); f0[i] = __builtin_amdgcn_exp2f(a0); f1[i] = __builtin_amdgcn_exp2f(a1); run0 += a0; run1 += a1; q0[i] = bflo(rq[i]); q1[i] = bfhi(rq[i]); } \
        *(LAS f32x2*)(SEG + wave * 128 + 2 * lane) = (f32x2){run0, run1}; } while (0)
#define SF_A(PAR_) do { LAS bf16* LQn_ = LQ0 + (PAR_) * 8704; LAS bf16* LKn_ = LK0 + (PAR_) * 8704; LAS float* En_ = E0 + (PAR_) * 384; \
        float pre0 = 0.f, pre1 = 0.f, r0 = 0.f, r1 = 0.f, t0_ = 0.f, t1_ = 0.f; \
        _Pragma("unroll") for (int w = 0; w < 8; ++w) { const f32x2 sg = *(const LAS f32x2*)(SEG + w * 128 + 2 * lane); if (w < wave) { pre0 += sg.x; pre1 += sg.y; } if (w < 4) { r0 += sg.x; r1 += sg.y; } t0_ += sg.x; t1_ += sg.y; } \
        float g0 = __builtin_amdgcn_exp2f(pre0 - r0), g1 = __builtin_amdgcn_exp2f(pre1 - r1), e0 = __builtin_amdgcn_exp2f(r0 - (pre0 + run0)), e1 = __builtin_amdgcn_exp2f(r1 - (pre1 + run1)); unsigned kq[8]; \
        _Pragma("unroll") for (int i = 0; i < 8; ++i) { g0 *= f0[i]; g1 *= f1[i]; *(LAS unsigned*)(LQn_ + (wave * 8 + i) * 136 + 2 * lane) = pk2(q0[i] * g0, q1[i] * g1); } \
        _Pragma("unroll") for (int i = 7; i >= 0; --i) { kq[i] = pk2((1.0f - f0[i]) * e0, (1.0f - f1[i]) * e1); e0 *= f0[i]; e1 *= f1[i]; } \
        _Pragma("unroll") for (int i = 0; i < 8; ++i) *(LAS unsigned*)(LKn_ + (wave * 8 + i) * 136 + 2 * lane) = kq[i]; \
        if (wave == 0) { *(LAS f32x2*)(En_ + 2 * lane) = (f32x2){__builtin_amdgcn_exp2f(r0), __builtin_amdgcn_exp2f(r1)}; *(LAS f32x2*)(En_ + 128 + 2 * lane) = (f32x2){__builtin_amdgcn_exp2f(t0_), __builtin_amdgcn_exp2f(t1_)}; *(LAS f32x2*)(En_ + 256 + 2 * lane) = (f32x2){__builtin_amdgcn_exp2f(t0_ - r0), __builtin_amdgcn_exp2f(t1_ - r1)}; } } while (0)
#define SF_FINAL(cp) do { const int lr_ = opq_v(lane & 15), lg_ = opq_v(lane >> 4); const f32x2 s2_ = *(const LAS f32x2*)(SS + 2 * (t0 + lr_)); \
        const float rs_ = rsqrtf((s2_.x + s2_.y) * (1.0f / 128.0f) + EPS); \
        _Pragma("unroll") for (int jj = 0; jj < 4; ++jj) { const int col_ = h * 128 + eh + 16 * jj + 4 * lg_; const f32x4 gn_ = *(const LAS f32x4*)(GNL + eh + 16 * jj + 4 * lg_); \
            const f32x4 gr_ = {bflo(pg[jj].x), bfhi(pg[jj].x), bflo(pg[jj].y), bfhi(pg[jj].y)}; f32x4 a_; \
            _Pragma("unroll") for (int e = 0; e < 4; ++e) a_[e] = po[jj][e] * rs_ * gn_[e] * gr_[e]; \
            *(GAS v2u*)((GAS char*)((GAS bf16*)AO + (rowbase + (size_t)(cp) * 64) * D) + (unsigned)(((t0 + lr_) * D + col_) * 2)) = pack4(a_); } } while (0)
    SF_LOADQF(0); SF_LOADV(0);
    SF_T(); SF_LOADQF(1);
    __syncthreads();
    SF_A(0);
    __syncthreads();
    for (int ch = 0; ch < 64; ++ch) {
        const int par = ch & 1;
        const LAS bf16* LQ = LQ0 + par * 8704; const LAS bf16* LK = LK0 + par * 8704; const LAS float* EC = E0 + par * 384;
        {
            const int tt = wave >> 1; f32x4 acc0 = {0.f, 0.f, 0.f, 0.f}, acc1 = acc0;
            if ((wave & 1) * 2 <= tt) {
                v4u qa[4], ka[4], kb[4];
                rd_sc12((unsigned)(size_t)(LQ + (tt * 16 + (lane & 15)) * 136 + 8 * (lane >> 4)), (unsigned)(size_t)(LK + ((wave & 1) * 32 + (lane & 15)) * 136 + 8 * (lane >> 4)), qa, ka, kb);
#pragma unroll
                for (int kk = 0; kk < 4; ++kk) { acc0 = MFMA16(__builtin_bit_cast(bf16x8, ka[kk]), __builtin_bit_cast(bf16x8, qa[kk]), acc0); acc1 = MFMA16(__builtin_bit_cast(bf16x8, kb[kk]), __builtin_bit_cast(bf16x8, qa[kk]), acc1); }
            }
#pragma unroll
            for (int jj = 0; jj < 2; ++jj) { const int st = (wave & 1) * 2 + jj; f32x4 acc = jj ? acc1 : acc0;
                if (st > tt) acc = (f32x4){0.f, 0.f, 0.f, 0.f};
                if (st == tt) {
#pragma unroll
                    for (int e = 0; e < 4; ++e) if (4 * (lane >> 4) + e > (lane & 15)) acc[e] = 0.f; }
                *(LAS v2u*)(LP + (tt * 16 + (lane & 15)) * 72 + st * 16 + 4 * (lane >> 4)) = pack4(acc); }
            const f32x4 er4 = *(const LAS f32x4*)(EC + wave * 16 + 4 * (lane >> 4));
#pragma unroll
            for (int j = 0; j < 8; ++j) *(LAS v2u*)(LST + (j * 16 + (lane & 15)) * 136 + wave * 16 + 4 * (lane >> 4)) = pack4(S[j] * er4);
        }
        __builtin_amdgcn_sched_barrier(0);
        if (ch > 0) SF_FINAL(ch - 1);
        __builtin_amdgcn_sched_barrier(0);
        { const GAS char* gb_ = (const GAS char*)((const GAS bf16*)GR + (rowbase + (size_t)ch * 64) * D); const unsigned go_ = (unsigned)opq_v(((t0 + (lane & 15)) * D + h * 128 + eh + 4 * (lane >> 4)) * 2);
#pragma unroll
          for (int jj = 0; jj < 4; ++jj) pg[jj] = *(const GAS v2u*)(gb_ + (go_ + (unsigned)(32 * jj))); }
        SF_T(); __builtin_amdgcn_sched_barrier(0);
        { const int c2 = (ch + 2 < 64) ? ch + 2 : 63; SF_LOADQF(c2); }
        __builtin_amdgcn_sched_barrier(0);
        *(LAS v4u*)(LV + (tid >> 4) * 136 + (tid & 15) * 8) = rv0; *(LAS v4u*)(LV + (32 + (tid >> 4)) * 136 + (tid & 15) * 8) = rv1;
        __syncthreads();
        TS_MARK(22, 0);
        { const int c1 = (ch + 1 < 64) ? ch + 1 : 63; SF_LOADV(c1); }
        {
            bf16x8 kf[2]; tr_k2(LK, wave, lane, kf);
            const f32x4 eb4 = *(const LAS f32x4*)(EC + 128 + wave * 16 + 4 * (lane >> 4)), ek4 = *(const LAS f32x4*)(EC + 256 + wave * 16 + 4 * (lane >> 4));
            const bf16x8 pf0 = *(const LAS bf16x8*)(LP + (t0 + (lane & 15)) * 72 + 8 * (lane >> 4)), pf1 = *(const LAS bf16x8*)(LP + (t0 + (lane & 15)) * 72 + 32 + 8 * (lane >> 4));
#pragma unroll
            for (int jj = 0; jj < 4; ++jj) po[jj] = (f32x4){0.f, 0.f, 0.f, 0.f};
#pragma unroll
            for (int hb = 0; hb < 2; ++hb) {
                bf16x8 vf[4][2]; tr_v4(LV + hb * 64, lane, vf);
                if (hb == (wave & 1)) {
#pragma unroll
                    for (int jj = 0; jj < 4; ++jj) { po[jj] = MFMA16(vf[jj][0], pf0, po[jj]); po[jj] = MFMA16(vf[jj][1], pf1, po[jj]); }
                }
#pragma unroll
                for (int jj = 0; jj < 4; ++jj) { f32x4 up = {0.f, 0.f, 0.f, 0.f}; up = MFMA16(kf[0], vf[jj][0], up); up = MFMA16(kf[1], vf[jj][1], up); S[hb * 4 + jj] = eb4 * S[hb * 4 + jj] + ek4 * up; }
            }
#pragma unroll
            for (int k2 = 0; k2 < 2; ++k2) { v4u qf[2], sf[2][4];
                rd_qs10((unsigned)(size_t)(LQ + (t0 + (lane & 15)) * 136 + k2 * 64 + 8 * (lane >> 4)), (unsigned)(size_t)(LST + (eh + (lane & 15)) * 136 + k2 * 64 + 8 * (lane >> 4)), qf, sf);
#pragma unroll
                for (int kk = 0; kk < 2; ++kk)
#pragma unroll
                    for (int jj = 0; jj < 4; ++jj) po[jj] = MFMA16(__builtin_bit_cast(bf16x8, sf[kk][jj]), __builtin_bit_cast(bf16x8, qf[kk]), po[jj]); }
            float ssq = 0.f;
#pragma unroll
            for (int jj = 0; jj < 4; ++jj) ssq += (po[jj][0] * po[jj][0] + po[jj][1] * po[jj][1]) + (po[jj][2] * po[jj][2] + po[jj][3] * po[jj][3]);
            ssq += __shfl_xor(ssq, 16); ssq += __shfl_xor(ssq, 32);
            if (lane < 16) SS[2 * (t0 + lane) + (wave & 1)] = ssq;
        }
        __builtin_amdgcn_sched_barrier(0);
        SF_A(par ^ 1);
        __syncthreads();
        TS_MARK(22, 1);
    }
    SF_FINAL(63);
#undef SF_LOADQF
#undef SF_LOADV
#undef SF_T
#undef SF_A
#undef SF_FINAL
    __syncthreads();
}

__device__ __forceinline__ void scan_m_unit(const Ctx& c, LAS unsigned char* lds, int u, int tid, int lane, int wave) {
    const bf16* MQ = (const bf16*)(c.ws + WS_MQ); const bf16* MK = (const bf16*)(c.ws + WS_MK); const bf16* MV = (const bf16*)(c.ws + WS_MV); bf16* HM = (bf16*)(c.ws + WS_H);
    const GAS float* LI = (const GAS float*)(c.ws + WS_LI); const GAS float* LF = (const GAS float*)(c.ws + WS_LF);
    LAS bf16* LK = (LAS bf16*)lds;
    LAS bf16* LV0 = (LAS bf16*)(lds + 33792);
    LAS bf16* LV1 = (LAS bf16*)(lds + 45056);
    LAS bf16* LP = (LAS bf16*)(lds + 56320);
    LAS bf16* LCT = (LAS bf16*)(lds + 65536);
    LAS float* AS = (LAS float*)(lds + 107776);
    LAS float* MXS = (LAS float*)(lds + 108032);
    LAS float* BS = (LAS float*)(lds + 108288);
    const int ux = u & 7, uk = u >> 3, bh_ = ux * 4 + (uk >> 2), vs = uk & 3, b = bh_ >> 2, h = bh_ & 3;
    const size_t rowbase = (size_t)b * SEQ;
    const int t0 = (wave >> 1) * 16;
    f32x4 C[2][5];
#pragma unroll
    for (int i = 0; i < 2; ++i)
#pragma unroll
        for (int j = 0; j < 5; ++j) C[i][j] = (f32x4){0.f, 0.f, 0.f, 0.f};
    float m = 0.f;
    for (int i = tid; i < 64 * 24; i += NTHR) { const int row = i / 24, col = 64 + i % 24; LV0[row * 88 + col] = (bf16)(col == 64 ? 0x3f80u : 0u); LV1[row * 88 + col] = (bf16)0u; }
    v4u qf[8], rk[4], rv; float rli, rlf;
#define SM_LOAD(ch) do { const int lk_ = opq_v((tid >> 5) * D + h * 256 + (tid & 31) * 8), lv_ = opq_v((tid >> 3) * D + h * 256 + vs * 64 + (tid & 7) * 8), lg_ = opq_v(lane * 4 + h); \
        const GAS bf16* kp_ = (const GAS bf16*)MK + (rowbase + (size_t)(ch) * 64) * D + lk_; \
        _Pragma("unroll") for (int k2 = 0; k2 < 4; ++k2) rk[k2] = *(const GAS v4u*)(kp_ + (size_t)k2 * 16 * D); \
        rv = *(const GAS v4u*)((const GAS bf16*)MV + (rowbase + (size_t)(ch) * 64) * D + lv_); \
        rli = LI[(rowbase + (size_t)(ch) * 64) * 4 + lg_]; rlf = LF[(rowbase + (size_t)(ch) * 64) * 4 + lg_]; } while (0)
#define SM_LOADQ(ch) do { const int lq_ = opq_v((t0 + (lane & 15)) * D + h * 256 + 8 * (lane >> 4)); const GAS bf16* qp_ = (const GAS bf16*)MQ + (rowbase + (size_t)(ch) * 64) * D + lq_; \
        _Pragma("unroll") for (int kk = 0; kk < 8; ++kk) qf[kk] = *(const GAS v4u*)(qp_ + kk * 32); } while (0)
    SM_LOAD(0); SM_LOADQ(0);
    float nbb = wave_scan_sum(rlf, lane), naa = rli - nbb, npm = wave_scan_max(naa, lane);
    for (int ch = 0; ch < 64; ++ch) {
        const int lane0 = lane; const int lane = opq_v(lane0), tid = opq_v((wave << 6) | lane0);
        const int lr = lane & 15, lq4 = lane >> 4, bK = lr * 264 + 8 * lq4, bC = lr * 264 + 4 * lq4, bP8 = lr * 72 + 8 * lq4, bP4 = lr * 72 + 4 * lq4;
        __syncthreads();
        TS_MARK(21, 0);
        const float bb = nbb, aa = naa, pm = npm;
        const float mx = fmaxf(m, pm);
        const float b63 = rdlane_f(bb, 63), mx63 = rdlane_f(mx, 63);
        if (wave == 0) { AS[lane] = aa; MXS[lane] = mx; BS[lane] = bb; LV1[lane * 88 + 64] = (bf16)f2bf(__expf(aa - mx63)); }
        { const int p = tid; *(LAS v4u*)(LK + (p >> 5) * 264 + (p & 31) * 8) = rk[0]; *(LAS v4u*)(LK + ((p + 512) >> 5) * 264 + (p & 31) * 8) = rk[1]; *(LAS v4u*)(LK + ((p + 1024) >> 5) * 264 + (p & 31) * 8) = rk[2]; *(LAS v4u*)(LK + ((p + 1536) >> 5) * 264 + (p & 31) * 8) = rk[3]; }
        { const int rr = tid >> 3; const float wv = __expf(__shfl(aa, rr) - mx63); const v4u rvc = rv;
          *(LAS v4u*)(LV0 + rr * 88 + (tid & 7) * 8) = rvc;
          v4u sv; sv.x = pk2(bflo(rvc.x) * wv, bfhi(rvc.x) * wv); sv.y = pk2(bflo(rvc.y) * wv, bfhi(rvc.y) * wv); sv.z = pk2(bflo(rvc.z) * wv, bfhi(rvc.z) * wv); sv.w = pk2(bflo(rvc.w) * wv, bfhi(rvc.w) * wv);
          *(LAS v4u*)(LV1 + rr * 88 + (tid & 7) * 8) = sv; }
        const float m_old = m;
        if (ch + 1 < 64) SM_LOAD(ch + 1);
        __syncthreads();
        TS_MARK(21, 1);
        {
            const int tt = wave >> 1;
#pragma unroll
            for (int jj = 0; jj < 2; ++jj) { const int st = (wave & 1) * 2 + jj; f32x4 acc = {0.f, 0.f, 0.f, 0.f};
                if (st <= tt) {
#pragma unroll
                    for (int kk = 0; kk < 8; ++kk) { const bf16x8 kfr = *(const LAS bf16x8*)(LK + bK + st * (16 * 264) + kk * 32); acc = MFMA16(kfr, __builtin_bit_cast(bf16x8, qf[kk]), acc); if ((kk & 3) == 3) __builtin_amdgcn_sched_barrier(0); }
                    const f32x4 a4 = *(const LAS f32x4*)(AS + st * 16 + 4 * lq4); const float mxt = MXS[tt * 16 + lr];
#pragma unroll
                    for (int e = 0; e < 4; ++e) acc[e] = (st == tt && 4 * lq4 + e > lr) ? 0.f : acc[e] * __expf(a4[e] - mxt); }
                *(LAS v2u*)(LP + bP4 + tt * (16 * 72) + st * 16) = pack4(acc); }
#pragma unroll
            for (int i = 0; i < 2; ++i)
#pragma unroll
                for (int j = 0; j < 5; ++j) *(LAS v2u*)(LCT + bC + j * (16 * 264) + (wave * 2 + i) * 16) = pack4(C[i][j]);
        }
        __syncthreads();
        TS_MARK(21, 2);
        {
            const int e0 = (wave & 1) * 32; f32x4 p0 = {0.f, 0.f, 0.f, 0.f}, p1 = p0, pd = p0, c0 = p0, c1 = p0, cd = p0;
            { bf16x8 vn[3][2]; tr_mnum(LV0, e0, lane, vn);
#pragma unroll
              for (int kk = 0; kk < 2; ++kk) { const bf16x8 pf = *(const LAS bf16x8*)(LP + bP8 + t0 * 72 + kk * 32);
                p0 = MFMA16(vn[0][kk], pf, p0); p1 = MFMA16(vn[1][kk], pf, p1); pd = MFMA16(vn[2][kk], pf, pd); } }
#pragma unroll
            for (int kk = 0; kk < 8; ++kk) { const bf16x8 q8 = __builtin_bit_cast(bf16x8, qf[kk]);
                const LAS bf16* xb_ = LCT + bK + e0 * 264 + kk * 32; const bf16x8 x0 = *(const LAS bf16x8*)xb_, x1 = *(const LAS bf16x8*)(xb_ + 16 * 264), xd = *(const LAS bf16x8*)(LCT + bK + 64 * 264 + kk * 32);
                c0 = MFMA16(x0, q8, c0); c1 = MFMA16(x1, q8, c1); cd = MFMA16(xd, q8, cd); if (kk & 1) __builtin_amdgcn_sched_barrier(0); }
            const float mxt = MXS[t0 + lr], bt = BS[t0 + lr], wi = __expf(m_old - mxt);
            const float den = __shfl(pd[0] + wi * cd[0], lr);
            const float inv = 1.0f / fmaxf(fabsf(den), __expf(-(bt + mxt)));
            GAS bf16* hp = (GAS bf16*)HM + (rowbase + (size_t)ch * 64) * D + opq_v((t0 + (lane & 15)) * D + h * 256 + vs * 64 + e0 + 4 * (lane >> 4));
            *(GAS v2u*)hp = pack4((p0 + c0 * wi) * inv); *(GAS v2u*)(hp + 16) = pack4((p1 + c1 * wi) * inv);
            const float dec = __expf(m_old - mx63);
#pragma unroll
            for (int i = 0; i < 2; ++i)
#pragma unroll
                for (int j = 0; j < 5; ++j) C[i][j] = C[i][j] * dec;
            { bf16x8 af[2], wf[5];
              tr_mupd<0>(LK, LV1, wave, lane, af, wf);
#pragma unroll
              for (int j = 0; j < 5; ++j) { C[0][j] = MFMA16(af[0], wf[j], C[0][j]); C[1][j] = MFMA16(af[1], wf[j], C[1][j]); }
              tr_mupd<1>(LK, LV1, wave, lane, af, wf);
#pragma unroll
              for (int j = 0; j < 5; ++j) { C[0][j] = MFMA16(af[0], wf[j], C[0][j]); C[1][j] = MFMA16(af[1], wf[j], C[1][j]); } }
            m = b63 + mx63;
            if (ch + 1 < 64) SM_LOADQ(ch + 1);
            nbb = wave_scan_sum(rlf, lane); naa = rli - nbb; npm = wave_scan_max(naa, lane);
        }
    }
#undef SM_LOAD
#undef SM_LOADQ
    __syncthreads();
}
#ifndef DLY_A
#define DLY_A 0
#define DLY_M 0
#define DLY_C 0
#endif
__device__ __forceinline__ void ph_scans(const Ctx& c, LAS unsigned char* lds, int l) {
    const int tid = TID(), lane = tid & 63, wave = __builtin_amdgcn_readfirstlane(tid >> 6);
    for (int u = BID(); u < 256; u += gridDim.x) {
#if DLY_A || DLY_M || DLY_C
        { const int dl = (u < 64) ? DLY_A : (u < 192) ? DLY_M : DLY_C; for (int i = 0; i < dl; ++i) { __builtin_amdgcn_s_sleep(127); asm volatile("" ::: "memory"); } }
#endif
        if (u < 64) scan_a_full_unit(c, lds, u, l, tid, lane, wave);
        else if (u < 192) scan_m_unit(c, lds, u - 64, tid, lane, wave);
        else { if (l + 1 < DEPTH) { ph_cvt(c, l + 1, lds, u - 192, 64, 2, 1); __syncthreads(); } }
    }
}
constexpr int TAB_OFF = MISC_OFF + 256, UT_OFF = MISC_OFF + 512;
__device__ __forceinline__ void moe_tables(const Ctx& c, int jm, LAS unsigned char* lds) {
    LAS int* tab = (LAS int*)(lds + TAB_OFF);
    __syncthreads();
    const int t = TID();
    if (t < 64) {
        unsigned* cnt = (unsigned*)c.ws + CW_CNT + 64 * jm;
        const int n = (t < 8) ? (int)__hip_atomic_load(cnt + t, __ATOMIC_RELAXED, __HIP_MEMORY_SCOPE_AGENT) : 0;
        const int p = (n + 255) >> 8; int accp = 0, mine = 0;
#pragma unroll
        for (int e = 0; e < 8; ++e) { const int pe_ = __builtin_amdgcn_readlane(p, e); if (t == e) mine = accp; accp += pe_; }
        if (t < 8) { tab[t] = p; tab[8 + t] = mine; }
        if (t == 0) tab[16] = accp;
    }
    __syncthreads();
}
__device__ __forceinline__ void ph_res1(const Ctx& c, int l, LAS unsigned char* lds, int dry = 0) {
    const int tid = TID(), lane = tid & 63, wave = tid >> 6, gw = BID() * NWAVES + wave, NGW = gridDim.x * NWAVES;
    const bool moe = (l & 1) != 0; const int jm = l >> 1;
    LAS f32x4* rt = (LAS f32x4*)lds;
    if (moe) { const GAS f32x4* src = (const GAS f32x4*)(c.in[I_ROUTER] + (size_t)jm * D * NEXP); for (int i = tid; i < D * NEXP / 4; i += NTHR) { const int ch = i >> 1; rt[((ch & 3) * 2 + (i & 1)) * 256 + (ch >> 2)] = src[i]; } }
    __syncthreads();
    const float* xin = c.in[I_X]; bf16* XB = (bf16*)(c.ws + WS_XB);
    const bf16* Y = (const bf16*)(c.ws + WS_PROJ) + (size_t)P_OS * PSTRIDE; bf16* H = (bf16*)(c.ws + WS_H);
    unsigned* cnt = (unsigned*)c.ws + CW_CNT + 64 * jm;
    int* TOKEP = (int*)(c.ws + WS_TOKEP); float* TOKW = (float*)(c.ws + WS_TOKW);
    for (int slot = gw; slot < M / 16; slot += NGW) {
        const int row0 = slot * 16, b = row0 / SEQ;
        f32x4 gpm[4], gt[4], gpf[4], scf[4], shf[4];
        ld_row_f32(c.in[I_GPOSTMIX] + (size_t)l * D, lane, gpm); ld_row_f32(modp(c, l, b, 2), lane, gt); ld_row_f32(c.in[I_GPREFFN] + (size_t)l * D, lane, gpf);
        ld_row_f32(modp(c, l, b, 4), lane, scf); ld_row_f32(modp(c, l, b, 3), lane, shf);
        int my1 = 0, my2 = 0; float myw = 0.f;
        v2u ya[4], yb[4]; f32x4 xa[4], xb[4];
#define R1_LOAD(YR, XR, ro_) do { _Pragma("unroll") for (int j = 0; j < 4; ++j) { YR[j] = *(const GAS v2u*)(Y + (ro_) + 4 * lane + 256 * j); if (l == 0) XR[j] = *(const GAS f32x4*)(xin + (ro_) + 4 * lane + 256 * j); else { const v2u w_ = *(const GAS v2u*)(XB + (ro_) + 4 * lane + 256 * j); XR[j] = (f32x4){bflo(w_.x), bfhi(w_.x), bflo(w_.y), bfhi(w_.y)}; } } } while (0)
        R1_LOAD(ya, xa, (size_t)row0 * D);
        for (int r = 0; r < 16; ++r) {
            const int row = row0 + r; const size_t ro = (size_t)row * D;
            if (r + 1 < 16) R1_LOAD(yb, xb, ro + D);
            f32x4 y[4], x[4], h[4];
#pragma unroll
            for (int j = 0; j < 4; ++j) { y[j] = (f32x4){bflo(ya[j].x), bfhi(ya[j].x), bflo(ya[j].y), bfhi(ya[j].y)}; x[j] = xa[j]; ya[j] = yb[j]; xa[j] = xb[j]; }
            const float rr = rsqrtf(row_sumsq(y) * (1.0f / 1024.0f) + EPS);
#pragma unroll
            for (int j = 0; j < 4; ++j) x[j] = x[j] + gt[j] * (y[j] * rr * gpm[j]);
            if (!dry) st_row_bf16(XB + ro, lane, x);
            norm_mod(x, gpf, scf, shf, h); if (!dry) st_row_bf16(H + ro, lane, h);
            if (moe) {
                f32x4 l0 = {0.f, 0.f, 0.f, 0.f}, l1 = l0;
#pragma unroll
                for (int j = 0; j < 4; ++j)
#pragma unroll
                    for (int i = 0; i < 4; ++i) { const int n = lane + 64 * j; l0 += rt[(i * 2) * 256 + n] * h[j][i]; l1 += rt[(i * 2 + 1) * 256 + n] * h[j][i]; }
                float lg[8];
#pragma unroll
                for (int e = 0; e < 4; ++e) { lg[e] = wave_sum(l0[e]); lg[4 + e] = wave_sum(l1[e]); }
                int i1 = 0; float v1 = lg[0];
#pragma unroll
                for (int e = 1; e < 8; ++e) if (lg[e] > v1) { v1 = lg[e]; i1 = e; }
                int i2 = -1; float v2 = -3.0e38f;
#pragma unroll
                for (int e = 0; e < 8; ++e) if (e != i1 && lg[e] > v2) { v2 = lg[e]; i2 = e; }
                if (lane == r) { my1 = i1; my2 = i2; myw = 1.0f / (1.0f + __expf(v2 - v1)); }
            }
        }
        if (moe && !dry) {
            const bool act = lane < 16; const unsigned long long below = (1ull << lane) - 1ull;
            int p1 = 0, p2 = 0;
            unsigned long long m1[8], m2[8]; int cn = 0;
#pragma unroll
            for (int e = 0; e < 8; ++e) { m1[e] = __ballot(act && my1 == e); m2[e] = __ballot(act && my2 == e); if (lane == e) cn = __popcll(m1[e]) + __popcll(m2[e]); }
            int basev = 0; if (lane < 8 && cn > 0) basev = (int)atomicAdd(cnt + lane, (unsigned)cn);
#pragma unroll
            for (int e = 0; e < 8; ++e) { const int be = __builtin_amdgcn_readlane(basev, e);
                if (my1 == e) p1 = be + __popcll(m1[e] & below);
                if (my2 == e) p2 = be + __popcll(m1[e]) + __popcll(m2[e] & below); }
            if (act) { *(GAS i32x4*)(TOKEP + (size_t)(row0 + lane) * 4) = (i32x4){my1, p1, my2, p2}; *(GAS f32x2*)(TOKW + (size_t)(row0 + lane) * 2) = (f32x2){myw, 1.0f - myw}; }
        }
    }
}
__device__ __forceinline__ void ph_gather(const Ctx& c, int l, LAS unsigned char* lds) {
    const int tid = TID(), lane = tid & 63, wave = tid >> 6, gw = BID() * NWAVES + wave, NGW = gridDim.x * NWAVES;
    moe_tables(c, l >> 1, lds); const LAS int* tab = (const LAS int*)(lds + TAB_OFF);
    const bf16* H = (const bf16*)(c.ws + WS_H); bf16* AG = (bf16*)(c.ws + WS_AG);
    const int* TOKEP = (const int*)(c.ws + WS_TOKEP); int* TOKD = (int*)(c.ws + WS_TOKD);
    for (int row0 = gw; row0 < M; row0 += 4 * NGW) {
        i32x4 ep[4]; v4u ra[4], rb[4];
#pragma unroll
        for (int k = 0; k < 4; ++k) { const int row = (row0 + k * NGW < M) ? row0 + k * NGW : row0; ep[k] = *(const GAS i32x4*)(TOKEP + (size_t)row * 4);
            ra[k] = *(const GAS v4u*)(H + (size_t)row * D + lane * 8); rb[k] = *(const GAS v4u*)(H + (size_t)row * D + 512 + lane * 8); }
#pragma unroll
        for (int k = 0; k < 4; ++k) { const int row = row0 + k * NGW; if (row >= M) continue;
            const int d1 = tab[8 + ep[k].x] * 256 + ep[k].y, d2 = tab[8 + ep[k].z] * 256 + ep[k].w;
            *(GAS v4u*)(AG + (size_t)d1 * D + lane * 8) = ra[k]; *(GAS v4u*)(AG + (size_t)d1 * D + 512 + lane * 8) = rb[k];
            *(GAS v4u*)(AG + (size_t)d2 * D + lane * 8) = ra[k]; *(GAS v4u*)(AG + (size_t)d2 * D + 512 + lane * 8) = rb[k];
            if (lane == 0) *(GAS i32x2*)(TOKD + (size_t)row * 2) = (i32x2){d1, d2}; }
    }
}
__device__ __forceinline__ void ph_res2(const Ctx& c, int l, int dry = 0) {
    const int tid = TID(), lane = tid & 63, wave = tid >> 6, gw = BID() * NWAVES + wave, NGW = gridDim.x * NWAVES;
    const bool moe = (l & 1) != 0;
    const bf16* Y2 = (const bf16*)(c.ws + WS_PROJ) + (size_t)4 * PSTRIDE; const bf16* YS = (const bf16*)(c.ws + WS_YS); bf16* H = (bf16*)(c.ws + WS_H); bf16* XB = (bf16*)(c.ws + WS_XB);
    const int* TOKD = (const int*)(c.ws + WS_TOKD); const float* TOKW = (const float*)(c.ws + WS_TOKW);
    const int ln = (l + 1 < DEPTH) ? l + 1 : l;
    for (int slot = gw; slot < M / 16; slot += NGW) {
        const int row0 = slot * 16, b = row0 / SEQ;
        f32x4 gpo[4], gt[4], gpm[4], scm[4], shm[4];
        ld_row_f32(c.in[I_GPOSTFFN] + (size_t)l * D, lane, gpo); ld_row_f32(modp(c, l, b, 5), lane, gt); ld_row_f32(c.in[I_GPREMIX] + (size_t)ln * D, lane, gpm);
        ld_row_f32(modp(c, ln, b, 1), lane, scm); ld_row_f32(modp(c, ln, b, 0), lane, shm);
        v2u ya[4], yb[4], za[4], zb[4]; f32x4 xa[4], xb[4]; f32x2 wa = {1.f, 0.f}, wb = wa;
#define R2_LOAD(YR, ZR, XR, WR, row_) do { const size_t ro_ = (size_t)(row_) * D; \
            if (moe) { const i32x2 d_ = *(const GAS i32x2*)(TOKD + (size_t)(row_) * 2); WR = *(const GAS f32x2*)(TOKW + (size_t)(row_) * 2); \
                _Pragma("unroll") for (int j = 0; j < 4; ++j) { YR[j] = *(const GAS v2u*)(YS + (size_t)d_.x * D + 4 * lane + 256 * j); ZR[j] = *(const GAS v2u*)(YS + (size_t)d_.y * D + 4 * lane + 256 * j); } } \
            else { _Pragma("unroll") for (int j = 0; j < 4; ++j) { YR[j] = *(const GAS v2u*)(Y2 + ro_ + 4 * lane + 256 * j); ZR[j] = (v2u){0u, 0u}; } } \
            _Pragma("unroll") for (int j = 0; j < 4; ++j) { const v2u w_ = *(const GAS v2u*)(XB + ro_ + 4 * lane + 256 * j); XR[j] = (f32x4){bflo(w_.x), bfhi(w_.x), bflo(w_.y), bfhi(w_.y)}; } } while (0)
        R2_LOAD(ya, za, xa, wa, row0);
        for (int r = 0; r < 16; ++r) {
            const int row = row0 + r; const size_t ro = (size_t)row * D;
            if (r + 1 < 16) R2_LOAD(yb, zb, xb, wb, row + 1);
            f32x4 y[4], x[4], h[4];
#pragma unroll
            for (int j = 0; j < 4; ++j) { const f32x4 p = {bflo(ya[j].x), bfhi(ya[j].x), bflo(ya[j].y), bfhi(ya[j].y)}, q = {bflo(za[j].x), bfhi(za[j].x), bflo(za[j].y), bfhi(za[j].y)};
                y[j] = p * wa.x + q * wa.y; x[j] = xa[j]; ya[j] = yb[j]; za[j] = zb[j]; xa[j] = xb[j]; }
            wa = wb;
            const float rr = rsqrtf(row_sumsq(y) * (1.0f / 1024.0f) + EPS);
#pragma unroll
            for (int j = 0; j < 4; ++j) { x[j] = x[j] + gt[j] * (y[j] * rr * gpo[j]); if (!dry && l + 1 == DEPTH) *(GAS f32x4*)(c.out + ro + 4 * lane + 256 * j) = x[j]; }
            if (!dry && l + 1 < DEPTH) st_row_bf16(XB + ro, lane, x);
            if (l + 1 < DEPTH) { norm_mod(x, gpm, scm, shm, h); if (!dry) st_row_bf16(H + ro, lane, h); }
        }
    }
}

constexpr int PH_PER_LAYER = 12, NPH = 2 + DEPTH * PH_PER_LAYER;
__global__ void __launch_bounds__(NTHR, 2) fwd(Ctx c) {
    extern __shared__ __attribute__((aligned(16))) unsigned char lds_raw[];
    LAS unsigned char* lds = (LAS unsigned char*)lds_raw;
    volatile LAS unsigned* MISC = (volatile LAS unsigned*)(lds + MISC_OFF);
    if (threadIdx.x < 64) MISC[threadIdx.x] = 0u;
    __syncthreads();
    const int lo = c.ph_lo, hi = c.ph_hi, G = gridDim.x;
    XcdBarrier bar; bar.bar = (unsigned*)c.ws + CW_BAR; bar.x = 0; bar.st = MISC + 8;
    if (hi - lo > 1) bar = xcd_barrier_post((unsigned*)c.ws + CW_BAR, MISC + 8);
#ifndef PH_MASK
#define PH_MASK 0xFFFF
#endif
#define IN(p) (lo <= (p) && (p) < hi)
#define ON(k) ((PH_MASK >> (k)) & 1)
#ifndef REPMASK
#define REPMASK 0
#endif
#define REP(k) for (int rep_ = 0; rep_ < (((REPMASK >> (k)) & 1) ? opq_s(2) : 1); ++rep_)
#ifndef TPROBE
#define TPROBE -1
#endif
#ifndef TPL
#define TPL -1
#define TPMUL 1
#endif
    int tp_layer = -1;
#ifndef TPB
#define TPB 0
#endif
#define TP_SEL(ty) (TPROBE == (ty) && blockIdx.x == TPB && threadIdx.x == 0 && (TPL < 0 || tp_layer == TPL))
#define TPU_BEGIN() do { if (TP_SEL(20)) MISC[48] = (unsigned)wall_clock64(); } while (0)
#define TPU_END() do { if (TP_SEL(20)) MISC[16] += (unsigned)wall_clock64() - MISC[48]; } while (0)
#define TP_BEGIN(ty) do { if (TP_SEL(ty)) MISC[48] = (unsigned)wall_clock64(); } while (0)
#define BAR_AFTER(p, ty) do { if ((p) + 1 < hi) xcd_barrier(bar); if (TP_SEL(ty)) MISC[16] += (unsigned)wall_clock64() - MISC[48]; } while (0)
    if (ON(12) && IN(0)) { TP_BEGIN(12); ph_mod(c, lds); ph_lb(c); ph_uz(c); REP(14) ph_cvt(c, 0, lds, BID(), (int)gridDim.x, 2); BAR_AFTER(0, 12); }
    if (ON(13) && IN(1)) { TP_BEGIN(13); ph_norm0(c); BAR_AFTER(1, 13); }
    for (int l = 0; l < DEPTH; ++l) {
        const int base = 2 + l * PH_PER_LAYER; const bool moe = (l & 1) != 0; tp_layer = l;
        Ctx cl = c; cl.ws = opq_p(c.ws); cl.out = (float*)opq_p((unsigned char*)c.out);
        unsigned char* ws = cl.ws; bf16* PJ = (bf16*)(ws + WS_PROJ); const int bid = BID();
        int KD = opq_s(D);
        if (ON(0) && IN(base + 0)) { TP_BEGIN(0);
            pg8::Gemm g{(const bf16*)(ws + WS_H), (const bf16*)(ws + WS_WIN), M, DIN, KD}; pg8::UOrder S; S.init(0, M, DIN, G, bid);
            pg8::EpiWin E{PJ, (const float*)(ws + WS_LB) + l * 1024, PSTRIDE};
            REP(0) { pg8::TOrder T; T.build(S, (LAS int*)(lds + UT_OFF)); pg8::gemm_phase<pg8::EpiWin, pg8::TOrder, true, true>(lds, g, T, E); }
            BAR_AFTER(base + 0, 0); }
        if (ON(1) && IN(base + 1)) { TP_BEGIN(1); REP(1) ph_prep(cl, l, lds); BAR_AFTER(base + 1, 1); }
        if (ON(2) && IN(base + 2)) { TP_BEGIN(2); TPU_BEGIN(); REP(2) ph_scans(cl, lds, l); TPU_END(); BAR_AFTER(base + 2, 2); }
        if (ON(4) && IN(base + 4)) { TP_BEGIN(4); REP(4) ph_post(cl, l); BAR_AFTER(base + 4, 4); }
        if (ON(5) && IN(base + 5)) { TP_BEGIN(5);
            pg8::Gemm g{PJ + (size_t)P_QA * PSTRIDE, (const bf16*)(ws + WS_WAB + (size_t)(l & 1) * WAB_STEP), M, D, KD}; pg8::UOrder S; S.init(1, M, D, G, bid);
            pg8::EpiProj E{PJ + (size_t)P_GTA * PSTRIDE, PSTRIDE, PJ + (size_t)P_GA * PSTRIDE, PJ + (size_t)P_VA * PSTRIDE};
            REP(5) { pg8::TOrder T; T.build(S, (LAS int*)(lds + UT_OFF)); pg8::gemm_phase<pg8::EpiProj, pg8::TOrder, true, true>(lds, g, T, E); }
            BAR_AFTER(base + 5, 5); }
        if (ON(6) && IN(base + 6)) { TP_BEGIN(6);
            pg8::Gemm g{PJ + (size_t)P_VA * PSTRIDE, (const bf16*)(ws + WS_WO + (size_t)(l & 1) * WO_STEP), M, D, KD}; pg8::UOrder S; S.init(0, M, D, G, bid);
            pg8::EpiPlain E{PJ + (size_t)P_OS * PSTRIDE, D};
            REP(6) { pg8::TOrder T; T.build(S, (LAS int*)(lds + UT_OFF)); pg8::gemm_phase<pg8::EpiPlain, pg8::TOrder, true, true>(lds, g, T, E); }
            BAR_AFTER(base + 6, 6); }
        if (ON(7) && IN(base + 7)) { TP_BEGIN(7); if ((REPMASK >> 7) & 1) ph_res1(cl, l, lds, opq_s(1)); ph_res1(cl, l, lds); BAR_AFTER(base + 7, 7); }
        if (ON(8) && IN(base + 8) && moe) { TP_BEGIN(8); ph_gather(cl, l, lds); BAR_AFTER(base + 8, 8); }
        if (ON(9) && IN(base + 9)) { TP_BEGIN(9);
            pg8::Gemm g{(const bf16*)(ws + (moe ? WS_AG : WS_H)), (const bf16*)(ws + (moe ? WS_WFM : WS_WFD)), M, 2 * DFF, KD}; pg8::UOrder S; S.init(0, M, 2 * DFF, G, bid);
            pg8::EpiSwi E{PJ, moe ? DFE : DFF, moe ? 28 : 22};
            if (moe) { moe_tables(cl, l >> 1, lds); S.mode = 2; S.NT = 28; S.tab = (const LAS int*)(lds + TAB_OFF); S.nwg = __builtin_amdgcn_readfirstlane(S.tab[16]) * 28; }
            REP(9) { pg8::TOrder T; T.build(S, (LAS int*)(lds + UT_OFF)); pg8::gemm_phase<pg8::EpiSwi, pg8::TOrder, true, true>(lds, g, T, E); }
            BAR_AFTER(base + 9, 9); }
        if (ON(10) && IN(base + 10)) { TP_BEGIN(10);
            pg8::Gemm g{PJ, (const bf16*)(ws + (moe ? WS_WFM + WF_W2_MOE : WS_WFD + WF_W2_DENSE)), M, D, moe ? DFE : DFF}; pg8::UOrder S; S.init(0, M, D, G, bid);
            pg8::EpiPlain E{moe ? (bf16*)(ws + WS_YS) : PJ + (size_t)4 * PSTRIDE, D};
            if (moe) { moe_tables(cl, l >> 1, lds); S.mode = 2; S.NT = 4; S.tab = (const LAS int*)(lds + TAB_OFF); S.nwg = __builtin_amdgcn_readfirstlane(S.tab[16]) * 4; }
            REP(10) { pg8::TOrder T; T.build(S, (LAS int*)(lds + UT_OFF)); pg8::gemm_phase<pg8::EpiPlain, pg8::TOrder, true, true>(lds, g, T, E); }
            BAR_AFTER(base + 10, 10); }
        if (ON(11) && IN(base + 11)) { TP_BEGIN(11); if ((REPMASK >> 11) & 1) ph_res2(cl, l, opq_s(1)); ph_res2(cl, l);  BAR_AFTER(base + 11, 11); }
    }
    if (TPROBE >= 0) { __syncthreads(); if (blockIdx.x == TPB && threadIdx.x == 0) { const unsigned tt = MISC[16] * (unsigned)TPMUL; const unsigned s0 = (unsigned)wall_clock64(); while ((unsigned)wall_clock64() - s0 < tt) __builtin_amdgcn_s_sleep(8); } }
#undef IN
#undef BAR_AFTER
}

#ifndef MK_ONE_LAUNCH
#define MK_ONE_LAUNCH 1
#endif
extern "C" void kernel_launch(void* const* d_in, const int* in_sizes, int n_in, void* d_out, int out_size, void* d_ws, size_t ws_size, hipStream_t stream) {
    static int grid = 0;
    if (grid == 0) {
        if (n_in != 32 || in_sizes[0] != M * D || out_size != M * D || ws_size < WS_END) { fprintf(stderr, "kernel_launch: unexpected shapes / workspace (%d inputs, ws %zu < %zu)\n", n_in, ws_size, (size_t)WS_END); grid = -1; return; }
        int dev = 0, cus = 0;
        if (hipGetDevice(&dev) != hipSuccess || hipDeviceGetAttribute(&cus, hipDeviceAttributeMultiprocessorCount, dev) != hipSuccess) { grid = -1; return; }
        if (hipFuncSetAttribute((const void*)fwd, hipFuncAttributeMaxDynamicSharedMemorySize, LDS_BYTES) != hipSuccess) { fprintf(stderr, "kernel_launch: hipFuncSetAttribute failed\n"); grid = -1; return; }
        (void)hipGetLastError();
        grid = cus;
    }
    if (grid < 0) return;
    if (hipMemsetAsync((char*)d_ws + WS_CTL, 0, CTL_ZERO_BYTES, stream) != hipSuccess) return;
    Ctx c{};
    for (int i = 0; i < 32; ++i) c.in[i] = (const float*)d_in[i];
    c.out = (float*)d_out; c.ws = (unsigned char*)d_ws;
#if MK_ONE_LAUNCH
    c.ph_lo = 0; c.ph_hi = NPH;
    hipLaunchKernelGGL(fwd, dim3(grid), dim3(NTHR), LDS_BYTES, stream, c);
#else
    for (int p = 0; p < NPH; ++p) {
        if (p >= 2) { const int l = (p - 2) / PH_PER_LAYER, k = (p - 2) % PH_PER_LAYER; if (k == 8 && !(l & 1)) continue; }
        c.ph_lo = p; c.ph_hi = p + 1;
        hipLaunchKernelGGL(fwd, dim3(grid), dim3(NTHR), LDS_BYTES, stream, c);
    }
#endif
}
```

```cpp
#include <hip/hip_runtime.h>
#include <cstdio>
#include <cstdint>
#ifndef TPROBE
#define TPROBE -1
#endif
namespace pg8 {
#define PG8_LAS __attribute__((address_space(3)))
typedef unsigned short bf16_t;
typedef short bf16x8 __attribute__((ext_vector_type(8)));
typedef float f32x4 __attribute__((ext_vector_type(4)));
typedef unsigned u32x4 __attribute__((ext_vector_type(4)));
constexpr int BM = 256, BK = 64, HALF = 128, HTB = HALF * BK * 2  , STAGE_BYTES = 8 * HTB, NXCD = 8, WGM = 4;

__host__ __device__ __forceinline__ int lds_byte(int r, int c) { const int st = (r >> 4) * 2 + (c >> 5), rr = r & 15, cc = c & 31, ob = rr * 64 + cc * 2; return st * 1024 + (ob ^ (((ob >> 9) & 1) << 5)); }
__host__ __device__ __forceinline__ void stage_rc(int b, int& R, int& C) { const int st = b / 1024, sb = b % 1024, swz = sb ^ (((sb >> 9) & 1) << 5); R = (st >> 1) * 16 + swz / 64; C = (st & 1) * 32 + (swz % 64) / 2; }
__host__ __device__ __forceinline__ int perm32(int rho) { const int n = rho >> 4, i = rho & 15; return 8 * (i >> 2) + 4 * n + (i & 3); }

struct Unit { int pm, pn; };
struct Gemm { const bf16_t* A; const bf16_t* Bt; int M, N, K; };

struct StaticOrder {
    int nM, nN, nwg, G, c;
    __host__ __device__ void init(int M, int N, int G_, int c_) { nM = M / BM; nN = N / BM; nwg = nM * nN; G = G_; c = c_; }
    __host__ __device__ bool next(int i, Unit& u) const {
        const long L = (long)i * G + c; if (L >= nwg) return false;
        int wgid = (int)L; { const int q = nwg / NXCD, r = nwg % NXCD, xcd = wgid % NXCD, off = wgid / NXCD; wgid = (xcd < r ? xcd * (q + 1) : r * (q + 1) + (xcd - r) * q) + off; }
        const int nig = WGM * nN, gid = wgid / nig, fm = gid * WGM, gsz = (nM - fm) < WGM ? (nM - fm) : WGM;
        u.pm = fm + ((wgid % nig) % gsz); u.pn = (wgid % nig) / gsz; return true;
    }
    __device__ __forceinline__ void a_ready(const Unit&) const {}
    __device__ __forceinline__ void done(const Unit&) const {}
};
typedef float f32x2c __attribute__((ext_vector_type(2)));
typedef __bf16 bf16x2c __attribute__((ext_vector_type(2)));
__device__ __forceinline__ unsigned cvt_pk_bf16(float lo, float hi) { const f32x2c v = {lo, hi}; return __builtin_bit_cast(unsigned, __builtin_convertvector(v, bf16x2c)); }
#define PG8_GAS __attribute__((address_space(1)))
struct UOrder {
    int mode, nM, nN, nwg, G, c, NT; const PG8_LAS int* tab;
    __device__ __forceinline__ void init(int mode_, int M, int N, int G_, int c_) { mode = mode_; nM = M / BM; nN = N / BM; nwg = nM * nN; G = G_; c = c_; NT = 1; tab = nullptr; }
    __device__ __forceinline__ bool next_raw(int i, Unit& u) const {
        const int which = (mode == 1) ? (i & 1) : 0; const int ii = (mode == 1) ? (i >> 1) : i;
        const long L = (long)ii * G + c; if (L >= nwg) return false;
        int wgid = (int)L; { const int q = nwg / NXCD, r = nwg % NXCD, xcd = wgid % NXCD, off = wgid / NXCD; wgid = (xcd < r ? xcd * (q + 1) : r * (q + 1) + (xcd - r) * q) + off; }
        if (mode == 2) {
            int r = wgid, E = 0;
#pragma unroll
            for (int k = 0; k < 7; ++k) { const int uk = tab[k] * NT; if (E == k && r >= uk) { r -= uk; E = k + 1; } }
            const int P = tab[E], B = tab[8 + E];
            const int nig = WGM * NT, gid = r / nig, fm = gid * WGM, gsz = (P - fm) < WGM ? (P - fm) : WGM, rr = r - gid * nig;
            u.pm = B + fm + rr % gsz; u.pn = E * NT + rr / gsz; return true;
        }
        const int nig = WGM * nN, gid = wgid / nig, fm = gid * WGM, gsz = (nM - fm) < WGM ? (nM - fm) : WGM;
        u.pm = fm + ((wgid % nig) % gsz); u.pn = (wgid % nig) / gsz;
        if (which) { u.pm += nM; u.pn += nN; }
        return true;
    }
    __device__ __forceinline__ void a_ready(const Unit&) const {}
    __device__ __forceinline__ void done(const Unit&) const {}
};
struct TOrder {
    const PG8_LAS int* ut; int n;
    __device__ __forceinline__ void build(const UOrder& S, PG8_LAS int* tabl) {
        const int t = threadIdx.x;
        if (t == 0) tabl[512] = 0;
        __syncthreads();
        if (t < 256) { Unit u; u.pm = 0; u.pn = 0; if (S.next_raw(t, u)) { tabl[2 * t] = u.pm; tabl[2 * t + 1] = u.pn; __hip_atomic_fetch_max(tabl + 512, t + 1, __ATOMIC_RELAXED, __HIP_MEMORY_SCOPE_WORKGROUP); } }
        __syncthreads();
        ut = tabl; n = __builtin_amdgcn_readfirstlane(tabl[512]);
    }
    __device__ __forceinline__ bool next(int i, Unit& u) const { if (i >= n) return false; u.pm = __builtin_amdgcn_readfirstlane(ut[2 * i]); u.pn = __builtin_amdgcn_readfirstlane(ut[2 * i + 1]); return true; }
    __device__ __forceinline__ void a_ready(const Unit&) const {}
    __device__ __forceinline__ void done(const Unit&) const {}
};

__device__ __forceinline__ float fsig(float v) { return __builtin_amdgcn_rcpf(1.0f + __expf(-v)); }
__device__ __forceinline__ float bflo(unsigned w) { return __uint_as_float(w << 16); }
__device__ __forceinline__ float bfhi(unsigned w) { return __uint_as_float(w & 0xffff0000u); }
#define PG8_X8(x, ai, bj, m) float x[8]; { const f32x4 _a = acc[ai][bj][m][0], _b = acc[ai][bj][m][1]; x[0] = _a[0]; x[1] = _a[1]; x[2] = _a[2]; x[3] = _a[3]; x[4] = _b[0]; x[5] = _b[1]; x[6] = _b[2]; x[7] = _b[3]; }
#define PG8_PACK8(w, x) u32x4 w; w.x = cvt_pk_bf16(x[0], x[1]); w.y = cvt_pk_bf16(x[2], x[3]); w.z = cvt_pk_bf16(x[4], x[5]); w.w = cvt_pk_bf16(x[6], x[7]);

struct EpiWin {
    static constexpr bool PERM = true, AFTER_DRAIN = false; static constexpr int NST = 16;
    bf16_t* P; const float* lb; size_t pstride;
    __device__ __forceinline__ void operator()(const f32x4 (&acc)[2][2][4][2], const Unit& u, int wr, int wc, int fr, int fq) const {
        const int part = u.pn >> 2;
        const int mode = (part == 0 || part == 3) ? 1 : (part == 1) ? 3 : (part >= 6) ? 2 : 0;
        bf16_t* base = P + (size_t)part * pstride;
        const int row0 = u.pm * BM + wr * 64 + fr, col0 = (u.pn & 3) * BM + wc * 32 + 8 * fq;
        float lbv[2][8];
#pragma unroll
        for (int bj = 0; bj < 2; ++bj)
#pragma unroll
            for (int j = 0; j < 8; ++j) lbv[bj][j] = 0.f;
        if (mode == 3) {
#pragma unroll
            for (int bj = 0; bj < 2; ++bj) { const f32x4 a = *(const PG8_GAS f32x4*)(lb + col0 + bj * HALF), b = *(const PG8_GAS f32x4*)(lb + col0 + bj * HALF + 4);
                lbv[bj][0] = a[0]; lbv[bj][1] = a[1]; lbv[bj][2] = a[2]; lbv[bj][3] = a[3]; lbv[bj][4] = b[0]; lbv[bj][5] = b[1]; lbv[bj][6] = b[2]; lbv[bj][7] = b[3]; }
        }
#pragma unroll
        for (int ai = 0; ai < 2; ++ai)
#pragma unroll
            for (int m = 0; m < 4; ++m) { bf16_t* rowp = base + (size_t)(row0 + ai * HALF + m * 16) * 1024 + col0;
#pragma unroll
                for (int bj = 0; bj < 2; ++bj) { PG8_X8(x, ai, bj, m)
                    if (mode == 1) {
#pragma unroll
                        for (int j = 0; j < 8; ++j) x[j] = x[j] * fsig(x[j]);
                    } else if (mode == 2) {
#pragma unroll
                        for (int j = 0; j < 8; ++j) x[j] = fsig(x[j]);
                    } else if (mode == 3) {
#pragma unroll
                        for (int j = 0; j < 8; ++j) x[j] = fmaxf(__builtin_amdgcn_logf(lbv[bj][j] + (1.0f - lbv[bj][j]) * fsig(x[j])), -43.28f);
                    }
                    PG8_PACK8(w, x) *(PG8_GAS u32x4*)(rowp + bj * HALF) = w; } }
    }
};
struct EpiProj {
    static constexpr bool PERM = true, AFTER_DRAIN = false; static constexpr int NST = 0;
    const bf16_t* gates; size_t pstride; bf16_t* T1; bf16_t* MX;
    __device__ __forceinline__ void operator()(const f32x4 (&acc)[2][2][4][2], const Unit& u, int wr, int wc, int fr, int fq) const {
        const int which = u.pn >> 2;
        const bf16_t* g = gates + (size_t)which * pstride;
        const int row0 = (u.pm & 127) * BM + wr * 64 + fr, col0 = (u.pn & 3) * BM + wc * 32 + 8 * fq;
#pragma unroll
        for (int ai = 0; ai < 2; ++ai)
#pragma unroll
            for (int m = 0; m < 4; ++m) { const size_t off = (size_t)(row0 + ai * HALF + m * 16) * 1024 + col0;
#pragma unroll
                for (int bj = 0; bj < 2; ++bj) { PG8_X8(x, ai, bj, m)
                    const u32x4 gv = *(const PG8_GAS u32x4*)(g + off + bj * HALF);
                    x[0] *= bflo(gv.x); x[1] *= bfhi(gv.x); x[2] *= bflo(gv.y); x[3] *= bfhi(gv.y); x[4] *= bflo(gv.z); x[5] *= bfhi(gv.z); x[6] *= bflo(gv.w); x[7] *= bfhi(gv.w);
                    if (which == 0) { PG8_PACK8(w, x) *(PG8_GAS u32x4*)(T1 + off + bj * HALF) = w; }
                    else { const u32x4 t = *(const PG8_GAS u32x4*)(T1 + off + bj * HALF);
                        x[0] += bflo(t.x); x[1] += bfhi(t.x); x[2] += bflo(t.y); x[3] += bfhi(t.y); x[4] += bflo(t.z); x[5] += bfhi(t.z); x[6] += bflo(t.w); x[7] += bfhi(t.w);
                        PG8_PACK8(w, x) *(PG8_GAS u32x4*)(MX + off + bj * HALF) = w; } } }
    }
};
struct EpiSwi {
    static constexpr bool PERM = true, AFTER_DRAIN = false; static constexpr int NST = 8;
    bf16_t* Gm; int ldg, NT;
    __device__ __forceinline__ void operator()(const f32x4 (&acc)[2][2][4][2], const Unit& u, int wr, int wc, int fr, int fq) const {
        const int pnl = u.pn - (u.pn / NT) * NT;
        const int row0 = u.pm * BM + wr * 64 + fr, col0 = pnl * HALF + wc * 32 + 8 * fq;
#pragma unroll
        for (int ai = 0; ai < 2; ++ai)
#pragma unroll
            for (int m = 0; m < 4; ++m) { bf16_t* rowp = Gm + (size_t)(row0 + ai * HALF + m * 16) * ldg + col0;
                PG8_X8(x, ai, 0, m) PG8_X8(y, ai, 1, m)
#pragma unroll
                for (int j = 0; j < 8; ++j) x[j] = x[j] * fsig(x[j]) * y[j];
                PG8_PACK8(w, x) *(PG8_GAS u32x4*)rowp = w; }
    }
};
struct EpiPlain {
    static constexpr bool PERM = true, AFTER_DRAIN = false; static constexpr int NST = 16;
    bf16_t* O; int ldc;
    __device__ __forceinline__ void operator()(const f32x4 (&acc)[2][2][4][2], const Unit& u, int wr, int wc, int fr, int fq) const {
        const int row0 = u.pm * BM + wr * 64 + fr, col0 = (u.pn & 3) * BM + wc * 32 + 8 * fq;
#pragma unroll
        for (int ai = 0; ai < 2; ++ai)
#pragma unroll
            for (int m = 0; m < 4; ++m) { bf16_t* rowp = O + (size_t)(row0 + ai * HALF + m * 16) * ldc + col0;
#pragma unroll
                for (int bj = 0; bj < 2; ++bj) { PG8_X8(x, ai, bj, m) PG8_PACK8(w, x) *(PG8_GAS u32x4*)(rowp + bj * HALF) = w; } }
    }
};
template <class Epi, class Sched, bool ALIGN_EPI = false, bool SP2 = false>
__device__ __forceinline__ void gemm_phase(PG8_LAS unsigned char* lds, const Gemm g, const Sched& S, const Epi& E) {
    int tid_ = threadIdx.x; asm volatile("" : "+v"(tid_));
    const int tid = tid_, wid = __builtin_amdgcn_readfirstlane(tid >> 6), lane = tid & 63, wr = wid >> 2, wc = wid & 3, fr = lane & 15, fq = lane >> 4;
    const int K = g.K, nt = K / BK;
    unsigned voffA[2], voffB[2];
#pragma unroll
    for (int i = 0; i < 2; ++i) { int R, C; stage_rc(tid * 16 + i * 8192, R, C); const int Rb = Epi::PERM ? ((R & ~31) + perm32(R & 31)) : R;
        voffA[i] = (unsigned)(R * K + C) * 2u; voffB[i] = (unsigned)(Rb * K + C) * 2u; }
    const size_t kstep = (size_t)(BK * 2);
    const size_t hstep = (size_t)HALF * K * 2;
    const size_t tstep = 2 * hstep;
    const unsigned ldsw = (unsigned)wid * 1024u;
    const int aoff = lds_byte(wr * 64 + fr, fq * 8), boff = lds_byte(wc * 32 + fr, fq * 8);
#define PG8_SA(b, h) (((b) * 2 + (h)) * HTB)
#define PG8_SB(b, h) ((4 + (b) * 2 + (h)) * HTB)
#define PG8_STAGE(bufoff, gbase, voff) do { _Pragma("unroll") for (int _i = 0; _i < 2; ++_i) \
        __builtin_amdgcn_global_load_lds((const unsigned*)((const char*)(gbase) + (voff)[_i]), (PG8_LAS unsigned*)(lds + (bufoff) + ldsw + _i * 8192), 16, 0, 0); } while (0)
#define PG8_LDA(dst, b, h) do { _Pragma("unroll") for (int m = 0; m < 4; ++m) _Pragma("unroll") for (int k = 0; k < 2; ++k) dst[m][k] = *(const PG8_LAS bf16x8*)(lds + PG8_SA(b, h) + aoff + m * 2048 + k * 1024); } while (0)
#define PG8_LDB(dst, b, h) do { _Pragma("unroll") for (int n = 0; n < 2; ++n) _Pragma("unroll") for (int k = 0; k < 2; ++k) dst[n][k] = *(const PG8_LAS bf16x8*)(lds + PG8_SB(b, h) + boff + n * 2048 + k * 1024); } while (0)
#define PG8_MMA(ai, bj, At, Bt) do { __builtin_amdgcn_s_setprio(1); _Pragma("unroll") for (int m = 0; m < 4; ++m) _Pragma("unroll") for (int n = 0; n < 2; ++n) _Pragma("unroll") for (int k = 0; k < 2; ++k) \
        acc[ai][bj][m][n] = __builtin_amdgcn_mfma_f32_16x16x32_bf16(Bt[n][k], At[m][k], acc[ai][bj][m][n], 0, 0, 0); __builtin_amdgcn_s_setprio(0); } while (0)
#define PG8_WAIT_V(n) asm volatile("s_waitcnt vmcnt(" #n ")" ::: "memory")
#define PG8_WAIT_L(n) asm volatile("s_waitcnt lgkmcnt(" #n ")" ::: "memory")
#define PG8_BAR __builtin_amdgcn_s_barrier()
#define PG8_SCHED __builtin_amdgcn_sched_barrier(0)
    Unit cur, nxt; int ui = 0;
    if (!S.next(0, cur)) return;
    f32x4 acc[2][2][4][2];
#pragma unroll
    for (int a = 0; a < 2; ++a)
#pragma unroll
        for (int b = 0; b < 2; ++b)
#pragma unroll
            for (int m = 0; m < 4; ++m)
#pragma unroll
                for (int n = 0; n < 2; ++n) acc[a][b][m][n] = (f32x4){0.f, 0.f, 0.f, 0.f};
    bf16x8 At[4][2], B0[2][2], B1[2][2];
    const char* cA = (const char*)g.A + (size_t)cur.pm * tstep; const char* cB = (const char*)g.Bt + (size_t)cur.pn * tstep;
    S.a_ready(cur);
    if constexpr (SP2) {
        PG8_STAGE(PG8_SB(0, 0), cB, voffB); PG8_STAGE(PG8_SB(0, 1), cB + hstep, voffB); PG8_STAGE(PG8_SA(0, 0), cA, voffA); PG8_STAGE(PG8_SA(0, 1), cA + hstep, voffA);
        if (wr == 1) PG8_BAR;
        PG8_WAIT_V(2); PG8_BAR;
        PG8_STAGE(PG8_SB(1, 0), cB + kstep, voffB); PG8_STAGE(PG8_SA(1, 0), cA + kstep, voffA); PG8_STAGE(PG8_SB(1, 1), cB + hstep + kstep, voffB);
        PG8_WAIT_V(6); PG8_BAR;
    } else {
        PG8_STAGE(PG8_SB(0, 0), cB, voffB); PG8_STAGE(PG8_SA(0, 0), cA, voffA); PG8_STAGE(PG8_SB(0, 1), cB + hstep, voffB); PG8_STAGE(PG8_SA(0, 1), cA + hstep, voffA);
        if (wr == 1) PG8_BAR;
        PG8_WAIT_V(4); PG8_BAR;
        PG8_STAGE(PG8_SB(1, 0), cB + kstep, voffB); PG8_STAGE(PG8_SA(1, 0), cA + kstep, voffA); PG8_STAGE(PG8_SB(1, 1), cB + hstep + kstep, voffB);
        PG8_WAIT_V(6); PG8_BAR;
    }
    for (;;) {
        const bool has_next = S.next(ui + 1, nxt);
        const char* nA = has_next ? (const char*)g.A + (size_t)nxt.pm * tstep : cA; const char* nB = has_next ? (const char*)g.Bt + (size_t)nxt.pn * tstep : cB;
        for (int t = 0; t < nt; t += 2) {
            const bool last = (t == nt - 2);
            const char* a1 = cA + (size_t)(t + 1) * kstep;
            const char* a2 = last ? nA : cA + (size_t)(t + 2) * kstep; const char* b2 = last ? nB : cB + (size_t)(t + 2) * kstep;
            const char* a3 = a2 + kstep; const char* b3 = b2 + kstep;
            if (last && has_next) S.a_ready(nxt);
            if constexpr (SP2) {
            PG8_LDB(B0, 0, 0); PG8_LDB(B1, 0, 1); PG8_SCHED; PG8_LDA(At, 0, 0); PG8_STAGE(PG8_SA(1, 1), a1 + hstep, voffA);
            PG8_WAIT_V(8); PG8_WAIT_L(0); PG8_BAR; PG8_MMA(0, 0, At, B0); PG8_MMA(0, 1, At, B1); PG8_BAR; PG8_SCHED;
            PG8_LDA(At, 0, 1); PG8_STAGE(PG8_SB(0, 0), b2, voffB); PG8_STAGE(PG8_SB(0, 1), b2 + hstep, voffB); PG8_STAGE(PG8_SA(0, 0), a2, voffA);
            PG8_WAIT_V(8); PG8_WAIT_L(0); PG8_BAR; PG8_MMA(1, 0, At, B0); PG8_MMA(1, 1, At, B1); PG8_BAR; PG8_SCHED;
            PG8_LDB(B0, 1, 0); PG8_LDB(B1, 1, 1); PG8_SCHED; PG8_LDA(At, 1, 0); PG8_STAGE(PG8_SA(0, 1), a2 + hstep, voffA);
            PG8_WAIT_V(8); PG8_WAIT_L(0); PG8_BAR; PG8_MMA(0, 0, At, B0); PG8_MMA(0, 1, At, B1); PG8_BAR; PG8_SCHED;
            PG8_LDA(At, 1, 1); PG8_STAGE(PG8_SB(1, 0), b3, voffB); PG8_STAGE(PG8_SB(1, 1), b3 + hstep, voffB); PG8_STAGE(PG8_SA(1, 0), a3, voffA);
            PG8_WAIT_V(8); PG8_WAIT_L(0); PG8_BAR; PG8_MMA(1, 0, At, B0); PG8_MMA(1, 1, At, B1); PG8_BAR; PG8_SCHED;
            } else {
            PG8_LDB(B0, 0, 0); PG8_SCHED; PG8_LDA(At, 0, 0); PG8_STAGE(PG8_SA(1, 1), a1 + hstep, voffA);
            PG8_WAIT_L(8); PG8_BAR; PG8_WAIT_L(0); PG8_MMA(0, 0, At, B0); PG8_BAR; PG8_SCHED;
            PG8_LDB(B1, 0, 1); PG8_STAGE(PG8_SB(0, 0), b2, voffB);
            PG8_BAR; PG8_WAIT_L(0); PG8_MMA(0, 1, At, B1); PG8_BAR;
            PG8_LDA(At, 0, 1); PG8_STAGE(PG8_SA(0, 0), a2, voffA);
            PG8_BAR; PG8_WAIT_L(0); PG8_MMA(1, 0, At, B0); PG8_BAR; PG8_SCHED;
            PG8_STAGE(PG8_SB(0, 1), b2 + hstep, voffB);
            PG8_WAIT_V(6); PG8_BAR; PG8_MMA(1, 1, At, B1); PG8_BAR;
            PG8_LDB(B0, 1, 0); PG8_SCHED; PG8_LDA(At, 1, 0); PG8_STAGE(PG8_SA(0, 1), a2 + hstep, voffA);
            PG8_WAIT_L(8); PG8_BAR; PG8_WAIT_L(0); PG8_MMA(0, 0, At, B0); PG8_BAR; PG8_SCHED;
            PG8_LDB(B1, 1, 1); PG8_STAGE(PG8_SB(1, 0), b3, voffB);
            PG8_BAR; PG8_WAIT_L(0); PG8_MMA(0, 1, At, B1); PG8_BAR;
            PG8_LDA(At, 1, 1); PG8_STAGE(PG8_SA(1, 0), a3, voffA);
            PG8_BAR; PG8_WAIT_L(0); PG8_MMA(1, 0, At, B0); PG8_BAR; PG8_SCHED;
            PG8_STAGE(PG8_SB(1, 1), b3 + hstep, voffB);
            PG8_WAIT_V(6); PG8_BAR; PG8_MMA(1, 1, At, B1); PG8_BAR;
            }
        }
        if constexpr (ALIGN_EPI) { if (wr == 0) PG8_BAR; }
#if TPROBE == 23
        if (blockIdx.x == 0 && threadIdx.x == 0) { volatile PG8_LAS unsigned* mp_ = (volatile PG8_LAS unsigned*)(lds + 131072); mp_[48] = (unsigned)wall_clock64(); }
#endif
        if constexpr (!Epi::AFTER_DRAIN) { E(acc, cur, wr, wc, fr, fq); S.done(cur); }
#if TPROBE == 23
        if (blockIdx.x == 0 && threadIdx.x == 0) { volatile PG8_LAS unsigned* mp_ = (volatile PG8_LAS unsigned*)(lds + 131072); mp_[16] += (unsigned)wall_clock64() - mp_[48]; }
#endif
        if (!has_next) break;
#pragma unroll
        for (int a = 0; a < 2; ++a)
#pragma unroll
            for (int b = 0; b < 2; ++b)
#pragma unroll
                for (int m = 0; m < 4; ++m)
#pragma unroll
                    for (int n = 0; n < 2; ++n) acc[a][b][m][n] = (f32x4){0.f, 0.f, 0.f, 0.f};
        cur = nxt; cA = nA; cB = nB; ++ui;
        if constexpr (ALIGN_EPI) { if (wr == 1) PG8_BAR; }
    }
    PG8_WAIT_V(0);
    if constexpr (!ALIGN_EPI) { if (wr == 0) PG8_BAR; }
    PG8_BAR;
    if constexpr (Epi::AFTER_DRAIN) { E.fused(acc, cur, wr, wc, fr, fq, lds, wid, lane); S.done(cur); }
#undef PG8_SA
#undef PG8_SB
#undef PG8_STAGE
#undef PG8_LDA
#undef PG8_LDB
#undef PG8_MMA
#undef PG8_WAIT_V
#undef PG8_WAIT_L
#undef PG8_BAR
#undef PG8_SCHED
}
}
constexpr int NWAVES = 8, NTHR = 512;
constexpr int D = 1024, NBATCH = 8, SEQ = 4096, M = NBATCH * SEQ, DEPTH = 4;
constexpr int DIN = 8192, DFF = 2816, NEXP = 8, DFE = 3584;
constexpr float EPS = 1e-6f;
constexpr size_t MiB = 1u << 20;
constexpr size_t WS_CTL = 0, CTL_ZERO_BYTES = 2 * MiB;
constexpr size_t WS_MOD = 1 * MiB;
constexpr size_t WS_LB = 2 * MiB;
constexpr size_t WS_LI = 2 * MiB + 64 * 1024, WS_LF = WS_LI + 512 * 1024;
constexpr size_t WS_TOKEP = 4 * MiB;
constexpr size_t WS_TOKW = WS_TOKEP + 512 * 1024;
constexpr size_t WS_TOKD = WS_TOKW + 256 * 1024;
constexpr size_t WS_UZ = 5 * MiB;
constexpr size_t WS_WIN = 6 * MiB;
constexpr size_t WS_WAB = 22 * MiB, WAB_STEP = 4 * MiB;
constexpr size_t WS_WO = 30 * MiB, WO_STEP = 2 * MiB;
constexpr size_t WS_WFD = 34 * MiB, WF_W2_DENSE = 12 * MiB;
constexpr size_t WS_WFM = 52 * MiB, WF_W2_MOE = 112 * MiB;
constexpr size_t WS_H = 220 * MiB;
constexpr size_t WS_PROJ = 284 * MiB, PART = 64 * MiB;
constexpr size_t WS_MQ = 796 * MiB, WS_MK = 860 * MiB, WS_MV = 924 * MiB, WS_XC = 988 * MiB;
constexpr size_t WS_AG = 796 * MiB, WS_YS = 928 * MiB;
constexpr size_t WS_XB = 1060 * MiB;
constexpr size_t WS_END = 1124 * MiB;
constexpr size_t PSTRIDE = (size_t)M * 1024;
enum { P_QA = 0, P_LF = 1, P_VA = 2, P_GA = 3, P_XM = 4, P_OS = 5, P_GTA = 6, P_GTB = 7 };
constexpr int CW_BAR = 4096;
constexpr int CW_CNT = 16384;
constexpr int RING_BYTES = 131072, MISC_OFF = RING_BYTES, LDS_BYTES = 147456;

#define GAS __attribute__((address_space(1)))
#define LAS __attribute__((address_space(3)))
typedef unsigned short bf16;
typedef unsigned v4u __attribute__((ext_vector_type(4)));
typedef unsigned v2u __attribute__((ext_vector_type(2)));
typedef float f32x4 __attribute__((ext_vector_type(4)));
typedef float f32x2 __attribute__((ext_vector_type(2)));
typedef int i32x4 __attribute__((ext_vector_type(4)));
typedef int i32x2 __attribute__((ext_vector_type(2)));
#define LDS_WAIT() asm volatile("s_waitcnt lgkmcnt(0)" ::: "memory")
#define VM_WAIT() asm volatile("s_waitcnt vmcnt(0)" ::: "memory")
__device__ __forceinline__ unsigned f2bf(float f) { unsigned u = __builtin_bit_cast(unsigned, f); return (u + 0x7fffu + ((u >> 16) & 1u)) >> 16; }
typedef __bf16 bf16x2_t __attribute__((ext_vector_type(2)));
__device__ __forceinline__ unsigned pk2(float lo, float hi) { const f32x2 v = {lo, hi}; return __builtin_bit_cast(unsigned, __builtin_convertvector(v, bf16x2_t)); }
__device__ __forceinline__ float bflo(unsigned w) { return __uint_as_float(w << 16); }
__device__ __forceinline__ float bfhi(unsigned w) { return __uint_as_float(w & 0xffff0000u); }
__device__ __forceinline__ float bf2f(bf16 b) { return __uint_as_float((unsigned)b << 16); }
__device__ __forceinline__ float fsigm(float v) { return 1.0f / (1.0f + __expf(-v)); }
__device__ __forceinline__ float fsigr(float v) { return __builtin_amdgcn_rcpf(1.0f + __expf(-v)); }
template <int CTRL> __device__ __forceinline__ float dpp_f(float old, float src) { return __builtin_bit_cast(float, __builtin_amdgcn_update_dpp(__builtin_bit_cast(int, old), __builtin_bit_cast(int, src), CTRL, 0xf, 0xf, false)); }
__device__ __forceinline__ float rdlane_f(float v, int l) { return __builtin_bit_cast(float, __builtin_amdgcn_readlane(__builtin_bit_cast(int, v), l)); }
__device__ __forceinline__ float row_allsum(float v) { v += dpp_f<0x128>(0.f, v); v += dpp_f<0x124>(0.f, v); v += dpp_f<0x122>(0.f, v); v += dpp_f<0x121>(0.f, v); return v; }
__device__ __forceinline__ float wave_sum(float v) { const float r = row_allsum(v); return (rdlane_f(r, 0) + rdlane_f(r, 16)) + (rdlane_f(r, 32) + rdlane_f(r, 48)); }
__device__ __forceinline__ float half_sum(float v) {
    const float r = row_allsum(v); const float lo = rdlane_f(r, 0) + rdlane_f(r, 16), hi = rdlane_f(r, 32) + rdlane_f(r, 48);
    return (threadIdx.x & 32) ? hi : lo; }
__device__ __forceinline__ float sum16(float v) {
#pragma unroll
    for (int o = 1; o < 16; o <<= 1) v += __shfl_xor(v, o);
    return v;
}

__device__ __forceinline__ int opq_v(int v) { asm volatile("" : "+v"(v)); return v; }
__device__ __forceinline__ int opq_s(int v) { asm volatile("" : "+s"(v)); return v; }
__device__ __forceinline__ unsigned char* opq_p(unsigned char* p) { asm volatile("" : "+s"(p)); return p; }
#define TID() opq_v((int)threadIdx.x)
#define BID() opq_s((int)blockIdx.x)
#define XB_TMO      128
#define XB_XCNT(j)  (256  + 64 * (j))
#define XB_XSUB(j)  (1280 + 64 * (j))
#define XB_XGEN(j)  (2304 + 64 * (j))
#define XB_TOP      3328
#define XB_TOPGEN   3392
#define XCD_BAR_WORDS 3456
#define XB_SPIN_CAP (1u << 18)

__device__ __forceinline__ unsigned xb_ld(unsigned* p)              { return __hip_atomic_load(p, __ATOMIC_RELAXED, __HIP_MEMORY_SCOPE_AGENT); }
__device__ __forceinline__ unsigned xb_add(unsigned* p, unsigned v) { return __hip_atomic_fetch_add(p, v, __ATOMIC_RELAXED, __HIP_MEMORY_SCOPE_AGENT); }
__device__ __forceinline__ unsigned xb_xcc_id() { return (unsigned)__builtin_amdgcn_s_getreg((3 << 11) | 20) & 0xFu; }
#define XB_SPIN(cond, bar) do { unsigned _sp = 0; while (cond) { __builtin_amdgcn_s_sleep(1); \
    if ((++_sp & 255u) == 0u) { if (xb_ld(&(bar)[XB_TMO])) break; if (_sp > XB_SPIN_CAP) { atomicAdd(&(bar)[XB_TMO], 1u); break; } } } } while (0)

struct XcdBarrier {
    unsigned* bar; unsigned x;
    volatile LAS unsigned* st;
};

__device__ __forceinline__ XcdBarrier xcd_barrier_post(unsigned* bar, volatile LAS unsigned* st) {
    XcdBarrier b; b.bar = bar; b.x = xb_xcc_id(); b.st = st;
    if (threadIdx.x == 0) (void)xb_add(&bar[XB_XCNT(b.x)], 1u);
    return b;
}
__device__ __forceinline__ void xcd_barrier_complete(unsigned* bar, unsigned x, unsigned& nloc, unsigned& nx) {
    const unsigned G = gridDim.x * gridDim.y * gridDim.z;
    unsigned sum, cnt, mine, sp = 0u;
    for (;;) {
        sum = 0u; cnt = 0u; mine = 0u;
#pragma unroll
        for (unsigned j = 0; j < 16; ++j) { const unsigned c = xb_ld(&bar[XB_XCNT(j)]); sum += c; cnt += (c > 0u) ? 1u : 0u; mine = (j == x) ? c : mine; }
        if (sum == G) break;
        __builtin_amdgcn_s_sleep(1);
        if ((++sp & 255u) == 0u) { if (xb_ld(&bar[XB_TMO])) break; if (sp > XB_SPIN_CAP) { atomicAdd(&bar[XB_TMO], 1u); break; } }
    }
    nloc = mine > 0u ? mine : 1u; nx = cnt > 0u ? cnt : 1u;
}

__device__ __forceinline__ void xcd_barrier(const XcdBarrier& b) {
    asm volatile("s_waitcnt vmcnt(0)" ::: "memory");
    __syncthreads();
    if (threadIdx.x == 0) {
        unsigned* bar = b.bar;
        __builtin_amdgcn_s_waitcnt(0);
        unsigned nloc = b.st[0], nx = b.st[1];
        if (nloc == 0u) { xcd_barrier_complete(bar, b.x, nloc, nx); b.st[0] = nloc; b.st[1] = nx; }
        const unsigned old = xb_add(&bar[XB_XSUB(b.x)], 1u);
        const unsigned gen = old / nloc;
        if (old + 1u == (gen + 1u) * nloc) {
            __builtin_amdgcn_fence(__ATOMIC_RELEASE, "agent");
            asm volatile("s_waitcnt vmcnt(0)" ::: "memory");
            const unsigned og = xb_add(&bar[XB_TOP], 1u);
            const unsigned tg = og / nx;
            if (og + 1u == (tg + 1u) * nx) xb_add(&bar[XB_TOPGEN], 1u);
            else XB_SPIN(xb_ld(&bar[XB_TOPGEN]) == tg, bar);
            __builtin_amdgcn_fence(__ATOMIC_ACQUIRE, "agent");
            xb_add(&bar[XB_XGEN(b.x)], 1u);
            asm volatile("s_waitcnt vmcnt(0)" ::: "memory");
        } else {
            XB_SPIN(xb_ld(&bar[XB_XGEN(b.x)]) == gen, bar);
            __builtin_amdgcn_fence(__ATOMIC_ACQUIRE, "agent");
            asm volatile("s_waitcnt vmcnt(0)" ::: "memory");
        }
    }
    __syncthreads();
}
struct Ctx { const float* in[32]; float* out; unsigned char* ws; int ph_lo, ph_hi; };
enum { I_X = 0, I_C, I_WADA, I_BADA, I_GPREMIX, I_GPOSTMIX, I_GPREFFN, I_GPOSTFFN, I_WIN, I_HLB, I_HGN, I_CONVW, I_CONVB, I_WQ, I_WK, I_WV, I_WIG, I_BIG, I_WFG, I_BFG,
       I_MGN, I_MSKIP, I_WPA, I_WPB, I_WOUT, I_F1, I_F3, I_F2, I_ROUTER, I_M1, I_M3, I_M2 };

__device__ __forceinline__ void ph_mod(const Ctx& c, LAS unsigned char* lds) {
    LAS float* cact = (LAS float*)lds;
    LAS float* part = (LAS float*)(lds + 32768);
    GAS float* MOD = (GAS float*)(c.ws + WS_MOD);
    const GAS float* cin = (const GAS float*)c.in[I_C]; const GAS float* wada = (const GAS float*)c.in[I_WADA]; const GAS float* bada = (const GAS float*)c.in[I_BADA];
    const int tid = TID(), lane = tid & 63, wave = tid >> 6;
    for (int i = tid; i < 8192; i += NTHR) { const float v = cin[i]; cact[i] = v * fsigm(v); }
    __syncthreads();
    for (int u = BID(); u < 384; u += gridDim.x) {
        const int l = u / 96, jb = u % 96, j = jb * 64 + lane;
        const GAS float* w = wada + ((size_t)l * 1024 + wave * 128) * 6144 + j;
        const LAS float* ca = cact + wave * 128;
        float a0 = 0.f, a1 = 0.f, a2 = 0.f, a3 = 0.f, a4 = 0.f, a5 = 0.f, a6 = 0.f, a7 = 0.f;
#pragma unroll 8
        for (int k = 0; k < 128; ++k) { const float wv = w[(size_t)k * 6144];
            a0 += ca[k] * wv; a1 += ca[1024 + k] * wv; a2 += ca[2048 + k] * wv; a3 += ca[3072 + k] * wv;
            a4 += ca[4096 + k] * wv; a5 += ca[5120 + k] * wv; a6 += ca[6144 + k] * wv; a7 += ca[7168 + k] * wv; }
        LAS float* pw = part + wave * 512 + lane;
        pw[0] = a0; pw[64] = a1; pw[128] = a2; pw[192] = a3; pw[256] = a4; pw[320] = a5; pw[384] = a6; pw[448] = a7;
        __syncthreads();
        { const int b = wave; float s = bada[l * 6144 + j];
#pragma unroll
            for (int ww = 0; ww < 8; ++ww) s += part[ww * 512 + b * 64 + lane];
            MOD[(size_t)(l * 8 + b) * 6144 + j] = s; }
        __syncthreads();
    }
}
__device__ __forceinline__ void ph_lb(const Ctx& c) {
    if (BID() != 0) return;
    GAS float* LB = (GAS float*)(c.ws + WS_LB); const GAS float* raw = (const GAS float*)c.in[I_HLB];
    for (int col = TID(); col < 1024; col += NTHR) {
        const float r0 = raw[col], r1 = raw[1024 + col], r2 = raw[2048 + col], r3 = raw[3072 + col];
        const float mx = fmaxf(fmaxf(r0, r1), fmaxf(r2, r3));
        const float e0 = __expf(r0 - mx), e1 = __expf(r1 - mx), e2 = __expf(r2 - mx), e3 = __expf(r3 - mx), inv = 1.0f / (e0 + e1 + e2 + e3);
        LB[col] = 0.f; LB[1024 + col] = e1 * inv; LB[2048 + col] = (e1 + e2) * inv; LB[3072 + col] = (e1 + e2 + e3) * inv;
    }
}
struct CvtJob { const float* W; bf16* WT; int K, N, rowbase, mode, item, pad_; };
__device__ __forceinline__ void cvt_load(const CvtJob& j, int lane, f32x4 (&r)[8]) {
    const int nblk = j.N / 32, kb = j.item / nblk, nb = j.item % nblk;
    const GAS float* p = (const GAS float*)j.W + (size_t)(64 * kb + (lane >> 3)) * j.N + 32 * nb + (lane & 7) * 4;
#pragma unroll
    for (int i = 0; i < 8; ++i) r[i] = __builtin_nontemporal_load((const GAS f32x4*)(p + (size_t)(8 * i) * j.N));
}
__device__ __forceinline__ void cvt_store(const CvtJob& j, int lane, const f32x4 (&r)[8], LAS float* scr) {
    const int nblk = j.N / 32, kb = j.item / nblk, nb = j.item % nblk, k0 = 64 * kb, n0 = 32 * nb;
#pragma unroll
    for (int i = 0; i < 8; ++i) { LAS float* s = scr + (8 * i + (lane >> 3)) * 33 + (lane & 7) * 4; s[0] = r[i][0]; s[1] = r[i][1]; s[2] = r[i][2]; s[3] = r[i][3]; }
    LDS_WAIT(); asm volatile("" ::: "memory");
    const int drow0 = j.rowbase + (j.mode ? ((n0 >> 7) * 256 + (n0 & 127)) : n0);
    const int cc = lane & 7;
#pragma unroll
    for (int jj = 0; jj < 4; ++jj) { const int n = (lane >> 3) + 8 * jj; const LAS float* s = scr + (8 * cc) * 33 + n;
        v4u o; o.x = pk2(s[0 * 33], s[1 * 33]); o.y = pk2(s[2 * 33], s[3 * 33]); o.z = pk2(s[4 * 33], s[5 * 33]); o.w = pk2(s[6 * 33], s[7 * 33]);
        *(GAS v4u*)(j.WT + (size_t)(drow0 + n) * j.K + k0 + 8 * cc) = o; }
    LDS_WAIT(); asm volatile("" ::: "memory");
}
__device__ __forceinline__ CvtJob cvt_decode(const Ctx& c, int l, int it) {
    bf16* WIN = (bf16*)(c.ws + WS_WIN); bf16* WAB = (bf16*)(c.ws + WS_WAB + (size_t)(l & 1) * WAB_STEP); bf16* WO = (bf16*)(c.ws + WS_WO + (size_t)(l & 1) * WO_STEP); bf16* WF = (bf16*)(c.ws + ((l & 1) ? WS_WFM : WS_WFD));
    const bool moe = (l & 1) != 0; const int j = l >> 1;
    constexpr int I_IN = 16 * 256, I_SQ = 16 * 32, I_D13 = 16 * 88, I_M13 = 16 * 112, I_M2E = 56 * 32;
    CvtJob q; q.pad_ = 0; q.mode = 0; q.rowbase = 0; q.K = D; q.N = D;
    int r = it;
    if (r < I_IN) { q.W = c.in[I_WIN] + (size_t)l * D * DIN; q.N = DIN; q.WT = WIN; q.item = r; return q; } r -= I_IN;
    if (r < I_SQ) { q.W = c.in[I_WPA] + (size_t)l * D * D; q.WT = WAB; q.item = r; return q; } r -= I_SQ;
    if (r < I_SQ) { q.W = c.in[I_WPB] + (size_t)l * D * D; q.WT = WAB; q.rowbase = 1024; q.item = r; return q; } r -= I_SQ;
    if (r < I_SQ) { q.W = c.in[I_WOUT] + (size_t)l * D * D; q.WT = WO; q.item = r; return q; } r -= I_SQ;
    if (!moe) {
        if (r < I_D13) { q.W = c.in[I_F1] + (size_t)j * D * DFF; q.N = DFF; q.WT = WF; q.mode = 1; q.item = r; return q; } r -= I_D13;
        if (r < I_D13) { q.W = c.in[I_F3] + (size_t)j * D * DFF; q.N = DFF; q.WT = WF; q.mode = 1; q.rowbase = 128; q.item = r; return q; } r -= I_D13;
        q.W = c.in[I_F2] + (size_t)j * DFF * D; q.K = DFF; q.WT = (bf16*)(c.ws + WS_WFD + WF_W2_DENSE); q.item = r; return q;
    }
    if (r < NEXP * I_M13) { const int e = r / I_M13; q.W = c.in[I_M1] + ((size_t)j * NEXP + e) * D * DFE; q.N = DFE; q.WT = WF; q.mode = 1; q.rowbase = e * 2 * DFE; q.item = r - e * I_M13; return q; } r -= NEXP * I_M13;
    if (r < NEXP * I_M13) { const int e = r / I_M13; q.W = c.in[I_M3] + ((size_t)j * NEXP + e) * D * DFE; q.N = DFE; q.WT = WF; q.mode = 1; q.rowbase = e * 2 * DFE + 128; q.item = r - e * I_M13; return q; } r -= NEXP * I_M13;
    { const int e = r / I_M2E; q.W = c.in[I_M2] + ((size_t)j * NEXP + e) * DFE * D; q.K = DFE; q.WT = (bf16*)(c.ws + WS_WFM + WF_W2_MOE); q.rowbase = e * D; q.item = r - e * I_M2E; return q; }
}
__device__ __forceinline__ void ph_cvt(const Ctx& c, int l, LAS unsigned char* lds, int wg, int nwg, int part, int nap = 0) {
    const int tid = TID(), lane = tid & 63, wave = __builtin_amdgcn_readfirstlane(tid >> 6);
    LAS float* scr = (LAS float*)(lds + wave * 16384);
    const int gw = wg * NWAVES + wave, NGW = nwg * NWAVES;
    const bool moe = (l & 1) != 0;
    const int total = 16 * 256 + 3 * 16 * 32 + (moe ? (2 * NEXP * 16 * 112 + NEXP * 56 * 32) : (2 * 16 * 88 + 44 * 32));
    const int first = (part == 1) ? 16 * 256 : 0, last = (part == 0) ? 16 * 256 : total;
    int it = first + gw; if (it >= last) return;
    CvtJob job = cvt_decode(c, l, it); f32x4 ra[8], rb[8]; cvt_load(job, lane, ra);
    for (;;) {
        const int nit = it + NGW; const bool more = nit < last; CvtJob jn = job;
        if (more) { jn = cvt_decode(c, l, nit); cvt_load(jn, lane, rb); }
        cvt_store(job, lane, ra, scr);
        if (!more) break;
        if (nap) __builtin_amdgcn_s_sleep(32);
#pragma unroll
        for (int i = 0; i < 8; ++i) ra[i] = rb[i];
        job = jn; it = nit;
    }
}

__device__ __forceinline__ void ld_row_f32(const float* p, int lane, f32x4 (&v)[4]) {
#pragma unroll
    for (int j = 0; j < 4; ++j) v[j] = *(const GAS f32x4*)(p + 4 * lane + 256 * j);
}
__device__ __forceinline__ void ld_row_bf16(const bf16* p, int lane, f32x4 (&v)[4]) {
#pragma unroll
    for (int j = 0; j < 4; ++j) { const v2u w = *(const GAS v2u*)(p + 4 * lane + 256 * j); v[j] = (f32x4){bflo(w.x), bfhi(w.x), bflo(w.y), bfhi(w.y)}; }
}
__device__ __forceinline__ void st_row_bf16(bf16* p, int lane, const f32x4 (&v)[4]) {
#pragma unroll
    for (int j = 0; j < 4; ++j) { v2u w; w.x = pk2(v[j][0], v[j][1]); w.y = pk2(v[j][2], v[j][3]); *(GAS v2u*)(p + 4 * lane + 256 * j) = w; }
}
__device__ __forceinline__ float row_sumsq(const f32x4 (&v)[4]) {
    float s = 0.f;
#pragma unroll
    for (int j = 0; j < 4; ++j) s += (v[j][0] * v[j][0] + v[j][1] * v[j][1]) + (v[j][2] * v[j][2] + v[j][3] * v[j][3]);
    return wave_sum(s);
}
__device__ __forceinline__ void norm_mod(const f32x4 (&x)[4], const f32x4 (&g)[4], const f32x4 (&sc)[4], const f32x4 (&sh)[4], f32x4 (&h)[4]) {
    const float r = rsqrtf(row_sumsq(x) * (1.0f / 1024.0f) + EPS);
#pragma unroll
    for (int j = 0; j < 4; ++j) h[j] = (x[j] * r) * g[j] * (sc[j] + 1.0f) + sh[j];
}
__device__ __forceinline__ const float* modp(const Ctx& c, int l, int b, int which) { return (const float*)(c.ws + WS_MOD) + ((size_t)(l * 8 + b) * 6 + which) * 1024; }

__device__ __forceinline__ void ph_norm0(const Ctx& c) {
    const int tid = TID(), lane = tid & 63, wave = tid >> 6, gw = BID() * NWAVES + wave, NGW = gridDim.x * NWAVES;
    bf16* H = (bf16*)(c.ws + WS_H);
    for (int slot = gw; slot < M / 16; slot += NGW) {
        const int row0 = slot * 16, b = row0 / SEQ;
        f32x4 g[4], sc[4], sh[4]; ld_row_f32(c.in[I_GPREMIX], lane, g); ld_row_f32(modp(c, 0, b, 1), lane, sc); ld_row_f32(modp(c, 0, b, 0), lane, sh);
        for (int r = 0; r < 16; ++r) { f32x4 x[4], h[4]; ld_row_f32(c.in[I_X] + (size_t)(row0 + r) * D, lane, x); norm_mod(x, g, sc, sh, h); st_row_bf16(H + (size_t)(row0 + r) * D, lane, h); }
    }
}
__device__ __forceinline__ void ph_uz(const Ctx& c) {
    GAS float* UZ = (GAS float*)(c.ws + WS_UZ);
    const int gt = BID() * NTHR + TID();
    if (gt >= DEPTH * D) return;
    const int l = gt >> 10, ch = gt & 1023, n = ch >> 2, i = ch & 3;
    const GAS float* wq = (const GAS float*)c.in[I_WQ] + (size_t)l * 4096 + n * 16 + i * 4; const GAS float* wk = (const GAS float*)c.in[I_WK] + (size_t)l * 4096 + n * 16 + i * 4; const GAS float* wv = (const GAS float*)c.in[I_WV] + (size_t)l * 4096 + n * 16 + i * 4;
    const GAS float* wig = (const GAS float*)c.in[I_WIG] + (size_t)l * 3072 * 4; const GAS float* wfg = (const GAS float*)c.in[I_WFG] + (size_t)l * 3072 * 4;
    f32x4 ui = {0.f, 0.f, 0.f, 0.f}, uf = ui, zi = ui, zf = ui;
#pragma unroll
    for (int o = 0; o < 4; ++o) { const float q = wq[o], k = wk[o], v = wv[o];
        ui += *(const GAS f32x4*)(wig + (size_t)(4 * n + o) * 4) * q + *(const GAS f32x4*)(wig + (size_t)(1024 + 4 * n + o) * 4) * k; zi += *(const GAS f32x4*)(wig + (size_t)(2048 + 4 * n + o) * 4) * v;
        uf += *(const GAS f32x4*)(wfg + (size_t)(4 * n + o) * 4) * q + *(const GAS f32x4*)(wfg + (size_t)(1024 + 4 * n + o) * 4) * k; zf += *(const GAS f32x4*)(wfg + (size_t)(2048 + 4 * n + o) * 4) * v; }
    GAS f32x4* UP = (GAS f32x4*)(UZ + (size_t)DEPTH * D * 16 + (size_t)l * 16 * D);
    UP[(i * 4 + 0) * 256 + n] = ui; UP[(i * 4 + 1) * 256 + n] = uf; UP[(i * 4 + 2) * 256 + n] = zi; UP[(i * 4 + 3) * 256 + n] = zf;
}
__device__ __forceinline__ void ph_prep(const Ctx& c, int l, LAS unsigned char* lds) {
    const int tid = TID(), lane = tid & 63, wave = tid >> 6, gw = BID() * NWAVES + wave, NGW = gridDim.x * NWAVES;
    LAS f32x4* UZL = (LAS f32x4*)lds;
    LAS f32x4* WTL = (LAS f32x4*)(lds + 65536);
    LAS f32x4* CWL = (LAS f32x4*)(lds + 114688);
    LAS f32x4* CBL = (LAS f32x4*)(lds + 135168);
    {   const GAS f32x4* ut = (const GAS f32x4*)((const float*)(c.ws + WS_UZ) + (size_t)DEPTH * D * 16 + (size_t)l * 16 * D);
        for (int i = tid; i < 4096; i += NTHR) UZL[i] = ut[i];
        for (int i = tid; i < 1024; i += NTHR) { const int ii = i >> 8, n = i & 255; const size_t so = (size_t)l * 4096 + n * 16 + ii * 4;
            WTL[i] = *(const GAS f32x4*)(c.in[I_WQ] + so); WTL[1024 + i] = *(const GAS f32x4*)(c.in[I_WK] + so); WTL[2048 + i] = *(const GAS f32x4*)(c.in[I_WV] + so); }
        for (int i = tid; i < 1024; i += NTHR) CWL[i] = *(const GAS f32x4*)(c.in[I_CONVW] + (size_t)l * 4 * D + i * 4);
        if (tid < 256) CBL[tid] = *(const GAS f32x4*)(c.in[I_CONVB] + (size_t)l * D + tid * 4);
        __syncthreads(); }
    const bf16* XM = (const bf16*)(c.ws + WS_PROJ) + (size_t)P_XM * PSTRIDE;
    bf16* MQ = (bf16*)(c.ws + WS_MQ); bf16* MK = (bf16*)(c.ws + WS_MK); bf16* MV = (bf16*)(c.ws + WS_MV); bf16* XC = (bf16*)(c.ws + WS_XC);
    GAS float* LI = (GAS float*)(c.ws + WS_LI); GAS float* LF = (GAS float*)(c.ws + WS_LF);
    const float* cw = c.in[I_CONVW] + (size_t)l * 4 * D; const float* cb = c.in[I_CONVB] + (size_t)l * D;
    const float* wq = c.in[I_WQ] + (size_t)l * 256 * 16; const float* wk = c.in[I_WK] + (size_t)l * 256 * 16; const float* wv = c.in[I_WV] + (size_t)l * 256 * 16;
    const float* UZ = (const float*)(c.ws + WS_UZ) + (size_t)l * D * 16;
    const int gidx = (lane >> 1) & 7;
    const float gbias = (gidx < 4) ? ((const GAS float*)c.in[I_BIG])[l * 4 + gidx] : ((const GAS float*)c.in[I_BFG])[l * 4 + gidx - 4];
    for (int slot = gw; slot < M / 16; slot += NGW) {
        const int row0 = slot * 16, tq0 = row0 & (SEQ - 1);
#define PREP_WIN(W_, TB_, J_) do { _Pragma("unroll") for (int r = 0; r < 7; ++r) { const int rel_ = (TB_) * 4 - 3 + r; const int rr_ = (tq0 + rel_ >= 0) ? rel_ : 0; \
            W_[r] = *(const GAS v2u*)(XM + (size_t)(row0 + rr_) * D + 4 * lane + 256 * (J_)); } } while (0)
        v2u wn[7]; PREP_WIN(wn, 0, 0);
#pragma unroll 1
        for (int tb = 0; tb < 4; ++tb) {
            f32x4 gi[4], gf[4];
#pragma unroll
            for (int tt = 0; tt < 4; ++tt) { gi[tt] = (f32x4){0.f, 0.f, 0.f, 0.f}; gf[tt] = gi[tt]; }
#pragma unroll 1
            for (int j = 0; j < 4; ++j) {
                const int ch = 4 * lane + 256 * j, n = lane + 64 * j;
                const f32x4 b4 = CBL[n];
                f32x4 xcs[4], xts[4];
                {
                    f32x4 w4[4];
#pragma unroll
                    for (int i = 0; i < 4; ++i) w4[i] = CWL[i * 256 + n];
                    v2u win[7];
#pragma unroll
                    for (int r = 0; r < 7; ++r) { const int rel = tb * 4 - 3 + r; win[r] = (tq0 + rel >= 0) ? wn[r] : (v2u){0u, 0u}; }
                    { const int itn = (tb * 4 + j + 1 < 16) ? tb * 4 + j + 1 : 15; PREP_WIN(wn, itn >> 2, itn & 3); }
#pragma unroll
                    for (int tt = 0; tt < 4; ++tt) {
                        f32x4 y = b4, xt = {0.f, 0.f, 0.f, 0.f};
#pragma unroll
                        for (int jj = 0; jj < 4; ++jj) { const v2u w = win[tt + jj]; const f32x4 xv = {bflo(w.x), bfhi(w.x), bflo(w.y), bfhi(w.y)}; y += w4[jj] * xv; if (jj == 3) xt = xv; }
                        f32x4 xc; xc[0] = y[0] * fsigr(y[0]); xc[1] = y[1] * fsigr(y[1]); xc[2] = y[2] * fsigr(y[2]); xc[3] = y[3] * fsigr(y[3]);
                        xcs[tt] = xc; xts[tt] = xt;
                        { v2u w; w.x = pk2(xc[0], xc[1]); w.y = pk2(xc[2], xc[3]); *(GAS v2u*)(XC + (size_t)(row0 + tb * 4 + tt) * D + ch) = w; }
                    }
                }
                asm volatile("" ::: "memory");
                {
                    f32x4 q4[4], k4[4], v4[4];
#pragma unroll
                    for (int i = 0; i < 4; ++i) { q4[i] = WTL[i * 256 + n]; k4[i] = WTL[1024 + i * 256 + n]; v4[i] = WTL[2048 + i * 256 + n]; }
#pragma unroll
                    for (int tt = 0; tt < 4; ++tt) {
                        f32x4 q = {0.f, 0.f, 0.f, 0.f}, k = q, v = q;
#pragma unroll
                        for (int i = 0; i < 4; ++i) { q += q4[i] * xcs[tt][i]; k += k4[i] * xcs[tt][i]; v += v4[i] * xts[tt][i]; }
                        const size_t off = (size_t)(row0 + tb * 4 + tt) * D + ch;
                        { v2u w; w.x = pk2(q[0], q[1]); w.y = pk2(q[2], q[3]); *(GAS v2u*)(MQ + off) = w; }
                        { v2u w; w.x = pk2(k[0] * 0.0625f, k[1] * 0.0625f); w.y = pk2(k[2] * 0.0625f, k[3] * 0.0625f); *(GAS v2u*)(MK + off) = w; }
                        { v2u w; w.x = pk2(v[0], v[1]); w.y = pk2(v[2], v[3]); *(GAS v2u*)(MV + off) = w; }
                    }
                }
                asm volatile("" ::: "memory");
                {
#pragma unroll
                    for (int i = 0; i < 4; ++i) { const f32x4 u0 = UZL[(i * 4 + 0) * 256 + n], u1 = UZL[(i * 4 + 1) * 256 + n], u2 = UZL[(i * 4 + 2) * 256 + n], u3 = UZL[(i * 4 + 3) * 256 + n];
#pragma unroll
                        for (int tt = 0; tt < 4; ++tt) { gi[tt] += u0 * xcs[tt][i] + u2 * xts[tt][i]; gf[tt] += u1 * xcs[tt][i] + u3 * xts[tt][i]; }
                        __builtin_amdgcn_sched_barrier(0); }
                }
            }
            float v[32];
#pragma unroll
            for (int tt = 0; tt < 4; ++tt)
#pragma unroll
                for (int hh = 0; hh < 4; ++hh) { v[tt * 8 + hh] = gi[tt][hh]; v[tt * 8 + 4 + hh] = gf[tt][hh]; }
#pragma unroll
            for (int st = 0; st < 5; ++st) { const int o = 32 >> st, nn = 32 >> st; const bool up = (lane & o) != 0;
#pragma unroll
                for (int i = 0; i < nn / 2; ++i) { const float lo = v[i], hi = v[i + nn / 2]; const float send = up ? lo : hi, keep = up ? hi : lo; v[i] = keep + __shfl_xor(send, o); } }
            const float tot = v[0] + __shfl_xor(v[0], 1) + gbias;
            if ((lane & 1) == 0) { const int tt = lane >> 4; const size_t row = (size_t)(row0 + tb * 4 + tt);
                if (gidx < 4) LI[row * 4 + gidx] = tot; else LF[row * 4 + gidx - 4] = fminf(tot, 0.f) - __logf(1.0f + __expf(-fabsf(tot))); }
        }
    }
#undef PREP_WIN
}

__device__ __forceinline__ void ph_scan_a_naive(const Ctx& c, LAS unsigned char* lds) {
    const int tid = TID();
    bf16* PJ = (bf16*)(c.ws + WS_PROJ);
    const bf16* Q = PJ + (size_t)P_QA * PSTRIDE; const bf16* LFp = PJ + (size_t)P_LF * PSTRIDE; bf16* V = PJ + (size_t)P_VA * PSTRIDE;
    LAS bf16* sq = (LAS bf16*)lds;
    LAS bf16* sf = (LAS bf16*)(lds + 32768);
    LAS bf16* sv = (LAS bf16*)(lds + 65536);
    LAS float* so = (LAS float*)(lds + 73728);
    const int dg = tid & 15, vv = tid >> 4;
    for (int u = BID(); u < 256; u += gridDim.x) {
        const int b = u >> 5, h = (u >> 2) & 7, vs = u & 3;
        const size_t rowbase = (size_t)b * SEQ;
        float S[8];
#pragma unroll
        for (int j = 0; j < 8; ++j) S[j] = 0.f;
        v4u rq[2], rf[2], rv = {0u, 0u, 0u, 0u};
#define SA_LOAD(ch) do { _Pragma("unroll") for (int k2 = 0; k2 < 2; ++k2) { const int p = tid + NTHR * k2, rr = p >> 4, c8 = p & 15; const size_t o_ = (rowbase + (size_t)(ch) * 64 + rr) * D + h * 128 + c8 * 8; \
            rq[k2] = *(const GAS v4u*)(Q + o_); rf[k2] = *(const GAS v4u*)(LFp + o_); } \
            if (tid < 256) { const int rr = tid >> 2, c8 = tid & 3; rv = *(const GAS v4u*)(V + (rowbase + (size_t)(ch) * 64 + rr) * D + h * 128 + vs * 32 + c8 * 8); } } while (0)
        SA_LOAD(0);
        for (int ch = 0; ch < 64; ++ch) {
            const int buf = ch & 1;
#pragma unroll
            for (int k2 = 0; k2 < 2; ++k2) { const int p = tid + NTHR * k2; *(LAS v4u*)(sq + buf * 8192 + p * 8) = rq[k2]; *(LAS v4u*)(sf + buf * 8192 + p * 8) = rf[k2]; }
            if (tid < 256) *(LAS v4u*)(sv + buf * 2048 + tid * 8) = rv;
            __syncthreads();
            if (ch + 1 < 64) SA_LOAD(ch + 1);
            for (int i = 0; i < 64; ++i) {
                const v4u qv = *(const LAS v4u*)(sq + buf * 8192 + i * 128 + dg * 8), fv = *(const LAS v4u*)(sf + buf * 8192 + i * 128 + dg * 8);
                const float vt = bf2f(sv[buf * 2048 + i * 32 + vv]);
                const float qq[8] = {bflo(qv.x), bfhi(qv.x), bflo(qv.y), bfhi(qv.y), bflo(qv.z), bfhi(qv.z), bflo(qv.w), bfhi(qv.w)};
                const float ff[8] = {bflo(fv.x), bfhi(fv.x), bflo(fv.y), bfhi(fv.y), bflo(fv.z), bfhi(fv.z), bflo(fv.w), bfhi(fv.w)};
                float o = 0.f;
#pragma unroll
                for (int j = 0; j < 8; ++j) { const float f = __expf(ff[j]); S[j] = f * S[j] + (1.0f - f) * vt; o += S[j] * qq[j]; }
                o = sum16(o);
                if (dg == 0) so[i * 32 + vv] = o;
            }
            __syncthreads();
            { const int rr = tid >> 3, c4 = (tid & 7) * 4; const f32x4 ov = *(const LAS f32x4*)(so + rr * 32 + c4);
                v2u w; w.x = pk2(ov[0], ov[1]); w.y = pk2(ov[2], ov[3]); *(GAS v2u*)(V + (rowbase + (size_t)ch * 64 + rr) * D + h * 128 + vs * 32 + c4) = w; }
        }
#undef SA_LOAD
        __syncthreads();
    }
}

__device__ __forceinline__ void ph_scan_m_naive(const Ctx& c, LAS unsigned char* lds) {
    const int tid = TID();
    const bf16* MQ = (const bf16*)(c.ws + WS_MQ); const bf16* MK = (const bf16*)(c.ws + WS_MK); bf16* MV = (bf16*)(c.ws + WS_MV);
    const float* LI = (const float*)(c.ws + WS_LI); const float* LF = (const float*)(c.ws + WS_LF);
    LAS bf16* sq = (LAS bf16*)lds;
    LAS bf16* sk = (LAS bf16*)(lds + 32768);
    LAS bf16* sv = (LAS bf16*)(lds + 65536);
    LAS float* sli = (LAS float*)(lds + 69632);
    LAS float* slf = (LAS float*)(lds + 69888);
    LAS float* so = (LAS float*)(lds + 70144);
    const int dg = tid & 15, vv = tid >> 4;
    for (int u = BID(); u < 256; u += gridDim.x) {
        const int b = u >> 5, h = (u >> 3) & 3, vs = u & 7;
        const size_t rowbase = (size_t)b * SEQ;
        float C[16], nn[16], m = 0.f;
#pragma unroll
        for (int j = 0; j < 16; ++j) { C[j] = 0.f; nn[j] = 0.f; }
        v4u rq[4], rk[4], rv = {0u, 0u, 0u, 0u}; float rli = 0.f, rlf = 0.f;
#define SM_LOAD(ch) do { _Pragma("unroll") for (int k2 = 0; k2 < 4; ++k2) { const int p = tid + NTHR * k2, rr = p >> 5, c8 = p & 31; const size_t o_ = (rowbase + (size_t)(ch) * 64 + rr) * D + h * 256 + c8 * 8; \
            rq[k2] = *(const GAS v4u*)(MQ + o_); rk[k2] = *(const GAS v4u*)(MK + o_); } \
            if (tid < 256) { const int rr = tid >> 2, c8 = tid & 3; rv = *(const GAS v4u*)(MV + (rowbase + (size_t)(ch) * 64 + rr) * D + h * 256 + vs * 32 + c8 * 8); } \
            if (tid < 64) { rli = LI[(rowbase + (size_t)(ch) * 64 + tid) * 4 + h]; rlf = LF[(rowbase + (size_t)(ch) * 64 + tid) * 4 + h]; } } while (0)
        SM_LOAD(0);
        for (int ch = 0; ch < 64; ++ch) {
#pragma unroll
            for (int k2 = 0; k2 < 4; ++k2) { const int p = tid + NTHR * k2; *(LAS v4u*)(sq + p * 8) = rq[k2]; *(LAS v4u*)(sk + p * 8) = rk[k2]; }
            if (tid < 256) *(LAS v4u*)(sv + tid * 8) = rv;
            if (tid < 64) { sli[tid] = rli; slf[tid] = rlf; }
            __syncthreads();
            if (ch + 1 < 64) SM_LOAD(ch + 1);
            for (int i = 0; i < 64; ++i) {
                const float li = sli[i], lf = slf[i];
                const float mn = fmaxf(lf + m, li), fg = __expf(lf + m - mn), ig = __expf(li - mn); m = mn;
                const float vt = bf2f(sv[i * 32 + vv]) * ig;
                float num = 0.f, den = 0.f;
#pragma unroll
                for (int hh = 0; hh < 2; ++hh) {
                    const v4u qv = *(const LAS v4u*)(sq + i * 256 + dg * 16 + hh * 8), kv = *(const LAS v4u*)(sk + i * 256 + dg * 16 + hh * 8);
                    const float qq[8] = {bflo(qv.x), bfhi(qv.x), bflo(qv.y), bfhi(qv.y), bflo(qv.z), bfhi(qv.z), bflo(qv.w), bfhi(qv.w)};
                    const float kk[8] = {bflo(kv.x), bfhi(kv.x), bflo(kv.y), bfhi(kv.y), bflo(kv.z), bfhi(kv.z), bflo(kv.w), bfhi(kv.w)};
#pragma unroll
                    for (int j = 0; j < 8; ++j) { const int jj = hh * 8 + j; C[jj] = fg * C[jj] + kk[j] * vt; nn[jj] = fg * nn[jj] + ig * kk[j]; num += qq[j] * C[jj]; den += qq[j] * nn[jj]; }
                }
                num = sum16(num); den = sum16(den);
                if (dg == 0) so[i * 32 + vv] = num / fmaxf(fabsf(den), __expf(-m));
            }
            __syncthreads();
            { const int rr = tid >> 3, c4 = (tid & 7) * 4; const f32x4 ov = *(const LAS f32x4*)(so + rr * 32 + c4);
                v2u w; w.x = pk2(ov[0], ov[1]); w.y = pk2(ov[2], ov[3]); *(GAS v2u*)(MV + (rowbase + (size_t)ch * 64 + rr) * D + h * 256 + vs * 32 + c4) = w; }
        }
#undef SM_LOAD
        __syncthreads();
    }
}

__device__ __forceinline__ void ph_post(const Ctx& c, int l) {
    const int tid = TID(), lane = tid & 63, wave = tid >> 6, gw = BID() * NWAVES + wave, NGW = gridDim.x * NWAVES;
    bf16* PJ = (bf16*)(c.ws + WS_PROJ);
    const bf16* OS = PJ + (size_t)P_OS * PSTRIDE; bf16* BO = PJ + (size_t)P_LF * PSTRIDE;
    const bf16* HM = (const bf16*)(c.ws + WS_H); const bf16* XC = (const bf16*)(c.ws + WS_XC);
    float gnm[2][8], skp[2][8];
#pragma unroll
    for (int j = 0; j < 2; ++j) { const int c0 = 8 * lane + 512 * j;
        const f32x4 b0 = *(const GAS f32x4*)(c.in[I_MGN] + (size_t)l * D + c0), b1 = *(const GAS f32x4*)(c.in[I_MGN] + (size_t)l * D + c0 + 4);
        const f32x4 s0 = *(const GAS f32x4*)(c.in[I_MSKIP] + (size_t)l * D + c0), s1 = *(const GAS f32x4*)(c.in[I_MSKIP] + (size_t)l * D + c0 + 4);
#pragma unroll
        for (int e = 0; e < 4; ++e) { gnm[j][e] = b0[e]; gnm[j][4 + e] = b1[e]; skp[j][e] = s0[e]; skp[j][4 + e] = s1[e]; } }
#define POST_LOAD(R, ro_) do { _Pragma("unroll") for (int j = 0; j < 2; ++j) { const size_t o_ = (ro_) + 8 * lane + 512 * j; R[0][j] = *(const GAS v4u*)(HM + o_); R[1][j] = *(const GAS v4u*)(XC + o_); R[2][j] = *(const GAS v4u*)(OS + o_); } } while (0)
#define UNPK8(F_, W_) do { const v4u q_ = (W_); F_[0] = bflo(q_.x); F_[1] = bfhi(q_.x); F_[2] = bflo(q_.y); F_[3] = bfhi(q_.y); F_[4] = bflo(q_.z); F_[5] = bfhi(q_.z); F_[6] = bflo(q_.w); F_[7] = bfhi(q_.w); } while (0)
    for (int slot = gw; slot < M / 16; slot += NGW) {
        v4u ra[3][2], rb[3][2], rc[3][2];
        POST_LOAD(ra, (size_t)(slot * 16) * D); POST_LOAD(rb, (size_t)(slot * 16 + 1) * D);
        for (int r = 0; r < 16; ++r) {
            const size_t ro = (size_t)(slot * 16 + r) * D;
            if (r + 2 < 16) POST_LOAD(rc, ro + 2 * D);
#pragma unroll
            for (int j = 0; j < 2; ++j) {
                float hm[8], xc[8], orw[8], bo[8];
                UNPK8(hm, ra[0][j]); UNPK8(xc, ra[1][j]); UNPK8(orw, ra[2][j]);
                float sm = 0.f;
#pragma unroll
                for (int e = 0; e < 8; ++e) sm += hm[e];
                const float mu = half_sum(sm) * (1.0f / 256.0f);
                float vs_ = 0.f;
#pragma unroll
                for (int e = 0; e < 8; ++e) { hm[e] -= mu; vs_ += hm[e] * hm[e]; }
                const float rsb = rsqrtf(half_sum(vs_) * (1.0f / 256.0f) + EPS);
#pragma unroll
                for (int e = 0; e < 8; ++e) bo[e] = fsigm(orw[e]) * (hm[e] * rsb * gnm[j][e] + skp[j][e] * xc[e]);
                *(GAS v4u*)(BO + ro + 8 * lane + 512 * j) = (v4u){pk2(bo[0], bo[1]), pk2(bo[2], bo[3]), pk2(bo[4], bo[5]), pk2(bo[6], bo[7])};
            }
#pragma unroll
            for (int s = 0; s < 3; ++s)
#pragma unroll
                for (int j = 0; j < 2; ++j) { ra[s][j] = rb[s][j]; rb[s][j] = rc[s][j]; }
        }
    }
#undef POST_LOAD
#undef UNPK8
}
typedef short bf16x8 __attribute__((ext_vector_type(8)));
#define MFMA16(a, b, c) __builtin_amdgcn_mfma_f32_16x16x32_bf16(a, b, c, 0, 0, 0)
__device__ __forceinline__ f32x4 mmT(const LAS bf16* X, int ldx, int m0, const LAS bf16* Y, int ldy, int n0, int k0, f32x4 acc, int lane) {
    const bf16x8 a = *(const LAS bf16x8*)(X + (m0 + (lane & 15)) * ldx + k0 + 8 * (lane >> 4));
    const bf16x8 b = *(const LAS bf16x8*)(Y + (n0 + (lane & 15)) * ldy + k0 + 8 * (lane >> 4));
    return MFMA16(b, a, acc);
}
__device__ __forceinline__ f32x4 mmN(const LAS bf16* X, int ldx, int m0, const LAS bf16* Y, int ldy, int n0, int k0, f32x4 acc, int lane) {
    const bf16x8 a = *(const LAS bf16x8*)(X + (m0 + (lane & 15)) * ldx + k0 + 8 * (lane >> 4));
    const bf16x8 b = *(const LAS bf16x8*)(Y + (n0 + (lane & 15)) * ldy + k0 + 8 * (lane >> 4));
    return MFMA16(a, b, acc);
}
__device__ __forceinline__ v2u pack4(const f32x4 v) { v2u w; w.x = pk2(v[0], v[1]); w.y = pk2(v[2], v[3]); return w; }

__device__ __forceinline__ bf16x8 tr_frag(const LAS bf16* T, int ld, int k0, int m0, int lane) {
    const int g = lane >> 4, q = (lane & 15) >> 2, p = lane & 3;
    const unsigned a0 = (unsigned)(size_t)(T + (k0 + 8 * g + q) * ld + m0 + 4 * p), a1 = a0 + (unsigned)(4 * ld * 2);
    v2u x, y; asm volatile("ds_read_b64_tr_b16 %0, %2\n\tds_read_b64_tr_b16 %1, %3\n\ts_waitcnt lgkmcnt(0)" : "=&v"(x), "=&v"(y) : "v"(a0), "v"(a1) : "memory");
    const v4u w = {x.x, x.y, y.x, y.y}; return __builtin_bit_cast(bf16x8, w);
}
struct Frag2 { bf16x8 a, b; };
__device__ __forceinline__ Frag2 tr_frag2(const LAS bf16* Ta, int lda, int k0a, int m0a, const LAS bf16* Tb, int ldb, int k0b, int m0b, int lane) {
    const int g = lane >> 4, q = (lane & 15) >> 2, p = lane & 3;
    const unsigned a0 = (unsigned)(size_t)(Ta + (k0a + 8 * g + q) * lda + m0a + 4 * p), a1 = a0 + (unsigned)(4 * lda * 2);
    const unsigned b0 = (unsigned)(size_t)(Tb + (k0b + 8 * g + q) * ldb + m0b + 4 * p), b1 = b0 + (unsigned)(4 * ldb * 2);
    v2u x, y, z, w; asm volatile("ds_read_b64_tr_b16 %0, %4\n\tds_read_b64_tr_b16 %1, %5\n\tds_read_b64_tr_b16 %2, %6\n\tds_read_b64_tr_b16 %3, %7\n\ts_waitcnt lgkmcnt(0)"
        : "=&v"(x), "=&v"(y), "=&v"(z), "=&v"(w) : "v"(a0), "v"(a1), "v"(b0), "v"(b1) : "memory");
    const v4u wa = {x.x, x.y, y.x, y.y}, wb = {z.x, z.y, w.x, w.y}; Frag2 r; r.a = __builtin_bit_cast(bf16x8, wa); r.b = __builtin_bit_cast(bf16x8, wb); return r;
}
#define TRH(P_, Q_) __builtin_bit_cast(bf16x8, (v4u){(P_).x, (P_).y, (Q_).x, (Q_).y})
__device__ __forceinline__ void tr_hgrn(const LAS bf16* LV, const LAS bf16* LK, int wave, int lane, bf16x8 (&vf)[4][2], bf16x8 (&kf)[2]) {
    const int g = lane >> 4, q = (lane & 15) >> 2, p = lane & 3;
    const unsigned av = (unsigned)(size_t)(LV + (8 * g + q) * 72 + 4 * p), ak = (unsigned)(size_t)(LK + (8 * g + q) * 136 + 4 * p + wave * 16);
    v2u a0, a1, a2, a3, a4, a5, a6, a7, b0, b1, b2, b3, b4, b5, b6, b7, k0, k1, k2, k3;
    asm volatile(
        "ds_read_b64_tr_b16 %0, %20\n\tds_read_b64_tr_b16 %1, %20 offset:576\n\tds_read_b64_tr_b16 %2, %20 offset:32\n\tds_read_b64_tr_b16 %3, %20 offset:608\n\t"
        "ds_read_b64_tr_b16 %4, %20 offset:64\n\tds_read_b64_tr_b16 %5, %20 offset:640\n\tds_read_b64_tr_b16 %6, %20 offset:96\n\tds_read_b64_tr_b16 %7, %20 offset:672\n\t"
        "ds_read_b64_tr_b16 %8, %20 offset:4608\n\tds_read_b64_tr_b16 %9, %20 offset:5184\n\tds_read_b64_tr_b16 %10, %20 offset:4640\n\tds_read_b64_tr_b16 %11, %20 offset:5216\n\t"
        "ds_read_b64_tr_b16 %12, %20 offset:4672\n\tds_read_b64_tr_b16 %13, %20 offset:5248\n\tds_read_b64_tr_b16 %14, %20 offset:4704\n\tds_read_b64_tr_b16 %15, %20 offset:5280\n\t"
        "ds_read_b64_tr_b16 %16, %21\n\tds_read_b64_tr_b16 %17, %21 offset:1088\n\tds_read_b64_tr_b16 %18, %21 offset:8704\n\tds_read_b64_tr_b16 %19, %21 offset:9792\n\t"
        "s_waitcnt lgkmcnt(0)"
        : "=&v"(a0), "=&v"(a1), "=&v"(a2), "=&v"(a3), "=&v"(a4), "=&v"(a5), "=&v"(a6), "=&v"(a7), "=&v"(b0), "=&v"(b1), "=&v"(b2), "=&v"(b3), "=&v"(b4), "=&v"(b5), "=&v"(b6), "=&v"(b7),
          "=&v"(k0), "=&v"(k1), "=&v"(k2), "=&v"(k3)
        : "v"(av), "v"(ak) : "memory");
    vf[0][0] = TRH(a0, a1); vf[1][0] = TRH(a2, a3); vf[2][0] = TRH(a4, a5); vf[3][0] = TRH(a6, a7);
    vf[0][1] = TRH(b0, b1); vf[1][1] = TRH(b2, b3); vf[2][1] = TRH(b4, b5); vf[3][1] = TRH(b6, b7);
    kf[0] = TRH(k0, k1); kf[1] = TRH(k2, k3);
}
__device__ __forceinline__ void tr_mnum(const LAS bf16* LV0, int e0, int lane, bf16x8 (&f)[3][2]) {
    const int g = lane >> 4, q = (lane & 15) >> 2, p = lane & 3;
    const unsigned av = (unsigned)(size_t)(LV0 + (8 * g + q) * 88 + 4 * p + e0), ad = (unsigned)(size_t)(LV0 + (8 * g + q) * 88 + 4 * p + 64);
    v2u a0, a1, a2, a3, a4, a5, b0, b1, b2, b3, b4, b5;
    asm volatile(
        "ds_read_b64_tr_b16 %0, %12\n\tds_read_b64_tr_b16 %1, %12 offset:704\n\tds_read_b64_tr_b16 %2, %12 offset:32\n\tds_read_b64_tr_b16 %3, %12 offset:736\n\tds_read_b64_tr_b16 %4, %13\n\tds_read_b64_tr_b16 %5, %13 offset:704\n\t"
        "ds_read_b64_tr_b16 %6, %12 offset:5632\n\tds_read_b64_tr_b16 %7, %12 offset:6336\n\tds_read_b64_tr_b16 %8, %12 offset:5664\n\tds_read_b64_tr_b16 %9, %12 offset:6368\n\tds_read_b64_tr_b16 %10, %13 offset:5632\n\tds_read_b64_tr_b16 %11, %13 offset:6336\n\t"
        "s_waitcnt lgkmcnt(0)"
        : "=&v"(a0), "=&v"(a1), "=&v"(a2), "=&v"(a3), "=&v"(a4), "=&v"(a5), "=&v"(b0), "=&v"(b1), "=&v"(b2), "=&v"(b3), "=&v"(b4), "=&v"(b5)
        : "v"(av), "v"(ad) : "memory");
    f[0][0] = TRH(a0, a1); f[1][0] = TRH(a2, a3); f[2][0] = TRH(a4, a5); f[0][1] = TRH(b0, b1); f[1][1] = TRH(b2, b3); f[2][1] = TRH(b4, b5);
}
template <int KS> __device__ __forceinline__ void tr_mupd(const LAS bf16* LK, const LAS bf16* LV1, int wave, int lane, bf16x8 (&af)[2], bf16x8 (&wf)[5]) {
    const int g = lane >> 4, q = (lane & 15) >> 2, p = lane & 3;
    const unsigned ak = (unsigned)(size_t)(LK + (KS * 32 + 8 * g + q) * 264 + 4 * p + wave * 32), av = (unsigned)(size_t)(LV1 + (KS * 32 + 8 * g + q) * 88 + 4 * p);
    v2u k0, k1, k2, k3, a0, a1, a2, a3, a4, a5, a6, a7, a8, a9;
    asm volatile(
        "ds_read_b64_tr_b16 %0, %14\n\tds_read_b64_tr_b16 %1, %14 offset:2112\n\tds_read_b64_tr_b16 %2, %14 offset:32\n\tds_read_b64_tr_b16 %3, %14 offset:2144\n\t"
        "ds_read_b64_tr_b16 %4, %15\n\tds_read_b64_tr_b16 %5, %15 offset:704\n\tds_read_b64_tr_b16 %6, %15 offset:32\n\tds_read_b64_tr_b16 %7, %15 offset:736\n\t"
        "ds_read_b64_tr_b16 %8, %15 offset:64\n\tds_read_b64_tr_b16 %9, %15 offset:768\n\tds_read_b64_tr_b16 %10, %15 offset:96\n\tds_read_b64_tr_b16 %11, %15 offset:800\n\t"
        "ds_read_b64_tr_b16 %12, %15 offset:128\n\tds_read_b64_tr_b16 %13, %15 offset:832\n\t"
        "s_waitcnt lgkmcnt(0)"
        : "=&v"(k0), "=&v"(k1), "=&v"(k2), "=&v"(k3), "=&v"(a0), "=&v"(a1), "=&v"(a2), "=&v"(a3), "=&v"(a4), "=&v"(a5), "=&v"(a6), "=&v"(a7), "=&v"(a8), "=&v"(a9)
        : "v"(ak), "v"(av) : "memory");
    af[0] = TRH(k0, k1); af[1] = TRH(k2, k3); wf[0] = TRH(a0, a1); wf[1] = TRH(a2, a3); wf[2] = TRH(a4, a5); wf[3] = TRH(a6, a7); wf[4] = TRH(a8, a9);
}
__device__ __forceinline__ float wave_scan_sum(float v, int lane) {
    v += dpp_f<0x111>(0.f, v); v += dpp_f<0x112>(0.f, v); v += dpp_f<0x114>(0.f, v); v += dpp_f<0x118>(0.f, v);
    const float r0 = rdlane_f(v, 15), r1 = rdlane_f(v, 31), r2 = rdlane_f(v, 47); const int row = lane >> 4;
    return v + (row == 1 ? r0 : row == 2 ? r0 + r1 : row == 3 ? (r0 + r1) + r2 : 0.f);
}
__device__ __forceinline__ float wave_scan_max(float v, int lane) {
    const float NI = -3.0e38f;
    v = fmaxf(v, dpp_f<0x111>(NI, v)); v = fmaxf(v, dpp_f<0x112>(NI, v)); v = fmaxf(v, dpp_f<0x114>(NI, v)); v = fmaxf(v, dpp_f<0x118>(NI, v));
    const float r0 = rdlane_f(v, 15), r1 = rdlane_f(v, 31), r2 = rdlane_f(v, 47); const int row = lane >> 4;
    return fmaxf(v, row == 1 ? r0 : row == 2 ? fmaxf(r0, r1) : row == 3 ? fmaxf(fmaxf(r0, r1), r2) : NI);
}
__device__ __forceinline__ void scan_a_unit(const Ctx& c, LAS unsigned char* lds, int u, int tid, int lane, int wave) {
    bf16* PJ = (bf16*)(c.ws + WS_PROJ);
    const bf16* Q = PJ + (size_t)P_QA * PSTRIDE; const bf16* LFp = PJ + (size_t)P_LF * PSTRIDE; const bf16* V = PJ + (size_t)P_VA * PSTRIDE; bf16* OA = PJ + (size_t)P_XM * PSTRIDE;
    LAS bf16* LQ = (LAS bf16*)lds;
    LAS bf16* LK = (LAS bf16*)(lds + 17408);
    LAS bf16* LV = (LAS bf16*)(lds + 34816);
    LAS bf16* LP = (LAS bf16*)(lds + 44032);
    LAS bf16* LST = (LAS bf16*)(lds + 53248);
    LAS float* SEG = (LAS float*)(lds + 70656);
    LAS float* ER = (LAS float*)(lds + 74752);
    LAS float* EB = (LAS float*)(lds + 75264);
    LAS float* EK = (LAS float*)(lds + 75776);
    const int ux = u & 7, uk = u >> 3, bh_ = ux * 8 + (uk >> 1), vs = uk & 1, b = bh_ >> 3, h = bh_ & 7;
    const size_t rowbase = (size_t)b * SEQ;
    f32x4 S[4];
#pragma unroll
    for (int j = 0; j < 4; ++j) S[j] = (f32x4){0.f, 0.f, 0.f, 0.f};
    unsigned rq[8], rf[8]; v4u rv;
#define SA_LOAD(ch) do { const int lo_ = opq_v(wave * 8 * D + h * 128 + 2 * lane), lv_ = opq_v((tid >> 3) * D + h * 128 + vs * 64 + (tid & 7) * 8); const size_t cb_ = (rowbase + (size_t)(ch) * 64) * D; \
        const GAS bf16* qp_ = (const GAS bf16*)Q + cb_ + lo_; const GAS bf16* fp_ = (const GAS bf16*)LFp + cb_ + lo_; \
        _Pragma("unroll") for (int i = 0; i < 8; ++i) { rq[i] = *(const GAS unsigned*)(qp_ + (size_t)i * D); rf[i] = *(const GAS unsigned*)(fp_ + (size_t)i * D); } \
        rv = *(const GAS v4u*)((const GAS bf16*)V + cb_ + lv_); } while (0)
    SA_LOAD(0);
    for (int ch = 0; ch < 64; ++ch) {
        float f0[8], f1[8], q0[8], q1[8]; float run0 = 0.f, run1 = 0.f;
#pragma unroll
        for (int i = 0; i < 8; ++i) { const float a0 = bflo(rf[i]), a1 = bfhi(rf[i]); f0[i] = __expf(a0); f1[i] = __expf(a1); run0 += a0; run1 += a1; q0[i] = bflo(rq[i]); q1[i] = bfhi(rq[i]); }
        *(LAS f32x2*)(SEG + wave * 128 + 2 * lane) = (f32x2){run0, run1};
        const v4u rvc = rv;
        if (ch + 1 < 64) SA_LOAD(ch + 1);
        __syncthreads();
        float pre0 = 0.f, pre1 = 0.f, r0 = 0.f, r1 = 0.f, t0_ = 0.f, t1_ = 0.f;
#pragma unroll
        for (int w = 0; w < 8; ++w) { const f32x2 sg = *(const LAS f32x2*)(SEG + w * 128 + 2 * lane); if (w < wave) { pre0 += sg.x; pre1 += sg.y; } if (w < 4) { r0 += sg.x; r1 += sg.y; } t0_ += sg.x; t1_ += sg.y; }
        *(LAS v4u*)(LV + (tid >> 3) * 72 + (tid & 7) * 8) = rvc;
        {   float g0 = __expf(pre0 - r0), g1 = __expf(pre1 - r1), e0 = __expf(r0 - (pre0 + run0)), e1 = __expf(r1 - (pre1 + run1));
            unsigned kq[8];
#pragma unroll
            for (int i = 0; i < 8; ++i) { g0 *= f0[i]; g1 *= f1[i]; *(LAS unsigned*)(LQ + (wave * 8 + i) * 136 + 2 * lane) = pk2(q0[i] * g0, q1[i] * g1); }
#pragma unroll
            for (int i = 7; i >= 0; --i) { kq[i] = pk2((1.0f - f0[i]) * e0, (1.0f - f1[i]) * e1); e0 *= f0[i]; e1 *= f1[i]; }
#pragma unroll
            for (int i = 0; i < 8; ++i) *(LAS unsigned*)(LK + (wave * 8 + i) * 136 + 2 * lane) = kq[i];
        }
        if (wave == 0) { *(LAS f32x2*)(ER + 2 * lane) = (f32x2){__expf(r0), __expf(r1)}; *(LAS f32x2*)(EB + 2 * lane) = (f32x2){__expf(t0_), __expf(t1_)}; *(LAS f32x2*)(EK + 2 * lane) = (f32x2){__expf(t0_ - r0), __expf(t1_ - r1)}; }
        __syncthreads();
        {
            const int tt = wave >> 1;
#pragma unroll
            for (int jj = 0; jj < 2; ++jj) { const int st = (wave & 1) * 2 + jj; f32x4 acc = {0.f, 0.f, 0.f, 0.f};
                if (st <= tt) {
#pragma unroll
                    for (int kk = 0; kk < 4; ++kk) acc = mmT(LQ, 136, tt * 16, LK, 136, st * 16, kk * 32, acc, lane);
                    if (st == tt) {
#pragma unroll
                        for (int e = 0; e < 4; ++e) if (4 * (lane >> 4) + e > (lane & 15)) acc[e] = 0.f; } }
                *(LAS v2u*)(LP + (tt * 16 + (lane & 15)) * 72 + st * 16 + 4 * (lane >> 4)) = pack4(acc); }
            const f32x4 er4 = *(const LAS f32x4*)(ER + wave * 16 + 4 * (lane >> 4));
#pragma unroll
            for (int j = 0; j < 4; ++j) *(LAS v2u*)(LST + (j * 16 + (lane & 15)) * 136 + wave * 16 + 4 * (lane >> 4)) = pack4(S[j] * er4);
        }
        __syncthreads();
        {
            bf16x8 vfr[4][2], kfv[2]; tr_hgrn(LV, LK, wave, lane, vfr, kfv);
            const bf16x8 vf00 = vfr[0][0], vf10 = vfr[1][0], vf20 = vfr[2][0], vf30 = vfr[3][0], vf01 = vfr[0][1], vf11 = vfr[1][1], vf21 = vfr[2][1], vf31 = vfr[3][1];
            struct { bf16x8 a, b; } kfr; kfr.a = kfv[0]; kfr.b = kfv[1];
            const int t0 = (wave >> 1) * 16; const bool hi = (wave & 1) != 0;
            const bf16x8 pf0 = *(const LAS bf16x8*)(LP + (t0 + (lane & 15)) * 72 + 8 * (lane >> 4)), pf1 = *(const LAS bf16x8*)(LP + (t0 + (lane & 15)) * 72 + 32 + 8 * (lane >> 4));
            f32x4 o0 = {0.f, 0.f, 0.f, 0.f}, o1 = o0;
            o0 = MFMA16(hi ? vf20 : vf00, pf0, o0); o0 = MFMA16(hi ? vf21 : vf01, pf1, o0);
            o1 = MFMA16(hi ? vf30 : vf10, pf0, o1); o1 = MFMA16(hi ? vf31 : vf11, pf1, o1);
            const int e0 = hi ? 32 : 0;
#pragma unroll
            for (int kk = 0; kk < 4; ++kk) { const bf16x8 qf = *(const LAS bf16x8*)(LQ + (t0 + (lane & 15)) * 136 + kk * 32 + 8 * (lane >> 4));
                const bf16x8 s0f = *(const LAS bf16x8*)(LST + (e0 + (lane & 15)) * 136 + kk * 32 + 8 * (lane >> 4)), s1f = *(const LAS bf16x8*)(LST + (e0 + 16 + (lane & 15)) * 136 + kk * 32 + 8 * (lane >> 4));
                o0 = MFMA16(s0f, qf, o0); o1 = MFMA16(s1f, qf, o1); }
            GAS bf16* op = (GAS bf16*)OA + (rowbase + (size_t)ch * 64) * D + opq_v((t0 + (lane & 15)) * D + h * 128 + vs * 64 + e0 + 4 * (lane >> 4));
            *(GAS v2u*)op = pack4(o0); *(GAS v2u*)(op + 16) = pack4(o1);
            const f32x4 eb4 = *(const LAS f32x4*)(EB + wave * 16 + 4 * (lane >> 4)), ek4 = *(const LAS f32x4*)(EK + wave * 16 + 4 * (lane >> 4));
            f32x4 up;
            up = (f32x4){0.f, 0.f, 0.f, 0.f}; up = MFMA16(kfr.a, vf00, up); up = MFMA16(kfr.b, vf01, up); S[0] = eb4 * S[0] + ek4 * up;
            up = (f32x4){0.f, 0.f, 0.f, 0.f}; up = MFMA16(kfr.a, vf10, up); up = MFMA16(kfr.b, vf11, up); S[1] = eb4 * S[1] + ek4 * up;
            up = (f32x4){0.f, 0.f, 0.f, 0.f}; up = MFMA16(kfr.a, vf20, up); up = MFMA16(kfr.b, vf21, up); S[2] = eb4 * S[2] + ek4 * up;
            up = (f32x4){0.f, 0.f, 0.f, 0.f}; up = MFMA16(kfr.a, vf30, up); up = MFMA16(kfr.b, vf31, up); S[3] = eb4 * S[3] + ek4 * up;
        }
    }
#undef SA_LOAD
    __syncthreads();
}

__device__ __forceinline__ void tr_v4(const LAS bf16* LVe, int lane, bf16x8 (&vf)[4][2]) {
    const int g = lane >> 4, q = (lane & 15) >> 2, p = lane & 3;
    const unsigned av = (unsigned)(size_t)(LVe + (8 * g + q) * 136 + 4 * p);
    v2u a0, a1, a2, a3, a4, a5, a6, a7, b0, b1, b2, b3, b4, b5, b6, b7;
    asm volatile(
        "ds_read_b64_tr_b16 %0, %16\n\tds_read_b64_tr_b16 %1, %16 offset:1088\n\tds_read_b64_tr_b16 %2, %16 offset:32\n\tds_read_b64_tr_b16 %3, %16 offset:1120\n\t"
        "ds_read_b64_tr_b16 %4, %16 offset:64\n\tds_read_b64_tr_b16 %5, %16 offset:1152\n\tds_read_b64_tr_b16 %6, %16 offset:96\n\tds_read_b64_tr_b16 %7, %16 offset:1184\n\t"
        "ds_read_b64_tr_b16 %8, %16 offset:8704\n\tds_read_b64_tr_b16 %9, %16 offset:9792\n\tds_read_b64_tr_b16 %10, %16 offset:8736\n\tds_read_b64_tr_b16 %11, %16 offset:9824\n\t"
        "ds_read_b64_tr_b16 %12, %16 offset:8768\n\tds_read_b64_tr_b16 %13, %16 offset:9856\n\tds_read_b64_tr_b16 %14, %16 offset:8800\n\tds_read_b64_tr_b16 %15, %16 offset:9888\n\t"
        "s_waitcnt lgkmcnt(0)"
        : "=&v"(a0), "=&v"(a1), "=&v"(a2), "=&v"(a3), "=&v"(a4), "=&v"(a5), "=&v"(a6), "=&v"(a7), "=&v"(b0), "=&v"(b1), "=&v"(b2), "=&v"(b3), "=&v"(b4), "=&v"(b5), "=&v"(b6), "=&v"(b7)
        : "v"(av) : "memory");
    vf[0][0] = TRH(a0, a1); vf[1][0] = TRH(a2, a3); vf[2][0] = TRH(a4, a5); vf[3][0] = TRH(a6, a7);
    vf[0][1] = TRH(b0, b1); vf[1][1] = TRH(b2, b3); vf[2][1] = TRH(b4, b5); vf[3][1] = TRH(b6, b7);
}
__device__ __forceinline__ void tr_k2(const LAS bf16* LK, int wave, int lane, bf16x8 (&kf)[2]) {
    const int g = lane >> 4, q = (lane & 15) >> 2, p = lane & 3;
    const unsigned ak = (unsigned)(size_t)(LK + (8 * g + q) * 136 + 4 * p + wave * 16);
    v2u k0, k1, k2, k3;
    asm volatile("ds_read_b64_tr_b16 %0, %4\n\tds_read_b64_tr_b16 %1, %4 offset:1088\n\tds_read_b64_tr_b16 %2, %4 offset:8704\n\tds_read_b64_tr_b16 %3, %4 offset:9792\n\ts_waitcnt lgkmcnt(0)"
        : "=&v"(k0), "=&v"(k1), "=&v"(k2), "=&v"(k3) : "v"(ak) : "memory");
    kf[0] = TRH(k0, k1); kf[1] = TRH(k2, k3);
}
#ifndef TPROBE
#define TPROBE -1
#endif
#ifndef TPS
#define TPS 0
#endif
#ifndef TPB
#define TPB 0
#endif
#define TS_MARK(UN_, K_) do { if (TPROBE == (UN_) && blockIdx.x == TPB && threadIdx.x == 0) { volatile LAS unsigned* mp_ = (volatile LAS unsigned*)(lds + MISC_OFF); const unsigned now_ = (unsigned)wall_clock64(); if (TPS == (K_)) mp_[16] += now_ - mp_[48]; mp_[48] = now_; } } while (0)
__device__ __forceinline__ void rd_sc12(unsigned aq, unsigned ak, v4u (&q)[4], v4u (&k0)[4], v4u (&k1)[4]) {
    asm volatile(
        "ds_read_b128 %0, %12\n\tds_read_b128 %1, %12 offset:64\n\tds_read_b128 %2, %12 offset:128\n\tds_read_b128 %3, %12 offset:192\n\t"
        "ds_read_b128 %4, %13\n\tds_read_b128 %5, %13 offset:64\n\tds_read_b128 %6, %13 offset:128\n\tds_read_b128 %7, %13 offset:192\n\t"
        "ds_read_b128 %8, %13 offset:4352\n\tds_read_b128 %9, %13 offset:4416\n\tds_read_b128 %10, %13 offset:4480\n\tds_read_b128 %11, %13 offset:4544\n\t"
        "s_waitcnt lgkmcnt(0)"
        : "=&v"(q[0]), "=&v"(q[1]), "=&v"(q[2]), "=&v"(q[3]), "=&v"(k0[0]), "=&v"(k0[1]), "=&v"(k0[2]), "=&v"(k0[3]), "=&v"(k1[0]), "=&v"(k1[1]), "=&v"(k1[2]), "=&v"(k1[3])
        : "v"(aq), "v"(ak) : "memory");
}
__device__ __forceinline__ void rd_qs10(unsigned aq, unsigned as, v4u (&q)[2], v4u (&x)[2][4]) {
    asm volatile(
        "ds_read_b128 %0, %10\n\tds_read_b128 %1, %10 offset:64\n\t"
        "ds_read_b128 %2, %11\n\tds_read_b128 %3, %11 offset:4352\n\tds_read_b128 %4, %11 offset:8704\n\tds_read_b128 %5, %11 offset:13056\n\t"
        "ds_read_b128 %6, %11 offset:64\n\tds_read_b128 %7, %11 offset:4416\n\tds_read_b128 %8, %11 offset:8768\n\tds_read_b128 %9, %11 offset:13120\n\t"
        "s_waitcnt lgkmcnt(0)"
        : "=&v"(q[0]), "=&v"(q[1]), "=&v"(x[0][0]), "=&v"(x[0][1]), "=&v"(x[0][2]), "=&v"(x[0][3]), "=&v"(x[1][0]), "=&v"(x[1][1]), "=&v"(x[1][2]), "=&v"(x[1][3])
        : "v"(aq), "v"(as) : "memory");
}
__device__ __forceinline__ void scan_a_full_unit(const Ctx& c, LAS unsigned char* lds, int u, int l, int tid, int lane, int wave) {
    bf16* PJ = (bf16*)(c.ws + WS_PROJ);
    const bf16* Q = PJ + (size_t)P_QA * PSTRIDE; const bf16* LFp = PJ + (size_t)P_LF * PSTRIDE; const bf16* V = PJ + (size_t)P_VA * PSTRIDE; const bf16* GR = PJ + (size_t)P_GA * PSTRIDE;
    bf16* AO = PJ + (size_t)P_QA * PSTRIDE;
    const float* GN = c.in[I_HGN] + (size_t)l * D;
    LAS bf16* LQ0 = (LAS bf16*)lds;
    LAS bf16* LK0 = (LAS bf16*)(lds + 34816);
    LAS bf16* LV = (LAS bf16*)(lds + 69632);
    LAS bf16* LP = (LAS bf16*)(lds + 87040);
    LAS bf16* LST = (LAS bf16*)(lds + 96256);
    LAS float* SEG = (LAS float*)(lds + 131328);
    LAS float* E0 = (LAS float*)(lds + 135424);
    LAS float* SS = (LAS float*)(lds + 138496);
    LAS float* GNL = (LAS float*)(lds + 139008);
    const int b = u >> 3, h = u & 7;
    const size_t rowbase = (size_t)b * SEQ;
    const int t0 = (wave >> 1) * 16, eh = (wave & 1) * 64;
    f32x4 S[8], po[4]; v2u pg[4];
#pragma unroll
    for (int j = 0; j < 8; ++j) S[j] = (f32x4){0.f, 0.f, 0.f, 0.f};
#pragma unroll
    for (int j = 0; j < 4; ++j) { po[j] = (f32x4){0.f, 0.f, 0.f, 0.f}; pg[j] = (v2u){0u, 0u}; }
    if (tid < 128) GNL[tid] = GN[h * 128 + tid];
    unsigned rq[8], rf[8]; v4u rv0, rv1;
    float f0[8], f1[8], q0[8], q1[8]; float run0 = 0.f, run1 = 0.f;
#define SF_LOADQF(ch) do { const unsigned lo_ = (unsigned)opq_v((wave * 8 * D + h * 128 + 2 * lane) * 2); const size_t cb_ = (rowbase + (size_t)(ch) * 64) * D; \
        const GAS char* qb_ = (const GAS char*)((const GAS bf16*)Q + cb_); const GAS char* fb_ = (const GAS char*)((const GAS bf16*)LFp + cb_);     \
        _Pragma("unroll") for (int i = 0; i < 8; ++i) { rq[i] = *(const GAS unsigned*)(qb_ + (lo_ + (unsigned)(i * D * 2))); rf[i] = *(const GAS unsigned*)(fb_ + (lo_ + (unsigned)(i * D * 2))); } } while (0)
#define SF_LOADV(ch) do { const unsigned lv_ = (unsigned)opq_v(((tid >> 4) * D + h * 128 + (tid & 15) * 8) * 2); const GAS char* vb_ = (const GAS char*)((const GAS bf16*)V + (rowbase + (size_t)(ch) * 64) * D); \
        rv0 = *(const GAS v4u*)(vb_ + lv_); rv1 = *(const GAS v4u*)(vb_ + (lv_ + (unsigned)(32 * D * 2))); } while (0)
#define SF_T() do { run0 = 0.f; run1 = 0.f; \
        _Pragma("unroll") for (int i = 0; i < 8; ++i) { const float a0 = bflo(rf[i]), a1 = bfhi(rf[i]); f0[i] = __builtin_amdgcn_exp2f(a0); f1[i] = __builtin_amdgcn_exp2f(a1); run0 += a0; run1 += a1; q0[i] = bflo(rq[i]); q1[i] = bfhi(rq[i]); } \
        *(LAS f32x2*)(SEG + wave * 128 + 2 * lane) = (f32x2){run0, run1}; } while (0)
#define SF_A(PAR_) do { LAS bf16* LQn_ = LQ0 + (PAR_) * 8704; LAS bf16* LKn_ = LK0 + (PAR_) * 8704; LAS float* En_ = E0 + (PAR_) * 384; \
        float pre0 = 0.f, pre1 = 0.f, r0 = 0.f, r1 = 0.f, t0_ = 0.f, t1_ = 0.f; \
        _Pragma("unroll") for (int w = 0; w < 8; ++w) { const f32x2 sg = *(const LAS f32x2*)(SEG + w * 128 + 2 * lane); if (w < wave) { pre0 += sg.x; pre1 += sg.y; } if (w < 4) { r0 += sg.x; r1 += sg.y; } t0_ += sg.x; t1_ += sg.y; } \
        float g0 = __builtin_amdgcn_exp2f(pre0 - r0), g1 = __builtin_amdgcn_exp2f(pre1 - r1), e0 = __builtin_amdgcn_exp2f(r0 - (pre0 + run0)), e1 = __builtin_amdgcn_exp2f(r1 - (pre1 + run1)); unsigned kq[8]; \
        _Pragma("unroll") for (int i = 0; i < 8; ++i) { g0 *= f0[i]; g1 *= f1[i]; *(LAS unsigned*)(LQn_ + (wave * 8 + i) * 136 + 2 * lane) = pk2(q0[i] * g0, q1[i] * g1); } \
        _Pragma("unroll") for (int i = 7; i >= 0; --i) { kq[i] = pk2((1.0f - f0[i]) * e0, (1.0f - f1[i]) * e1); e0 *= f0[i]; e1 *= f1[i]; } \
        _Pragma("unroll") for (int i = 0; i < 8; ++i) *(LAS unsigned*)(LKn_ + (wave * 8 + i) * 136 + 2 * lane) = kq[i]; \
        if (wave == 0) { *(LAS f32x2*)(En_ + 2 * lane) = (f32x2){__builtin_amdgcn_exp2f(r0), __builtin_amdgcn_exp2f(r1)}; *(LAS f32x2*)(En_ + 128 + 2 * lane) = (f32x2){__builtin_amdgcn_exp2f(t0_), __builtin_amdgcn_exp2f(t1_)}; *(LAS f32x2*)(En_ + 256 + 2 * lane) = (f32x2){__builtin_amdgcn_exp2f(t0_ - r0), __builtin_amdgcn_exp2f(t1_ - r1)}; } } while (0)
#define SF_FINAL(cp) do { const int lr_ = opq_v(lane & 15), lg_ = opq_v(lane >> 4); const f32x2 s2_ = *(const LAS f32x2*)(SS + 2 * (t0 + lr_)); \
        const float rs_ = rsqrtf((s2_.x + s2_.y) * (1.0f / 128.0f) + EPS); \
        _Pragma("unroll") for (int jj = 0; jj < 4; ++jj) { const int col_ = h * 128 + eh + 16 * jj + 4 * lg_; const f32x4 gn_ = *(const LAS f32x4*)(GNL + eh + 16 * jj + 4 * lg_); \
            const f32x4 gr_ = {bflo(pg[jj].x), bfhi(pg[jj].x), bflo(pg[jj].y), bfhi(pg[jj].y)}; f32x4 a_; \
            _Pragma("unroll") for (int e = 0; e < 4; ++e) a_[e] = po[jj][e] * rs_ * gn_[e] * gr_[e]; \
            *(GAS v2u*)((GAS char*)((GAS bf16*)AO + (rowbase + (size_t)(cp) * 64) * D) + (unsigned)(((t0 + lr_) * D + col_) * 2)) = pack4(a_); } } while (0)
    SF_LOADQF(0); SF_LOADV(0);
    SF_T(); SF_LOADQF(1);
    __syncthreads();
    SF_A(0);
    __syncthreads();
    for (int ch = 0; ch < 64; ++ch) {
        const int par = ch & 1;
        const LAS bf16* LQ = LQ0 + par * 8704; const LAS bf16* LK = LK0 + par * 8704; const LAS float* EC = E0 + par * 384;
        {
            const int tt = wave >> 1; f32x4 acc0 = {0.f, 0.f, 0.f, 0.f}, acc1 = acc0;
            if ((wave & 1) * 2 <= tt) {
                v4u qa[4], ka[4], kb[4];
                rd_sc12((unsigned)(size_t)(LQ + (tt * 16 + (lane & 15)) * 136 + 8 * (lane >> 4)), (unsigned)(size_t)(LK + ((wave & 1) * 32 + (lane & 15)) * 136 + 8 * (lane >> 4)), qa, ka, kb);
#pragma unroll
                for (int kk = 0; kk < 4; ++kk) { acc0 = MFMA16(__builtin_bit_cast(bf16x8, ka[kk]), __builtin_bit_cast(bf16x8, qa[kk]), acc0); acc1 = MFMA16(__builtin_bit_cast(bf16x8, kb[kk]), __builtin_bit_cast(bf16x8, qa[kk]), acc1); }
            }
#pragma unroll
            for (int jj = 0; jj < 2; ++jj) { const int st = (wave & 1) * 2 + jj; f32x4 acc = jj ? acc1 : acc0;
                if (st > tt) acc = (f32x4){0.f, 0.f, 0.f, 0.f};
                if (st == tt) {
#pragma unroll
                    for (int e = 0; e < 4; ++e) if (4 * (lane >> 4) + e > (lane & 15)) acc[e] = 0.f; }
                *(LAS v2u*)(LP + (tt * 16 + (lane & 15)) * 72 + st * 16 + 4 * (lane >> 4)) = pack4(acc); }
            const f32x4 er4 = *(const LAS f32x4*)(EC + wave * 16 + 4 * (lane >> 4));
#pragma unroll
            for (int j = 0; j < 8; ++j) *(LAS v2u*)(LST + (j * 16 + (lane & 15)) * 136 + wave * 16 + 4 * (lane >> 4)) = pack4(S[j] * er4);
        }
        __builtin_amdgcn_sched_barrier(0);
        if (ch > 0) SF_FINAL(ch - 1);
        __builtin_amdgcn_sched_barrier(0);
        { const GAS char* gb_ = (const GAS char*)((const GAS bf16*)GR + (rowbase + (size_t)ch * 64) * D); const unsigned go_ = (unsigned)opq_v(((t0 + (lane & 15)) * D + h * 128 + eh + 4 * (lane >> 4)) * 2);
#pragma unroll
          for (int jj = 0; jj < 4; ++jj) pg[jj] = *(const GAS v2u*)(gb_ + (go_ + (unsigned)(32 * jj))); }
        SF_T(); __builtin_amdgcn_sched_barrier(0);
        { const int c2 = (ch + 2 < 64) ? ch + 2 : 63; SF_LOADQF(c2); }
        __builtin_amdgcn_sched_barrier(0);
        *(LAS v4u*)(LV + (tid >> 4) * 136 + (tid & 15) * 8) = rv0; *(LAS v4u*)(LV + (32 + (tid >> 4)) * 136 + (tid & 15) * 8) = rv1;
        __syncthreads();
        TS_MARK(22, 0);
        { const int c1 = (ch + 1 < 64) ? ch + 1 : 63; SF_LOADV(c1); }
        {
            bf16x8 kf[2]; tr_k2(LK, wave, lane, kf);
            const f32x4 eb4 = *(const LAS f32x4*)(EC + 128 + wave * 16 + 4 * (lane >> 4)), ek4 = *(const LAS f32x4*)(EC + 256 + wave * 16 + 4 * (lane >> 4));
            const bf16x8 pf0 = *(const LAS bf16x8*)(LP + (t0 + (lane & 15)) * 72 + 8 * (lane >> 4)), pf1 = *(const LAS bf16x8*)(LP + (t0 + (lane & 15)) * 72 + 32 + 8 * (lane >> 4));
#pragma unroll
            for (int jj = 0; jj < 4; ++jj) po[jj] = (f32x4){0.f, 0.f, 0.f, 0.f};
#pragma unroll
            for (int hb = 0; hb < 2; ++hb) {
                bf16x8 vf[4][2]; tr_v4(LV + hb * 64, lane, vf);
                if (hb == (wave & 1)) {
#pragma unroll
                    for (int jj = 0; jj < 4; ++jj) { po[jj] = MFMA16(vf[jj][0], pf0, po[jj]); po[jj] = MFMA16(vf[jj][1], pf1, po[jj]); }
                }
#pragma unroll
                for (int jj = 0; jj < 4; ++jj) { f32x4 up = {0.f, 0.f, 0.f, 0.f}; up = MFMA16(kf[0], vf[jj][0], up); up = MFMA16(kf[1], vf[jj][1], up); S[hb * 4 + jj] = eb4 * S[hb * 4 + jj] + ek4 * up; }
            }
#pragma unroll
            for (int k2 = 0; k2 < 2; ++k2) { v4u qf[2], sf[2][4];
                rd_qs10((unsigned)(size_t)(LQ + (t0 + (lane & 15)) * 136 + k2 * 64 + 8 * (lane >> 4)), (unsigned)(size_t)(LST + (eh + (lane & 15)) * 136 + k2 * 64 + 8 * (lane >> 4)), qf, sf);
#pragma unroll
                for (int kk = 0; kk < 2; ++kk)
#pragma unroll
                    for (int jj = 0; jj < 4; ++jj) po[jj] = MFMA16(__builtin_bit_cast(bf16x8, sf[kk][jj]), __builtin_bit_cast(bf16x8, qf[kk]), po[jj]); }
            float ssq = 0.f;
#pragma unroll
            for (int jj = 0; jj < 4; ++jj) ssq += (po[jj][0] * po[jj][0] + po[jj][1] * po[jj][1]) + (po[jj][2] * po[jj][2] + po[jj][3] * po[jj][3]);
            ssq += __shfl_xor(ssq, 16); ssq += __shfl_xor(ssq, 32);
            if (lane < 16) SS[2 * (t0 + lane) + (wave & 1)] = ssq;
        }
        __builtin_amdgcn_sched_barrier(0);
        SF_A(par ^ 1);
        __syncthreads();
        TS_MARK(22, 1);
    }
    SF_FINAL(63);
#undef SF_LOADQF
#undef SF_LOADV
#undef SF_T
#undef SF_A
#undef SF_FINAL
    __syncthreads();
}

__device__ __forceinline__ void scan_m_unit(const Ctx& c, LAS unsigned char* lds, int u, int tid, int lane, int wave) {
    const bf16* MQ = (const bf16*)(c.ws + WS_MQ); const bf16* MK = (const bf16*)(c.ws + WS_MK); const bf16* MV = (const bf16*)(c.ws + WS_MV); bf16* HM = (bf16*)(c.ws + WS_H);
    const GAS float* LI = (const GAS float*)(c.ws + WS_LI); const GAS float* LF = (const GAS float*)(c.ws + WS_LF);
    LAS bf16* LK = (LAS bf16*)lds;
    LAS bf16* LV0 = (LAS bf16*)(lds + 33792);
    LAS bf16* LV1 = (LAS bf16*)(lds + 45056);
    LAS bf16* LP = (LAS bf16*)(lds + 56320);
    LAS bf16* LCT = (LAS bf16*)(lds + 65536);
    LAS float* AS = (LAS float*)(lds + 107776);
    LAS float* MXS = (LAS float*)(lds + 108032);
    LAS float* BS = (LAS float*)(lds + 108288);
    const int ux = u & 7, uk = u >> 3, bh_ = ux * 4 + (uk >> 2), vs = uk & 3, b = bh_ >> 2, h = bh_ & 3;
    const size_t rowbase = (size_t)b * SEQ;
    const int t0 = (wave >> 1) * 16;
    f32x4 C[2][5];
#pragma unroll
    for (int i = 0; i < 2; ++i)
#pragma unroll
        for (int j = 0; j < 5; ++j) C[i][j] = (f32x4){0.f, 0.f, 0.f, 0.f};
    float m = 0.f;
    for (int i = tid; i < 64 * 24; i += NTHR) { const int row = i / 24, col = 64 + i % 24; LV0[row * 88 + col] = (bf16)(col == 64 ? 0x3f80u : 0u); LV1[row * 88 + col] = (bf16)0u; }
    v4u qf[8], rk[4], rv; float rli, rlf;
#define SM_LOAD(ch) do { const int lk_ = opq_v((tid >> 5) * D + h * 256 + (tid & 31) * 8), lv_ = opq_v((tid >> 3) * D + h * 256 + vs * 64 + (tid & 7) * 8), lg_ = opq_v(lane * 4 + h); \
        const GAS bf16* kp_ = (const GAS bf16*)MK + (rowbase + (size_t)(ch) * 64) * D + lk_; \
        _Pragma("unroll") for (int k2 = 0; k2 < 4; ++k2) rk[k2] = *(const GAS v4u*)(kp_ + (size_t)k2 * 16 * D); \
        rv = *(const GAS v4u*)((const GAS bf16*)MV + (rowbase + (size_t)(ch) * 64) * D + lv_); \
        rli = LI[(rowbase + (size_t)(ch) * 64) * 4 + lg_]; rlf = LF[(rowbase + (size_t)(ch) * 64) * 4 + lg_]; } while (0)
#define SM_LOADQ(ch) do { const int lq_ = opq_v((t0 + (lane & 15)) * D + h * 256 + 8 * (lane >> 4)); const GAS bf16* qp_ = (const GAS bf16*)MQ + (rowbase + (size_t)(ch) * 64) * D + lq_; \
        _Pragma("unroll") for (int kk = 0; kk < 8; ++kk) qf[kk] = *(const GAS v4u*)(qp_ + kk * 32); } while (0)
    SM_LOAD(0); SM_LOADQ(0);
    float nbb = wave_scan_sum(rlf, lane), naa = rli - nbb, npm = wave_scan_max(naa, lane);
    for (int ch = 0; ch < 64; ++ch) {
        const int lane0 = lane; const int lane = opq_v(lane0), tid = opq_v((wave << 6) | lane0);
        const int lr = lane & 15, lq4 = lane >> 4, bK = lr * 264 + 8 * lq4, bC = lr * 264 + 4 * lq4, bP8 = lr * 72 + 8 * lq4, bP4 = lr * 72 + 4 * lq4;
        __syncthreads();
        TS_MARK(21, 0);
        const float bb = nbb, aa = naa, pm = npm;
        const float mx = fmaxf(m, pm);
        const float b63 = rdlane_f(bb, 63), mx63 = rdlane_f(mx, 63);
        if (wave == 0) { AS[lane] = aa; MXS[lane] = mx; BS[lane] = bb; LV1[lane * 88 + 64] = (bf16)f2bf(__expf(aa - mx63)); }
        { const int p = tid; *(LAS v4u*)(LK + (p >> 5) * 264 + (p & 31) * 8) = rk[0]; *(LAS v4u*)(LK + ((p + 512) >> 5) * 264 + (p & 31) * 8) = rk[1]; *(LAS v4u*)(LK + ((p + 1024) >> 5) * 264 + (p & 31) * 8) = rk[2]; *(LAS v4u*)(LK + ((p + 1536) >> 5) * 264 + (p & 31) * 8) = rk[3]; }
        { const int rr = tid >> 3; const float wv = __expf(__shfl(aa, rr) - mx63); const v4u rvc = rv;
          *(LAS v4u*)(LV0 + rr * 88 + (tid & 7) * 8) = rvc;
          v4u sv; sv.x = pk2(bflo(rvc.x) * wv, bfhi(rvc.x) * wv); sv.y = pk2(bflo(rvc.y) * wv, bfhi(rvc.y) * wv); sv.z = pk2(bflo(rvc.z) * wv, bfhi(rvc.z) * wv); sv.w = pk2(bflo(rvc.w) * wv, bfhi(rvc.w) * wv);
          *(LAS v4u*)(LV1 + rr * 88 + (tid & 7) * 8) = sv; }
        const float m_old = m;
        if (ch + 1 < 64) SM_LOAD(ch + 1);
        __syncthreads();
        TS_MARK(21, 1);
        {
            const int tt = wave >> 1;
#pragma unroll
            for (int jj = 0; jj < 2; ++jj) { const int st = (wave & 1) * 2 + jj; f32x4 acc = {0.f, 0.f, 0.f, 0.f};
                if (st <= tt) {
#pragma unroll
                    for (int kk = 0; kk < 8; ++kk) { const bf16x8 kfr = *(const LAS bf16x8*)(LK + bK + st * (16 * 264) + kk * 32); acc = MFMA16(kfr, __builtin_bit_cast(bf16x8, qf[kk]), acc); if ((kk & 3) == 3) __builtin_amdgcn_sched_barrier(0); }
                    const f32x4 a4 = *(const LAS f32x4*)(AS + st * 16 + 4 * lq4); const float mxt = MXS[tt * 16 + lr];
#pragma unroll
                    for (int e = 0; e < 4; ++e) acc[e] = (st == tt && 4 * lq4 + e > lr) ? 0.f : acc[e] * __expf(a4[e] - mxt); }
                *(LAS v2u*)(LP + bP4 + tt * (16 * 72) + st * 16) = pack4(acc); }
#pragma unroll
            for (int i = 0; i < 2; ++i)
#pragma unroll
                for (int j = 0; j < 5; ++j) *(LAS v2u*)(LCT + bC + j * (16 * 264) + (wave * 2 + i) * 16) = pack4(C[i][j]);
        }
        __syncthreads();
        TS_MARK(21, 2);
        {
            const int e0 = (wave & 1) * 32; f32x4 p0 = {0.f, 0.f, 0.f, 0.f}, p1 = p0, pd = p0, c0 = p0, c1 = p0, cd = p0;
            { bf16x8 vn[3][2]; tr_mnum(LV0, e0, lane, vn);
#pragma unroll
              for (int kk = 0; kk < 2; ++kk) { const bf16x8 pf = *(const LAS bf16x8*)(LP + bP8 + t0 * 72 + kk * 32);
                p0 = MFMA16(vn[0][kk], pf, p0); p1 = MFMA16(vn[1][kk], pf, p1); pd = MFMA16(vn[2][kk], pf, pd); } }
#pragma unroll
            for (int kk = 0; kk < 8; ++kk) { const bf16x8 q8 = __builtin_bit_cast(bf16x8, qf[kk]);
                const LAS bf16* xb_ = LCT + bK + e0 * 264 + kk * 32; const bf16x8 x0 = *(const LAS bf16x8*)xb_, x1 = *(const LAS bf16x8*)(xb_ + 16 * 264), xd = *(const LAS bf16x8*)(LCT + bK + 64 * 264 + kk * 32);
                c0 = MFMA16(x0, q8, c0); c1 = MFMA16(x1, q8, c1); cd = MFMA16(xd, q8, cd); if (kk & 1) __builtin_amdgcn_sched_barrier(0); }
            const float mxt = MXS[t0 + lr], bt = BS[t0 + lr], wi = __expf(m_old - mxt);
            const float den = __shfl(pd[0] + wi * cd[0], lr);
            const float inv = 1.0f / fmaxf(fabsf(den), __expf(-(bt + mxt)));
            GAS bf16* hp = (GAS bf16*)HM + (rowbase + (size_t)ch * 64) * D + opq_v((t0 + (lane & 15)) * D + h * 256 + vs * 64 + e0 + 4 * (lane >> 4));
            *(GAS v2u*)hp = pack4((p0 + c0 * wi) * inv); *(GAS v2u*)(hp + 16) = pack4((p1 + c1 * wi) * inv);
            const float dec = __expf(m_old - mx63);
#pragma unroll
            for (int i = 0; i < 2; ++i)
#pragma unroll
                for (int j = 0; j < 5; ++j) C[i][j] = C[i][j] * dec;
            { bf16x8 af[2], wf[5];
              tr_mupd<0>(LK, LV1, wave, lane, af, wf);
#pragma unroll
              for (int j = 0; j < 5; ++j) { C[0][j] = MFMA16(af[0], wf[j], C[0][j]); C[1][j] = MFMA16(af[1], wf[j], C[1][j]); }
              tr_mupd<1>(LK, LV1, wave, lane, af, wf);
#pragma unroll
              for (int j = 0; j < 5; ++j) { C[0][j] = MFMA16(af[0], wf[j], C[0][j]); C[1][j] = MFMA16(af[1], wf[j], C[1][j]); } }
            m = b63 + mx63;
            if (ch + 1 < 64) SM_LOADQ(ch + 1);
            nbb = wave_scan_sum(rlf, lane); naa = rli - nbb; npm = wave_scan_max(naa, lane);
        }
    }
#undef SM_LOAD
#undef SM_LOADQ
    __syncthreads();
}
#ifndef DLY_A
#define DLY_A 0
#define DLY_M 0
#define DLY_C 0
#endif
__device__ __forceinline__ void ph_scans(const Ctx& c, LAS unsigned char* lds, int l) {
    const int tid = TID(), lane = tid & 63, wave = __builtin_amdgcn_readfirstlane(tid >> 6);
    for (int u = BID(); u < 256; u += gridDim.x) {
#if DLY_A || DLY_M || DLY_C
        { const int dl = (u < 64) ? DLY_A : (u < 192) ? DLY_M : DLY_C; for (int i = 0; i < dl; ++i) { __builtin_amdgcn_s_sleep(127); asm volatile("" ::: "memory"); } }
#endif
        if (u < 64) scan_a_full_unit(c, lds, u, l, tid, lane, wave);
        else if (u < 192) scan_m_unit(c, lds, u - 64, tid, lane, wave);
        else { if (l + 1 < DEPTH) { ph_cvt(c, l + 1, lds, u - 192, 64, 2, 1); __syncthreads(); } }
    }
}
constexpr int TAB_OFF = MISC_OFF + 256, UT_OFF = MISC_OFF + 512;
__device__ __forceinline__ void moe_tables(const Ctx& c, int jm, LAS unsigned char* lds) {
    LAS int* tab = (LAS int*)(lds + TAB_OFF);
    __syncthreads();
    const int t = TID();
    if (t < 64) {
        unsigned* cnt = (unsigned*)c.ws + CW_CNT + 64 * jm;
        const int n = (t < 8) ? (int)__hip_atomic_load(cnt + t, __ATOMIC_RELAXED, __HIP_MEMORY_SCOPE_AGENT) : 0;
        const int p = (n + 255) >> 8; int accp = 0, mine = 0;
#pragma unroll
        for (int e = 0; e < 8; ++e) { const int pe_ = __builtin_amdgcn_readlane(p, e); if (t == e) mine = accp; accp += pe_; }
        if (t < 8) { tab[t] = p; tab[8 + t] = mine; }
        if (t == 0) tab[16] = accp;
    }
    __syncthreads();
}
__device__ __forceinline__ void ph_res1(const Ctx& c, int l, LAS unsigned char* lds, int dry = 0) {
    const int tid = TID(), lane = tid & 63, wave = tid >> 6, gw = BID() * NWAVES + wave, NGW = gridDim.x * NWAVES;
    const bool moe = (l & 1) != 0; const int jm = l >> 1;
    LAS f32x4* rt = (LAS f32x4*)lds;
    if (moe) { const GAS f32x4* src = (const GAS f32x4*)(c.in[I_ROUTER] + (size_t)jm * D * NEXP); for (int i = tid; i < D * NEXP / 4; i += NTHR) { const int ch = i >> 1; rt[((ch & 3) * 2 + (i & 1)) * 256 + (ch >> 2)] = src[i]; } }
    __syncthreads();
    const float* xin = c.in[I_X]; bf16* XB = (bf16*)(c.ws + WS_XB);
    const bf16* Y = (const bf16*)(c.ws + WS_PROJ) + (size_t)P_OS * PSTRIDE; bf16* H = (bf16*)(c.ws + WS_H);
    unsigned* cnt = (unsigned*)c.ws + CW_CNT + 64 * jm;
    int* TOKEP = (int*)(c.ws + WS_TOKEP); float* TOKW = (float*)(c.ws + WS_TOKW);
    for (int slot = gw; slot < M / 16; slot += NGW) {
        const int row0 = slot * 16, b = row0 / SEQ;
        f32x4 gpm[4], gt[4], gpf[4], scf[4], shf[4];
        ld_row_f32(c.in[I_GPOSTMIX] + (size_t)l * D, lane, gpm); ld_row_f32(modp(c, l, b, 2), lane, gt); ld_row_f32(c.in[I_GPREFFN] + (size_t)l * D, lane, gpf);
        ld_row_f32(modp(c, l, b, 4), lane, scf); ld_row_f32(modp(c, l, b, 3), lane, shf);
        int my1 = 0, my2 = 0; float myw = 0.f;
        v2u ya[4], yb[4]; f32x4 xa[4], xb[4];
#define R1_LOAD(YR, XR, ro_) do { _Pragma("unroll") for (int j = 0; j < 4; ++j) { YR[j] = *(const GAS v2u*)(Y + (ro_) + 4 * lane + 256 * j); if (l == 0) XR[j] = *(const GAS f32x4*)(xin + (ro_) + 4 * lane + 256 * j); else { const v2u w_ = *(const GAS v2u*)(XB + (ro_) + 4 * lane + 256 * j); XR[j] = (f32x4){bflo(w_.x), bfhi(w_.x), bflo(w_.y), bfhi(w_.y)}; } } } while (0)
        R1_LOAD(ya, xa, (size_t)row0 * D);
        for (int r = 0; r < 16; ++r) {
            const int row = row0 + r; const size_t ro = (size_t)row * D;
            if (r + 1 < 16) R1_LOAD(yb, xb, ro + D);
            f32x4 y[4], x[4], h[4];
#pragma unroll
            for (int j = 0; j < 4; ++j) { y[j] = (f32x4){bflo(ya[j].x), bfhi(ya[j].x), bflo(ya[j].y), bfhi(ya[j].y)}; x[j] = xa[j]; ya[j] = yb[j]; xa[j] = xb[j]; }
            const float rr = rsqrtf(row_sumsq(y) * (1.0f / 1024.0f) + EPS);
#pragma unroll
            for (int j = 0; j < 4; ++j) x[j] = x[j] + gt[j] * (y[j] * rr * gpm[j]);
            if (!dry) st_row_bf16(XB + ro, lane, x);
            norm_mod(x, gpf, scf, shf, h); if (!dry) st_row_bf16(H + ro, lane, h);
            if (moe) {
                f32x4 l0 = {0.f, 0.f, 0.f, 0.f}, l1 = l0;
#pragma unroll
                for (int j = 0; j < 4; ++j)
#pragma unroll
                    for (int i = 0; i < 4; ++i) { const int n = lane + 64 * j; l0 += rt[(i * 2) * 256 + n] * h[j][i]; l1 += rt[(i * 2 + 1) * 256 + n] * h[j][i]; }
                float lg[8];
#pragma unroll
                for (int e = 0; e < 4; ++e) { lg[e] = wave_sum(l0[e]); lg[4 + e] = wave_sum(l1[e]); }
                int i1 = 0; float v1 = lg[0];
#pragma unroll
                for (int e = 1; e < 8; ++e) if (lg[e] > v1) { v1 = lg[e]; i1 = e; }
                int i2 = -1; float v2 = -3.0e38f;
#pragma unroll
                for (int e = 0; e < 8; ++e) if (e != i1 && lg[e] > v2) { v2 = lg[e]; i2 = e; }
                if (lane == r) { my1 = i1; my2 = i2; myw = 1.0f / (1.0f + __expf(v2 - v1)); }
            }
        }
        if (moe && !dry) {
            const bool act = lane < 16; const unsigned long long below = (1ull << lane) - 1ull;
            int p1 = 0, p2 = 0;
            unsigned long long m1[8], m2[8]; int cn = 0;
#pragma unroll
            for (int e = 0; e < 8; ++e) { m1[e] = __ballot(act && my1 == e); m2[e] = __ballot(act && my2 == e); if (lane == e) cn = __popcll(m1[e]) + __popcll(m2[e]); }
            int basev = 0; if (lane < 8 && cn > 0) basev = (int)atomicAdd(cnt + lane, (unsigned)cn);
#pragma unroll
            for (int e = 0; e < 8; ++e) { const int be = __builtin_amdgcn_readlane(basev, e);
                if (my1 == e) p1 = be + __popcll(m1[e] & below);
                if (my2 == e) p2 = be + __popcll(m1[e]) + __popcll(m2[e] & below); }
            if (act) { *(GAS i32x4*)(TOKEP + (size_t)(row0 + lane) * 4) = (i32x4){my1, p1, my2, p2}; *(GAS f32x2*)(TOKW + (size_t)(row0 + lane) * 2) = (f32x2){myw, 1.0f - myw}; }
        }
    }
}
__device__ __forceinline__ void ph_gather(const Ctx& c, int l, LAS unsigned char* lds) {
    const int tid = TID(), lane = tid & 63, wave = tid >> 6, gw = BID() * NWAVES + wave, NGW = gridDim.x * NWAVES;
    moe_tables(c, l >> 1, lds); const LAS int* tab = (const LAS int*)(lds + TAB_OFF);
    const bf16* H = (const bf16*)(c.ws + WS_H); bf16* AG = (bf16*)(c.ws + WS_AG);
    const int* TOKEP = (const int*)(c.ws + WS_TOKEP); int* TOKD = (int*)(c.ws + WS_TOKD);
    for (int row0 = gw; row0 < M; row0 += 4 * NGW) {
        i32x4 ep[4]; v4u ra[4], rb[4];
#pragma unroll
        for (int k = 0; k < 4; ++k) { const int row = (row0 + k * NGW < M) ? row0 + k * NGW : row0; ep[k] = *(const GAS i32x4*)(TOKEP + (size_t)row * 4);
            ra[k] = *(const GAS v4u*)(H + (size_t)row * D + lane * 8); rb[k] = *(const GAS v4u*)(H + (size_t)row * D + 512 + lane * 8); }
#pragma unroll
        for (int k = 0; k < 4; ++k) { const int row = row0 + k * NGW; if (row >= M) continue;
            const int d1 = tab[8 + ep[k].x] * 256 + ep[k].y, d2 = tab[8 + ep[k].z] * 256 + ep[k].w;
            *(GAS v4u*)(AG + (size_t)d1 * D + lane * 8) = ra[k]; *(GAS v4u*)(AG + (size_t)d1 * D + 512 + lane * 8) = rb[k];
            *(GAS v4u*)(AG + (size_t)d2 * D + lane * 8) = ra[k]; *(GAS v4u*)(AG + (size_t)d2 * D + 512 + lane * 8) = rb[k];
            if (lane == 0) *(GAS i32x2*)(TOKD + (size_t)row * 2) = (i32x2){d1, d2}; }
    }
}
__device__ __forceinline__ void ph_res2(const Ctx& c, int l, int dry = 0) {
    const int tid = TID(), lane = tid & 63, wave = tid >> 6, gw = BID() * NWAVES + wave, NGW = gridDim.x * NWAVES;
    const bool moe = (l & 1) != 0;
    const bf16* Y2 = (const bf16*)(c.ws + WS_PROJ) + (size_t)4 * PSTRIDE; const bf16* YS = (const bf16*)(c.ws + WS_YS); bf16* H = (bf16*)(c.ws + WS_H); bf16* XB = (bf16*)(c.ws + WS_XB);
    const int* TOKD = (const int*)(c.ws + WS_TOKD); const float* TOKW = (const float*)(c.ws + WS_TOKW);
    const int ln = (l + 1 < DEPTH) ? l + 1 : l;
    for (int slot = gw; slot < M / 16; slot += NGW) {
        const int row0 = slot * 16, b = row0 / SEQ;
        f32x4 gpo[4], gt[4], gpm[4], scm[4], shm[4];
        ld_row_f32(c.in[I_GPOSTFFN] + (size_t)l * D, lane, gpo); ld_row_f32(modp(c, l, b, 5), lane, gt); ld_row_f32(c.in[I_GPREMIX] + (size_t)ln * D, lane, gpm);
        ld_row_f32(modp(c, ln, b, 1), lane, scm); ld_row_f32(modp(c, ln, b, 0), lane, shm);
        v2u ya[4], yb[4], za[4], zb[4]; f32x4 xa[4], xb[4]; f32x2 wa = {1.f, 0.f}, wb = wa;
#define R2_LOAD(YR, ZR, XR, WR, row_) do { const size_t ro_ = (size_t)(row_) * D; \
            if (moe) { const i32x2 d_ = *(const GAS i32x2*)(TOKD + (size_t)(row_) * 2); WR = *(const GAS f32x2*)(TOKW + (size_t)(row_) * 2); \
                _Pragma("unroll") for (int j = 0; j < 4; ++j) { YR[j] = *(const GAS v2u*)(YS + (size_t)d_.x * D + 4 * lane + 256 * j); ZR[j] = *(const GAS v2u*)(YS + (size_t)d_.y * D + 4 * lane + 256 * j); } } \
            else { _Pragma("unroll") for (int j = 0; j < 4; ++j) { YR[j] = *(const GAS v2u*)(Y2 + ro_ + 4 * lane + 256 * j); ZR[j] = (v2u){0u, 0u}; } } \
            _Pragma("unroll") for (int j = 0; j < 4; ++j) { const v2u w_ = *(const GAS v2u*)(XB + ro_ + 4 * lane + 256 * j); XR[j] = (f32x4){bflo(w_.x), bfhi(w_.x), bflo(w_.y), bfhi(w_.y)}; } } while (0)
        R2_LOAD(ya, za, xa, wa, row0);
        for (int r = 0; r < 16; ++r) {
            const int row = row0 + r; const size_t ro = (size_t)row * D;
            if (r + 1 < 16) R2_LOAD(yb, zb, xb, wb, row + 1);
            f32x4 y[4], x[4], h[4];
#pragma unroll
            for (int j = 0; j < 4; ++j) { const f32x4 p = {bflo(ya[j].x), bfhi(ya[j].x), bflo(ya[j].y), bfhi(ya[j].y)}, q = {bflo(za[j].x), bfhi(za[j].x), bflo(za[j].y), bfhi(za[j].y)};
                y[j] = p * wa.x + q * wa.y; x[j] = xa[j]; ya[j] = yb[j]; za[j] = zb[j]; xa[j] = xb[j]; }
            wa = wb;
            const float rr = rsqrtf(row_sumsq(y) * (1.0f / 1024.0f) + EPS);
#pragma unroll
            for (int j = 0; j < 4; ++j) { x[j] = x[j] + gt[j] * (y[j] * rr * gpo[j]); if (!dry && l + 1 == DEPTH) *(GAS f32x4*)(c.out + ro + 4 * lane + 256 * j) = x[j]; }
            if (!dry && l + 1 < DEPTH) st_row_bf16(XB + ro, lane, x);
            if (l + 1 < DEPTH) { norm_mod(x, gpm, scm, shm, h); if (!dry) st_row_bf16(H + ro, lane, h); }
        }
    }
}

constexpr int PH_PER_LAYER = 12, NPH = 2 + DEPTH * PH_PER_LAYER;
__global__ void __launch_bounds__(NTHR, 2) fwd(Ctx c) {
    extern __shared__ __attribute__((aligned(16))) unsigned char lds_raw[];
    LAS unsigned char* lds = (LAS unsigned char*)lds_raw;
    volatile LAS unsigned* MISC = (volatile LAS unsigned*)(lds + MISC_OFF);
    if (threadIdx.x < 64) MISC[threadIdx.x] = 0u;
    __syncthreads();
    const int lo = c.ph_lo, hi = c.ph_hi, G = gridDim.x;
    XcdBarrier bar; bar.bar = (unsigned*)c.ws + CW_BAR; bar.x = 0; bar.st = MISC + 8;
    if (hi - lo > 1) bar = xcd_barrier_post((unsigned*)c.ws + CW_BAR, MISC + 8);
#ifndef PH_MASK
#define PH_MASK 0xFFFF
#endif
#define IN(p) (lo <= (p) && (p) < hi)
#define ON(k) ((PH_MASK >> (k)) & 1)
#ifndef REPMASK
#define REPMASK 0
#endif
#define REP(k) for (int rep_ = 0; rep_ < (((REPMASK >> (k)) & 1) ? opq_s(2) : 1); ++rep_)
#ifndef TPROBE
#define TPROBE -1
#endif
#ifndef TPL
#define TPL -1
#define TPMUL 1
#endif
    int tp_layer = -1;
#ifndef TPB
#define TPB 0
#endif
#define TP_SEL(ty) (TPROBE == (ty) && blockIdx.x == TPB && threadIdx.x == 0 && (TPL < 0 || tp_layer == TPL))
#define TPU_BEGIN() do { if (TP_SEL(20)) MISC[48] = (unsigned)wall_clock64(); } while (0)
#define TPU_END() do { if (TP_SEL(20)) MISC[16] += (unsigned)wall_clock64() - MISC[48]; } while (0)
#define TP_BEGIN(ty) do { if (TP_SEL(ty)) MISC[48] = (unsigned)wall_clock64(); } while (0)
#define BAR_AFTER(p, ty) do { if ((p) + 1 < hi) xcd_barrier(bar); if (TP_SEL(ty)) MISC[16] += (unsigned)wall_clock64() - MISC[48]; } while (0)
    if (ON(12) && IN(0)) { TP_BEGIN(12); ph_mod(c, lds); ph_lb(c); ph_uz(c); REP(14) ph_cvt(c, 0, lds, BID(), (int)gridDim.x, 2); BAR_AFTER(0, 12); }
    if (ON(13) && IN(1)) { TP_BEGIN(13); ph_norm0(c); BAR_AFTER(1, 13); }
    for (int l = 0; l < DEPTH; ++l) {
        const int base = 2 + l * PH_PER_LAYER; const bool moe = (l & 1) != 0; tp_layer = l;
        Ctx cl = c; cl.ws = opq_p(c.ws); cl.out = (float*)opq_p((unsigned char*)c.out);
        unsigned char* ws = cl.ws; bf16* PJ = (bf16*)(ws + WS_PROJ); const int bid = BID();
        int KD = opq_s(D);
        if (ON(0) && IN(base + 0)) { TP_BEGIN(0);
            pg8::Gemm g{(const bf16*)(ws + WS_H), (const bf16*)(ws + WS_WIN), M, DIN, KD}; pg8::UOrder S; S.init(0, M, DIN, G, bid);
            pg8::EpiWin E{PJ, (const float*)(ws + WS_LB) + l * 1024, PSTRIDE};
            REP(0) { pg8::TOrder T; T.build(S, (LAS int*)(lds + UT_OFF)); pg8::gemm_phase<pg8::EpiWin, pg8::TOrder, true, true>(lds, g, T, E); }
            BAR_AFTER(base + 0, 0); }
        if (ON(1) && IN(base + 1)) { TP_BEGIN(1); REP(1) ph_prep(cl, l, lds); BAR_AFTER(base + 1, 1); }
        if (ON(2) && IN(base + 2)) { TP_BEGIN(2); TPU_BEGIN(); REP(2) ph_scans(cl, lds, l); TPU_END(); BAR_AFTER(base + 2, 2); }
        if (ON(4) && IN(base + 4)) { TP_BEGIN(4); REP(4) ph_post(cl, l); BAR_AFTER(base + 4, 4); }
        if (ON(5) && IN(base + 5)) { TP_BEGIN(5);
            pg8::Gemm g{PJ + (size_t)P_QA * PSTRIDE, (const bf16*)(ws + WS_WAB + (size_t)(l & 1) * WAB_STEP), M, D, KD}; pg8::UOrder S; S.init(1, M, D, G, bid);
            pg8::EpiProj E{PJ + (size_t)P_GTA * PSTRIDE, PSTRIDE, PJ + (size_t)P_GA * PSTRIDE, PJ + (size_t)P_VA * PSTRIDE};
            REP(5) { pg8::TOrder T; T.build(S, (LAS int*)(lds + UT_OFF)); pg8::gemm_phase<pg8::EpiProj, pg8::TOrder, true, true>(lds, g, T, E); }
            BAR_AFTER(base + 5, 5); }
        if (ON(6) && IN(base + 6)) { TP_BEGIN(6);
            pg8::Gemm g{PJ + (size_t)P_VA * PSTRIDE, (const bf16*)(ws + WS_WO + (size_t)(l & 1) * WO_STEP), M, D, KD}; pg8::UOrder S; S.init(0, M, D, G, bid);
            pg8::EpiPlain E{PJ + (size_t)P_OS * PSTRIDE, D};
            REP(6) { pg8::TOrder T; T.build(S, (LAS int*)(lds + UT_OFF)); pg8::gemm_phase<pg8::EpiPlain, pg8::TOrder, true, true>(lds, g, T, E); }
            BAR_AFTER(base + 6, 6); }
        if (ON(7) && IN(base + 7)) { TP_BEGIN(7); if ((REPMASK >> 7) & 1) ph_res1(cl, l, lds, opq_s(1)); ph_res1(cl, l, lds); BAR_AFTER(base + 7, 7); }
        if (ON(8) && IN(base + 8) && moe) { TP_BEGIN(8); ph_gather(cl, l, lds); BAR_AFTER(base + 8, 8); }
        if (ON(9) && IN(base + 9)) { TP_BEGIN(9);
            pg8::Gemm g{(const bf16*)(ws + (moe ? WS_AG : WS_H)), (const bf16*)(ws + (moe ? WS_WFM : WS_WFD)), M, 2 * DFF, KD}; pg8::UOrder S; S.init(0, M, 2 * DFF, G, bid);
            pg8::EpiSwi E{PJ, moe ? DFE : DFF, moe ? 28 : 22};
            if (moe) { moe_tables(cl, l >> 1, lds); S.mode = 2; S.NT = 28; S.tab = (const LAS int*)(lds + TAB_OFF); S.nwg = __builtin_amdgcn_readfirstlane(S.tab[16]) * 28; }
            REP(9) { pg8::TOrder T; T.build(S, (LAS int*)(lds + UT_OFF)); pg8::gemm_phase<pg8::EpiSwi, pg8::TOrder, true, true>(lds, g, T, E); }
            BAR_AFTER(base + 9, 9); }
        if (ON(10) && IN(base + 10)) { TP_BEGIN(10);
            pg8::Gemm g{PJ, (const bf16*)(ws + (moe ? WS_WFM + WF_W2_MOE : WS_WFD + WF_W2_DENSE)), M, D, moe ? DFE : DFF}; pg8::UOrder S; S.init(0, M, D, G, bid);
            pg8::EpiPlain E{moe ? (bf16*)(ws + WS_YS) : PJ + (size_t)4 * PSTRIDE, D};
            if (moe) { moe_tables(cl, l >> 1, lds); S.mode = 2; S.NT = 4; S.tab = (const LAS int*)(lds + TAB_OFF); S.nwg = __builtin_amdgcn_readfirstlane(S.tab[16]) * 4; }
            REP(10) { pg8::TOrder T; T.build(S, (LAS int*)(lds + UT_OFF)); pg8::gemm_phase<pg8::EpiPlain, pg8::TOrder, true, true>(lds, g, T, E); }
            BAR_AFTER(base + 10, 10); }
        if (ON(11) && IN(base + 11)) { TP_BEGIN(11); if ((REPMASK >> 11) & 1) ph_res2(cl, l, opq_s(1)); ph_res2(cl, l);  BAR_AFTER(base + 11, 11); }
    }
    if (TPROBE >= 0) { __syncthreads(); if (blockIdx.x == TPB && threadIdx.x == 0) { const unsigned tt = MISC[16] * (unsigned)TPMUL; const unsigned s0 = (unsigned)wall_clock64(); while ((unsigned)wall_clock64() - s0 < tt) __builtin_amdgcn_s_sleep(8); } }
#undef IN
#undef BAR_AFTER
}

#ifndef MK_ONE_LAUNCH
#define MK_ONE_LAUNCH 1
#endif
extern "C" void kernel_launch(void* const* d_in, const int* in_sizes, int n_in, void* d_out, int out_size, void* d_ws, size_t ws_size, hipStream_t stream) {
    static int grid = 0;
    if (grid == 0) {
        if (n_in != 32 || in_sizes[0] != M * D || out_size != M * D || ws_size < WS_END) { fprintf(stderr, "kernel_launch: unexpected shapes / workspace (%d inputs, ws %zu < %zu)\n", n_in, ws_size, (size_t)WS_END); grid = -1; return; }
        int dev = 0, cus = 0;
        if (hipGetDevice(&dev) != hipSuccess || hipDeviceGetAttribute(&cus, hipDeviceAttributeMultiprocessorCount, dev) != hipSuccess) { grid = -1; return; }
        if (hipFuncSetAttribute((const void*)fwd, hipFuncAttributeMaxDynamicSharedMemorySize, LDS_BYTES) != hipSuccess) { fprintf(stderr, "kernel_launch: hipFuncSetAttribute failed\n"); grid = -1; return; }
        (void)hipGetLastError();
        grid = cus;
    }
    if (grid < 0) return;
    if (hipMemsetAsync((char*)d_ws + WS_CTL, 0, CTL_ZERO_BYTES, stream) != hipSuccess) return;
    Ctx c{};
    for (int i = 0; i < 32; ++i) c.in[i] = (const float*)d_in[i];
    c.out = (float*)d_out; c.ws = (unsigned char*)d_ws;
#if MK_ONE_LAUNCH
    c.ph_lo = 0; c.ph_hi = NPH;
    hipLaunchKernelGGL(fwd, dim3(grid), dim3(NTHR), LDS_BYTES, stream, c);
#else
    for (int p = 0; p < NPH; ++p) {
        if (p >= 2) { const int l = (p - 2) / PH_PER_LAYER, k = (p - 2) % PH_PER_LAYER; if (k == 8 && !(l & 1)) continue; }
        c.ph_lo = p; c.ph_hi = p + 1;
        hipLaunchKernelGGL(fwd, dim3(grid), dim3(NTHR), LDS_BYTES, stream, c);
    }
#endif
}
```

```cpp
#include <hip/hip_runtime.h>
#include <cstdio>
#include <cstdint>
#ifndef TPROBE
#define TPROBE -1
#endif
namespace pg8 {
#define PG8_LAS __attribute__((address_space(3)))
typedef unsigned short bf16_t;
typedef short bf16x8 __attribute__((ext_vector_type(8)));
typedef float f32x4 __attribute__((ext_vector_type(4)));
typedef unsigned u32x4 __attribute__((ext_vector_type(4)));
constexpr int BM = 256, BK = 64, HALF = 128, HTB = HALF * BK * 2  , STAGE_BYTES = 8 * HTB, NXCD = 8, WGM = 4;

__host__ __device__ __forceinline__ int lds_byte(int r, int c) { const int st = (r >> 4) * 2 + (c >> 5), rr = r & 15, cc = c & 31, ob = rr * 64 + cc * 2; return st * 1024 + (ob ^ (((ob >> 9) & 1) << 5)); }
__host__ __device__ __forceinline__ void stage_rc(int b, int& R, int& C) { const int st = b / 1024, sb = b % 1024, swz = sb ^ (((sb >> 9) & 1) << 5); R = (st >> 1) * 16 + swz / 64; C = (st & 1) * 32 + (swz % 64) / 2; }
__host__ __device__ __forceinline__ int perm32(int rho) { const int n = rho >> 4, i = rho & 15; return 8 * (i >> 2) + 4 * n + (i & 3); }

struct Unit { int pm, pn; };
struct Gemm { const bf16_t* A; const bf16_t* Bt; int M, N, K; };

struct StaticOrder {
    int nM, nN, nwg, G, c;
    __host__ __device__ void init(int M, int N, int G_, int c_) { nM = M / BM; nN = N / BM; nwg = nM * nN; G = G_; c = c_; }
    __host__ __device__ bool next(int i, Unit& u) const {
        const long L = (long)i * G + c; if (L >= nwg) return false;
        int wgid = (int)L; { const int q = nwg / NXCD, r = nwg % NXCD, xcd = wgid % NXCD, off = wgid / NXCD; wgid = (xcd < r ? xcd * (q + 1) : r * (q + 1) + (xcd - r) * q) + off; }
        const int nig = WGM * nN, gid = wgid / nig, fm = gid * WGM, gsz = (nM - fm) < WGM ? (nM - fm) : WGM;
        u.pm = fm + ((wgid % nig) % gsz); u.pn = (wgid % nig) / gsz; return true;
    }
    __device__ __forceinline__ void a_ready(const Unit&) const {}
    __device__ __forceinline__ void done(const Unit&) const {}
};
typedef float f32x2c __attribute__((ext_vector_type(2)));
typedef __bf16 bf16x2c __attribute__((ext_vector_type(2)));
__device__ __forceinline__ unsigned cvt_pk_bf16(float lo, float hi) { const f32x2c v = {lo, hi}; return __builtin_bit_cast(unsigned, __builtin_convertvector(v, bf16x2c)); }
#define PG8_GAS __attribute__((address_space(1)))
struct UOrder {
    int mode, nM, nN, nwg, G, c, NT; const PG8_LAS int* tab;
    __device__ __forceinline__ void init(int mode_, int M, int N, int G_, int c_) { mode = mode_; nM = M / BM; nN = N / BM; nwg = nM * nN; G = G_; c = c_; NT = 1; tab = nullptr; }
    __device__ __forceinline__ bool next_raw(int i, Unit& u) const {
        const int which = (mode == 1) ? (i & 1) : 0; const int ii = (mode == 1) ? (i >> 1) : i;
        const long L = (long)ii * G + c; if (L >= nwg) return false;
        int wgid = (int)L; { const int q = nwg / NXCD, r = nwg % NXCD, xcd = wgid % NXCD, off = wgid / NXCD; wgid = (xcd < r ? xcd * (q + 1) : r * (q + 1) + (xcd - r) * q) + off; }
        if (mode == 2) {
            int r = wgid, E = 0;
#pragma unroll
            for (int k = 0; k < 7; ++k) { const int uk = tab[k] * NT; if (E == k && r >= uk) { r -= uk; E = k + 1; } }
            const int P = tab[E], B = tab[8 + E];
            const int nig = WGM * NT, gid = r / nig, fm = gid * WGM, gsz = (P - fm) < WGM ? (P - fm) : WGM, rr = r - gid * nig;
            u.pm = B + fm + rr % gsz; u.pn = E * NT + rr / gsz; return true;
        }
        const int nig = WGM * nN, gid = wgid / nig, fm = gid * WGM, gsz = (nM - fm) < WGM ? (nM - fm) : WGM;
        u.pm = fm + ((wgid % nig) % gsz); u.pn = (wgid % nig) / gsz;
        if (nN == 32) u.pn = (u.pn + 4 * (gid & 7)) & 31;
        if (which) { u.pm += nM; u.pn += nN; }
        return true;
    }
    __device__ __forceinline__ void a_ready(const Unit&) const {}
    __device__ __forceinline__ void done(const Unit&) const {}
};
struct TOrder {
    const PG8_LAS int* ut; int n;
    __device__ __forceinline__ void build(const UOrder& S, PG8_LAS int* tabl) {
        const int t = threadIdx.x;
        if (t == 0) tabl[512] = 0;
        __syncthreads();
        if (t < 256) { Unit u; u.pm = 0; u.pn = 0; if (S.next_raw(t, u)) { tabl[2 * t] = u.pm; tabl[2 * t + 1] = u.pn; __hip_atomic_fetch_max(tabl + 512, t + 1, __ATOMIC_RELAXED, __HIP_MEMORY_SCOPE_WORKGROUP); } }
        __syncthreads();
        ut = tabl; n = __builtin_amdgcn_readfirstlane(tabl[512]);
    }
    __device__ __forceinline__ bool next(int i, Unit& u) const { if (i >= n) return false; u.pm = __builtin_amdgcn_readfirstlane(ut[2 * i]); u.pn = __builtin_amdgcn_readfirstlane(ut[2 * i + 1]); return true; }
    __device__ __forceinline__ void a_ready(const Unit&) const {}
    __device__ __forceinline__ void done(const Unit&) const {}
};

__device__ __forceinline__ float fsig(float v) { return __builtin_amdgcn_rcpf(1.0f + __expf(-v)); }
__device__ __forceinline__ float bflo(unsigned w) { return __uint_as_float(w << 16); }
__device__ __forceinline__ float bfhi(unsigned w) { return __uint_as_float(w & 0xffff0000u); }
#define PG8_X8(x, ai, bj, m) float x[8]; { const f32x4 _a = acc[ai][bj][m][0], _b = acc[ai][bj][m][1]; x[0] = _a[0]; x[1] = _a[1]; x[2] = _a[2]; x[3] = _a[3]; x[4] = _b[0]; x[5] = _b[1]; x[6] = _b[2]; x[7] = _b[3]; }
#define PG8_PACK8(w, x) u32x4 w; w.x = cvt_pk_bf16(x[0], x[1]); w.y = cvt_pk_bf16(x[2], x[3]); w.z = cvt_pk_bf16(x[4], x[5]); w.w = cvt_pk_bf16(x[6], x[7]);

struct EpiWin {
    static constexpr bool PERM = true, AFTER_DRAIN = false, CHAIN = false; static constexpr int NST = 16;
    bf16_t* P; const float* lb; size_t pstride;
    __device__ __forceinline__ void operator()(const f32x4 (&acc)[2][2][4][2], const Unit& u, int wr, int wc, int fr, int fq) const {
        if (u.pn >= 24) {
            const int row0 = u.pm * BM + wr * 64 + fr, cg = (u.pn - 24) * HALF + wc * 32 + 8 * fq;
#pragma unroll
            for (int ai = 0; ai < 2; ++ai)
#pragma unroll
                for (int m = 0; m < 4; ++m) { const size_t off = (size_t)(row0 + ai * HALF + m * 16) * 1024 + cg; float xa[8], xb[8]; { const f32x4 a0 = acc[ai][0][m][0], a1 = acc[ai][0][m][1], b0 = acc[ai][1][m][0], b1 = acc[ai][1][m][1];
#pragma unroll
                      for (int j = 0; j < 4; ++j) { xa[j] = a0[j]; xa[4 + j] = a1[j]; xb[j] = b0[j]; xb[4 + j] = b1[j]; } }
#pragma unroll
                    for (int j = 0; j < 8; ++j) { const float sb = fmaxf(fsig(xb[j]), 1.0e-30f); xa[j] = fsig(xa[j]) * __builtin_amdgcn_rcpf(sb); xb[j] = sb; }
                    u32x4 wq, wg; wq[0] = cvt_pk_bf16(xa[0], xa[1]); wq[1] = cvt_pk_bf16(xa[2], xa[3]); wq[2] = cvt_pk_bf16(xa[4], xa[5]); wq[3] = cvt_pk_bf16(xa[6], xa[7]);
                    wg[0] = cvt_pk_bf16(xb[0], xb[1]); wg[1] = cvt_pk_bf16(xb[2], xb[3]); wg[2] = cvt_pk_bf16(xb[4], xb[5]); wg[3] = cvt_pk_bf16(xb[6], xb[7]);
                    *(PG8_GAS u32x4*)(P + 6 * pstride + off) = wq; *(PG8_GAS u32x4*)(P + 7 * pstride + off) = wg; }
            return;
        }
        const int part = u.pn >> 2;
        const int mode = (part == 0 || part == 3) ? 1 : (part == 1) ? 3 : (part >= 6) ? 2 : 0;
        bf16_t* base = P + (size_t)part * pstride;
        const int row0 = u.pm * BM + wr * 64 + fr, col0 = (u.pn & 3) * BM + wc * 32 + 8 * fq;
        float lbv[2][8];
#pragma unroll
        for (int bj = 0; bj < 2; ++bj)
#pragma unroll
            for (int j = 0; j < 8; ++j) lbv[bj][j] = 0.f;
        if (mode == 3) {
#pragma unroll
            for (int bj = 0; bj < 2; ++bj) { const f32x4 a = *(const PG8_GAS f32x4*)(lb + col0 + bj * HALF), b = *(const PG8_GAS f32x4*)(lb + col0 + bj * HALF + 4);
                lbv[bj][0] = a[0]; lbv[bj][1] = a[1]; lbv[bj][2] = a[2]; lbv[bj][3] = a[3]; lbv[bj][4] = b[0]; lbv[bj][5] = b[1]; lbv[bj][6] = b[2]; lbv[bj][7] = b[3]; }
        }
#pragma unroll
        for (int ai = 0; ai < 2; ++ai)
#pragma unroll
            for (int m = 0; m < 4; ++m) { bf16_t* rowp = base + (size_t)(row0 + ai * HALF + m * 16) * 1024 + col0;
#pragma unroll
                for (int bj = 0; bj < 2; ++bj) { PG8_X8(x, ai, bj, m)
                    if (mode == 1) {
#pragma unroll
                        for (int j = 0; j < 8; ++j) x[j] = x[j] * fsig(x[j]);
                    } else if (mode == 2) {
#pragma unroll
                        for (int j = 0; j < 8; ++j) x[j] = fsig(x[j]);
                    } else if (mode == 3) {
#pragma unroll
                        for (int j = 0; j < 8; ++j) x[j] = fmaxf(__builtin_amdgcn_logf(lbv[bj][j] + (1.0f - lbv[bj][j]) * fsig(x[j])), -43.28f);
                    }
                    PG8_PACK8(w, x) *(PG8_GAS u32x4*)(rowp + bj * HALF) = w; } }
    }
};
struct EpiProj {
    static constexpr bool PERM = true, AFTER_DRAIN = false, CHAIN = true; static constexpr int NST = 0;
    const bf16_t* gates; size_t pstride; bf16_t* T1; bf16_t* MX;
    __device__ __forceinline__ void operator()(const f32x4 (&acc)[2][2][4][2], const Unit& u, int wr, int wc, int fr, int fq) const {
        const int which = u.pn >> 2;
        const bf16_t* g = gates + (size_t)which * pstride;
        const int row0 = (u.pm & 127) * BM + wr * 64 + fr, col0 = (u.pn & 3) * BM + wc * 32 + 8 * fq;
#define PG8_PROJ_OFF(ai, m, bj) ((size_t)(row0 + (ai) * HALF + (m) * 16) * 1024 + col0 + (bj) * HALF)
#define PG8_PROJ_GATE(x, gq) do { x[0] *= bflo(gq.x); x[1] *= bfhi(gq.x); x[2] *= bflo(gq.y); x[3] *= bfhi(gq.y); x[4] *= bflo(gq.z); x[5] *= bfhi(gq.z); x[6] *= bflo(gq.w); x[7] *= bfhi(gq.w); } while (0)
        if (which == 0) {
#pragma unroll
            for (int ai = 0; ai < 2; ++ai) {
                u32x4 gv[4][2];
#pragma unroll
                for (int m = 0; m < 4; ++m)
#pragma unroll
                    for (int bj = 0; bj < 2; ++bj) gv[m][bj] = *(const PG8_GAS u32x4*)(g + PG8_PROJ_OFF(ai, m, bj));
                __builtin_amdgcn_sched_barrier(0);
#pragma unroll
                for (int m = 0; m < 4; ++m)
#pragma unroll
                    for (int bj = 0; bj < 2; ++bj) { PG8_X8(x, ai, bj, m) const u32x4 gq = gv[m][bj]; PG8_PROJ_GATE(x, gq); PG8_PACK8(w, x) *(PG8_GAS u32x4*)(T1 + PG8_PROJ_OFF(ai, m, bj)) = w; }
                __builtin_amdgcn_sched_barrier(0);
            }
        } else {
#pragma unroll
            for (int ai = 0; ai < 2; ++ai)
#pragma unroll
                for (int mh = 0; mh < 2; ++mh) {
                    u32x4 gv[2][2], tv[2][2];
#pragma unroll
                    for (int m = 0; m < 2; ++m)
#pragma unroll
                        for (int bj = 0; bj < 2; ++bj) { gv[m][bj] = *(const PG8_GAS u32x4*)(g + PG8_PROJ_OFF(ai, 2 * mh + m, bj)); tv[m][bj] = *(const PG8_GAS u32x4*)(T1 + PG8_PROJ_OFF(ai, 2 * mh + m, bj)); }
                    __builtin_amdgcn_sched_barrier(0);
#pragma unroll
                    for (int m = 0; m < 2; ++m)
#pragma unroll
                        for (int bj = 0; bj < 2; ++bj) { PG8_X8(x, ai, bj, 2 * mh + m) const u32x4 gq = gv[m][bj], t = tv[m][bj]; PG8_PROJ_GATE(x, gq);
                            x[0] += bflo(t.x); x[1] += bfhi(t.x); x[2] += bflo(t.y); x[3] += bfhi(t.y); x[4] += bflo(t.z); x[5] += bfhi(t.z); x[6] += bflo(t.w); x[7] += bfhi(t.w);
                            PG8_PACK8(w, x) *(PG8_GAS u32x4*)(MX + PG8_PROJ_OFF(ai, 2 * mh + m, bj)) = w; }
                    __builtin_amdgcn_sched_barrier(0);
                }
        }
#undef PG8_PROJ_OFF
#undef PG8_PROJ_GATE
    }

    __device__ __forceinline__ bool chain(f32x4 (&acc)[2][2][4][2], const Unit& u, int wr, int wc, int fr, int fq) const {
        const int which = u.pn >> 2;
        const int row0 = (u.pm & 127) * BM + wr * 64 + fr, col0 = (u.pn & 3) * BM + wc * 32 + 8 * fq;
#define PG8_PROJ_OFF(ai, m, bj) ((size_t)(row0 + (ai) * HALF + (m) * 16) * 1024 + col0 + (bj) * HALF)
        if (which == 0) {
            const bf16_t* gr = gates;
#pragma unroll
            for (int ai = 0; ai < 2; ++ai) {
                u32x4 rv[4][2];
#pragma unroll
                for (int m = 0; m < 4; ++m)
#pragma unroll
                    for (int bj = 0; bj < 2; ++bj) rv[m][bj] = *(const PG8_GAS u32x4*)(gr + PG8_PROJ_OFF(ai, m, bj));
                __builtin_amdgcn_sched_barrier(0);
#pragma unroll
                for (int m = 0; m < 4; ++m)
#pragma unroll
                    for (int bj = 0; bj < 2; ++bj) { const u32x4 a = rv[m][bj]; f32x4 lo = acc[ai][bj][m][0], hi = acc[ai][bj][m][1];
                        lo[0] *= bflo(a.x); lo[1] *= bfhi(a.x); lo[2] *= bflo(a.y); lo[3] *= bfhi(a.y); hi[0] *= bflo(a.z); hi[1] *= bfhi(a.z); hi[2] *= bflo(a.w); hi[3] *= bfhi(a.w);
                        acc[ai][bj][m][0] = lo; acc[ai][bj][m][1] = hi; }
                __builtin_amdgcn_sched_barrier(0);
            }
            return true;
        }
        const bf16_t* g = gates + pstride;
#pragma unroll
        for (int ai = 0; ai < 2; ++ai) {
            u32x4 gv[4][2];
#pragma unroll
            for (int m = 0; m < 4; ++m)
#pragma unroll
                for (int bj = 0; bj < 2; ++bj) gv[m][bj] = *(const PG8_GAS u32x4*)(g + PG8_PROJ_OFF(ai, m, bj));
            __builtin_amdgcn_sched_barrier(0);
#pragma unroll
            for (int m = 0; m < 4; ++m)
#pragma unroll
                for (int bj = 0; bj < 2; ++bj) { PG8_X8(x, ai, bj, m) const u32x4 gq = gv[m][bj];
                    x[0] *= bflo(gq.x); x[1] *= bfhi(gq.x); x[2] *= bflo(gq.y); x[3] *= bfhi(gq.y); x[4] *= bflo(gq.z); x[5] *= bfhi(gq.z); x[6] *= bflo(gq.w); x[7] *= bfhi(gq.w);
                    PG8_PACK8(w, x) *(PG8_GAS u32x4*)(MX + PG8_PROJ_OFF(ai, m, bj)) = w; }
            __builtin_amdgcn_sched_barrier(0);
        }
#undef PG8_PROJ_OFF
        return false;
    }
};
struct EpiSwi {
    static constexpr bool PERM = true, AFTER_DRAIN = false, CHAIN = false; static constexpr int NST = 8;
    bf16_t* Gm; int ldg, NT;
    __device__ __forceinline__ void operator()(const f32x4 (&acc)[2][2][4][2], const Unit& u, int wr, int wc, int fr, int fq) const {
        const int pnl = u.pn - (u.pn / NT) * NT;
        const int row0 = u.pm * BM + wr * 64 + fr, col0 = pnl * HALF + wc * 32 + 8 * fq;
#pragma unroll
        for (int ai = 0; ai < 2; ++ai)
#pragma unroll
            for (int m = 0; m < 4; ++m) { bf16_t* rowp = Gm + (size_t)(row0 + ai * HALF + m * 16) * ldg + col0;
                PG8_X8(x, ai, 0, m) PG8_X8(y, ai, 1, m)
#pragma unroll
                for (int j = 0; j < 8; ++j) x[j] = x[j] * fsig(x[j]) * y[j];
                PG8_PACK8(w, x) *(PG8_GAS u32x4*)rowp = w; }
    }
};
struct EpiPlain {
    static constexpr bool PERM = true, AFTER_DRAIN = false, CHAIN = false; static constexpr int NST = 16;
    bf16_t* O; int ldc;
    __device__ __forceinline__ void operator()(const f32x4 (&acc)[2][2][4][2], const Unit& u, int wr, int wc, int fr, int fq) const {
        const int row0 = u.pm * BM + wr * 64 + fr, col0 = (u.pn & 3) * BM + wc * 32 + 8 * fq;
#pragma unroll
        for (int ai = 0; ai < 2; ++ai)
#pragma unroll
            for (int m = 0; m < 4; ++m) { bf16_t* rowp = O + (size_t)(row0 + ai * HALF + m * 16) * ldc + col0;
#pragma unroll
                for (int bj = 0; bj < 2; ++bj) { PG8_X8(x, ai, bj, m) PG8_PACK8(w, x) *(PG8_GAS u32x4*)(rowp + bj * HALF) = w; } }
    }
};
template <class Epi, class Sched, bool ALIGN_EPI = false, bool SP2 = false>
__device__ __forceinline__ void gemm_phase(PG8_LAS unsigned char* lds, const Gemm g, const Sched& S, const Epi& E) {
    int tid_ = threadIdx.x; asm volatile("" : "+v"(tid_));
    const int tid = tid_, wid = __builtin_amdgcn_readfirstlane(tid >> 6), lane = tid & 63, wr = wid >> 2, wc = wid & 3, fr = lane & 15, fq = lane >> 4;
    const int K = g.K, nt = K / BK;
    unsigned voffA[2], voffB[2];
#pragma unroll
    for (int i = 0; i < 2; ++i) { int R, C; stage_rc(tid * 16 + i * 8192, R, C); const int Rb = Epi::PERM ? ((R & ~31) + perm32(R & 31)) : R;
        voffA[i] = (unsigned)(R * K + C) * 2u; voffB[i] = (unsigned)(Rb * K + C) * 2u; }
    const size_t kstep = (size_t)(BK * 2);
    const size_t hstep = (size_t)HALF * K * 2;
    const size_t tstep = 2 * hstep;
    const unsigned ldsw = (unsigned)wid * 1024u;
    const int aoff = lds_byte(wr * 64 + fr, fq * 8), boff = lds_byte(wc * 32 + fr, fq * 8);
#define PG8_SA(b, h) (((b) * 2 + (h)) * HTB)
#define PG8_SB(b, h) ((4 + (b) * 2 + (h)) * HTB)
#define PG8_STAGE(bufoff, gbase, voff) do { _Pragma("unroll") for (int _i = 0; _i < 2; ++_i) \
        __builtin_amdgcn_global_load_lds((const unsigned*)((const char*)(gbase) + (voff)[_i]), (PG8_LAS unsigned*)(lds + (bufoff) + ldsw + _i * 8192), 16, 0, 0); } while (0)
#define PG8_LDA(dst, b, h) do { _Pragma("unroll") for (int m = 0; m < 4; ++m) _Pragma("unroll") for (int k = 0; k < 2; ++k) dst[m][k] = *(const PG8_LAS bf16x8*)(lds + PG8_SA(b, h) + aoff + m * 2048 + k * 1024); } while (0)
#define PG8_LDB(dst, b, h) do { _Pragma("unroll") for (int n = 0; n < 2; ++n) _Pragma("unroll") for (int k = 0; k < 2; ++k) dst[n][k] = *(const PG8_LAS bf16x8*)(lds + PG8_SB(b, h) + boff + n * 2048 + k * 1024); } while (0)
#define PG8_MMA(ai, bj, At, Bt) do { __builtin_amdgcn_s_setprio(1); _Pragma("unroll") for (int m = 0; m < 4; ++m) _Pragma("unroll") for (int n = 0; n < 2; ++n) _Pragma("unroll") for (int k = 0; k < 2; ++k) \
        acc[ai][bj][m][n] = __builtin_amdgcn_mfma_f32_16x16x32_bf16(Bt[n][k], At[m][k], acc[ai][bj][m][n], 0, 0, 0); __builtin_amdgcn_s_setprio(0); } while (0)
#define PG8_WAIT_V(n) asm volatile("s_waitcnt vmcnt(" #n ")" ::: "memory")
#define PG8_WAIT_L(n) asm volatile("s_waitcnt lgkmcnt(" #n ")" ::: "memory")
#define PG8_BAR __builtin_amdgcn_s_barrier()
#define PG8_SCHED __builtin_amdgcn_sched_barrier(0)
    Unit cur, nxt; int ui = 0;
    if (!S.next(0, cur)) return;
    f32x4 acc[2][2][4][2];
#pragma unroll
    for (int a = 0; a < 2; ++a)
#pragma unroll
        for (int b = 0; b < 2; ++b)
#pragma unroll
            for (int m = 0; m < 4; ++m)
#pragma unroll
                for (int n = 0; n < 2; ++n) acc[a][b][m][n] = (f32x4){0.f, 0.f, 0.f, 0.f};
    bf16x8 At[4][2], B0[2][2], B1[2][2];
    const char* cA = (const char*)g.A + (size_t)cur.pm * tstep; const char* cB = (const char*)g.Bt + (size_t)cur.pn * tstep;
    S.a_ready(cur);
    if constexpr (SP2) {
        PG8_STAGE(PG8_SB(0, 0), cB, voffB); PG8_STAGE(PG8_SB(0, 1), cB + hstep, voffB); PG8_STAGE(PG8_SA(0, 0), cA, voffA); PG8_STAGE(PG8_SA(0, 1), cA + hstep, voffA);
        if (wr == 1) PG8_BAR;
        PG8_WAIT_V(2); PG8_BAR;
        PG8_STAGE(PG8_SB(1, 0), cB + kstep, voffB); PG8_STAGE(PG8_SA(1, 0), cA + kstep, voffA); PG8_STAGE(PG8_SB(1, 1), cB + hstep + kstep, voffB);
        PG8_WAIT_V(6); PG8_BAR;
    } else {
        PG8_STAGE(PG8_SB(0, 0), cB, voffB); PG8_STAGE(PG8_SA(0, 0), cA, voffA); PG8_STAGE(PG8_SB(0, 1), cB + hstep, voffB); PG8_STAGE(PG8_SA(0, 1), cA + hstep, voffA);
        if (wr == 1) PG8_BAR;
        PG8_WAIT_V(4); PG8_BAR;
        PG8_STAGE(PG8_SB(1, 0), cB + kstep, voffB); PG8_STAGE(PG8_SA(1, 0), cA + kstep, voffA); PG8_STAGE(PG8_SB(1, 1), cB + hstep + kstep, voffB);
        PG8_WAIT_V(6); PG8_BAR;
    }
    for (;;) {
        const bool has_next = S.next(ui + 1, nxt);
        const char* nA = has_next ? (const char*)g.A + (size_t)nxt.pm * tstep : cA; const char* nB = has_next ? (const char*)g.Bt + (size_t)nxt.pn * tstep : cB;
        for (int t = 0; t < nt; t += 2) {
            const bool last = (t == nt - 2);
            const char* a1 = cA + (size_t)(t + 1) * kstep;
            const char* a2 = last ? nA : cA + (size_t)(t + 2) * kstep; const char* b2 = last ? nB : cB + (size_t)(t + 2) * kstep;
            const char* a3 = a2 + kstep; const char* b3 = b2 + kstep;
            if (last && has_next) S.a_ready(nxt);
            if constexpr (SP2) {
            PG8_LDB(B0, 0, 0); PG8_LDB(B1, 0, 1); PG8_SCHED; PG8_LDA(At, 0, 0); PG8_STAGE(PG8_SA(1, 1), a1 + hstep, voffA);
            PG8_WAIT_V(8); PG8_WAIT_L(0); PG8_BAR; PG8_MMA(0, 0, At, B0); PG8_MMA(0, 1, At, B1); PG8_BAR; PG8_SCHED;
            PG8_LDA(At, 0, 1); PG8_STAGE(PG8_SB(0, 0), b2, voffB); PG8_STAGE(PG8_SB(0, 1), b2 + hstep, voffB); PG8_STAGE(PG8_SA(0, 0), a2, voffA);
            PG8_WAIT_V(8); PG8_WAIT_L(0); PG8_BAR; PG8_MMA(1, 0, At, B0); PG8_MMA(1, 1, At, B1); PG8_BAR; PG8_SCHED;
            PG8_LDB(B0, 1, 0); PG8_LDB(B1, 1, 1); PG8_SCHED; PG8_LDA(At, 1, 0); PG8_STAGE(PG8_SA(0, 1), a2 + hstep, voffA);
            PG8_WAIT_V(8); PG8_WAIT_L(0); PG8_BAR; PG8_MMA(0, 0, At, B0); PG8_MMA(0, 1, At, B1); PG8_BAR; PG8_SCHED;
            PG8_LDA(At, 1, 1); PG8_STAGE(PG8_SB(1, 0), b3, voffB); PG8_STAGE(PG8_SB(1, 1), b3 + hstep, voffB); PG8_STAGE(PG8_SA(1, 0), a3, voffA);
            PG8_WAIT_V(8); PG8_WAIT_L(0); PG8_BAR; PG8_MMA(1, 0, At, B0); PG8_MMA(1, 1, At, B1); PG8_BAR; PG8_SCHED;
            } else {
            PG8_LDB(B0, 0, 0); PG8_SCHED; PG8_LDA(At, 0, 0); PG8_STAGE(PG8_SA(1, 1), a1 + hstep, voffA);
            PG8_WAIT_L(8); PG8_BAR; PG8_WAIT_L(0); PG8_MMA(0, 0, At, B0); PG8_BAR; PG8_SCHED;
            PG8_LDB(B1, 0, 1); PG8_STAGE(PG8_SB(0, 0), b2, voffB);
            PG8_BAR; PG8_WAIT_L(0); PG8_MMA(0, 1, At, B1); PG8_BAR;
            PG8_LDA(At, 0, 1); PG8_STAGE(PG8_SA(0, 0), a2, voffA);
            PG8_BAR; PG8_WAIT_L(0); PG8_MMA(1, 0, At, B0); PG8_BAR; PG8_SCHED;
            PG8_STAGE(PG8_SB(0, 1), b2 + hstep, voffB);
            PG8_WAIT_V(6); PG8_BAR; PG8_MMA(1, 1, At, B1); PG8_BAR;
            PG8_LDB(B0, 1, 0); PG8_SCHED; PG8_LDA(At, 1, 0); PG8_STAGE(PG8_SA(0, 1), a2 + hstep, voffA);
            PG8_WAIT_L(8); PG8_BAR; PG8_WAIT_L(0); PG8_MMA(0, 0, At, B0); PG8_BAR; PG8_SCHED;
            PG8_LDB(B1, 1, 1); PG8_STAGE(PG8_SB(1, 0), b3, voffB);
            PG8_BAR; PG8_WAIT_L(0); PG8_MMA(0, 1, At, B1); PG8_BAR;
            PG8_LDA(At, 1, 1); PG8_STAGE(PG8_SA(1, 0), a3, voffA);
            PG8_BAR; PG8_WAIT_L(0); PG8_MMA(1, 0, At, B0); PG8_BAR; PG8_SCHED;
            PG8_STAGE(PG8_SB(1, 1), b3 + hstep, voffB);
            PG8_WAIT_V(6); PG8_BAR; PG8_MMA(1, 1, At, B1); PG8_BAR;
            }
        }
        if constexpr (ALIGN_EPI) { if (wr == 0) PG8_BAR; }
#if TPROBE == 23
        if (blockIdx.x == 0 && threadIdx.x == 0) { volatile PG8_LAS unsigned* mp_ = (volatile PG8_LAS unsigned*)(lds + 131072); mp_[48] = (unsigned)wall_clock64(); }
#endif
        bool keep = false;
        if constexpr (Epi::CHAIN) { keep = E.chain(acc, cur, wr, wc, fr, fq); S.done(cur); }
        else if constexpr (!Epi::AFTER_DRAIN) { E(acc, cur, wr, wc, fr, fq); S.done(cur); }
#if TPROBE == 23
        if (blockIdx.x == 0 && threadIdx.x == 0) { volatile PG8_LAS unsigned* mp_ = (volatile PG8_LAS unsigned*)(lds + 131072); mp_[16] += (unsigned)wall_clock64() - mp_[48]; }
#endif
        if (!has_next) break;
        if (!keep)
#pragma unroll
        for (int a = 0; a < 2; ++a)
#pragma unroll
            for (int b = 0; b < 2; ++b)
#pragma unroll
                for (int m = 0; m < 4; ++m)
#pragma unroll
                    for (int n = 0; n < 2; ++n) acc[a][b][m][n] = (f32x4){0.f, 0.f, 0.f, 0.f};
        cur = nxt; cA = nA; cB = nB; ++ui;
        if constexpr (ALIGN_EPI) { if (wr == 1) PG8_BAR; }
    }
    PG8_WAIT_V(0);
    if constexpr (!ALIGN_EPI) { if (wr == 0) PG8_BAR; }
    PG8_BAR;
    if constexpr (Epi::AFTER_DRAIN) { E.fused(acc, cur, wr, wc, fr, fq, lds, wid, lane); S.done(cur); }
#undef PG8_SA
#undef PG8_SB
#undef PG8_STAGE
#undef PG8_LDA
#undef PG8_LDB
#undef PG8_MMA
#undef PG8_WAIT_V
#undef PG8_WAIT_L
#undef PG8_BAR
#undef PG8_SCHED
}
}
constexpr int NWAVES = 8, NTHR = 512;
constexpr int D = 1024, NBATCH = 8, SEQ = 4096, M = NBATCH * SEQ, DEPTH = 4;
constexpr int DIN = 8192, DFF = 2816, NEXP = 8, DFE = 3584;
constexpr float EPS = 1e-6f;
constexpr size_t MiB = 1u << 20;
constexpr size_t WS_CTL = 0, CTL_ZERO_BYTES = 2 * MiB;
constexpr size_t WS_MOD = 1 * MiB;
constexpr size_t WS_LB = 2 * MiB;
constexpr size_t WS_LI = 2 * MiB + 64 * 1024, WS_LF = WS_LI + 512 * 1024;
constexpr size_t WS_TOKEP = 4 * MiB;
constexpr size_t WS_TOKW = WS_TOKEP + 512 * 1024;
constexpr size_t WS_TOKD = WS_TOKW + 256 * 1024;
constexpr size_t WS_UZ = 5 * MiB;
constexpr size_t WS_WIN = 6 * MiB;
constexpr size_t WS_WAB = 22 * MiB, WAB_STEP = 4 * MiB;
constexpr size_t WS_WO = 30 * MiB, WO_STEP = 2 * MiB;
constexpr size_t WS_WFD = 34 * MiB, WF_W2_DENSE = 12 * MiB;
constexpr size_t WS_WFM = 52 * MiB, WF_W2_MOE = 112 * MiB;
constexpr size_t WS_H = 220 * MiB;
constexpr size_t WS_PROJ = 284 * MiB, PART = 64 * MiB;
constexpr size_t WS_MQ = 796 * MiB, WS_MK = 860 * MiB, WS_MV = 924 * MiB, WS_XC = 988 * MiB;
constexpr size_t WS_AG = 796 * MiB, WS_YS = 928 * MiB;
constexpr size_t WS_XB = 1060 * MiB;
constexpr size_t WS_END = 1124 * MiB;
constexpr size_t PSTRIDE = (size_t)M * 1024;
enum { P_QA = 0, P_LF = 1, P_VA = 2, P_GA = 3, P_XM = 4, P_OS = 5, P_GTA = 6, P_GTB = 7 };
constexpr int CW_BAR = 4096;
constexpr int CW_CNT = 16384;
constexpr int RING_BYTES = 131072, MISC_OFF = RING_BYTES, LDS_BYTES = 147456;

#define GAS __attribute__((address_space(1)))
#define LAS __attribute__((address_space(3)))
typedef unsigned short bf16;
typedef unsigned v4u __attribute__((ext_vector_type(4)));
typedef unsigned v2u __attribute__((ext_vector_type(2)));
typedef float f32x4 __attribute__((ext_vector_type(4)));
typedef float f32x2 __attribute__((ext_vector_type(2)));
typedef int i32x4 __attribute__((ext_vector_type(4)));
typedef int i32x2 __attribute__((ext_vector_type(2)));
#define LDS_WAIT() asm volatile("s_waitcnt lgkmcnt(0)" ::: "memory")
#define VM_WAIT() asm volatile("s_waitcnt vmcnt(0)" ::: "memory")
__device__ __forceinline__ unsigned f2bf(float f) { unsigned u = __builtin_bit_cast(unsigned, f); return (u + 0x7fffu + ((u >> 16) & 1u)) >> 16; }
typedef __bf16 bf16x2_t __attribute__((ext_vector_type(2)));
__device__ __forceinline__ unsigned pk2(float lo, float hi) { const f32x2 v = {lo, hi}; return __builtin_bit_cast(unsigned, __builtin_convertvector(v, bf16x2_t)); }
__device__ __forceinline__ float bflo(unsigned w) { return __uint_as_float(w << 16); }
__device__ __forceinline__ float bfhi(unsigned w) { return __uint_as_float(w & 0xffff0000u); }
__device__ __forceinline__ float bf2f(bf16 b) { return __uint_as_float((unsigned)b << 16); }
__device__ __forceinline__ float fsigm(float v) { return 1.0f / (1.0f + __expf(-v)); }
__device__ __forceinline__ float fsigr(float v) { return __builtin_amdgcn_rcpf(1.0f + __expf(-v)); }
template <int CTRL> __device__ __forceinline__ float dpp_f(float old, float src) { return __builtin_bit_cast(float, __builtin_amdgcn_update_dpp(__builtin_bit_cast(int, old), __builtin_bit_cast(int, src), CTRL, 0xf, 0xf, false)); }
__device__ __forceinline__ float rdlane_f(float v, int l) { return __builtin_bit_cast(float, __builtin_amdgcn_readlane(__builtin_bit_cast(int, v), l)); }
__device__ __forceinline__ float row_allsum(float v) { v += dpp_f<0x128>(0.f, v); v += dpp_f<0x124>(0.f, v); v += dpp_f<0x122>(0.f, v); v += dpp_f<0x121>(0.f, v); return v; }
__device__ __forceinline__ float wave_sum(float v) { const float r = row_allsum(v); return (rdlane_f(r, 0) + rdlane_f(r, 16)) + (rdlane_f(r, 32) + rdlane_f(r, 48)); }
__device__ __forceinline__ float half_sum(float v) {
    const float r = row_allsum(v); const float lo = rdlane_f(r, 0) + rdlane_f(r, 16), hi = rdlane_f(r, 32) + rdlane_f(r, 48);
    return (threadIdx.x & 32) ? hi : lo; }
__device__ __forceinline__ float sum16(float v) {
#pragma unroll
    for (int o = 1; o < 16; o <<= 1) v += __shfl_xor(v, o);
    return v;
}

__device__ __forceinline__ int opq_v(int v) { asm volatile("" : "+v"(v)); return v; }
__device__ __forceinline__ int opq_s(int v) { asm volatile("" : "+s"(v)); return v; }
__device__ __forceinline__ unsigned char* opq_p(unsigned char* p) { asm volatile("" : "+s"(p)); return p; }
#define TID() opq_v((int)threadIdx.x)
#define BID() opq_s((int)blockIdx.x)
#define XB_TMO      128
#define XB_XCNT(j)  (256  + 64 * (j))
#define XB_XSUB(j)  (1280 + 64 * (j))
#define XB_XGEN(j)  (2304 + 64 * (j))
#define XB_TOP      3328
#define XB_TOPGEN   3392
#define XCD_BAR_WORDS 3456
#define XB_SPIN_CAP (1u << 18)

__device__ __forceinline__ unsigned xb_ld(unsigned* p)              { return __hip_atomic_load(p, __ATOMIC_RELAXED, __HIP_MEMORY_SCOPE_AGENT); }
__device__ __forceinline__ unsigned xb_add(unsigned* p, unsigned v) { return __hip_atomic_fetch_add(p, v, __ATOMIC_RELAXED, __HIP_MEMORY_SCOPE_AGENT); }
__device__ __forceinline__ unsigned xb_xcc_id() { return (unsigned)__builtin_amdgcn_s_getreg((3 << 11) | 20) & 0xFu; }
#define XB_SPIN(cond, bar) do { unsigned _sp = 0; while (cond) { __builtin_amdgcn_s_sleep(1); \
    if ((++_sp & 255u) == 0u) { if (xb_ld(&(bar)[XB_TMO])) break; if (_sp > XB_SPIN_CAP) { atomicAdd(&(bar)[XB_TMO], 1u); break; } } } } while (0)

struct XcdBarrier {
    unsigned* bar; unsigned x;
    volatile LAS unsigned* st;
};

__device__ __forceinline__ XcdBarrier xcd_barrier_post(unsigned* bar, volatile LAS unsigned* st) {
    XcdBarrier b; b.bar = bar; b.x = xb_xcc_id(); b.st = st;
    if (threadIdx.x == 0) (void)xb_add(&bar[XB_XCNT(b.x)], 1u);
    return b;
}
__device__ __forceinline__ void xcd_barrier_complete(unsigned* bar, unsigned x, unsigned& nloc, unsigned& nx) {
    const unsigned G = gridDim.x * gridDim.y * gridDim.z;
    unsigned sum, cnt, mine, sp = 0u;
    for (;;) {
        sum = 0u; cnt = 0u; mine = 0u;
#pragma unroll
        for (unsigned j = 0; j < 16; ++j) { const unsigned c = xb_ld(&bar[XB_XCNT(j)]); sum += c; cnt += (c > 0u) ? 1u : 0u; mine = (j == x) ? c : mine; }
        if (sum == G) break;
        __builtin_amdgcn_s_sleep(1);
        if ((++sp & 255u) == 0u) { if (xb_ld(&bar[XB_TMO])) break; if (sp > XB_SPIN_CAP) { atomicAdd(&bar[XB_TMO], 1u); break; } }
    }
    nloc = mine > 0u ? mine : 1u; nx = cnt > 0u ? cnt : 1u;
}

__device__ __forceinline__ void xcd_barrier(const XcdBarrier& b) {
    asm volatile("s_waitcnt vmcnt(0)" ::: "memory");
    __syncthreads();
    if (threadIdx.x == 0) {
        unsigned* bar = b.bar;
        __builtin_amdgcn_s_waitcnt(0);
        unsigned nloc = b.st[0], nx = b.st[1];
        if (nloc == 0u) { xcd_barrier_complete(bar, b.x, nloc, nx); b.st[0] = nloc; b.st[1] = nx; }
        const unsigned old = xb_add(&bar[XB_XSUB(b.x)], 1u);
        const unsigned gen = old / nloc;
        if (old + 1u == (gen + 1u) * nloc) {
            __builtin_amdgcn_fence(__ATOMIC_RELEASE, "agent");
            asm volatile("s_waitcnt vmcnt(0)" ::: "memory");
            const unsigned og = xb_add(&bar[XB_TOP], 1u);
            const unsigned tg = og / nx;
            if (og + 1u == (tg + 1u) * nx) xb_add(&bar[XB_TOPGEN], 1u);
            else XB_SPIN(xb_ld(&bar[XB_TOPGEN]) == tg, bar);
            __builtin_amdgcn_fence(__ATOMIC_ACQUIRE, "agent");
            xb_add(&bar[XB_XGEN(b.x)], 1u);
            asm volatile("s_waitcnt vmcnt(0)" ::: "memory");
        } else {
            XB_SPIN(xb_ld(&bar[XB_XGEN(b.x)]) == gen, bar);
            __builtin_amdgcn_fence(__ATOMIC_ACQUIRE, "agent");
            asm volatile("s_waitcnt vmcnt(0)" ::: "memory");
        }
    }
    __syncthreads();
}
struct Ctx { const float* in[32]; float* out; unsigned char* ws; int ph_lo, ph_hi; };
enum { I_X = 0, I_C, I_WADA, I_BADA, I_GPREMIX, I_GPOSTMIX, I_GPREFFN, I_GPOSTFFN, I_WIN, I_HLB, I_HGN, I_CONVW, I_CONVB, I_WQ, I_WK, I_WV, I_WIG, I_BIG, I_WFG, I_BFG,
       I_MGN, I_MSKIP, I_WPA, I_WPB, I_WOUT, I_F1, I_F3, I_F2, I_ROUTER, I_M1, I_M3, I_M2 };

__device__ __forceinline__ void ph_mod(const Ctx& c, LAS unsigned char* lds) {
    LAS float* cact = (LAS float*)lds;
    LAS float* part = (LAS float*)(lds + 32768);
    GAS float* MOD = (GAS float*)(c.ws + WS_MOD);
    const GAS float* cin = (const GAS float*)c.in[I_C]; const GAS float* wada = (const GAS float*)c.in[I_WADA]; const GAS float* bada = (const GAS float*)c.in[I_BADA];
    const int tid = TID(), lane = tid & 63, wave = tid >> 6;
    for (int i = tid; i < 8192; i += NTHR) { const float v = cin[i]; cact[i] = v * fsigm(v); }
    __syncthreads();
    for (int u = BID(); u < 384; u += gridDim.x) {
        const int l = u / 96, jb = u % 96, j = jb * 64 + lane;
        const GAS float* w = wada + ((size_t)l * 1024 + wave * 128) * 6144 + j;
        const LAS float* ca = cact + wave * 128;
        float a0 = 0.f, a1 = 0.f, a2 = 0.f, a3 = 0.f, a4 = 0.f, a5 = 0.f, a6 = 0.f, a7 = 0.f;
#pragma unroll 32
        for (int k = 0; k < 128; ++k) { const float wv = w[(size_t)k * 6144];
            a0 += ca[k] * wv; a1 += ca[1024 + k] * wv; a2 += ca[2048 + k] * wv; a3 += ca[3072 + k] * wv;
            a4 += ca[4096 + k] * wv; a5 += ca[5120 + k] * wv; a6 += ca[6144 + k] * wv; a7 += ca[7168 + k] * wv; }
        LAS float* pw = part + wave * 512 + lane;
        pw[0] = a0; pw[64] = a1; pw[128] = a2; pw[192] = a3; pw[256] = a4; pw[320] = a5; pw[384] = a6; pw[448] = a7;
        __syncthreads();
        { const int b = wave; float s = bada[l * 6144 + j];
#pragma unroll
            for (int ww = 0; ww < 8; ++ww) s += part[ww * 512 + b * 64 + lane];
            MOD[(size_t)(l * 8 + b) * 6144 + j] = s; }
        __syncthreads();
    }
}
__device__ __forceinline__ void ph_lb(const Ctx& c) {
    if (BID() != 0) return;
    GAS float* LB = (GAS float*)(c.ws + WS_LB); const GAS float* raw = (const GAS float*)c.in[I_HLB];
    for (int col = TID(); col < 1024; col += NTHR) {
        const float r0 = raw[col], r1 = raw[1024 + col], r2 = raw[2048 + col], r3 = raw[3072 + col];
        const float mx = fmaxf(fmaxf(r0, r1), fmaxf(r2, r3));
        const float e0 = __expf(r0 - mx), e1 = __expf(r1 - mx), e2 = __expf(r2 - mx), e3 = __expf(r3 - mx), inv = 1.0f / (e0 + e1 + e2 + e3);
        LB[col] = 0.f; LB[1024 + col] = e1 * inv; LB[2048 + col] = (e1 + e2) * inv; LB[3072 + col] = (e1 + e2 + e3) * inv;
    }
}
struct CvtJob { const float* W; bf16* WT; int K, N, rowbase, mode, item, pad_; };
__device__ __forceinline__ void cvt_load(const CvtJob& j, int lane, f32x4 (&r)[8]) {
    const int nblk = j.N / 32, kb = j.item / nblk, nb = j.item % nblk;
    const GAS float* p = (const GAS float*)j.W + (size_t)(64 * kb + (lane >> 3)) * j.N + 32 * nb + (lane & 7) * 4;
#pragma unroll
    for (int i = 0; i < 8; ++i) r[i] = __builtin_nontemporal_load((const GAS f32x4*)(p + (size_t)(8 * i) * j.N));
}
__device__ __forceinline__ void cvt_store(const CvtJob& j, int lane, const f32x4 (&r)[8], LAS float* scr) {
    const int nblk = j.N / 32, kb = j.item / nblk, nb = j.item % nblk, k0 = 64 * kb, n0 = 32 * nb;
#pragma unroll
    for (int i = 0; i < 8; ++i) { LAS float* s = scr + (8 * i + (lane >> 3)) * 33 + (lane & 7) * 4; s[0] = r[i][0]; s[1] = r[i][1]; s[2] = r[i][2]; s[3] = r[i][3]; }
    LDS_WAIT(); asm volatile("" ::: "memory");
    const int drow0 = j.rowbase + (j.mode == 1 ? ((n0 >> 7) * 256 + (n0 & 127)) : (j.mode == 2 && n0 >= 6144) ? (6144 + (((n0 - 6144) & 1023) >> 7) * 256 + ((n0 >= 7168) ? 128 : 0) + (n0 & 127)) : n0);
    const int cc = lane & 7;
#pragma unroll
    for (int jj = 0; jj < 4; ++jj) { const int n = (lane >> 3) + 8 * jj; const LAS float* s = scr + (8 * cc) * 33 + n;
        v4u o; o.x = pk2(s[0 * 33], s[1 * 33]); o.y = pk2(s[2 * 33], s[3 * 33]); o.z = pk2(s[4 * 33], s[5 * 33]); o.w = pk2(s[6 * 33], s[7 * 33]);
        *(GAS v4u*)(j.WT + (size_t)(drow0 + n) * j.K + k0 + 8 * cc) = o; }
    LDS_WAIT(); asm volatile("" ::: "memory");
}
__device__ __forceinline__ CvtJob cvt_decode(const Ctx& c, int l, int it) {
    bf16* WIN = (bf16*)(c.ws + WS_WIN); bf16* WAB = (bf16*)(c.ws + WS_WAB + (size_t)(l & 1) * WAB_STEP); bf16* WO = (bf16*)(c.ws + WS_WO + (size_t)(l & 1) * WO_STEP); bf16* WF = (bf16*)(c.ws + ((l & 1) ? WS_WFM : WS_WFD));
    const bool moe = (l & 1) != 0; const int j = l >> 1;
    constexpr int I_IN = 16 * 256, I_SQ = 16 * 32, I_D13 = 16 * 88, I_M13 = 16 * 112, I_M2E = 56 * 32;
    CvtJob q; q.pad_ = 0; q.mode = 0; q.rowbase = 0; q.K = D; q.N = D;
    int r = it;
    if (r < I_IN) { q.W = c.in[I_WIN] + (size_t)l * D * DIN; q.N = DIN; q.WT = WIN; q.item = r; q.mode = 2; return q; } r -= I_IN;
    if (r < I_SQ) { q.W = c.in[I_WPA] + (size_t)l * D * D; q.WT = WAB; q.item = r; return q; } r -= I_SQ;
    if (r < I_SQ) { q.W = c.in[I_WPB] + (size_t)l * D * D; q.WT = WAB; q.rowbase = 1024; q.item = r; return q; } r -= I_SQ;
    if (r < I_SQ) { q.W = c.in[I_WOUT] + (size_t)l * D * D; q.WT = WO; q.item = r; return q; } r -= I_SQ;
    if (!moe) {
        if (r < I_D13) { q.W = c.in[I_F1] + (size_t)j * D * DFF; q.N = DFF; q.WT = WF; q.mode = 1; q.item = r; return q; } r -= I_D13;
        if (r < I_D13) { q.W = c.in[I_F3] + (size_t)j * D * DFF; q.N = DFF; q.WT = WF; q.mode = 1; q.rowbase = 128; q.item = r; return q; } r -= I_D13;
        q.W = c.in[I_F2] + (size_t)j * DFF * D; q.K = DFF; q.WT = (bf16*)(c.ws + WS_WFD + WF_W2_DENSE); q.item = r; return q;
    }
    if (r < NEXP * I_M13) { const int e = r / I_M13; q.W = c.in[I_M1] + ((size_t)j * NEXP + e) * D * DFE; q.N = DFE; q.WT = WF; q.mode = 1; q.rowbase = e * 2 * DFE; q.item = r - e * I_M13; return q; } r -= NEXP * I_M13;
    if (r < NEXP * I_M13) { const int e = r / I_M13; q.W = c.in[I_M3] + ((size_t)j * NEXP + e) * D * DFE; q.N = DFE; q.WT = WF; q.mode = 1; q.rowbase = e * 2 * DFE + 128; q.item = r - e * I_M13; return q; } r -= NEXP * I_M13;
    { const int e = r / I_M2E; q.W = c.in[I_M2] + ((size_t)j * NEXP + e) * DFE * D; q.K = DFE; q.WT = (bf16*)(c.ws + WS_WFM + WF_W2_MOE); q.rowbase = e * D; q.item = r - e * I_M2E; return q; }
}
__device__ __forceinline__ void ph_cvt(const Ctx& c, int l, LAS unsigned char* lds, int wg, int nwg, int part, int nap = 0) {
    const int tid = TID(), lane = tid & 63, wave = __builtin_amdgcn_readfirstlane(tid >> 6);
    LAS float* scr = (LAS float*)(lds + wave * 16384);
    const int gw = wg * NWAVES + wave, NGW = nwg * NWAVES;
    const bool moe = (l & 1) != 0;
    const int total = 16 * 256 + 3 * 16 * 32 + (moe ? (2 * NEXP * 16 * 112 + NEXP * 56 * 32) : (2 * 16 * 88 + 44 * 32));
    const int first = (part == 1) ? 16 * 256 : 0, last = (part == 0) ? 16 * 256 : total;
    int it = first + gw; if (it >= last) return;
    CvtJob ja = cvt_decode(c, l, it), jb = ja; f32x4 ra[8], rb[8]; cvt_load(ja, lane, ra);
    for (;;) {
        { const int nit = it + NGW; jb = cvt_decode(c, l, nit < last ? nit : it); cvt_load(jb, lane, rb); }
        cvt_store(ja, lane, ra, scr);
        it += NGW; if (it >= last) break;
        if (nap) __builtin_amdgcn_s_sleep(32);
        { const int nit = it + NGW; ja = cvt_decode(c, l, nit < last ? nit : it); cvt_load(ja, lane, ra); }
        cvt_store(jb, lane, rb, scr);
        it += NGW; if (it >= last) break;
        if (nap) __builtin_amdgcn_s_sleep(32);
    }
}

__device__ __forceinline__ void ld_row_f32(const float* p, int lane, f32x4 (&v)[4]) {
#pragma unroll
    for (int j = 0; j < 4; ++j) v[j] = *(const GAS f32x4*)(p + 4 * lane + 256 * j);
}
__device__ __forceinline__ void ld_row_bf16(const bf16* p, int lane, f32x4 (&v)[4]) {
#pragma unroll
    for (int j = 0; j < 4; ++j) { const v2u w = *(const GAS v2u*)(p + 4 * lane + 256 * j); v[j] = (f32x4){bflo(w.x), bfhi(w.x), bflo(w.y), bfhi(w.y)}; }
}
__device__ __forceinline__ void st_row_bf16(bf16* p, int lane, const f32x4 (&v)[4]) {
#pragma unroll
    for (int j = 0; j < 4; ++j) { v2u w; w.x = pk2(v[j][0], v[j][1]); w.y = pk2(v[j][2], v[j][3]); *(GAS v2u*)(p + 4 * lane + 256 * j) = w; }
}
__device__ __forceinline__ float row_sumsq(const f32x4 (&v)[4]) {
    float s = 0.f;
#pragma unroll
    for (int j = 0; j < 4; ++j) s += (v[j][0] * v[j][0] + v[j][1] * v[j][1]) + (v[j][2] * v[j][2] + v[j][3] * v[j][3]);
    return wave_sum(s);
}
__device__ __forceinline__ void norm_mod(const f32x4 (&x)[4], const f32x4 (&g)[4], const f32x4 (&sc)[4], const f32x4 (&sh)[4], f32x4 (&h)[4]) {
    const float r = rsqrtf(row_sumsq(x) * (1.0f / 1024.0f) + EPS);
#pragma unroll
    for (int j = 0; j < 4; ++j) h[j] = (x[j] * r) * g[j] * (sc[j] + 1.0f) + sh[j];
}
__device__ __forceinline__ const float* modp(const Ctx& c, int l, int b, int which) { return (const float*)(c.ws + WS_MOD) + ((size_t)(l * 8 + b) * 6 + which) * 1024; }

__device__ __forceinline__ void ph_norm0(const Ctx& c) {
    const int tid = TID(), lane = tid & 63, wave = tid >> 6, gw = BID() * NWAVES + wave, NGW = gridDim.x * NWAVES;
    bf16* H = (bf16*)(c.ws + WS_H);
    for (int slot = gw; slot < M / 16; slot += NGW) {
        const int row0 = slot * 16, b = row0 / SEQ;
        f32x4 g[4], sc[4], sh[4]; ld_row_f32(c.in[I_GPREMIX], lane, g); ld_row_f32(modp(c, 0, b, 1), lane, sc); ld_row_f32(modp(c, 0, b, 0), lane, sh);
        for (int r = 0; r < 16; ++r) { f32x4 x[4], h[4]; ld_row_f32(c.in[I_X] + (size_t)(row0 + r) * D, lane, x); norm_mod(x, g, sc, sh, h); st_row_bf16(H + (size_t)(row0 + r) * D, lane, h); }
    }
}
__device__ __forceinline__ void ph_uz(const Ctx& c) {
    GAS float* UZ = (GAS float*)(c.ws + WS_UZ);
    const int gt = BID() * NTHR + TID();
    if (gt >= DEPTH * D) return;
    const int l = gt >> 10, ch = gt & 1023, n = ch >> 2, i = ch & 3;
    const GAS float* wq = (const GAS float*)c.in[I_WQ] + (size_t)l * 4096 + n * 16 + i * 4; const GAS float* wk = (const GAS float*)c.in[I_WK] + (size_t)l * 4096 + n * 16 + i * 4; const GAS float* wv = (const GAS float*)c.in[I_WV] + (size_t)l * 4096 + n * 16 + i * 4;
    const GAS float* wig = (const GAS float*)c.in[I_WIG] + (size_t)l * 3072 * 4; const GAS float* wfg = (const GAS float*)c.in[I_WFG] + (size_t)l * 3072 * 4;
    f32x4 ui = {0.f, 0.f, 0.f, 0.f}, uf = ui, zi = ui, zf = ui;
#pragma unroll
    for (int o = 0; o < 4; ++o) { const float q = wq[o], k = wk[o], v = wv[o];
        ui += *(const GAS f32x4*)(wig + (size_t)(4 * n + o) * 4) * q + *(const GAS f32x4*)(wig + (size_t)(1024 + 4 * n + o) * 4) * k; zi += *(const GAS f32x4*)(wig + (size_t)(2048 + 4 * n + o) * 4) * v;
        uf += *(const GAS f32x4*)(wfg + (size_t)(4 * n + o) * 4) * q + *(const GAS f32x4*)(wfg + (size_t)(1024 + 4 * n + o) * 4) * k; zf += *(const GAS f32x4*)(wfg + (size_t)(2048 + 4 * n + o) * 4) * v; }
    GAS f32x4* UP = (GAS f32x4*)(UZ + (size_t)DEPTH * D * 16 + (size_t)l * 16 * D);
    UP[(i * 4 + 0) * 256 + n] = ui; UP[(i * 4 + 1) * 256 + n] = uf; UP[(i * 4 + 2) * 256 + n] = zi; UP[(i * 4 + 3) * 256 + n] = zf;
}
__device__ __forceinline__ void ph_prep(const Ctx& c, int l, LAS unsigned char* lds) {
    const int tid = TID(), lane = tid & 63, wave = tid >> 6, gw = BID() * NWAVES + wave, NGW = gridDim.x * NWAVES;
    LAS f32x4* UZL = (LAS f32x4*)lds;
    LAS f32x4* WTL = (LAS f32x4*)(lds + 65536);
    LAS f32x4* CWL = (LAS f32x4*)(lds + 114688);
    LAS f32x4* CBL = (LAS f32x4*)(lds + 135168);
    {   const GAS f32x4* ut = (const GAS f32x4*)((const float*)(c.ws + WS_UZ) + (size_t)DEPTH * D * 16 + (size_t)l * 16 * D);
        for (int i = tid; i < 4096; i += NTHR) UZL[i] = ut[i];
        for (int i = tid; i < 1024; i += NTHR) { const int ii = i >> 8, n = i & 255; const size_t so = (size_t)l * 4096 + n * 16 + ii * 4;
            WTL[i] = *(const GAS f32x4*)(c.in[I_WQ] + so); WTL[1024 + i] = *(const GAS f32x4*)(c.in[I_WK] + so); WTL[2048 + i] = *(const GAS f32x4*)(c.in[I_WV] + so); }
        for (int i = tid; i < 1024; i += NTHR) CWL[i] = *(const GAS f32x4*)(c.in[I_CONVW] + (size_t)l * 4 * D + i * 4);
        if (tid < 256) CBL[tid] = *(const GAS f32x4*)(c.in[I_CONVB] + (size_t)l * D + tid * 4);
        __syncthreads(); }
    const bf16* XM = (const bf16*)(c.ws + WS_PROJ) + (size_t)P_XM * PSTRIDE;
    bf16* MQ = (bf16*)(c.ws + WS_MQ); bf16* MK = (bf16*)(c.ws + WS_MK); bf16* MV = (bf16*)(c.ws + WS_MV); bf16* XC = (bf16*)(c.ws + WS_XC);
    GAS float* LI = (GAS float*)(c.ws + WS_LI); GAS float* LF = (GAS float*)(c.ws + WS_LF);
    const float* cw = c.in[I_CONVW] + (size_t)l * 4 * D; const float* cb = c.in[I_CONVB] + (size_t)l * D;
    const float* wq = c.in[I_WQ] + (size_t)l * 256 * 16; const float* wk = c.in[I_WK] + (size_t)l * 256 * 16; const float* wv = c.in[I_WV] + (size_t)l * 256 * 16;
    const float* UZ = (const float*)(c.ws + WS_UZ) + (size_t)l * D * 16;
    const int gidx = (lane >> 1) & 7;
    const float gbias = (gidx < 4) ? ((const GAS float*)c.in[I_BIG])[l * 4 + gidx] : ((const GAS float*)c.in[I_BFG])[l * 4 + gidx - 4];
    for (int slot = gw; slot < M / 16; slot += NGW) {
        const int row0 = slot * 16, tq0 = row0 & (SEQ - 1);
#define PREP_WIN(W_, TB_, J_) do { _Pragma("unroll") for (int r = 0; r < 7; ++r) { const int rel_ = (TB_) * 4 - 3 + r; const int rr_ = (tq0 + rel_ >= 0) ? rel_ : 0; \
            W_[r] = *(const GAS v2u*)(XM + (size_t)(row0 + rr_) * D + 4 * lane + 256 * (J_)); } } while (0)
        v2u wn[7]; PREP_WIN(wn, 0, 0);
#pragma unroll 1
        for (int tb = 0; tb < 4; ++tb) {
            f32x4 gi[4], gf[4];
#pragma unroll
            for (int tt = 0; tt < 4; ++tt) { gi[tt] = (f32x4){0.f, 0.f, 0.f, 0.f}; gf[tt] = gi[tt]; }
#pragma unroll 1
            for (int j = 0; j < 4; ++j) {
                const int ch = 4 * lane + 256 * j, n = lane + 64 * j;
                const f32x4 b4 = CBL[n];
                f32x4 xcs[4], xts[4];
                {
                    f32x4 w4[4];
#pragma unroll
                    for (int i = 0; i < 4; ++i) w4[i] = CWL[i * 256 + n];
                    v2u win[7];
#pragma unroll
                    for (int r = 0; r < 7; ++r) { const int rel = tb * 4 - 3 + r; win[r] = (tq0 + rel >= 0) ? wn[r] : (v2u){0u, 0u}; }
                    { const int itn = (tb * 4 + j + 1 < 16) ? tb * 4 + j + 1 : 15; PREP_WIN(wn, itn >> 2, itn & 3); }
#pragma unroll
                    for (int tt = 0; tt < 4; ++tt) {
                        f32x4 y = b4, xt = {0.f, 0.f, 0.f, 0.f};
#pragma unroll
                        for (int jj = 0; jj < 4; ++jj) { const v2u w = win[tt + jj]; const f32x4 xv = {bflo(w.x), bfhi(w.x), bflo(w.y), bfhi(w.y)}; y += w4[jj] * xv; if (jj == 3) xt = xv; }
                        f32x4 xc; xc[0] = y[0] * fsigr(y[0]); xc[1] = y[1] * fsigr(y[1]); xc[2] = y[2] * fsigr(y[2]); xc[3] = y[3] * fsigr(y[3]);
                        xcs[tt] = xc; xts[tt] = xt;
                        { v2u w; w.x = pk2(xc[0], xc[1]); w.y = pk2(xc[2], xc[3]); *(GAS v2u*)(XC + (size_t)(row0 + tb * 4 + tt) * D + ch) = w; }
                    }
                }
                asm volatile("" ::: "memory");
                {
                    f32x4 q4[4], k4[4], v4[4];
#pragma unroll
                    for (int i = 0; i < 4; ++i) { q4[i] = WTL[i * 256 + n]; k4[i] = WTL[1024 + i * 256 + n]; v4[i] = WTL[2048 + i * 256 + n]; }
#pragma unroll
                    for (int tt = 0; tt < 4; ++tt) {
                        f32x4 q = {0.f, 0.f, 0.f, 0.f}, k = q, v = q;
#pragma unroll
                        for (int i = 0; i < 4; ++i) { q += q4[i] * xcs[tt][i]; k += k4[i] * xcs[tt][i]; v += v4[i] * xts[tt][i]; }
                        const size_t off = (size_t)(row0 + tb * 4 + tt) * D + ch;
                        { v2u w; w.x = pk2(q[0], q[1]); w.y = pk2(q[2], q[3]); *(GAS v2u*)(MQ + off) = w; }
                        { v2u w; w.x = pk2(k[0] * 0.0625f, k[1] * 0.0625f); w.y = pk2(k[2] * 0.0625f, k[3] * 0.0625f); *(GAS v2u*)(MK + off) = w; }
                        { v2u w; w.x = pk2(v[0], v[1]); w.y = pk2(v[2], v[3]); *(GAS v2u*)(MV + off) = w; }
                    }
                }
                asm volatile("" ::: "memory");
                {
#pragma unroll
                    for (int i = 0; i < 4; ++i) { const f32x4 u0 = UZL[(i * 4 + 0) * 256 + n], u1 = UZL[(i * 4 + 1) * 256 + n], u2 = UZL[(i * 4 + 2) * 256 + n], u3 = UZL[(i * 4 + 3) * 256 + n];
#pragma unroll
                        for (int tt = 0; tt < 4; ++tt) { gi[tt] += u0 * xcs[tt][i] + u2 * xts[tt][i]; gf[tt] += u1 * xcs[tt][i] + u3 * xts[tt][i]; }
                        __builtin_amdgcn_sched_barrier(0); }
                }
            }
            float v[32];
#pragma unroll
            for (int tt = 0; tt < 4; ++tt)
#pragma unroll
                for (int hh = 0; hh < 4; ++hh) { v[tt * 8 + hh] = gi[tt][hh]; v[tt * 8 + 4 + hh] = gf[tt][hh]; }
#pragma unroll
            for (int st = 0; st < 5; ++st) { const int o = 32 >> st, nn = 32 >> st; const bool up = (lane & o) != 0;
#pragma unroll
                for (int i = 0; i < nn / 2; ++i) { const float lo = v[i], hi = v[i + nn / 2]; const float send = up ? lo : hi, keep = up ? hi : lo; v[i] = keep + __shfl_xor(send, o); } }
            const float tot = v[0] + __shfl_xor(v[0], 1) + gbias;
            if ((lane & 1) == 0) { const int tt = lane >> 4; const size_t row = (size_t)(row0 + tb * 4 + tt);
                if (gidx < 4) LI[row * 4 + gidx] = tot; else LF[row * 4 + gidx - 4] = fminf(tot, 0.f) - __logf(1.0f + __expf(-fabsf(tot))); }
        }
    }
#undef PREP_WIN
}

__device__ __forceinline__ void ph_scan_a_naive(const Ctx& c, LAS unsigned char* lds) {
    const int tid = TID();
    bf16* PJ = (bf16*)(c.ws + WS_PROJ);
    const bf16* Q = PJ + (size_t)P_QA * PSTRIDE; const bf16* LFp = PJ + (size_t)P_LF * PSTRIDE; bf16* V = PJ + (size_t)P_VA * PSTRIDE;
    LAS bf16* sq = (LAS bf16*)lds;
    LAS bf16* sf = (LAS bf16*)(lds + 32768);
    LAS bf16* sv = (LAS bf16*)(lds + 65536);
    LAS float* so = (LAS float*)(lds + 73728);
    const int dg = tid & 15, vv = tid >> 4;
    for (int u = BID(); u < 256; u += gridDim.x) {
        const int b = u >> 5, h = (u >> 2) & 7, vs = u & 3;
        const size_t rowbase = (size_t)b * SEQ;
        float S[8];
#pragma unroll
        for (int j = 0; j < 8; ++j) S[j] = 0.f;
        v4u rq[2], rf[2], rv = {0u, 0u, 0u, 0u};
#define SA_LOAD(ch) do { _Pragma("unroll") for (int k2 = 0; k2 < 2; ++k2) { const int p = tid + NTHR * k2, rr = p >> 4, c8 = p & 15; const size_t o_ = (rowbase + (size_t)(ch) * 64 + rr) * D + h * 128 + c8 * 8; \
            rq[k2] = *(const GAS v4u*)(Q + o_); rf[k2] = *(const GAS v4u*)(LFp + o_); } \
            if (tid < 256) { const int rr = tid >> 2, c8 = tid & 3; rv = *(const GAS v4u*)(V + (rowbase + (size_t)(ch) * 64 + rr) * D + h * 128 + vs * 32 + c8 * 8); } } while (0)
        SA_LOAD(0);
        for (int ch = 0; ch < 64; ++ch) {
            const int buf = ch & 1;
#pragma unroll
            for (int k2 = 0; k2 < 2; ++k2) { const int p = tid + NTHR * k2; *(LAS v4u*)(sq + buf * 8192 + p * 8) = rq[k2]; *(LAS v4u*)(sf + buf * 8192 + p * 8) = rf[k2]; }
            if (tid < 256) *(LAS v4u*)(sv + buf * 2048 + tid * 8) = rv;
            __syncthreads();
            if (ch + 1 < 64) SA_LOAD(ch + 1);
            for (int i = 0; i < 64; ++i) {
                const v4u qv = *(const LAS v4u*)(sq + buf * 8192 + i * 128 + dg * 8), fv = *(const LAS v4u*)(sf + buf * 8192 + i * 128 + dg * 8);
                const float vt = bf2f(sv[buf * 2048 + i * 32 + vv]);
                const float qq[8] = {bflo(qv.x), bfhi(qv.x), bflo(qv.y), bfhi(qv.y), bflo(qv.z), bfhi(qv.z), bflo(qv.w), bfhi(qv.w)};
                const float ff[8] = {bflo(fv.x), bfhi(fv.x), bflo(fv.y), bfhi(fv.y), bflo(fv.z), bfhi(fv.z), bflo(fv.w), bfhi(fv.w)};
                float o = 0.f;
#pragma unroll
                for (int j = 0; j < 8; ++j) { const float f = __expf(ff[j]); S[j] = f * S[j] + (1.0f - f) * vt; o += S[j] * qq[j]; }
                o = sum16(o);
                if (dg == 0) so[i * 32 + vv] = o;
            }
            __syncthreads();
            { const int rr = tid >> 3, c4 = (tid & 7) * 4; const f32x4 ov = *(const LAS f32x4*)(so + rr * 32 + c4);
                v2u w; w.x = pk2(ov[0], ov[1]); w.y = pk2(ov[2], ov[3]); *(GAS v2u*)(V + (rowbase + (size_t)ch * 64 + rr) * D + h * 128 + vs * 32 + c4) = w; }
        }
#undef SA_LOAD
        __syncthreads();
    }
}

__device__ __forceinline__ void ph_scan_m_naive(const Ctx& c, LAS unsigned char* lds) {
    const int tid = TID();
    const bf16* MQ = (const bf16*)(c.ws + WS_MQ); const bf16* MK = (const bf16*)(c.ws + WS_MK); bf16* MV = (bf16*)(c.ws + WS_MV);
    const float* LI = (const float*)(c.ws + WS_LI); const float* LF = (const float*)(c.ws + WS_LF);
    LAS bf16* sq = (LAS bf16*)lds;
    LAS bf16* sk = (LAS bf16*)(lds + 32768);
    LAS bf16* sv = (LAS bf16*)(lds + 65536);
    LAS float* sli = (LAS float*)(lds + 69632);
    LAS float* slf = (LAS float*)(lds + 69888);
    LAS float* so = (LAS float*)(lds + 70144);
    const int dg = tid & 15, vv = tid >> 4;
    for (int u = BID(); u < 256; u += gridDim.x) {
        const int b = u >> 5, h = (u >> 3) & 3, vs = u & 7;
        const size_t rowbase = (size_t)b * SEQ;
        float C[16], nn[16], m = 0.f;
#pragma unroll
        for (int j = 0; j < 16; ++j) { C[j] = 0.f; nn[j] = 0.f; }
        v4u rq[4], rk[4], rv = {0u, 0u, 0u, 0u}; float rli = 0.f, rlf = 0.f;
#define SM_LOAD(ch) do { _Pragma("unroll") for (int k2 = 0; k2 < 4; ++k2) { const int p = tid + NTHR * k2, rr = p >> 5, c8 = p & 31; const size_t o_ = (rowbase + (size_t)(ch) * 64 + rr) * D + h * 256 + c8 * 8; \
            rq[k2] = *(const GAS v4u*)(MQ + o_); rk[k2] = *(const GAS v4u*)(MK + o_); } \
            if (tid < 256) { const int rr = tid >> 2, c8 = tid & 3; rv = *(const GAS v4u*)(MV + (rowbase + (size_t)(ch) * 64 + rr) * D + h * 256 + vs * 32 + c8 * 8); } \
            if (tid < 64) { rli = LI[(rowbase + (size_t)(ch) * 64 + tid) * 4 + h]; rlf = LF[(rowbase + (size_t)(ch) * 64 + tid) * 4 + h]; } } while (0)
        SM_LOAD(0);
        for (int ch = 0; ch < 64; ++ch) {
#pragma unroll
            for (int k2 = 0; k2 < 4; ++k2) { const int p = tid + NTHR * k2; *(LAS v4u*)(sq + p * 8) = rq[k2]; *(LAS v4u*)(sk + p * 8) = rk[k2]; }
            if (tid < 256) *(LAS v4u*)(sv + tid * 8) = rv;
            if (tid < 64) { sli[tid] = rli; slf[tid] = rlf; }
            __syncthreads();
            if (ch + 1 < 64) SM_LOAD(ch + 1);
            for (int i = 0; i < 64; ++i) {
                const float li = sli[i], lf = slf[i];
                const float mn = fmaxf(lf + m, li), fg = __expf(lf + m - mn), ig = __expf(li - mn); m = mn;
                const float vt = bf2f(sv[i * 32 + vv]) * ig;
                float num = 0.f, den = 0.f;
#pragma unroll
                for (int hh = 0; hh < 2; ++hh) {
                    const v4u qv = *(const LAS v4u*)(sq + i * 256 + dg * 16 + hh * 8), kv = *(const LAS v4u*)(sk + i * 256 + dg * 16 + hh * 8);
                    const float qq[8] = {bflo(qv.x), bfhi(qv.x), bflo(qv.y), bfhi(qv.y), bflo(qv.z), bfhi(qv.z), bflo(qv.w), bfhi(qv.w)};
                    const float kk[8] = {bflo(kv.x), bfhi(kv.x), bflo(kv.y), bfhi(kv.y), bflo(kv.z), bfhi(kv.z), bflo(kv.w), bfhi(kv.w)};
#pragma unroll
                    for (int j = 0; j < 8; ++j) { const int jj = hh * 8 + j; C[jj] = fg * C[jj] + kk[j] * vt; nn[jj] = fg * nn[jj] + ig * kk[j]; num += qq[j] * C[jj]; den += qq[j] * nn[jj]; }
                }
                num = sum16(num); den = sum16(den);
                if (dg == 0) so[i * 32 + vv] = num / fmaxf(fabsf(den), __expf(-m));
            }
            __syncthreads();
            { const int rr = tid >> 3, c4 = (tid & 7) * 4; const f32x4 ov = *(const LAS f32x4*)(so + rr * 32 + c4);
                v2u w; w.x = pk2(ov[0], ov[1]); w.y = pk2(ov[2], ov[3]); *(GAS v2u*)(MV + (rowbase + (size_t)ch * 64 + rr) * D + h * 256 + vs * 32 + c4) = w; }
        }
#undef SM_LOAD
        __syncthreads();
    }
}

__device__ __forceinline__ void ph_post(const Ctx& c, int l) {
    const int tid = TID(), lane = tid & 63, wave = tid >> 6, gw = BID() * NWAVES + wave, NGW = gridDim.x * NWAVES;
    bf16* PJ = (bf16*)(c.ws + WS_PROJ);
    const bf16* OS = PJ + (size_t)P_OS * PSTRIDE; bf16* BO = PJ + (size_t)P_LF * PSTRIDE;
    const bf16* HM = (const bf16*)(c.ws + WS_H); const bf16* XC = (const bf16*)(c.ws + WS_XC);
    float gnm[2][8], skp[2][8];
#pragma unroll
    for (int j = 0; j < 2; ++j) { const int c0 = 8 * lane + 512 * j;
        const f32x4 b0 = *(const GAS f32x4*)(c.in[I_MGN] + (size_t)l * D + c0), b1 = *(const GAS f32x4*)(c.in[I_MGN] + (size_t)l * D + c0 + 4);
        const f32x4 s0 = *(const GAS f32x4*)(c.in[I_MSKIP] + (size_t)l * D + c0), s1 = *(const GAS f32x4*)(c.in[I_MSKIP] + (size_t)l * D + c0 + 4);
#pragma unroll
        for (int e = 0; e < 4; ++e) { gnm[j][e] = b0[e]; gnm[j][4 + e] = b1[e]; skp[j][e] = s0[e]; skp[j][4 + e] = s1[e]; } }
#define POST_LOAD(R, ro_) do { _Pragma("unroll") for (int j = 0; j < 2; ++j) { const size_t o_ = (ro_) + 8 * lane + 512 * j; R[0][j] = *(const GAS v4u*)(HM + o_); R[1][j] = *(const GAS v4u*)(XC + o_); R[2][j] = *(const GAS v4u*)(OS + o_); } } while (0)
#define UNPK8(F_, W_) do { const v4u q_ = (W_); F_[0] = bflo(q_.x); F_[1] = bfhi(q_.x); F_[2] = bflo(q_.y); F_[3] = bfhi(q_.y); F_[4] = bflo(q_.z); F_[5] = bfhi(q_.z); F_[6] = bflo(q_.w); F_[7] = bfhi(q_.w); } while (0)
    for (int slot = gw; slot < M / 16; slot += NGW) {
        v4u ra[3][2], rb[3][2], rc[3][2];
        POST_LOAD(ra, (size_t)(slot * 16) * D); POST_LOAD(rb, (size_t)(slot * 16 + 1) * D);
        for (int r = 0; r < 16; ++r) {
            const size_t ro = (size_t)(slot * 16 + r) * D;
            if (r + 2 < 16) POST_LOAD(rc, ro + 2 * D);
#pragma unroll
            for (int j = 0; j < 2; ++j) {
                float hm[8], xc[8], orw[8], bo[8];
                UNPK8(hm, ra[0][j]); UNPK8(xc, ra[1][j]); UNPK8(orw, ra[2][j]);
                float sm = 0.f;
#pragma unroll
                for (int e = 0; e < 8; ++e) sm += hm[e];
                const float mu = half_sum(sm) * (1.0f / 256.0f);
                float vs_ = 0.f;
#pragma unroll
                for (int e = 0; e < 8; ++e) { hm[e] -= mu; vs_ += hm[e] * hm[e]; }
                const float rsb = rsqrtf(half_sum(vs_) * (1.0f / 256.0f) + EPS);
#pragma unroll
                for (int e = 0; e < 8; ++e) bo[e] = fsigr(orw[e]) * (hm[e] * rsb * gnm[j][e] + skp[j][e] * xc[e]);
                *(GAS v4u*)(BO + ro + 8 * lane + 512 * j) = (v4u){pk2(bo[0], bo[1]), pk2(bo[2], bo[3]), pk2(bo[4], bo[5]), pk2(bo[6], bo[7])};
            }
#pragma unroll
            for (int s = 0; s < 3; ++s)
#pragma unroll
                for (int j = 0; j < 2; ++j) { ra[s][j] = rb[s][j]; rb[s][j] = rc[s][j]; }
        }
    }
#undef POST_LOAD
#undef UNPK8
}
typedef short bf16x8 __attribute__((ext_vector_type(8)));
#define MFMA16(a, b, c) __builtin_amdgcn_mfma_f32_16x16x32_bf16(a, b, c, 0, 0, 0)
__device__ __forceinline__ f32x4 mmT(const LAS bf16* X, int ldx, int m0, const LAS bf16* Y, int ldy, int n0, int k0, f32x4 acc, int lane) {
    const bf16x8 a = *(const LAS bf16x8*)(X + (m0 + (lane & 15)) * ldx + k0 + 8 * (lane >> 4));
    const bf16x8 b = *(const LAS bf16x8*)(Y + (n0 + (lane & 15)) * ldy + k0 + 8 * (lane >> 4));
    return MFMA16(b, a, acc);
}
__device__ __forceinline__ f32x4 mmN(const LAS bf16* X, int ldx, int m0, const LAS bf16* Y, int ldy, int n0, int k0, f32x4 acc, int lane) {
    const bf16x8 a = *(const LAS bf16x8*)(X + (m0 + (lane & 15)) * ldx + k0 + 8 * (lane >> 4));
    const bf16x8 b = *(const LAS bf16x8*)(Y + (n0 + (lane & 15)) * ldy + k0 + 8 * (lane >> 4));
    return MFMA16(a, b, acc);
}
__device__ __forceinline__ v2u pack4(const f32x4 v) { v2u w; w.x = pk2(v[0], v[1]); w.y = pk2(v[2], v[3]); return w; }

__device__ __forceinline__ bf16x8 tr_frag(const LAS bf16* T, int ld, int k0, int m0, int lane) {
    const int g = lane >> 4, q = (lane & 15) >> 2, p = lane & 3;
    const unsigned a0 = (unsigned)(size_t)(T + (k0 + 8 * g + q) * ld + m0 + 4 * p), a1 = a0 + (unsigned)(4 * ld * 2);
    v2u x, y; asm volatile("ds_read_b64_tr_b16 %0, %2\n\tds_read_b64_tr_b16 %1, %3\n\ts_waitcnt lgkmcnt(0)" : "=&v"(x), "=&v"(y) : "v"(a0), "v"(a1) : "memory");
    const v4u w = {x.x, x.y, y.x, y.y}; return __builtin_bit_cast(bf16x8, w);
}
struct Frag2 { bf16x8 a, b; };
__device__ __forceinline__ Frag2 tr_frag2(const LAS bf16* Ta, int lda, int k0a, int m0a, const LAS bf16* Tb, int ldb, int k0b, int m0b, int lane) {
    const int g = lane >> 4, q = (lane & 15) >> 2, p = lane & 3;
    const unsigned a0 = (unsigned)(size_t)(Ta + (k0a + 8 * g + q) * lda + m0a + 4 * p), a1 = a0 + (unsigned)(4 * lda * 2);
    const unsigned b0 = (unsigned)(size_t)(Tb + (k0b + 8 * g + q) * ldb + m0b + 4 * p), b1 = b0 + (unsigned)(4 * ldb * 2);
    v2u x, y, z, w; asm volatile("ds_read_b64_tr_b16 %0, %4\n\tds_read_b64_tr_b16 %1, %5\n\tds_read_b64_tr_b16 %2, %6\n\tds_read_b64_tr_b16 %3, %7\n\ts_waitcnt lgkmcnt(0)"
        : "=&v"(x), "=&v"(y), "=&v"(z), "=&v"(w) : "v"(a0), "v"(a1), "v"(b0), "v"(b1) : "memory");
    const v4u wa = {x.x, x.y, y.x, y.y}, wb = {z.x, z.y, w.x, w.y}; Frag2 r; r.a = __builtin_bit_cast(bf16x8, wa); r.b = __builtin_bit_cast(bf16x8, wb); return r;
}
#define TRH(P_, Q_) __builtin_bit_cast(bf16x8, (v4u){(P_).x, (P_).y, (Q_).x, (Q_).y})
__device__ __forceinline__ void tr_hgrn(const LAS bf16* LV, const LAS bf16* LK, int wave, int lane, bf16x8 (&vf)[4][2], bf16x8 (&kf)[2]) {
    const int g = lane >> 4, q = (lane & 15) >> 2, p = lane & 3;
    const unsigned av = (unsigned)(size_t)(LV + (8 * g + q) * 72 + 4 * p), ak = (unsigned)(size_t)(LK + (8 * g + q) * 136 + 4 * p + wave * 16);
    v2u a0, a1, a2, a3, a4, a5, a6, a7, b0, b1, b2, b3, b4, b5, b6, b7, k0, k1, k2, k3;
    asm volatile(
        "ds_read_b64_tr_b16 %0, %20\n\tds_read_b64_tr_b16 %1, %20 offset:576\n\tds_read_b64_tr_b16 %2, %20 offset:32\n\tds_read_b64_tr_b16 %3, %20 offset:608\n\t"
        "ds_read_b64_tr_b16 %4, %20 offset:64\n\tds_read_b64_tr_b16 %5, %20 offset:640\n\tds_read_b64_tr_b16 %6, %20 offset:96\n\tds_read_b64_tr_b16 %7, %20 offset:672\n\t"
        "ds_read_b64_tr_b16 %8, %20 offset:4608\n\tds_read_b64_tr_b16 %9, %20 offset:5184\n\tds_read_b64_tr_b16 %10, %20 offset:4640\n\tds_read_b64_tr_b16 %11, %20 offset:5216\n\t"
        "ds_read_b64_tr_b16 %12, %20 offset:4672\n\tds_read_b64_tr_b16 %13, %20 offset:5248\n\tds_read_b64_tr_b16 %14, %20 offset:4704\n\tds_read_b64_tr_b16 %15, %20 offset:5280\n\t"
        "ds_read_b64_tr_b16 %16, %21\n\tds_read_b64_tr_b16 %17, %21 offset:1088\n\tds_read_b64_tr_b16 %18, %21 offset:8704\n\tds_read_b64_tr_b16 %19, %21 offset:9792\n\t"
        "s_waitcnt lgkmcnt(0)"
        : "=&v"(a0), "=&v"(a1), "=&v"(a2), "=&v"(a3), "=&v"(a4), "=&v"(a5), "=&v"(a6), "=&v"(a7), "=&v"(b0), "=&v"(b1), "=&v"(b2), "=&v"(b3), "=&v"(b4), "=&v"(b5), "=&v"(b6), "=&v"(b7),
          "=&v"(k0), "=&v"(k1), "=&v"(k2), "=&v"(k3)
        : "v"(av), "v"(ak) : "memory");
    vf[0][0] = TRH(a0, a1); vf[1][0] = TRH(a2, a3); vf[2][0] = TRH(a4, a5); vf[3][0] = TRH(a6, a7);
    vf[0][1] = TRH(b0, b1); vf[1][1] = TRH(b2, b3); vf[2][1] = TRH(b4, b5); vf[3][1] = TRH(b6, b7);
    kf[0] = TRH(k0, k1); kf[1] = TRH(k2, k3);
}
__device__ __forceinline__ void tr_mnum(const LAS bf16* LV0, int e0, int lane, bf16x8 (&f)[3][2]) {
    const int g = lane >> 4, q = (lane & 15) >> 2, p = lane & 3;
    const unsigned av = (unsigned)(size_t)(LV0 + (8 * g + q) * 88 + 4 * p + e0), ad = (unsigned)(size_t)(LV0 + (8 * g + q) * 88 + 4 * p + 64);
    v2u a0, a1, a2, a3, a4, a5, b0, b1, b2, b3, b4, b5;
    asm volatile(
        "ds_read_b64_tr_b16 %0, %12\n\tds_read_b64_tr_b16 %1, %12 offset:704\n\tds_read_b64_tr_b16 %2, %12 offset:32\n\tds_read_b64_tr_b16 %3, %12 offset:736\n\tds_read_b64_tr_b16 %4, %13\n\tds_read_b64_tr_b16 %5, %13 offset:704\n\t"
        "ds_read_b64_tr_b16 %6, %12 offset:5632\n\tds_read_b64_tr_b16 %7, %12 offset:6336\n\tds_read_b64_tr_b16 %8, %12 offset:5664\n\tds_read_b64_tr_b16 %9, %12 offset:6368\n\tds_read_b64_tr_b16 %10, %13 offset:5632\n\tds_read_b64_tr_b16 %11, %13 offset:6336\n\t"
        "s_waitcnt lgkmcnt(0)"
        : "=&v"(a0), "=&v"(a1), "=&v"(a2), "=&v"(a3), "=&v"(a4), "=&v"(a5), "=&v"(b0), "=&v"(b1), "=&v"(b2), "=&v"(b3), "=&v"(b4), "=&v"(b5)
        : "v"(av), "v"(ad) : "memory");
    f[0][0] = TRH(a0, a1); f[1][0] = TRH(a2, a3); f[2][0] = TRH(a4, a5); f[0][1] = TRH(b0, b1); f[1][1] = TRH(b2, b3); f[2][1] = TRH(b4, b5);
}
template <int KS> __device__ __forceinline__ void tr_mupd(const LAS bf16* LK, const LAS bf16* LV1, int wave, int lane, bf16x8 (&af)[2], bf16x8 (&wf)[5]) {
    const int g = lane >> 4, q = (lane & 15) >> 2, p = lane & 3;
    const unsigned ak = (unsigned)(size_t)(LK + (KS * 32 + 8 * g + q) * 264 + 4 * p + wave * 32), av = (unsigned)(size_t)(LV1 + (KS * 32 + 8 * g + q) * 88 + 4 * p);
    v2u k0, k1, k2, k3, a0, a1, a2, a3, a4, a5, a6, a7, a8, a9;
    asm volatile(
        "ds_read_b64_tr_b16 %0, %14\n\tds_read_b64_tr_b16 %1, %14 offset:2112\n\tds_read_b64_tr_b16 %2, %14 offset:32\n\tds_read_b64_tr_b16 %3, %14 offset:2144\n\t"
        "ds_read_b64_tr_b16 %4, %15\n\tds_read_b64_tr_b16 %5, %15 offset:704\n\tds_read_b64_tr_b16 %6, %15 offset:32\n\tds_read_b64_tr_b16 %7, %15 offset:736\n\t"
        "ds_read_b64_tr_b16 %8, %15 offset:64\n\tds_read_b64_tr_b16 %9, %15 offset:768\n\tds_read_b64_tr_b16 %10, %15 offset:96\n\tds_read_b64_tr_b16 %11, %15 offset:800\n\t"
        "ds_read_b64_tr_b16 %12, %15 offset:128\n\tds_read_b64_tr_b16 %13, %15 offset:832\n\t"
        "s_waitcnt lgkmcnt(0)"
        : "=&v"(k0), "=&v"(k1), "=&v"(k2), "=&v"(k3), "=&v"(a0), "=&v"(a1), "=&v"(a2), "=&v"(a3), "=&v"(a4), "=&v"(a5), "=&v"(a6), "=&v"(a7), "=&v"(a8), "=&v"(a9)
        : "v"(ak), "v"(av) : "memory");
    af[0] = TRH(k0, k1); af[1] = TRH(k2, k3); wf[0] = TRH(a0, a1); wf[1] = TRH(a2, a3); wf[2] = TRH(a4, a5); wf[3] = TRH(a6, a7); wf[4] = TRH(a8, a9);
}
__device__ __forceinline__ float wave_scan_sum(float v, int lane) {
    v += dpp_f<0x111>(0.f, v); v += dpp_f<0x112>(0.f, v); v += dpp_f<0x114>(0.f, v); v += dpp_f<0x118>(0.f, v);
    const float r0 = rdlane_f(v, 15), r1 = rdlane_f(v, 31), r2 = rdlane_f(v, 47); const int row = lane >> 4;
    return v + (row == 1 ? r0 : row == 2 ? r0 + r1 : row == 3 ? (r0 + r1) + r2 : 0.f);
}
__device__ __forceinline__ float wave_scan_max(float v, int lane) {
    const float NI = -3.0e38f;
    v = fmaxf(v, dpp_f<0x111>(NI, v)); v = fmaxf(v, dpp_f<0x112>(NI, v)); v = fmaxf(v, dpp_f<0x114>(NI, v)); v = fmaxf(v, dpp_f<0x118>(NI, v));
    const float r0 = rdlane_f(v, 15), r1 = rdlane_f(v, 31), r2 = rdlane_f(v, 47); const int row = lane >> 4;
    return fmaxf(v, row == 1 ? r0 : row == 2 ? fmaxf(r0, r1) : row == 3 ? fmaxf(fmaxf(r0, r1), r2) : NI);
}
__device__ __forceinline__ void scan_a_unit(const Ctx& c, LAS unsigned char* lds, int u, int tid, int lane, int wave) {
    bf16* PJ = (bf16*)(c.ws + WS_PROJ);
    const bf16* Q = PJ + (size_t)P_QA * PSTRIDE; const bf16* LFp = PJ + (size_t)P_LF * PSTRIDE; const bf16* V = PJ + (size_t)P_VA * PSTRIDE; bf16* OA = PJ + (size_t)P_XM * PSTRIDE;
    LAS bf16* LQ = (LAS bf16*)lds;
    LAS bf16* LK = (LAS bf16*)(lds + 17408);
    LAS bf16* LV = (LAS bf16*)(lds + 34816);
    LAS bf16* LP = (LAS bf16*)(lds + 44032);
    LAS bf16* LST = (LAS bf16*)(lds + 53248);
    LAS float* SEG = (LAS float*)(lds + 70656);
    LAS float* ER = (LAS float*)(lds + 74752);
    LAS float* EB = (LAS float*)(lds + 75264);
    LAS float* EK = (LAS float*)(lds + 75776);
    const int ux = u & 7, uk = u >> 3, bh_ = ux * 8 + (uk >> 1), vs = uk & 1, b = bh_ >> 3, h = bh_ & 7;
    const size_t rowbase = (size_t)b * SEQ;
    f32x4 S[4];
#pragma unroll
    for (int j = 0; j < 4; ++j) S[j] = (f32x4){0.f, 0.f, 0.f, 0.f};
    unsigned rq[8], rf[8]; v4u rv;
#define SA_LOAD(ch) do { const int lo_ = opq_v(wave * 8 * D + h * 128 + 2 * lane), lv_ = opq_v((tid >> 3) * D + h * 128 + vs * 64 + (tid & 7) * 8); const size_t cb_ = (rowbase + (size_t)(ch) * 64) * D; \
        const GAS bf16* qp_ = (const GAS bf16*)Q + cb_ + lo_; const GAS bf16* fp_ = (const GAS bf16*)LFp + cb_ + lo_; \
        _Pragma("unroll") for (int i = 0; i < 8; ++i) { rq[i] = *(const GAS unsigned*)(qp_ + (size_t)i * D); rf[i] = *(const GAS unsigned*)(fp_ + (size_t)i * D); } \
        rv = *(const GAS v4u*)((const GAS bf16*)V + cb_ + lv_); } while (0)
    SA_LOAD(0);
    for (int ch = 0; ch < 64; ++ch) {
        float f0[8], f1[8], q0[8], q1[8]; float run0 = 0.f, run1 = 0.f;
#pragma unroll
        for (int i = 0; i < 8; ++i) { const float a0 = bflo(rf[i]), a1 = bfhi(rf[i]); f0[i] = __expf(a0); f1[i] = __expf(a1); run0 += a0; run1 += a1; q0[i] = bflo(rq[i]); q1[i] = bfhi(rq[i]); }
        *(LAS f32x2*)(SEG + wave * 128 + 2 * lane) = (f32x2){run0, run1};
        const v4u rvc = rv;
        if (ch + 1 < 64) SA_LOAD(ch + 1);
        __syncthreads();
        float pre0 = 0.f, pre1 = 0.f, r0 = 0.f, r1 = 0.f, t0_ = 0.f, t1_ = 0.f;
#pragma unroll
        for (int w = 0; w < 8; ++w) { const f32x2 sg = *(const LAS f32x2*)(SEG + w * 128 + 2 * lane); if (w < wave) { pre0 += sg.x; pre1 += sg.y; } if (w < 4) { r0 += sg.x; r1 += sg.y; } t0_ += sg.x; t1_ += sg.y; }
        *(LAS v4u*)(LV + (tid >> 3) * 72 + (tid & 7) * 8) = rvc;
        {   float g0 = __expf(pre0 - r0), g1 = __expf(pre1 - r1), e0 = __expf(r0 - (pre0 + run0)), e1 = __expf(r1 - (pre1 + run1));
            unsigned kq[8];
#pragma unroll
            for (int i = 0; i < 8; ++i) { g0 *= f0[i]; g1 *= f1[i]; *(LAS unsigned*)(LQ + (wave * 8 + i) * 136 + 2 * lane) = pk2(q0[i] * g0, q1[i] * g1); }
#pragma unroll
            for (int i = 7; i >= 0; --i) { kq[i] = pk2((1.0f - f0[i]) * e0, (1.0f - f1[i]) * e1); e0 *= f0[i]; e1 *= f1[i]; }
#pragma unroll
            for (int i = 0; i < 8; ++i) *(LAS unsigned*)(LK + (wave * 8 + i) * 136 + 2 * lane) = kq[i];
        }
        if (wave == 0) { *(LAS f32x2*)(ER + 2 * lane) = (f32x2){__expf(r0), __expf(r1)}; *(LAS f32x2*)(EB + 2 * lane) = (f32x2){__expf(t0_), __expf(t1_)}; *(LAS f32x2*)(EK + 2 * lane) = (f32x2){__expf(t0_ - r0), __expf(t1_ - r1)}; }
        __syncthreads();
        {
            const int tt = wave >> 1;
#pragma unroll
            for (int jj = 0; jj < 2; ++jj) { const int st = (wave & 1) * 2 + jj; f32x4 acc = {0.f, 0.f, 0.f, 0.f};
                if (st <= tt) {
#pragma unroll
                    for (int kk = 0; kk < 4; ++kk) acc = mmT(LQ, 136, tt * 16, LK, 136, st * 16, kk * 32, acc, lane);
                    if (st == tt) {
#pragma unroll
                        for (int e = 0; e < 4; ++e) if (4 * (lane >> 4) + e > (lane & 15)) acc[e] = 0.f; } }
                *(LAS v2u*)(LP + (tt * 16 + (lane & 15)) * 72 + st * 16 + 4 * (lane >> 4)) = pack4(acc); }
            const f32x4 er4 = *(const LAS f32x4*)(ER + wave * 16 + 4 * (lane >> 4));
#pragma unroll
            for (int j = 0; j < 4; ++j) *(LAS v2u*)(LST + (j * 16 + (lane & 15)) * 136 + wave * 16 + 4 * (lane >> 4)) = pack4(S[j] * er4);
        }
        __syncthreads();
        {
            bf16x8 vfr[4][2], kfv[2]; tr_hgrn(LV, LK, wave, lane, vfr, kfv);
            const bf16x8 vf00 = vfr[0][0], vf10 = vfr[1][0], vf20 = vfr[2][0], vf30 = vfr[3][0], vf01 = vfr[0][1], vf11 = vfr[1][1], vf21 = vfr[2][1], vf31 = vfr[3][1];
            struct { bf16x8 a, b; } kfr; kfr.a = kfv[0]; kfr.b = kfv[1];
            const int t0 = (wave >> 1) * 16; const bool hi = (wave & 1) != 0;
            const bf16x8 pf0 = *(const LAS bf16x8*)(LP + (t0 + (lane & 15)) * 72 + 8 * (lane >> 4)), pf1 = *(const LAS bf16x8*)(LP + (t0 + (lane & 15)) * 72 + 32 + 8 * (lane >> 4));
            f32x4 o0 = {0.f, 0.f, 0.f, 0.f}, o1 = o0;
            o0 = MFMA16(hi ? vf20 : vf00, pf0, o0); o0 = MFMA16(hi ? vf21 : vf01, pf1, o0);
            o1 = MFMA16(hi ? vf30 : vf10, pf0, o1); o1 = MFMA16(hi ? vf31 : vf11, pf1, o1);
            const int e0 = hi ? 32 : 0;
#pragma unroll
            for (int kk = 0; kk < 4; ++kk) { const bf16x8 qf = *(const LAS bf16x8*)(LQ + (t0 + (lane & 15)) * 136 + kk * 32 + 8 * (lane >> 4));
                const bf16x8 s0f = *(const LAS bf16x8*)(LST + (e0 + (lane & 15)) * 136 + kk * 32 + 8 * (lane >> 4)), s1f = *(const LAS bf16x8*)(LST + (e0 + 16 + (lane & 15)) * 136 + kk * 32 + 8 * (lane >> 4));
                o0 = MFMA16(s0f, qf, o0); o1 = MFMA16(s1f, qf, o1); }
            GAS bf16* op = (GAS bf16*)OA + (rowbase + (size_t)ch * 64) * D + opq_v((t0 + (lane & 15)) * D + h * 128 + vs * 64 + e0 + 4 * (lane >> 4));
            *(GAS v2u*)op = pack4(o0); *(GAS v2u*)(op + 16) = pack4(o1);
            const f32x4 eb4 = *(const LAS f32x4*)(EB + wave * 16 + 4 * (lane >> 4)), ek4 = *(const LAS f32x4*)(EK + wave * 16 + 4 * (lane >> 4));
            f32x4 up;
            up = (f32x4){0.f, 0.f, 0.f, 0.f}; up = MFMA16(kfr.a, vf00, up); up = MFMA16(kfr.b, vf01, up); S[0] = eb4 * S[0] + ek4 * up;
            up = (f32x4){0.f, 0.f, 0.f, 0.f}; up = MFMA16(kfr.a, vf10, up); up = MFMA16(kfr.b, vf11, up); S[1] = eb4 * S[1] + ek4 * up;
            up = (f32x4){0.f, 0.f, 0.f, 0.f}; up = MFMA16(kfr.a, vf20, up); up = MFMA16(kfr.b, vf21, up); S[2] = eb4 * S[2] + ek4 * up;
            up = (f32x4){0.f, 0.f, 0.f, 0.f}; up = MFMA16(kfr.a, vf30, up); up = MFMA16(kfr.b, vf31, up); S[3] = eb4 * S[3] + ek4 * up;
        }
    }
#undef SA_LOAD
    __syncthreads();
}

__device__ __forceinline__ void tr_v4(const LAS bf16* LVe, int lane, bf16x8 (&vf)[4][2]) {
    const int g = lane >> 4, q = (lane & 15) >> 2, p = lane & 3;
    const unsigned av = (unsigned)(size_t)(LVe + (8 * g + q) * 136 + 4 * p);
    v2u a0, a1, a2, a3, a4, a5, a6, a7, b0, b1, b2, b3, b4, b5, b6, b7;
    asm volatile(
        "ds_read_b64_tr_b16 %0, %16\n\tds_read_b64_tr_b16 %1, %16 offset:1088\n\tds_read_b64_tr_b16 %2, %16 offset:32\n\tds_read_b64_tr_b16 %3, %16 offset:1120\n\t"
        "ds_read_b64_tr_b16 %4, %16 offset:64\n\tds_read_b64_tr_b16 %5, %16 offset:1152\n\tds_read_b64_tr_b16 %6, %16 offset:96\n\tds_read_b64_tr_b16 %7, %16 offset:1184\n\t"
        "ds_read_b64_tr_b16 %8, %16 offset:8704\n\tds_read_b64_tr_b16 %9, %16 offset:9792\n\tds_read_b64_tr_b16 %10, %16 offset:8736\n\tds_read_b64_tr_b16 %11, %16 offset:9824\n\t"
        "ds_read_b64_tr_b16 %12, %16 offset:8768\n\tds_read_b64_tr_b16 %13, %16 offset:9856\n\tds_read_b64_tr_b16 %14, %16 offset:8800\n\tds_read_b64_tr_b16 %15, %16 offset:9888\n\t"
        "s_waitcnt lgkmcnt(0)"
        : "=&v"(a0), "=&v"(a1), "=&v"(a2), "=&v"(a3), "=&v"(a4), "=&v"(a5), "=&v"(a6), "=&v"(a7), "=&v"(b0), "=&v"(b1), "=&v"(b2), "=&v"(b3), "=&v"(b4), "=&v"(b5), "=&v"(b6), "=&v"(b7)
        : "v"(av) : "memory");
    vf[0][0] = TRH(a0, a1); vf[1][0] = TRH(a2, a3); vf[2][0] = TRH(a4, a5); vf[3][0] = TRH(a6, a7);
    vf[0][1] = TRH(b0, b1); vf[1][1] = TRH(b2, b3); vf[2][1] = TRH(b4, b5); vf[3][1] = TRH(b6, b7);
}
__device__ __forceinline__ void tr_k2(const LAS bf16* LK, int wave, int lane, bf16x8 (&kf)[2]) {
    const int g = lane >> 4, q = (lane & 15) >> 2, p = lane & 3;
    const unsigned ak = (unsigned)(size_t)(LK + (8 * g + q) * 136 + 4 * p + wave * 16);
    v2u k0, k1, k2, k3;
    asm volatile("ds_read_b64_tr_b16 %0, %4\n\tds_read_b64_tr_b16 %1, %4 offset:1088\n\tds_read_b64_tr_b16 %2, %4 offset:8704\n\tds_read_b64_tr_b16 %3, %4 offset:9792\n\ts_waitcnt lgkmcnt(0)"
        : "=&v"(k0), "=&v"(k1), "=&v"(k2), "=&v"(k3) : "v"(ak) : "memory");
    kf[0] = TRH(k0, k1); kf[1] = TRH(k2, k3);
}
#ifndef TPROBE
#define TPROBE -1
#endif
#ifndef TPS
#define TPS 0
#endif
#ifndef TPB
#define TPB 0
#endif
#define TS_MARK(UN_, K_) do { if (TPROBE == (UN_) && blockIdx.x == TPB && threadIdx.x == 0) { volatile LAS unsigned* mp_ = (volatile LAS unsigned*)(lds + MISC_OFF); const unsigned now_ = (unsigned)wall_clock64(); if (TPS == (K_)) mp_[16] += now_ - mp_[48]; mp_[48] = now_; } } while (0)
__device__ __forceinline__ void rd_sc12(unsigned aq, unsigned ak, v4u (&q)[4], v4u (&k0)[4], v4u (&k1)[4]) {
    asm volatile(
        "ds_read_b128 %0, %12\n\tds_read_b128 %1, %12 offset:64\n\tds_read_b128 %2, %12 offset:128\n\tds_read_b128 %3, %12 offset:192\n\t"
        "ds_read_b128 %4, %13\n\tds_read_b128 %5, %13 offset:64\n\tds_read_b128 %6, %13 offset:128\n\tds_read_b128 %7, %13 offset:192\n\t"
        "ds_read_b128 %8, %13 offset:4352\n\tds_read_b128 %9, %13 offset:4416\n\tds_read_b128 %10, %13 offset:4480\n\tds_read_b128 %11, %13 offset:4544\n\t"
        "s_waitcnt lgkmcnt(0)"
        : "=&v"(q[0]), "=&v"(q[1]), "=&v"(q[2]), "=&v"(q[3]), "=&v"(k0[0]), "=&v"(k0[1]), "=&v"(k0[2]), "=&v"(k0[3]), "=&v"(k1[0]), "=&v"(k1[1]), "=&v"(k1[2]), "=&v"(k1[3])
        : "v"(aq), "v"(ak) : "memory");
}
__device__ __forceinline__ void rd_qs10(unsigned aq, unsigned as, v4u (&q)[2], v4u (&x)[2][4]) {
    asm volatile(
        "ds_read_b128 %0, %10\n\tds_read_b128 %1, %10 offset:64\n\t"
        "ds_read_b128 %2, %11\n\tds_read_b128 %3, %11 offset:4352\n\tds_read_b128 %4, %11 offset:8704\n\tds_read_b128 %5, %11 offset:13056\n\t"
        "ds_read_b128 %6, %11 offset:64\n\tds_read_b128 %7, %11 offset:4416\n\tds_read_b128 %8, %11 offset:8768\n\tds_read_b128 %9, %11 offset:13120\n\t"
        "s_waitcnt lgkmcnt(0)"
        : "=&v"(q[0]), "=&v"(q[1]), "=&v"(x[0][0]), "=&v"(x[0][1]), "=&v"(x[0][2]), "=&v"(x[0][3]), "=&v"(x[1][0]), "=&v"(x[1][1]), "=&v"(x[1][2]), "=&v"(x[1][3])
        : "v"(aq), "v"(as) : "memory");
}
__device__ __forceinline__ void scan_a_full_unit(const Ctx& c, LAS unsigned char* lds, int u, int l, int tid, int lane, int wave) {
    bf16* PJ = (bf16*)(c.ws + WS_PROJ);
    const bf16* Q = PJ + (size_t)P_QA * PSTRIDE; const bf16* LFp = PJ + (size_t)P_LF * PSTRIDE; const bf16* V = PJ + (size_t)P_VA * PSTRIDE; const bf16* GR = PJ + (size_t)P_GA * PSTRIDE;
    bf16* AO = PJ + (size_t)P_QA * PSTRIDE;
    const float* GN = c.in[I_HGN] + (size_t)l * D;
    LAS bf16* LQ0 = (LAS bf16*)lds;
    LAS bf16* LK0 = (LAS bf16*)(lds + 34816);
    LAS bf16* LV = (LAS bf16*)(lds + 69632);
    LAS bf16* LP = (LAS bf16*)(lds + 87040);
    LAS bf16* LST = (LAS bf16*)(lds + 96256);
    LAS float* SEG = (LAS float*)(lds + 131328);
    LAS float* E0 = (LAS float*)(lds + 135424);
    LAS float* SS = (LAS float*)(lds + 138496);
    LAS float* GNL = (LAS float*)(lds + 139008);
    const int b = u >> 3, h = u & 7;
    const size_t rowbase = (size_t)b * SEQ;
    const int t0 = (wave >> 1) * 16, eh = (wave & 1) * 64;
    f32x4 S[8], po[4]; v2u pg[4];
#pragma unroll
    for (int j = 0; j < 8; ++j) S[j] = (f32x4){0.f, 0.f, 0.f, 0.f};
#pragma unroll
    for (int j = 0; j < 4; ++j) { po[j] = (f32x4){0.f, 0.f, 0.f, 0.f}; pg[j] = (v2u){0u, 0u}; }
    if (tid < 128) GNL[tid] = GN[h * 128 + tid];
    unsigned rq[8], rf[8]; v4u rv0, rv1;
    float f0[8], f1[8]; float run0 = 0.f, run1 = 0.f;
#define SF_LOADF(ch) do { const unsigned lo_ = (unsigned)opq_v((wave * 8 * D + h * 128 + 2 * lane) * 2); const GAS char* fb_ = (const GAS char*)((const GAS bf16*)LFp + (rowbase + (size_t)(ch) * 64) * D);     \
        _Pragma("unroll") for (int i = 0; i < 8; ++i) rf[i] = *(const GAS unsigned*)(fb_ + (lo_ + (unsigned)(i * D * 2))); } while (0)
#define SF_LOADQ(ch) do { const unsigned lo_ = (unsigned)opq_v((wave * 8 * D + h * 128 + 2 * lane) * 2); const GAS char* qb_ = (const GAS char*)((const GAS bf16*)Q + (rowbase + (size_t)(ch) * 64) * D); \
        _Pragma("unroll") for (int i = 0; i < 8; ++i) rq[i] = *(const GAS unsigned*)(qb_ + (lo_ + (unsigned)(i * D * 2))); } while (0)
#define SF_LOADV(ch) do { const unsigned lv_ = (unsigned)opq_v(((tid >> 4) * D + h * 128 + (tid & 15) * 8) * 2); const GAS char* vb_ = (const GAS char*)((const GAS bf16*)V + (rowbase + (size_t)(ch) * 64) * D); \
        rv0 = *(const GAS v4u*)(vb_ + lv_); rv1 = *(const GAS v4u*)(vb_ + (lv_ + (unsigned)(32 * D * 2))); } while (0)
#define SF_T() do { run0 = 0.f; run1 = 0.f; \
        _Pragma("unroll") for (int i = 0; i < 8; ++i) { const float a0 = bflo(rf[i]), a1 = bfhi(rf[i]); f0[i] = __builtin_amdgcn_exp2f(a0); f1[i] = __builtin_amdgcn_exp2f(a1); run0 += a0; run1 += a1; } \
        *(LAS f32x2*)(SEG + wave * 128 + 2 * lane) = (f32x2){run0, run1}; } while (0)
#define SF_A(PAR_) do { LAS bf16* LQn_ = LQ0 + (PAR_) * 8704; LAS bf16* LKn_ = LK0 + (PAR_) * 8704; LAS float* En_ = E0 + (PAR_) * 384; \
        float pre0 = 0.f, pre1 = 0.f, r0 = 0.f, r1 = 0.f, t0_ = 0.f, t1_ = 0.f; \
        _Pragma("unroll") for (int w = 0; w < 8; ++w) { const f32x2 sg = *(const LAS f32x2*)(SEG + w * 128 + 2 * lane); if (w < wave) { pre0 += sg.x; pre1 += sg.y; } if (w < 4) { r0 += sg.x; r1 += sg.y; } t0_ += sg.x; t1_ += sg.y; } \
        float g0 = __builtin_amdgcn_exp2f(pre0 - r0), g1 = __builtin_amdgcn_exp2f(pre1 - r1), e0 = __builtin_amdgcn_exp2f(r0 - (pre0 + run0)), e1 = __builtin_amdgcn_exp2f(r1 - (pre1 + run1)); unsigned kq[8]; \
        _Pragma("unroll") for (int i = 0; i < 8; ++i) { g0 *= f0[i]; g1 *= f1[i]; *(LAS unsigned*)(LQn_ + (wave * 8 + i) * 136 + 2 * lane) = pk2(bflo(rq[i]) * g0, bfhi(rq[i]) * g1); } \
        _Pragma("unroll") for (int i = 7; i >= 0; --i) { kq[i] = pk2((1.0f - f0[i]) * e0, (1.0f - f1[i]) * e1); e0 *= f0[i]; e1 *= f1[i]; } \
        _Pragma("unroll") for (int i = 0; i < 8; ++i) *(LAS unsigned*)(LKn_ + (wave * 8 + i) * 136 + 2 * lane) = kq[i]; \
        if (wave == 0) { *(LAS f32x2*)(En_ + 2 * lane) = (f32x2){__builtin_amdgcn_exp2f(r0), __builtin_amdgcn_exp2f(r1)}; *(LAS f32x2*)(En_ + 128 + 2 * lane) = (f32x2){__builtin_amdgcn_exp2f(t0_), __builtin_amdgcn_exp2f(t1_)}; *(LAS f32x2*)(En_ + 256 + 2 * lane) = (f32x2){__builtin_amdgcn_exp2f(t0_ - r0), __builtin_amdgcn_exp2f(t1_ - r1)}; } } while (0)
#define SF_FINAL(cp) do { const int lr_ = opq_v(lane & 15), lg_ = opq_v(lane >> 4); const f32x2 s2_ = *(const LAS f32x2*)(SS + 2 * (t0 + lr_)); \
        const float rs_ = rsqrtf((s2_.x + s2_.y) * (1.0f / 128.0f) + EPS); \
        _Pragma("unroll") for (int jj = 0; jj < 4; ++jj) { const int col_ = h * 128 + eh + 16 * jj + 4 * lg_; const f32x4 gn_ = *(const LAS f32x4*)(GNL + eh + 16 * jj + 4 * lg_); \
            const f32x4 gr_ = {bflo(pg[jj].x), bfhi(pg[jj].x), bflo(pg[jj].y), bfhi(pg[jj].y)}; f32x4 a_; \
            _Pragma("unroll") for (int e = 0; e < 4; ++e) a_[e] = po[jj][e] * rs_ * gn_[e] * gr_[e]; \
            *(GAS v2u*)((GAS char*)((GAS bf16*)AO + (rowbase + (size_t)(cp) * 64) * D) + (unsigned)(((t0 + lr_) * D + col_) * 2)) = pack4(a_); } } while (0)
    SF_LOADF(0); SF_LOADQ(0); SF_LOADV(0);
    SF_T(); SF_LOADF(1);
    __syncthreads();
    SF_A(0); SF_LOADQ(1);
    __syncthreads();
    for (int ch = 0; ch < 64; ++ch) {
        const int par = ch & 1;
        const LAS bf16* LQ = LQ0 + par * 8704; const LAS bf16* LK = LK0 + par * 8704; const LAS float* EC = E0 + par * 384;
        {
            const int tt = wave >> 1; f32x4 acc0 = {0.f, 0.f, 0.f, 0.f}, acc1 = acc0;
            if ((wave & 1) * 2 <= tt) {
                v4u qa[4], ka[4], kb[4];
                rd_sc12((unsigned)(size_t)(LQ + (tt * 16 + (lane & 15)) * 136 + 8 * (lane >> 4)), (unsigned)(size_t)(LK + ((wave & 1) * 32 + (lane & 15)) * 136 + 8 * (lane >> 4)), qa, ka, kb);
#pragma unroll
                for (int kk = 0; kk < 4; ++kk) { acc0 = MFMA16(__builtin_bit_cast(bf16x8, ka[kk]), __builtin_bit_cast(bf16x8, qa[kk]), acc0); acc1 = MFMA16(__builtin_bit_cast(bf16x8, kb[kk]), __builtin_bit_cast(bf16x8, qa[kk]), acc1); }
            }
#pragma unroll
            for (int jj = 0; jj < 2; ++jj) { const int st = (wave & 1) * 2 + jj; f32x4 acc = jj ? acc1 : acc0;
                if (st > tt) acc = (f32x4){0.f, 0.f, 0.f, 0.f};
                if (st == tt) {
#pragma unroll
                    for (int e = 0; e < 4; ++e) if (4 * (lane >> 4) + e > (lane & 15)) acc[e] = 0.f; }
                *(LAS v2u*)(LP + (tt * 16 + (lane & 15)) * 72 + st * 16 + 4 * (lane >> 4)) = pack4(acc); }
            const f32x4 er4 = *(const LAS f32x4*)(EC + wave * 16 + 4 * (lane >> 4));
#pragma unroll
            for (int j = 0; j < 8; ++j) *(LAS v2u*)(LST + (j * 16 + (lane & 15)) * 136 + wave * 16 + 4 * (lane >> 4)) = pack4(S[j] * er4);
        }
        TS_MARK(22, 2);
        __builtin_amdgcn_sched_barrier(0);
        if (ch > 0) SF_FINAL(ch - 1);
        __builtin_amdgcn_sched_barrier(0);
        { const GAS char* gb_ = (const GAS char*)((const GAS bf16*)GR + (rowbase + (size_t)ch * 64) * D); const unsigned go_ = (unsigned)opq_v(((t0 + (lane & 15)) * D + h * 128 + eh + 4 * (lane >> 4)) * 2);
#pragma unroll
          for (int jj = 0; jj < 4; ++jj) pg[jj] = *(const GAS v2u*)(gb_ + (go_ + (unsigned)(32 * jj))); }
        TS_MARK(22, 3);
        SF_T(); __builtin_amdgcn_sched_barrier(0);
        { const int c2 = (ch + 2 < 64) ? ch + 2 : 63; SF_LOADF(c2); }
        TS_MARK(22, 4);
        __builtin_amdgcn_sched_barrier(0);
        *(LAS v4u*)(LV + (tid >> 4) * 136 + (tid & 15) * 8) = rv0; *(LAS v4u*)(LV + (32 + (tid >> 4)) * 136 + (tid & 15) * 8) = rv1;
        __syncthreads();
        TS_MARK(22, 0);
        { const int c1 = (ch + 1 < 64) ? ch + 1 : 63; SF_LOADV(c1); }
        {
            bf16x8 kf[2]; tr_k2(LK, wave, lane, kf);
            const f32x4 eb4 = *(const LAS f32x4*)(EC + 128 + wave * 16 + 4 * (lane >> 4)), ek4 = *(const LAS f32x4*)(EC + 256 + wave * 16 + 4 * (lane >> 4));
            const bf16x8 pf0 = *(const LAS bf16x8*)(LP + (t0 + (lane & 15)) * 72 + 8 * (lane >> 4)), pf1 = *(const LAS bf16x8*)(LP + (t0 + (lane & 15)) * 72 + 32 + 8 * (lane >> 4));
#pragma unroll
            for (int jj = 0; jj < 4; ++jj) po[jj] = (f32x4){0.f, 0.f, 0.f, 0.f};
#pragma unroll
            for (int hb = 0; hb < 2; ++hb) {
                bf16x8 vf[4][2]; tr_v4(LV + hb * 64, lane, vf);
                if (hb == (wave & 1)) {
#pragma unroll
                    for (int jj = 0; jj < 4; ++jj) { po[jj] = MFMA16(vf[jj][0], pf0, po[jj]); po[jj] = MFMA16(vf[jj][1], pf1, po[jj]); }
                }
#pragma unroll
                for (int jj = 0; jj < 4; ++jj) { f32x4 up = {0.f, 0.f, 0.f, 0.f}; up = MFMA16(kf[0], vf[jj][0], up); up = MFMA16(kf[1], vf[jj][1], up); S[hb * 4 + jj] = eb4 * S[hb * 4 + jj] + ek4 * up; }
            }
#pragma unroll
            for (int k2 = 0; k2 < 2; ++k2) { v4u qf[2], sf[2][4];
                rd_qs10((unsigned)(size_t)(LQ + (t0 + (lane & 15)) * 136 + k2 * 64 + 8 * (lane >> 4)), (unsigned)(size_t)(LST + (eh + (lane & 15)) * 136 + k2 * 64 + 8 * (lane >> 4)), qf, sf);
#pragma unroll
                for (int kk = 0; kk < 2; ++kk)
#pragma unroll
                    for (int jj = 0; jj < 4; ++jj) po[jj] = MFMA16(__builtin_bit_cast(bf16x8, sf[kk][jj]), __builtin_bit_cast(bf16x8, qf[kk]), po[jj]); }
            float ssq = 0.f;
#pragma unroll
            for (int jj = 0; jj < 4; ++jj) ssq += (po[jj][0] * po[jj][0] + po[jj][1] * po[jj][1]) + (po[jj][2] * po[jj][2] + po[jj][3] * po[jj][3]);
            ssq += __shfl_xor(ssq, 16); ssq += __shfl_xor(ssq, 32);
            if (lane < 16) SS[2 * (t0 + lane) + (wave & 1)] = ssq;
        }
        __builtin_amdgcn_sched_barrier(0);
        SF_A(par ^ 1);
        { const int c2 = (ch + 2 < 64) ? ch + 2 : 63; SF_LOADQ(c2); }
        __syncthreads();
        TS_MARK(22, 1);
    }
    SF_FINAL(63);
#undef SF_LOADF
#undef SF_LOADQ
#undef SF_LOADV
#undef SF_T
#undef SF_A
#undef SF_FINAL
    __syncthreads();
}

__device__ __forceinline__ void scan_m_unit(const Ctx& c, LAS unsigned char* lds, int u, int tid, int lane, int wave) {
    const bf16* MQ = (const bf16*)(c.ws + WS_MQ); const bf16* MK = (const bf16*)(c.ws + WS_MK); const bf16* MV = (const bf16*)(c.ws + WS_MV); bf16* HM = (bf16*)(c.ws + WS_H);
    const GAS float* LI = (const GAS float*)(c.ws + WS_LI); const GAS float* LF = (const GAS float*)(c.ws + WS_LF);
    LAS bf16* LK = (LAS bf16*)lds;
    LAS bf16* LV0 = (LAS bf16*)(lds + 33792);
    LAS bf16* LV1 = (LAS bf16*)(lds + 45056);
    LAS bf16* LP = (LAS bf16*)(lds + 56320);
    LAS bf16* LCT = (LAS bf16*)(lds + 65536);
    LAS float* AS = (LAS float*)(lds + 107776);
    LAS float* MXS = (LAS float*)(lds + 108032);
    LAS float* BS = (LAS float*)(lds + 108288);
    const int ux = u & 7, uk = u >> 3, bh_ = ux * 4 + (uk >> 2), vs = uk & 3, b = bh_ >> 2, h = bh_ & 3;
    const size_t rowbase = (size_t)b * SEQ;
    const int t0 = (wave >> 1) * 16;
    f32x4 C[2][5];
#pragma unroll
    for (int i = 0; i < 2; ++i)
#pragma unroll
        for (int j = 0; j < 5; ++j) C[i][j] = (f32x4){0.f, 0.f, 0.f, 0.f};
    float m = 0.f;
    for (int i = tid; i < 64 * 24; i += NTHR) { const int row = i / 24, col = 64 + i % 24; LV0[row * 88 + col] = (bf16)(col == 64 ? 0x3f80u : 0u); LV1[row * 88 + col] = (bf16)0u; }
    v4u qf[8], rk[4], rv; float rli, rlf;
#define SM_LOAD(ch) do { const int lk_ = opq_v((tid >> 5) * D + h * 256 + (tid & 31) * 8), lv_ = opq_v((tid >> 3) * D + h * 256 + vs * 64 + (tid & 7) * 8), lg_ = opq_v(lane * 4 + h); \
        const GAS bf16* kp_ = (const GAS bf16*)MK + (rowbase + (size_t)(ch) * 64) * D + lk_; \
        _Pragma("unroll") for (int k2 = 0; k2 < 4; ++k2) rk[k2] = *(const GAS v4u*)(kp_ + (size_t)k2 * 16 * D); \
        rv = *(const GAS v4u*)((const GAS bf16*)MV + (rowbase + (size_t)(ch) * 64) * D + lv_); \
        rli = LI[(rowbase + (size_t)(ch) * 64) * 4 + lg_]; rlf = LF[(rowbase + (size_t)(ch) * 64) * 4 + lg_]; } while (0)
#define SM_LOADQ(ch) do { const int lq_ = opq_v((t0 + (lane & 15)) * D + h * 256 + 8 * (lane >> 4)); const GAS bf16* qp_ = (const GAS bf16*)MQ + (rowbase + (size_t)(ch) * 64) * D + lq_; \
        _Pragma("unroll") for (int kk = 0; kk < 8; ++kk) qf[kk] = *(const GAS v4u*)(qp_ + kk * 32); } while (0)
    SM_LOAD(0); SM_LOADQ(0);
    float nbb = wave_scan_sum(rlf, lane), naa = rli - nbb, npm = wave_scan_max(naa, lane);
    for (int ch = 0; ch < 64; ++ch) {
        const int lane0 = lane; const int lane = opq_v(lane0), tid = opq_v((wave << 6) | lane0);
        const int lr = lane & 15, lq4 = lane >> 4, bK = lr * 264 + 8 * lq4, bC = lr * 264 + 4 * lq4, bP8 = lr * 72 + 8 * lq4, bP4 = lr * 72 + 4 * lq4;
        __syncthreads();
        TS_MARK(21, 0);
        const float bb = nbb, aa = naa, pm = npm;
        const float mx = fmaxf(m, pm);
        const float b63 = rdlane_f(bb, 63), mx63 = rdlane_f(mx, 63);
        if (wave == 0) { AS[lane] = aa; MXS[lane] = mx; BS[lane] = bb; LV1[lane * 88 + 64] = (bf16)f2bf(__expf(aa - mx63)); }
        { const int p = tid; *(LAS v4u*)(LK + (p >> 5) * 264 + (p & 31) * 8) = rk[0]; *(LAS v4u*)(LK + ((p + 512) >> 5) * 264 + (p & 31) * 8) = rk[1]; *(LAS v4u*)(LK + ((p + 1024) >> 5) * 264 + (p & 31) * 8) = rk[2]; *(LAS v4u*)(LK + ((p + 1536) >> 5) * 264 + (p & 31) * 8) = rk[3]; }
        { const int rr = tid >> 3; const float wv = __expf(__shfl(aa, rr) - mx63); const v4u rvc = rv;
          *(LAS v4u*)(LV0 + rr * 88 + (tid & 7) * 8) = rvc;
          v4u sv; sv.x = pk2(bflo(rvc.x) * wv, bfhi(rvc.x) * wv); sv.y = pk2(bflo(rvc.y) * wv, bfhi(rvc.y) * wv); sv.z = pk2(bflo(rvc.z) * wv, bfhi(rvc.z) * wv); sv.w = pk2(bflo(rvc.w) * wv, bfhi(rvc.w) * wv);
          *(LAS v4u*)(LV1 + rr * 88 + (tid & 7) * 8) = sv; }
        const float m_old = m;
        if (ch + 1 < 64) SM_LOAD(ch + 1);
        __syncthreads();
        TS_MARK(21, 1);
        {
            const int tt = wave >> 1;
#pragma unroll
            for (int jj = 0; jj < 2; ++jj) { const int st = (wave & 1) * 2 + jj; f32x4 acc = {0.f, 0.f, 0.f, 0.f};
                if (st <= tt) {
#pragma unroll
                    for (int kk = 0; kk < 8; ++kk) { const bf16x8 kfr = *(const LAS bf16x8*)(LK + bK + st * (16 * 264) + kk * 32); acc = MFMA16(kfr, __builtin_bit_cast(bf16x8, qf[kk]), acc); if ((kk & 3) == 3) __builtin_amdgcn_sched_barrier(0); }
                    const f32x4 a4 = *(const LAS f32x4*)(AS + st * 16 + 4 * lq4); const float mxt = MXS[tt * 16 + lr];
#pragma unroll
                    for (int e = 0; e < 4; ++e) acc[e] = (st == tt && 4 * lq4 + e > lr) ? 0.f : acc[e] * __expf(a4[e] - mxt); }
                *(LAS v2u*)(LP + bP4 + tt * (16 * 72) + st * 16) = pack4(acc); }
#pragma unroll
            for (int i = 0; i < 2; ++i)
#pragma unroll
                for (int j = 0; j < 5; ++j) *(LAS v2u*)(LCT + bC + j * (16 * 264) + (wave * 2 + i) * 16) = pack4(C[i][j]);
        }
        __syncthreads();
        TS_MARK(21, 2);
        {
            const int e0 = (wave & 1) * 32; f32x4 p0 = {0.f, 0.f, 0.f, 0.f}, p1 = p0, pd = p0, c0 = p0, c1 = p0, cd = p0;
            { bf16x8 vn[3][2]; tr_mnum(LV0, e0, lane, vn);
#pragma unroll
              for (int kk = 0; kk < 2; ++kk) { const bf16x8 pf = *(const LAS bf16x8*)(LP + bP8 + t0 * 72 + kk * 32);
                p0 = MFMA16(vn[0][kk], pf, p0); p1 = MFMA16(vn[1][kk], pf, p1); pd = MFMA16(vn[2][kk], pf, pd); } }
#pragma unroll
            for (int kk = 0; kk < 8; ++kk) { const bf16x8 q8 = __builtin_bit_cast(bf16x8, qf[kk]);
                const LAS bf16* xb_ = LCT + bK + e0 * 264 + kk * 32; const bf16x8 x0 = *(const LAS bf16x8*)xb_, x1 = *(const LAS bf16x8*)(xb_ + 16 * 264), xd = *(const LAS bf16x8*)(LCT + bK + 64 * 264 + kk * 32);
                c0 = MFMA16(x0, q8, c0); c1 = MFMA16(x1, q8, c1); cd = MFMA16(xd, q8, cd); if (kk & 1) __builtin_amdgcn_sched_barrier(0); }
            const float mxt = MXS[t0 + lr], bt = BS[t0 + lr], wi = __expf(m_old - mxt);
            const float den = __shfl(pd[0] + wi * cd[0], lr);
            const float inv = __builtin_amdgcn_rcpf(fmaxf(fabsf(den), __expf(-(bt + mxt))));
            GAS bf16* hp = (GAS bf16*)HM + (rowbase + (size_t)ch * 64) * D + opq_v((t0 + (lane & 15)) * D + h * 256 + vs * 64 + e0 + 4 * (lane >> 4));
            *(GAS v2u*)hp = pack4((p0 + c0 * wi) * inv); *(GAS v2u*)(hp + 16) = pack4((p1 + c1 * wi) * inv);
            const float dec = __expf(m_old - mx63);
#pragma unroll
            for (int i = 0; i < 2; ++i)
#pragma unroll
                for (int j = 0; j < 5; ++j) C[i][j] = C[i][j] * dec;
            { bf16x8 af[2], wf[5];
              tr_mupd<0>(LK, LV1, wave, lane, af, wf);
#pragma unroll
              for (int j = 0; j < 5; ++j) { C[0][j] = MFMA16(af[0], wf[j], C[0][j]); C[1][j] = MFMA16(af[1], wf[j], C[1][j]); }
              tr_mupd<1>(LK, LV1, wave, lane, af, wf);
#pragma unroll
              for (int j = 0; j < 5; ++j) { C[0][j] = MFMA16(af[0], wf[j], C[0][j]); C[1][j] = MFMA16(af[1], wf[j], C[1][j]); } }
            m = b63 + mx63;
            if (ch + 1 < 64) SM_LOADQ(ch + 1);
            nbb = wave_scan_sum(rlf, lane); naa = rli - nbb; npm = wave_scan_max(naa, lane);
        }
    }
#undef SM_LOAD
#undef SM_LOADQ
    __syncthreads();
}
#ifndef DLY_A
#define DLY_A 0
#define DLY_M 0
#define DLY_C 0
#endif
__device__ __forceinline__ void ph_scans(const Ctx& c, LAS unsigned char* lds, int l) {
    const int tid = TID(), lane = tid & 63, wave = __builtin_amdgcn_readfirstlane(tid >> 6);
    for (int u = BID(); u < 256; u += gridDim.x) {
#if DLY_A || DLY_M || DLY_C
        { const int dl = (u < 64) ? DLY_A : (u < 192) ? DLY_M : DLY_C; for (int i = 0; i < dl; ++i) { __builtin_amdgcn_s_sleep(127); asm volatile("" ::: "memory"); } }
#endif
        if (u < 64) scan_a_full_unit(c, lds, u, l, tid, lane, wave);
        else if (u < 192) scan_m_unit(c, lds, u - 64, tid, lane, wave);
        else { if (l + 1 < DEPTH) { ph_cvt(c, l + 1, lds, u - 192, 64, 2, 1); __syncthreads(); } }
    }
}
constexpr int TAB_OFF = MISC_OFF + 256, UT_OFF = MISC_OFF + 512;
__device__ __forceinline__ void moe_tables(const Ctx& c, int jm, LAS unsigned char* lds) {
    LAS int* tab = (LAS int*)(lds + TAB_OFF);
    __syncthreads();
    const int t = TID();
    if (t < 64) {
        unsigned* cnt = (unsigned*)c.ws + CW_CNT + 64 * jm;
        const int n = (t < 8) ? (int)__hip_atomic_load(cnt + t, __ATOMIC_RELAXED, __HIP_MEMORY_SCOPE_AGENT) : 0;
        const int p = (n + 255) >> 8; int accp = 0, mine = 0;
#pragma unroll
        for (int e = 0; e < 8; ++e) { const int pe_ = __builtin_amdgcn_readlane(p, e); if (t == e) mine = accp; accp += pe_; }
        if (t < 8) { tab[t] = p; tab[8 + t] = mine; }
        if (t == 0) tab[16] = accp;
    }
    __syncthreads();
}
template <bool L0>
__device__ __forceinline__ void ph_res1(const Ctx& c, int l, LAS unsigned char* lds, int dry = 0) {
    const int tid = TID(), lane = tid & 63, wave = tid >> 6, gw = BID() * NWAVES + wave, NGW = gridDim.x * NWAVES;
    const bool moe = (l & 1) != 0; const int jm = l >> 1;
    LAS f32x4* rt = (LAS f32x4*)lds;
    if (moe) { const GAS f32x4* src = (const GAS f32x4*)(c.in[I_ROUTER] + (size_t)jm * D * NEXP); for (int i = tid; i < D * NEXP / 4; i += NTHR) { const int ch = i >> 1; rt[((ch & 3) * 2 + (i & 1)) * 256 + (ch >> 2)] = src[i]; } }
    __syncthreads();
    const float* xin = c.in[I_X]; bf16* XB = (bf16*)(c.ws + WS_XB);
    const bf16* Y = (const bf16*)(c.ws + WS_PROJ) + (size_t)P_OS * PSTRIDE; bf16* H = (bf16*)(c.ws + WS_H);
    unsigned* cnt = (unsigned*)c.ws + CW_CNT + 64 * jm;
    int* TOKEP = (int*)(c.ws + WS_TOKEP); float* TOKW = (float*)(c.ws + WS_TOKW);
    for (int slot = gw; slot < M / 16; slot += NGW) {
        const int row0 = slot * 16, b = row0 / SEQ;
        f32x4 gpm[4], gt[4], gpf[4], scf[4], shf[4];
        ld_row_f32(c.in[I_GPOSTMIX] + (size_t)l * D, lane, gpm); ld_row_f32(modp(c, l, b, 2), lane, gt); ld_row_f32(c.in[I_GPREFFN] + (size_t)l * D, lane, gpf);
        ld_row_f32(modp(c, l, b, 4), lane, scf); ld_row_f32(modp(c, l, b, 3), lane, shf);
        int my1 = 0, my2 = 0; float myw = 0.f;
        v2u ya[4], yb[4], pa[4], pb[4]; f32x4 xa[4], xb[4];
#pragma unroll
        for (int j = 0; j < 4; ++j) { pa[j] = (v2u){0u, 0u}; pb[j] = pa[j]; xa[j] = (f32x4){0.f, 0.f, 0.f, 0.f}; xb[j] = xa[j]; }
#define R1_LOAD(YR, XR, PR, ro_) do { _Pragma("unroll") for (int j = 0; j < 4; ++j) { YR[j] = *(const GAS v2u*)(Y + (ro_) + 4 * lane + 256 * j); if (L0) XR[j] = *(const GAS f32x4*)(xin + (ro_) + 4 * lane + 256 * j); else PR[j] = *(const GAS v2u*)(XB + (ro_) + 4 * lane + 256 * j); } } while (0)
        R1_LOAD(ya, xa, pa, (size_t)row0 * D);
        for (int r = 0; r < 16; ++r) {
            const int row = row0 + r; const size_t ro = (size_t)row * D;
            if (r + 1 < 16) R1_LOAD(yb, xb, pb, ro + D);
            f32x4 y[4], x[4], h[4];
#pragma unroll
            for (int j = 0; j < 4; ++j) { y[j] = (f32x4){bflo(ya[j].x), bfhi(ya[j].x), bflo(ya[j].y), bfhi(ya[j].y)};
                x[j] = L0 ? xa[j] : (f32x4){bflo(pa[j].x), bfhi(pa[j].x), bflo(pa[j].y), bfhi(pa[j].y)}; ya[j] = yb[j]; xa[j] = xb[j]; pa[j] = pb[j]; }
            const float rr = rsqrtf(row_sumsq(y) * (1.0f / 1024.0f) + EPS);
#pragma unroll
            for (int j = 0; j < 4; ++j) x[j] = x[j] + gt[j] * (y[j] * rr * gpm[j]);
            if (!dry) st_row_bf16(XB + ro, lane, x);
            norm_mod(x, gpf, scf, shf, h); if (!dry) st_row_bf16(H + ro, lane, h);
            if (moe) {
                f32x4 l0 = {0.f, 0.f, 0.f, 0.f}, l1 = l0;
#pragma unroll
                for (int j = 0; j < 4; ++j)
#pragma unroll
                    for (int i = 0; i < 4; ++i) { const int n = lane + 64 * j; l0 += rt[(i * 2) * 256 + n] * h[j][i]; l1 += rt[(i * 2 + 1) * 256 + n] * h[j][i]; }
                float lg[8];
#pragma unroll
                for (int e = 0; e < 4; ++e) { lg[e] = wave_sum(l0[e]); lg[4 + e] = wave_sum(l1[e]); }
                int i1 = 0; float v1 = lg[0];
#pragma unroll
                for (int e = 1; e < 8; ++e) if (lg[e] > v1) { v1 = lg[e]; i1 = e; }
                int i2 = -1; float v2 = -3.0e38f;
#pragma unroll
                for (int e = 0; e < 8; ++e) if (e != i1 && lg[e] > v2) { v2 = lg[e]; i2 = e; }
                if (lane == r) { my1 = i1; my2 = i2; myw = 1.0f / (1.0f + __expf(v2 - v1)); }
            }
        }
        if (moe && !dry) {
            const bool act = lane < 16; const unsigned long long below = (1ull << lane) - 1ull;
            int p1 = 0, p2 = 0;
            unsigned long long m1[8], m2[8]; int cn = 0;
#pragma unroll
            for (int e = 0; e < 8; ++e) { m1[e] = __ballot(act && my1 == e); m2[e] = __ballot(act && my2 == e); if (lane == e) cn = __popcll(m1[e]) + __popcll(m2[e]); }
            int basev = 0; if (lane < 8 && cn > 0) basev = (int)atomicAdd(cnt + lane, (unsigned)cn);
#pragma unroll
            for (int e = 0; e < 8; ++e) { const int be = __builtin_amdgcn_readlane(basev, e);
                if (my1 == e) p1 = be + __popcll(m1[e] & below);
                if (my2 == e) p2 = be + __popcll(m1[e]) + __popcll(m2[e] & below); }
            if (act) { *(GAS i32x4*)(TOKEP + (size_t)(row0 + lane) * 4) = (i32x4){my1, p1, my2, p2}; *(GAS f32x2*)(TOKW + (size_t)(row0 + lane) * 2) = (f32x2){myw, 1.0f - myw}; }
        }
    }
}
__device__ __forceinline__ void ph_gather(const Ctx& c, int l, LAS unsigned char* lds) {
    const int tid = TID(), lane = tid & 63, wave = tid >> 6, gw = BID() * NWAVES + wave, NGW = gridDim.x * NWAVES;
    moe_tables(c, l >> 1, lds); const LAS int* tab = (const LAS int*)(lds + TAB_OFF);
    const bf16* H = (const bf16*)(c.ws + WS_H); bf16* AG = (bf16*)(c.ws + WS_AG);
    const int* TOKEP = (const int*)(c.ws + WS_TOKEP); int* TOKD = (int*)(c.ws + WS_TOKD);
    for (int row0 = gw; row0 < M; row0 += 4 * NGW) {
        i32x4 ep[4]; v4u ra[4], rb[4];
#pragma unroll
        for (int k = 0; k < 4; ++k) { const int row = (row0 + k * NGW < M) ? row0 + k * NGW : row0; ep[k] = *(const GAS i32x4*)(TOKEP + (size_t)row * 4);
            ra[k] = *(const GAS v4u*)(H + (size_t)row * D + lane * 8); rb[k] = *(const GAS v4u*)(H + (size_t)row * D + 512 + lane * 8); }
#pragma unroll
        for (int k = 0; k < 4; ++k) { const int row = row0 + k * NGW; if (row >= M) continue;
            const int d1 = tab[8 + ep[k].x] * 256 + ep[k].y, d2 = tab[8 + ep[k].z] * 256 + ep[k].w;
            *(GAS v4u*)(AG + (size_t)d1 * D + lane * 8) = ra[k]; *(GAS v4u*)(AG + (size_t)d1 * D + 512 + lane * 8) = rb[k];
            *(GAS v4u*)(AG + (size_t)d2 * D + lane * 8) = ra[k]; *(GAS v4u*)(AG + (size_t)d2 * D + 512 + lane * 8) = rb[k];
            if (lane == 0) *(GAS i32x2*)(TOKD + (size_t)row * 2) = (i32x2){d1, d2}; }
    }
}
__device__ __forceinline__ void ph_res2(const Ctx& c, int l, int dry = 0) {
    const int tid = TID(), lane = tid & 63, wave = tid >> 6, gw = BID() * NWAVES + wave, NGW = gridDim.x * NWAVES;
    const bool moe = (l & 1) != 0;
    const bf16* Y2 = (const bf16*)(c.ws + WS_PROJ) + (size_t)4 * PSTRIDE; const bf16* YS = (const bf16*)(c.ws + WS_YS); bf16* H = (bf16*)(c.ws + WS_H); bf16* XB = (bf16*)(c.ws + WS_XB);
    const int* TOKD = (const int*)(c.ws + WS_TOKD); const float* TOKW = (const float*)(c.ws + WS_TOKW);
    const int ln = (l + 1 < DEPTH) ? l + 1 : l;
    for (int slot = gw; slot < M / 16; slot += NGW) {
        const int row0 = slot * 16, b = row0 / SEQ;
        f32x4 gpo[4], gt[4], gpm[4], scm[4], shm[4];
        ld_row_f32(c.in[I_GPOSTFFN] + (size_t)l * D, lane, gpo); ld_row_f32(modp(c, l, b, 5), lane, gt); ld_row_f32(c.in[I_GPREMIX] + (size_t)ln * D, lane, gpm);
        ld_row_f32(modp(c, ln, b, 1), lane, scm); ld_row_f32(modp(c, ln, b, 0), lane, shm);
        v2u ya[4], yb[4], za[4], zb[4], xa[4], xb[4]; f32x2 wa = {1.f, 0.f}, wb = wa;
#define R2_LOAD(YR, ZR, XR, WR, row_) do { const size_t ro_ = (size_t)(row_) * D; \
            if (moe) { const int rl_ = (row_) - row0; i32x2 d_; d_.x = __builtin_amdgcn_readlane(dl.x, rl_); d_.y = __builtin_amdgcn_readlane(dl.y, rl_); WR.x = rdlane_f(wl.x, rl_); WR.y = rdlane_f(wl.y, rl_); \
                _Pragma("unroll") for (int j = 0; j < 4; ++j) { YR[j] = *(const GAS v2u*)(YS + (size_t)d_.x * D + 4 * lane + 256 * j); ZR[j] = *(const GAS v2u*)(YS + (size_t)d_.y * D + 4 * lane + 256 * j); } } \
            else { _Pragma("unroll") for (int j = 0; j < 4; ++j) { YR[j] = *(const GAS v2u*)(Y2 + ro_ + 4 * lane + 256 * j); ZR[j] = (v2u){0u, 0u}; } } \
            _Pragma("unroll") for (int j = 0; j < 4; ++j) XR[j] = *(const GAS v2u*)(XB + ro_ + 4 * lane + 256 * j); } while (0)
        i32x2 dl = {0, 0}; f32x2 wl = {1.f, 0.f};
        if (moe) { const int rl = row0 + (lane & 15); dl = *(const GAS i32x2*)(TOKD + (size_t)rl * 2); wl = *(const GAS f32x2*)(TOKW + (size_t)rl * 2); }
        R2_LOAD(ya, za, xa, wa, row0);
        for (int r = 0; r < 16; ++r) {
            const int row = row0 + r; const size_t ro = (size_t)row * D;
            if (r + 1 < 16) R2_LOAD(yb, zb, xb, wb, row + 1);
            f32x4 y[4], x[4], h[4];
#pragma unroll
            for (int j = 0; j < 4; ++j) { const f32x4 p = {bflo(ya[j].x), bfhi(ya[j].x), bflo(ya[j].y), bfhi(ya[j].y)}, q = {bflo(za[j].x), bfhi(za[j].x), bflo(za[j].y), bfhi(za[j].y)};
                y[j] = p * wa.x + q * wa.y; x[j] = (f32x4){bflo(xa[j].x), bfhi(xa[j].x), bflo(xa[j].y), bfhi(xa[j].y)}; ya[j] = yb[j]; za[j] = zb[j]; xa[j] = xb[j]; }
            wa = wb;
            const float rr = rsqrtf(row_sumsq(y) * (1.0f / 1024.0f) + EPS);
#pragma unroll
            for (int j = 0; j < 4; ++j) { x[j] = x[j] + gt[j] * (y[j] * rr * gpo[j]); if (!dry && l + 1 == DEPTH) *(GAS f32x4*)(c.out + ro + 4 * lane + 256 * j) = x[j]; }
            if (!dry && l + 1 < DEPTH) st_row_bf16(XB + ro, lane, x);
            if (l + 1 < DEPTH) { norm_mod(x, gpm, scm, shm, h); if (!dry) st_row_bf16(H + ro, lane, h); }
        }
    }
}

constexpr int PH_PER_LAYER = 12, NPH = 2 + DEPTH * PH_PER_LAYER;
__global__ void __launch_bounds__(NTHR, 2) fwd(Ctx c) {
    extern __shared__ __attribute__((aligned(16))) unsigned char lds_raw[];
    LAS unsigned char* lds = (LAS unsigned char*)lds_raw;
    volatile LAS unsigned* MISC = (volatile LAS unsigned*)(lds + MISC_OFF);
    if (threadIdx.x < 64) MISC[threadIdx.x] = 0u;
    __syncthreads();
    const int lo = c.ph_lo, hi = c.ph_hi, G = gridDim.x;
    XcdBarrier bar; bar.bar = (unsigned*)c.ws + CW_BAR; bar.x = 0; bar.st = MISC + 8;
    if (hi - lo > 1) bar = xcd_barrier_post((unsigned*)c.ws + CW_BAR, MISC + 8);
#ifndef PH_MASK
#define PH_MASK 0xFFFF
#endif
#define IN(p) (lo <= (p) && (p) < hi)
#define ON(k) ((PH_MASK >> (k)) & 1)
#ifndef REPMASK
#define REPMASK 0
#endif
#define REP(k) for (int rep_ = 0; rep_ < (((REPMASK >> (k)) & 1) ? opq_s(2) : 1); ++rep_)
#ifndef TPROBE
#define TPROBE -1
#endif
#ifndef TPL
#define TPL -1
#define TPMUL 1
#endif
    int tp_layer = -1;
#ifndef TPB
#define TPB 0
#endif
#define TP_SEL(ty) (TPROBE == (ty) && blockIdx.x == TPB && threadIdx.x == 0 && (TPL < 0 || tp_layer == TPL))
#define TPU_BEGIN() do { if (TP_SEL(20)) MISC[48] = (unsigned)wall_clock64(); } while (0)
#define TPU_END() do { if (TP_SEL(20)) MISC[16] += (unsigned)wall_clock64() - MISC[48]; } while (0)
#define TP_BEGIN(ty) do { if (TP_SEL(ty)) MISC[48] = (unsigned)wall_clock64(); } while (0)
#define BAR_AFTER(p, ty) do { if ((p) + 1 < hi) xcd_barrier(bar); if (TP_SEL(ty)) MISC[16] += (unsigned)wall_clock64() - MISC[48]; } while (0)
    if (ON(12) && IN(0)) { TP_BEGIN(12); ph_mod(c, lds); ph_lb(c); ph_uz(c); REP(14) ph_cvt(c, 0, lds, BID(), (int)gridDim.x, 2); BAR_AFTER(0, 12); }
    if (ON(13) && IN(1)) { TP_BEGIN(13); ph_norm0(c); BAR_AFTER(1, 13); }
    for (int l = 0; l < DEPTH; ++l) {
        const int base = 2 + l * PH_PER_LAYER; const bool moe = (l & 1) != 0; tp_layer = l;
        Ctx cl = c; cl.ws = opq_p(c.ws); cl.out = (float*)opq_p((unsigned char*)c.out);
        unsigned char* ws = cl.ws; bf16* PJ = (bf16*)(ws + WS_PROJ); const int bid = BID();
        int KD = opq_s(D);
        if (ON(0) && IN(base + 0)) { TP_BEGIN(0);
            pg8::Gemm g{(const bf16*)(ws + WS_H), (const bf16*)(ws + WS_WIN), M, DIN, KD}; pg8::UOrder S; S.init(0, M, DIN, G, bid);
            pg8::EpiWin E{PJ, (const float*)(ws + WS_LB) + l * 1024, PSTRIDE};
            REP(0) { pg8::TOrder T; T.build(S, (LAS int*)(lds + UT_OFF)); pg8::gemm_phase<pg8::EpiWin, pg8::TOrder, true, true>(lds, g, T, E); }
            BAR_AFTER(base + 0, 0); }
        if (ON(1) && IN(base + 1)) { TP_BEGIN(1); REP(1) ph_prep(cl, l, lds); BAR_AFTER(base + 1, 1); }
        if (ON(2) && IN(base + 2)) { TP_BEGIN(2); TPU_BEGIN(); REP(2) ph_scans(cl, lds, l); TPU_END(); BAR_AFTER(base + 2, 2); }
        if (ON(4) && IN(base + 4)) { TP_BEGIN(4); REP(4) ph_post(cl, l); BAR_AFTER(base + 4, 4); }
        if (ON(5) && IN(base + 5)) { TP_BEGIN(5);
            pg8::Gemm g{PJ + (size_t)P_QA * PSTRIDE, (const bf16*)(ws + WS_WAB + (size_t)(l & 1) * WAB_STEP), M, D, KD}; pg8::UOrder S; S.init(1, M, D, G, bid);
            pg8::EpiProj E{PJ + (size_t)P_GTA * PSTRIDE, PSTRIDE, PJ + (size_t)P_GA * PSTRIDE, PJ + (size_t)P_VA * PSTRIDE};
            REP(5) { pg8::TOrder T; T.build(S, (LAS int*)(lds + UT_OFF)); pg8::gemm_phase<pg8::EpiProj, pg8::TOrder, true, true>(lds, g, T, E); }
            BAR_AFTER(base + 5, 5); }
        if (ON(6) && IN(base + 6)) { TP_BEGIN(6);
            pg8::Gemm g{PJ + (size_t)P_VA * PSTRIDE, (const bf16*)(ws + WS_WO + (size_t)(l & 1) * WO_STEP), M, D, KD}; pg8::UOrder S; S.init(0, M, D, G, bid);
            pg8::EpiPlain E{PJ + (size_t)P_OS * PSTRIDE, D};
            REP(6) { pg8::TOrder T; T.build(S, (LAS int*)(lds + UT_OFF)); pg8::gemm_phase<pg8::EpiPlain, pg8::TOrder, true, true>(lds, g, T, E); }
            BAR_AFTER(base + 6, 6); }
        if (ON(7) && IN(base + 7)) { TP_BEGIN(7); if ((REPMASK >> 7) & 1) ph_res1<false>(cl, l, lds, opq_s(1)); if (l == 0) ph_res1<true>(cl, l, lds); else ph_res1<false>(cl, l, lds); BAR_AFTER(base + 7, 7); }
        if (ON(8) && IN(base + 8) && moe) { TP_BEGIN(8); ph_gather(cl, l, lds); BAR_AFTER(base + 8, 8); }
        if (ON(9) && IN(base + 9)) { TP_BEGIN(9);
            pg8::Gemm g{(const bf16*)(ws + (moe ? WS_AG : WS_H)), (const bf16*)(ws + (moe ? WS_WFM : WS_WFD)), M, 2 * DFF, KD}; pg8::UOrder S; S.init(0, M, 2 * DFF, G, bid);
            pg8::EpiSwi E{PJ, moe ? DFE : DFF, moe ? 28 : 22};
            if (moe) { moe_tables(cl, l >> 1, lds); S.mode = 2; S.NT = 28; S.tab = (const LAS int*)(lds + TAB_OFF); S.nwg = __builtin_amdgcn_readfirstlane(S.tab[16]) * 28; }
            REP(9) { pg8::TOrder T; T.build(S, (LAS int*)(lds + UT_OFF)); pg8::gemm_phase<pg8::EpiSwi, pg8::TOrder, true, true>(lds, g, T, E); }
            BAR_AFTER(base + 9, 9); }
        if (ON(10) && IN(base + 10)) { TP_BEGIN(10);
            pg8::Gemm g{PJ, (const bf16*)(ws + (moe ? WS_WFM + WF_W2_MOE : WS_WFD + WF_W2_DENSE)), M, D, moe ? DFE : DFF}; pg8::UOrder S; S.init(0, M, D, G, bid);
            pg8::EpiPlain E{moe ? (bf16*)(ws + WS_YS) : PJ + (size_t)4 * PSTRIDE, D};
            if (moe) { moe_tables(cl, l >> 1, lds); S.mode = 2; S.NT = 4; S.tab = (const LAS int*)(lds + TAB_OFF); S.nwg = __builtin_amdgcn_readfirstlane(S.tab[16]) * 4; }
            REP(10) { pg8::TOrder T; T.build(S, (LAS int*)(lds + UT_OFF)); pg8::gemm_phase<pg8::EpiPlain, pg8::TOrder, true, true>(lds, g, T, E); }
            BAR_AFTER(base + 10, 10); }
        if (ON(11) && IN(base + 11)) { TP_BEGIN(11); if ((REPMASK >> 11) & 1) ph_res2(cl, l, opq_s(1)); ph_res2(cl, l);  BAR_AFTER(base + 11, 11); }
    }
    if (TPROBE >= 0) { __syncthreads(); if (blockIdx.x == TPB && threadIdx.x == 0) { const unsigned tt = MISC[16] * (unsigned)TPMUL; const unsigned s0 = (unsigned)wall_clock64(); while ((unsigned)wall_clock64() - s0 < tt) __builtin_amdgcn_s_sleep(8); } }
#undef IN
#undef BAR_AFTER
}

#ifndef MK_ONE_LAUNCH
#define MK_ONE_LAUNCH 1
#endif
extern "C" void kernel_launch(void* const* d_in, const int* in_sizes, int n_in, void* d_out, int out_size, void* d_ws, size_t ws_size, hipStream_t stream) {
    static int grid = 0;
    if (grid == 0) {
        if (n_in != 32 || in_sizes[0] != M * D || out_size != M * D || ws_size < WS_END) { fprintf(stderr, "kernel_launch: unexpected shapes / workspace (%d inputs, ws %zu < %zu)\n", n_in, ws_size, (size_t)WS_END); grid = -1; return; }
        int dev = 0, cus = 0;
        if (hipGetDevice(&dev) != hipSuccess || hipDeviceGetAttribute(&cus, hipDeviceAttributeMultiprocessorCount, dev) != hipSuccess) { grid = -1; return; }
        if (hipFuncSetAttribute((const void*)fwd, hipFuncAttributeMaxDynamicSharedMemorySize, LDS_BYTES) != hipSuccess) { fprintf(stderr, "kernel_launch: hipFuncSetAttribute failed\n"); grid = -1; return; }
        (void)hipGetLastError();
        grid = cus;
    }
    if (grid < 0) return;
    if (hipMemsetAsync((char*)d_ws + WS_CTL, 0, CTL_ZERO_BYTES, stream) != hipSuccess) return;
    Ctx c{};
    for (int i = 0; i < 32; ++i) c.in[i] = (const float*)d_in[i];
    c.out = (float*)d_out; c.ws = (unsigned char*)d_ws;
#if MK_ONE_LAUNCH
    c.ph_lo = 0; c.ph_hi = NPH;
    hipLaunchKernelGGL(fwd, dim3(grid), dim3(NTHR), LDS_BYTES, stream, c);
#else
    for (int p = 0; p < NPH; ++p) {
        if (p >= 2) { const int l = (p - 2) / PH_PER_LAYER, k = (p - 2) % PH_PER_LAYER; if (k == 8 && !(l & 1)) continue; }
        c.ph_lo = p; c.ph_hi = p + 1;
        hipLaunchKernelGGL(fwd, dim3(grid), dim3(NTHR), LDS_BYTES, stream, c);
    }
#endif
}
```
